# Optimizing an MI355X kernel written in HIP

```python
import jax
import jax.numpy as jnp
from jax import lax
import numpy as np

D_MODEL = 2048
BATCH = 4
SEQ = 4096
DEPTH = 4

N_MEM = 256
NORM_EPS = 1e-6

RWKV_HEADS = 16
RWKV_HEAD_DIM = 64
RWKV_WIDTH = RWKV_HEADS * RWKV_HEAD_DIM
DECAY_LORA = 96
ICLR_LORA = 96
VRES_LORA = 64
GATE_LORA = 256
RWKV_GN_EPS = 64e-5

MLA_HEADS = 8
QK_NOPE_DIM = 128
QK_ROPE_DIM = 64
V_HEAD_DIM = 128
Q_LORA_RANK = 512
KV_LORA_RANK = 256
MLA_WIDTH = MLA_HEADS * V_HEAD_DIM
ROPE_THETA = 10000.0
Q_BLOCK = 128

MIX_WIDTH = RWKV_WIDTH + MLA_WIDTH
RWKV_IN = 3 * RWKV_WIDTH + DECAY_LORA + ICLR_LORA + GATE_LORA
MLA_IN = Q_LORA_RANK + KV_LORA_RANK + QK_ROPE_DIM
IN_WIDTH = RWKV_IN + MLA_IN

MEM_HEADS = 4
MEM_HEAD_DIM = 128
MEM_WIDTH = MEM_HEADS * MEM_HEAD_DIM

D_FF = 4 * D_MODEL

kernel_name = 'hybrid_rwkv7_mla_memory_block'


def rms_norm(x, g):
    x32 = x.astype(jnp.float32)
    y = x32 * lax.rsqrt(jnp.mean(jnp.square(x32), axis=-1, keepdims=True) + NORM_EPS)
    return (y * g.astype(jnp.float32)).astype(x.dtype)


def token_shift(y, mu):
    y_prev = jnp.pad(y[:, :-1], ((0, 0), (1, 0), (0, 0)))
    return y + (y_prev - y) * mu


def rope_tables(seq_len):
    pos = jnp.arange(seq_len, dtype=jnp.float32)
    inv_freq = ROPE_THETA ** (-jnp.arange(0, QK_ROPE_DIM, 2, dtype=jnp.float32) / QK_ROPE_DIM)
    ang = pos[:, None] * inv_freq[None, :]
    return jnp.cos(ang), jnp.sin(ang)


def apply_rope(x, cos, sin):
    half = x.shape[-1] // 2
    x1 = x[..., :half].astype(jnp.float32)
    x2 = x[..., half:].astype(jnp.float32)
    return jnp.concatenate([x1 * cos - x2 * sin, x1 * sin + x2 * cos], axis=-1).astype(x.dtype)


def rwkv7_scan(r, decay, k, v, kk, a):
    B, S, H, N = r.shape

    def step(state, inp):
        r_t, w_t, k_t, v_t, kk_t, b_t = inp
        sa = jnp.einsum('bhvk,bhk->bhv', state, -kk_t)
        state = (state * w_t[:, :, None, :]
                 + sa[..., :, None] * b_t[:, :, None, :]
                 + v_t[..., :, None] * k_t[:, :, None, :])
        return state, jnp.einsum('bhvk,bhk->bhv', state, r_t)

    xs = tuple(jnp.moveaxis(t, 1, 0) for t in (r, decay, k, v, kk, kk * a))
    _, out = lax.scan(step, jnp.zeros((B, H, N, N), jnp.float32), xs)
    return jnp.moveaxis(out, 0, 1)


def rwkv7_time_mix(cols, mu, w0, w_up, a0, a_up, g_up, k_k, k_a, r_k, lnx_g, lnx_b,
                   v_first, vres_cols, mu_vres, v0, v_up):
    B, S, _ = cols.shape
    H, N, C = RWKV_HEADS, RWKV_HEAD_DIM, RWKV_WIDTH
    f32 = jnp.float32
    c = token_shift(cols, mu)
    r, k, v, wl, al, gl = jnp.split(
        c, [C, 2 * C, 3 * C, 3 * C + DECAY_LORA, 3 * C + DECAY_LORA + ICLR_LORA], axis=-1)
    log_w = -jax.nn.softplus(-(w0 + jnp.tanh(wl) @ w_up).astype(f32)) - 0.5
    a = jax.nn.sigmoid((a0 + al @ a_up).astype(f32))
    g = jax.nn.sigmoid(gl) @ g_up
    if v_first is None:
        v_first = v
    else:
        vr = token_shift(vres_cols, mu_vres)
        v = v + (v_first - v) * jax.nn.sigmoid(v0 + vr @ v_up)

    def heads(t):
        return t.reshape(B, S, H, N).astype(f32)

    r, k, v, a, log_w = heads(r), heads(k), heads(v), heads(a), heads(log_w)
    kk = k * k_k.reshape(H, N).astype(f32)
    kk = kk * lax.rsqrt(jnp.maximum(jnp.sum(kk * kk, axis=-1, keepdims=True), 1e-24))
    k = k * (1.0 + (a - 1.0) * k_a.reshape(H, N).astype(f32))
    decay = jnp.exp(-jnp.exp(log_w))
    o = rwkv7_scan(r, decay, k, v, kk, a)
    mean = jnp.mean(o, axis=-1, keepdims=True)
    var = jnp.mean(jnp.square(o - mean), axis=-1, keepdims=True)
    o = ((o - mean) * lax.rsqrt(var + RWKV_GN_EPS)).reshape(B, S, C) * lnx_g + lnx_b
    bonus = jnp.sum(r * k * r_k.astype(f32), axis=-1, keepdims=True) * v
    o = o + bonus.reshape(B, S, C)
    return (o * g).astype(cols.dtype), v_first


def causal_block_attention(qn, qr, kn, kr, v):
    S = qn.shape[1]
    scale = (QK_NOPE_DIM + QK_ROPE_DIM) ** -0.5
    outs = []
    for i in range(S // Q_BLOCK):
        q0, q1 = i * Q_BLOCK, (i + 1) * Q_BLOCK
        s = (jnp.einsum('bqhd,bkhd->bhqk', qn[:, q0:q1], kn[:, :q1])
             + jnp.einsum('bqhr,bkr->bhqk', qr[:, q0:q1], kr[:, :q1])).astype(jnp.float32) * scale
        mask = (q0 + jnp.arange(Q_BLOCK))[:, None] >= jnp.arange(q1)[None, :]
        s = jnp.where(mask, s, jnp.finfo(jnp.float32).min)
        p = jax.nn.softmax(s, axis=-1).astype(v.dtype)
        outs.append(jnp.einsum('bhqk,bkhd->bqhd', p, v[:, :q1]))
    return jnp.concatenate(outs, axis=1)


def mla_heads(cols, q_norm_g, w_uq, kv_norm_g, w_ukv, cos, sin):
    B, S, _ = cols.shape
    cq, ckv, kr = jnp.split(cols, [Q_LORA_RANK, Q_LORA_RANK + KV_LORA_RANK], axis=-1)
    q = (rms_norm(cq, q_norm_g) @ w_uq).reshape(B, S, MLA_HEADS, QK_NOPE_DIM + QK_ROPE_DIM)
    kv = (rms_norm(ckv, kv_norm_g) @ w_ukv).reshape(B, S, MLA_HEADS, QK_NOPE_DIM + V_HEAD_DIM)
    qn, qr = q[..., :QK_NOPE_DIM], q[..., QK_NOPE_DIM:]
    kn, v = kv[..., :QK_NOPE_DIM], kv[..., QK_NOPE_DIM:]
    qr = apply_rope(qr, cos[:, None, :], sin[:, None, :])
    kr = apply_rope(kr, cos, sin)
    o = causal_block_attention(qn, qr, kn, kr, v)
    return o.reshape(B, S, MLA_WIDTH)


def memory_cross_attention(u, mem_n, wq, wk, wv, wo):
    B, S, _ = u.shape
    M = mem_n.shape[1]
    q = (u @ wq).reshape(B, S, MEM_HEADS, MEM_HEAD_DIM)
    k = (mem_n @ wk).reshape(B, M, MEM_HEADS, MEM_HEAD_DIM)
    v = (mem_n @ wv).reshape(B, M, MEM_HEADS, MEM_HEAD_DIM)
    s = jnp.einsum('bqhd,bmhd->bhqm', q, k).astype(jnp.float32) * MEM_HEAD_DIM ** -0.5
    p = jax.nn.softmax(s, axis=-1).astype(v.dtype)
    o = jnp.einsum('bhqm,bmhd->bqhd', p, v).reshape(B, S, MEM_WIDTH)
    return o @ wo


def setup_inputs(seed: int = 0) -> dict:
    key = jax.random.key(seed)
    keys = iter(jax.random.split(key, 48))
    f32 = jnp.float32

    def normal(shape, scale):
        return scale * jax.random.normal(next(keys), shape, f32)

    def gain(shape):
        return 1.0 + 0.05 * jax.random.normal(next(keys), shape, f32)

    def uniform(shape, lo, hi):
        return jax.random.uniform(next(keys), shape, f32, lo, hi)

    L, L1, D = DEPTH, DEPTH - 1, D_MODEL
    return {
        'x': normal((BATCH, SEQ, D), 1.0),
        'mem': normal((BATCH, N_MEM, D), 1.0),
        'mem_norm_g': gain((D,)),
        'mix_pre_g': gain((L, D)),
        'w_in': normal((L, D, IN_WIDTH), D ** -0.5),
        'w_in_vres': normal((L1, D, VRES_LORA), D ** -0.5),
        'mu_rwkv': uniform((L, RWKV_IN), 0.0, 1.0),
        'mu_vres': uniform((L1, VRES_LORA), 0.0, 1.0),
        'w0': uniform((L, RWKV_WIDTH), -6.0, -1.0),
        'w_up': normal((L, DECAY_LORA, RWKV_WIDTH), 0.5 * DECAY_LORA ** -0.5),
        'a0': normal((L, RWKV_WIDTH), 0.1),
        'a_up': normal((L, ICLR_LORA, RWKV_WIDTH), ICLR_LORA ** -0.5),
        'v0': 1.0 + normal((L1, RWKV_WIDTH), 0.1),
        'v_up': normal((L1, VRES_LORA, RWKV_WIDTH), VRES_LORA ** -0.5),
        'g_up': normal((L, GATE_LORA, RWKV_WIDTH), GATE_LORA ** -0.5),
        'k_k': 0.85 + normal((L, RWKV_WIDTH), 0.05),
        'k_a': gain((L, RWKV_WIDTH)),
        'r_k': normal((L, RWKV_HEADS, RWKV_HEAD_DIM), 0.1),
        'lnx_g': gain((L, RWKV_WIDTH)),
        'lnx_b': normal((L, RWKV_WIDTH), 0.01),
        'q_norm_g': gain((L, Q_LORA_RANK)),
        'w_uq': normal((L, Q_LORA_RANK, MLA_HEADS * (QK_NOPE_DIM + QK_ROPE_DIM)), Q_LORA_RANK ** -0.5),
        'kv_norm_g': gain((L, KV_LORA_RANK)),
        'w_ukv': normal((L, KV_LORA_RANK, MLA_HEADS * (QK_NOPE_DIM + V_HEAD_DIM)), KV_LORA_RANK ** -0.5),
        'w_out': normal((L, MIX_WIDTH, D), MIX_WIDTH ** -0.5),
        'mix_post_g': gain((L, D)),
        'mem_pre_g': gain((L, D)),
        'wq_mem': normal((L, D, MEM_WIDTH), D ** -0.5),
        'wk_mem': normal((L, D, MEM_WIDTH), D ** -0.5),
        'wv_mem': normal((L, D, MEM_WIDTH), D ** -0.5),
        'wo_mem': normal((L, MEM_WIDTH, D), MEM_WIDTH ** -0.5),
        'mem_post_g': gain((L, D)),
        'ffn_pre_g': gain((L, D)),
        'w_ff1': normal((L, D, D_FF), D ** -0.5),
        'w_ff2': normal((L, D_FF, D), D_FF ** -0.5),
        'ffn_post_g': gain((L, D)),
    }


def reference(x, mem, mem_norm_g, mix_pre_g, w_in, w_in_vres, mu_rwkv, mu_vres, w0, w_up, a0, a_up,
              v0, v_up, g_up, k_k, k_a, r_k, lnx_g, lnx_b, q_norm_g, w_uq, kv_norm_g, w_ukv, w_out,
              mix_post_g, mem_pre_g, wq_mem, wk_mem, wv_mem, wo_mem, mem_post_g, ffn_pre_g, w_ff1,
              w_ff2, ffn_post_g):
    cos, sin = rope_tables(x.shape[1])
    mem_n = rms_norm(mem, mem_norm_g)
    h = x
    v_first = None
    for l in range(DEPTH):
        u = rms_norm(h, mix_pre_g[l])
        if l == 0:
            proj = u @ w_in[0]
            vres_cols, mu_v, v0_l, v_up_l = None, None, None, None
        else:
            proj = u @ jnp.concatenate([w_in[l], w_in_vres[l - 1]], axis=1)
            vres_cols, mu_v, v0_l, v_up_l = proj[..., IN_WIDTH:], mu_vres[l - 1], v0[l - 1], v_up[l - 1]
        y_rwkv, v_first = rwkv7_time_mix(
            proj[..., :RWKV_IN], mu_rwkv[l], w0[l], w_up[l], a0[l], a_up[l], g_up[l], k_k[l], k_a[l],
            r_k[l], lnx_g[l], lnx_b[l], v_first, vres_cols, mu_v, v0_l, v_up_l)
        y_mla = mla_heads(proj[..., RWKV_IN:IN_WIDTH], q_norm_g[l], w_uq[l], kv_norm_g[l], w_ukv[l], cos, sin)
        y = jnp.concatenate([y_rwkv, y_mla], axis=-1) @ w_out[l]
        h = h + rms_norm(y, mix_post_g[l])
        u = rms_norm(h, mem_pre_g[l])
        y = memory_cross_attention(u, mem_n, wq_mem[l], wk_mem[l], wv_mem[l], wo_mem[l])
        h = h + rms_norm(y, mem_post_g[l])
        u = rms_norm(h, ffn_pre_g[l])
        y = jnp.square(jax.nn.relu(u @ w_ff1[l])) @ w_ff2[l]
        h = h + rms_norm(y, ffn_post_g[l])
    return h
```

```cpp
#include <hip/hip_runtime.h>
#include <cstdio>
#include <cstdint>

#define GAS __attribute__((address_space(1)))
#define LAS __attribute__((address_space(3)))
typedef unsigned short bf16;
typedef short bf16x8 __attribute__((ext_vector_type(8)));
typedef short s16x4 __attribute__((ext_vector_type(4)));
typedef float f32x2 __attribute__((ext_vector_type(2)));
typedef float f32x4 __attribute__((ext_vector_type(4)));
typedef float f32x16 __attribute__((ext_vector_type(16)));
typedef unsigned u32x2 __attribute__((ext_vector_type(2)));
typedef unsigned u32x4 __attribute__((ext_vector_type(4)));
typedef __bf16 bf16x2_t __attribute__((ext_vector_type(2)));

#ifndef ONE_LAUNCH
#define ONE_LAUNCH 1
#endif
#ifndef STOP_PHASE
#define STOP_PHASE 1000
#endif

constexpr int T = 16384, SEQ = 4096, NB = 4, D = 2048, NL = 4, FF = 8192;
constexpr int RIN = 3520, INW = 4352, PROJ_LD = 4608;
constexpr int NMEM = 256;
constexpr float NORM_EPS = 1e-6f, GN_EPS = 64e-5f;
constexpr float QSCALE_MLA = 0.07216878364870323f * 1.4426950408889634f;
constexpr float QSCALE_MEM = 0.08838834764831845f * 1.4426950408889634f;
constexpr int NWAVES = 8, NTHR = 512;
constexpr int NPH = 16, NPHASES = 1 + NL * NPH;

enum { I_X = 0, I_MEM, I_MEMG, I_MIXPRE, I_WIN, I_WINV, I_MU, I_MUV, I_W0, I_WUP, I_A0, I_AUP, I_V0, I_VUP, I_GUP, I_KK, I_KA, I_RK, I_LNG, I_LNB,
       I_QNG, I_WUQ, I_KVNG, I_WUKV, I_WOUT, I_MIXPOST, I_MEMPRE, I_WQM, I_WKM, I_WVM, I_WOM, I_MEMPOST, I_FFNPRE, I_FF1, I_FF2, I_FFNPOST, N_IN };

constexpr size_t KiB = 1024, MiB = 1024 * 1024;
constexpr size_t WS_CTL = 0, CTL_BYTES = 1 * MiB;
constexpr size_t WS_COS = 1 * MiB, WS_SIN = 1 * MiB + 512 * KiB;
constexpr size_t WS_MEMN = 2 * MiB, WS_MEMK = 6 * MiB, WS_MEMV = 7 * MiB, WS_RKB = 8 * MiB;
constexpr size_t WS_W = 16 * MiB, W_LSTRIDE = 38 * MiB;
constexpr size_t WS_WFF = 92 * MiB;
constexpr size_t WS_HB = 156 * MiB;
constexpr size_t WS_SCAN = 220 * MiB;
constexpr size_t WO_IN = 0, WO_UP = 18 * MiB, WO_AUP = 18 * MiB + 256 * KiB, WO_GUP = 18 * MiB + 512 * KiB, WO_VUP = 19 * MiB, WO_UQ = 19 * MiB + 512 * KiB,
                 WO_UKV = 21 * MiB, WO_OUT = 22 * MiB, WO_QM = 30 * MiB, WO_KM = 32 * MiB, WO_VM = 34 * MiB, WO_OM = 36 * MiB, WO_FF1 = 38 * MiB, WO_FF2 = 70 * MiB;
constexpr size_t WS_U = 424 * MiB, WS_Y = 488 * MiB, WS_VF = 552 * MiB;
constexpr size_t WS_PROJ = 584 * MiB, WS_LORA = 728 * MiB, WS_WLOG = 748 * MiB, WS_AIC = 780 * MiB, WS_GATE = 812 * MiB, WS_VV = 844 * MiB,
                 WS_CQN = 876 * MiB, WS_CKVN = 892 * MiB, WS_KR = 900 * MiB, WS_QB = 902 * MiB, WS_KV = 950 * MiB, WS_END = 1014 * MiB;
constexpr size_t WS_HID = 584 * MiB, WS_QMEM = 840 * MiB, WS_OMEM = 856 * MiB;
constexpr int LORA_LD = 640;
constexpr int CW_TMO = 0, CW_BAR = 4096;

constexpr int RING_BYTES = 163328, LDSCTL_OFF = RING_BYTES, MISC_OFF = LDSCTL_OFF + 320, LDS_BYTES = 163840;

__device__ __forceinline__ unsigned cvt_pk(float lo, float hi) { f32x2 v = {lo, hi}; bf16x2_t b = __builtin_convertvector(v, bf16x2_t); return __builtin_bit_cast(unsigned, b); }
__device__ __forceinline__ float bflo(unsigned w) { return __uint_as_float(w << 16); }
__device__ __forceinline__ float bfhi(unsigned w) { return __uint_as_float(w & 0xffff0000u); }
__device__ __forceinline__ float bf1(bf16 b) { return __uint_as_float((unsigned)b << 16); }
__device__ __forceinline__ bf16 f2bf(float f) { return (bf16)(cvt_pk(f, 0.f) & 0xffffu); }
template <int CTRL> __device__ __forceinline__ float dpp_add(float x) { return x + __int_as_float(__builtin_amdgcn_update_dpp(0, __float_as_int(x), CTRL, 0xf, 0xf, true)); }
__device__ __forceinline__ float sum4(float x) { x = dpp_add<0xB1>(x); x = dpp_add<0x4E>(x); return x; }
__device__ __forceinline__ float sum8(float x) { x = sum4(x); x = dpp_add<0x141>(x); return x; }
__device__ __forceinline__ float sum16(float x) { x = sum8(x); x = dpp_add<0x140>(x); return x; }
__device__ __forceinline__ float wave_sum(float x) {
    x = sum16(x);
    { auto r = __builtin_amdgcn_permlane16_swap(__float_as_uint(x), __float_as_uint(x), false, false); x = __uint_as_float(r[0]) + __uint_as_float(r[1]); }
    { auto r = __builtin_amdgcn_permlane32_swap(__float_as_uint(x), __float_as_uint(x), false, false); x = __uint_as_float(r[0]) + __uint_as_float(r[1]); }
    return x;
}
__device__ __forceinline__ float sigmoidf_(float x) { return __builtin_amdgcn_rcpf(1.f + __builtin_amdgcn_exp2f(-1.4426950408889634f * x)); }
__device__ __forceinline__ float tanhf_(float x) { const float e = __builtin_amdgcn_exp2f(-2.f * 1.4426950408889634f * fabsf(x)); const float t = (1.f - e) * __builtin_amdgcn_rcpf(1.f + e); return x < 0.f ? -t : t; }
__device__ __forceinline__ void unpack8(u32x4 w, float (&f)[8]) {
    f[0] = bflo(w.x); f[1] = bfhi(w.x); f[2] = bflo(w.y); f[3] = bfhi(w.y); f[4] = bflo(w.z); f[5] = bfhi(w.z); f[6] = bflo(w.w); f[7] = bfhi(w.w);
}
__device__ __forceinline__ u32x4 pack8(const float (&f)[8]) { u32x4 w; w.x = cvt_pk(f[0], f[1]); w.y = cvt_pk(f[2], f[3]); w.z = cvt_pk(f[4], f[5]); w.w = cvt_pk(f[6], f[7]); return w; }

__device__ __forceinline__ int crow(int r, int hi) { return (r & 3) + 8 * (r >> 2) + 4 * hi; }
typedef short v4i16_t __attribute__((ext_vector_type(4)));

namespace pg8 {
#define PG8_LAS __attribute__((address_space(3)))
typedef unsigned short bf16_t;
constexpr int BM = 256, BK = 64, HALF = 128, HTB = HALF * BK * 2, STAGE_BYTES = 8 * HTB, NXCD = 8, WGM = 4;
__host__ __device__ __forceinline__ int lds_byte(int r, int c) { const int st = (r >> 4) * 2 + (c >> 5), rr = r & 15, cc = c & 31, ob = rr * 64 + cc * 2; return st * 1024 + (ob ^ (((ob >> 9) & 1) << 5)); }
__host__ __device__ __forceinline__ void stage_rc(int b, int& R, int& C) { const int st = b / 1024, sb = b % 1024, swz = sb ^ (((sb >> 9) & 1) << 5); R = (st >> 1) * 16 + swz / 64; C = (st & 1) * 32 + (swz % 64) / 2; }
__host__ __device__ __forceinline__ int perm32(int rho) { const int n = rho >> 4, i = rho & 15; return 8 * (i >> 2) + 4 * n + (i & 3); }
struct Unit { int pm, pn; };
struct Gemm { const bf16_t* A; const bf16_t* Bt; int M, N, K, lda, ldb; };
struct StaticOrder {
    int nM, nN, nwg, G, c;
    __host__ __device__ void init(int M, int N, int G_, int c_) { nM = M / BM; nN = N / BM; nwg = nM * nN; G = G_; c = c_; }
    __host__ __device__ bool next(int i, Unit& u) const {
        const long L = (long)i * G + c; if (L >= nwg) return false;
        int wgid = (int)L; { const int q = nwg / NXCD, r = nwg % NXCD, xcd = wgid % NXCD, off = wgid / NXCD; wgid = (xcd < r ? xcd * (q + 1) : r * (q + 1) + (xcd - r) * q) + off; }
        const int nig = WGM * nN, gid = wgid / nig, fm = gid * WGM, gsz = (nM - fm) < WGM ? (nM - fm) : WGM;
        u.pm = fm + ((wgid % nig) % gsz); u.pn = (wgid % nig) / gsz; return true;
    }
};
template <class F> struct Epi8 {
    F f;
    __device__ __forceinline__ void operator()(const f32x4 (&acc)[2][2][4][2], const Unit& u, int wr, int wc, int fr, int fq) const {
        const int row0 = u.pm * BM + wr * 64 + fr, col0 = u.pn * BM + wc * 32 + 8 * fq;
#pragma unroll
        for (int ai = 0; ai < 2; ++ai)
#pragma unroll
            for (int m = 0; m < 4; ++m)
#pragma unroll
                for (int bj = 0; bj < 2; ++bj) { f(row0 + ai * HALF + m * 16, col0 + bj * HALF, acc[ai][bj][m][0], acc[ai][bj][m][1]); if (F::HEAVY) __builtin_amdgcn_sched_barrier(0); }
    }
};

template <class Epi>
__device__ __forceinline__ void gemm_phase(PG8_LAS unsigned char* lds, const Gemm g, const StaticOrder& S, const Epi& E) {
    int tid = threadIdx.x; asm volatile("" : "+v"(tid));
    const int wid = __builtin_amdgcn_readfirstlane(tid >> 6), lane = tid & 63, wr = wid >> 2, wc = wid & 3, fr = lane & 15, fq = lane >> 4;
    int K = g.K; asm volatile("" : "+s"(K));
    const int nt = K / BK;
    unsigned voffA[2], voffB[2];
#pragma unroll
    for (int i = 0; i < 2; ++i) { int R, C; stage_rc(tid * 16 + i * 8192, R, C); const int Rb = (R & ~31) + perm32(R & 31);
        voffA[i] = (unsigned)(R * g.lda + C) * 2u; voffB[i] = (unsigned)(Rb * g.ldb + C) * 2u; }
    const size_t kstep = (size_t)(BK * 2);
    const size_t hsA = (size_t)HALF * g.lda * 2, hsB = (size_t)HALF * g.ldb * 2;
    const size_t tsA = 2 * hsA, tsB = 2 * hsB;
    const unsigned ldsw = (unsigned)wid * 1024u;
    const int aoff = lds_byte(wr * 64 + fr, fq * 8), boff = lds_byte(wc * 32 + fr, fq * 8);
#define PG8_SA(b, h) (((b) * 2 + (h)) * HTB)
#define PG8_SB(b, h) ((4 + (b) * 2 + (h)) * HTB)
#define PG8_STAGE(bufoff, gbase, voff) do { _Pragma("unroll") for (int _i = 0; _i < 2; ++_i) \
        __builtin_amdgcn_global_load_lds((const unsigned*)((const char*)(gbase) + (voff)[_i]), (PG8_LAS unsigned*)(lds + (bufoff) + ldsw + _i * 8192), 16, 0, 0); } while (0)
#define PG8_LDA(dst, b, h) do { _Pragma("unroll") for (int m = 0; m < 4; ++m) _Pragma("unroll") for (int k = 0; k < 2; ++k) dst[m][k] = *(const PG8_LAS bf16x8*)(lds + PG8_SA(b, h) + aoff + m * 2048 + k * 1024); } while (0)
#define PG8_LDB(dst, b, h) do { _Pragma("unroll") for (int n = 0; n < 2; ++n) _Pragma("unroll") for (int k = 0; k < 2; ++k) dst[n][k] = *(const PG8_LAS bf16x8*)(lds + PG8_SB(b, h) + boff + n * 2048 + k * 1024); } while (0)
#define PG8_MMA(ai, bj, At, Bt) do { __builtin_amdgcn_s_setprio(1); _Pragma("unroll") for (int m = 0; m < 4; ++m) _Pragma("unroll") for (int n = 0; n < 2; ++n) _Pragma("unroll") for (int k = 0; k < 2; ++k) \
        acc[ai][bj][m][n] = __builtin_amdgcn_mfma_f32_16x16x32_bf16(Bt[n][k], At[m][k], acc[ai][bj][m][n], 0, 0, 0); __builtin_amdgcn_s_setprio(0); } while (0)
#define PG8_WAIT_V(n) asm volatile("s_waitcnt vmcnt(" #n ")" ::: "memory")
#define PG8_WAIT_L(n) asm volatile("s_waitcnt lgkmcnt(" #n ")" ::: "memory")
#define PG8_BAR __builtin_amdgcn_s_barrier()
#define PG8_SCHED __builtin_amdgcn_sched_barrier(0)
    Unit cur, nxt; int ui = 0;
    if (!S.next(0, cur)) return;
    f32x4 acc[2][2][4][2];
#pragma unroll
    for (int a = 0; a < 2; ++a)
#pragma unroll
        for (int b = 0; b < 2; ++b)
#pragma unroll
            for (int m = 0; m < 4; ++m)
#pragma unroll
                for (int n = 0; n < 2; ++n) acc[a][b][m][n] = (f32x4){0.f, 0.f, 0.f, 0.f};
    bf16x8 At[4][2], B0[2][2], B1[2][2];
    const char* cA = (const char*)g.A + (size_t)cur.pm * tsA; const char* cB = (const char*)g.Bt + (size_t)cur.pn * tsB;
    PG8_STAGE(PG8_SB(0, 0), cB, voffB); PG8_STAGE(PG8_SB(0, 1), cB + hsB, voffB); PG8_STAGE(PG8_SA(0, 0), cA, voffA); PG8_STAGE(PG8_SA(0, 1), cA + hsA, voffA);
    if (wr == 1) PG8_BAR;
    PG8_WAIT_V(2); PG8_BAR;
    PG8_STAGE(PG8_SB(1, 0), cB + kstep, voffB); PG8_STAGE(PG8_SA(1, 0), cA + kstep, voffA); PG8_STAGE(PG8_SB(1, 1), cB + hsB + kstep, voffB);
    PG8_WAIT_V(6); PG8_BAR;
    for (;;) {
        const bool has_next = S.next(ui + 1, nxt);
        const char* nA = has_next ? (const char*)g.A + (size_t)nxt.pm * tsA : cA; const char* nB = has_next ? (const char*)g.Bt + (size_t)nxt.pn * tsB : cB;
        for (int t = 0; t < nt; t += 2) {
            const bool last = (t == nt - 2);
            const char* a1 = cA + (size_t)(t + 1) * kstep;
            const char* a2 = last ? nA : cA + (size_t)(t + 2) * kstep; const char* b2 = last ? nB : cB + (size_t)(t + 2) * kstep;
            const char* a3 = a2 + kstep; const char* b3 = b2 + kstep;
            PG8_LDB(B0, 0, 0); PG8_LDB(B1, 0, 1); PG8_SCHED; PG8_LDA(At, 0, 0); PG8_STAGE(PG8_SA(1, 1), a1 + hsA, voffA);
            PG8_WAIT_V(8); PG8_WAIT_L(0); PG8_BAR; PG8_MMA(0, 0, At, B0); PG8_MMA(0, 1, At, B1); PG8_BAR; PG8_SCHED;
            PG8_LDA(At, 0, 1); PG8_STAGE(PG8_SB(0, 0), b2, voffB); PG8_STAGE(PG8_SB(0, 1), b2 + hsB, voffB); PG8_STAGE(PG8_SA(0, 0), a2, voffA);
            PG8_WAIT_V(8); PG8_WAIT_L(0); PG8_BAR; PG8_MMA(1, 0, At, B0); PG8_MMA(1, 1, At, B1); PG8_BAR; PG8_SCHED;
            PG8_LDB(B0, 1, 0); PG8_LDB(B1, 1, 1); PG8_SCHED; PG8_LDA(At, 1, 0); PG8_STAGE(PG8_SA(0, 1), a2 + hsA, voffA);
            PG8_WAIT_V(8); PG8_WAIT_L(0); PG8_BAR; PG8_MMA(0, 0, At, B0); PG8_MMA(0, 1, At, B1); PG8_BAR; PG8_SCHED;
            PG8_LDA(At, 1, 1); PG8_STAGE(PG8_SB(1, 0), b3, voffB); PG8_STAGE(PG8_SB(1, 1), b3 + hsB, voffB); PG8_STAGE(PG8_SA(1, 0), a3, voffA);
            PG8_WAIT_V(8); PG8_WAIT_L(0); PG8_BAR; PG8_MMA(1, 0, At, B0); PG8_MMA(1, 1, At, B1); PG8_BAR; PG8_SCHED;
        }
        if (wr == 0) PG8_BAR;
        E(acc, cur, wr, wc, fr, fq);
        if (!has_next) break;
#pragma unroll
        for (int a = 0; a < 2; ++a)
#pragma unroll
            for (int b = 0; b < 2; ++b)
#pragma unroll
                for (int m = 0; m < 4; ++m)
#pragma unroll
                    for (int n = 0; n < 2; ++n) acc[a][b][m][n] = (f32x4){0.f, 0.f, 0.f, 0.f};
        cur = nxt; cA = nA; cB = nB; ++ui;
        if (wr == 1) PG8_BAR;
    }
    PG8_WAIT_V(0);
    PG8_BAR;
#undef PG8_SA
#undef PG8_SB
#undef PG8_STAGE
#undef PG8_LDA
#undef PG8_LDB
#undef PG8_MMA
#undef PG8_WAIT_V
#undef PG8_WAIT_L
#undef PG8_BAR
#undef PG8_SCHED
}
}

__device__ __forceinline__ void st16_wt(void* p, u32x4 w) { asm volatile("global_store_dwordx4 %0, %1, off sc1\n\ts_nop 1" :: "v"(p), "v"(w) : "memory"); }
struct FPlain { static constexpr bool HEAVY = false; bf16* O; int ld; float sc;
    __device__ __forceinline__ void operator()(int row, int col, f32x4 a, f32x4 b) const {
        u32x4 w; w.x = cvt_pk(a[0] * sc, a[1] * sc); w.y = cvt_pk(a[2] * sc, a[3] * sc); w.z = cvt_pk(b[0] * sc, b[1] * sc); w.w = cvt_pk(b[2] * sc, b[3] * sc);
        st16_wt(O + (size_t)row * ld + col, w); } };
struct FRelu2 { static constexpr bool HEAVY = false; bf16* O; int ld;
    __device__ __forceinline__ void operator()(int row, int col, f32x4 a, f32x4 b) const {
        float v[8] = {a[0], a[1], a[2], a[3], b[0], b[1], b[2], b[3]};
#pragma unroll
        for (int i = 0; i < 8; ++i) { const float r = fmaxf(v[i], 0.f); v[i] = r * r; }
        st16_wt(O + (size_t)row * ld + col, pack8(v)); } };
template <int MODE> struct FSig { static constexpr bool HEAVY = true; bf16* O; int ld; const float* bias;
    __device__ __forceinline__ void operator()(int row, int col, f32x4 a, f32x4 b) const {
        const f32x4 b0 = *(const f32x4*)(bias + col), b1 = *(const f32x4*)(bias + col + 4);
        float v[8] = {a[0] + b0[0], a[1] + b0[1], a[2] + b0[2], a[3] + b0[3], b[0] + b1[0], b[1] + b1[1], b[2] + b1[2], b[3] + b1[3]};
#pragma unroll
        for (int i = 0; i < 8; ++i) { const float s = sigmoidf_(v[i]); v[i] = MODE == 0 ? -0.6065306597126334f * s : s; }
        *(u32x4*)(O + (size_t)row * ld + col) = pack8(v); } };
struct FVup { static constexpr bool HEAVY = true; bf16* O; const float* v0; const float* mu; const bf16* proj; const bf16* vfirst;
    __device__ __forceinline__ void operator()(int row, int col, f32x4 a, f32x4 b) const {
        const f32x4 b0 = *(const f32x4*)(v0 + col), b1 = *(const f32x4*)(v0 + col + 4), m0 = *(const f32x4*)(mu + col), m1 = *(const f32x4*)(mu + col + 4);
        float cur[8], prv[8], vf[8];
        unpack8(*(const u32x4*)(proj + (size_t)row * PROJ_LD + 2048 + col), cur);
        if ((row & (SEQ - 1)) != 0) unpack8(*(const u32x4*)(proj + (size_t)(row - 1) * PROJ_LD + 2048 + col), prv);
        else {
#pragma unroll
            for (int i = 0; i < 8; ++i) prv[i] = 0.f; }
        unpack8(*(const u32x4*)(vfirst + (size_t)row * 1024 + col), vf);
        const float acc8[8] = {a[0] + b0[0], a[1] + b0[1], a[2] + b0[2], a[3] + b0[3], b[0] + b1[0], b[1] + b1[1], b[2] + b1[2], b[3] + b1[3]};
        const float mu8[8] = {m0[0], m0[1], m0[2], m0[3], m1[0], m1[1], m1[2], m1[3]};
        float v[8];
#pragma unroll
        for (int i = 0; i < 8; ++i) { const float vs = cur[i] + (prv[i] - cur[i]) * mu8[i]; v[i] = vs + (vf[i] - vs) * sigmoidf_(acc8[i]); }
        *(u32x4*)(O + (size_t)row * 1024 + col) = pack8(v); } };
struct FQ { static constexpr bool HEAVY = true; bf16* O; const float* cosT; const float* sinT;
    __device__ __forceinline__ void operator()(int row, int col, f32x4 a, f32x4 b) const {
        const int cc = col % 192;
        float v[8] = {a[0], a[1], a[2], a[3], b[0], b[1], b[2], b[3]};
        if (cc >= 128) { const int i0 = (cc - 128) >> 1, pos = row & (SEQ - 1);
            const f32x4 c = *(const f32x4*)(cosT + pos * 32 + i0), s = *(const f32x4*)(sinT + pos * 32 + i0);
#pragma unroll
            for (int i = 0; i < 4; ++i) { const float x1 = v[2 * i], x2 = v[2 * i + 1]; v[2 * i] = x1 * c[i] - x2 * s[i]; v[2 * i + 1] = x1 * s[i] + x2 * c[i]; } }
#pragma unroll
        for (int i = 0; i < 8; ++i) v[i] *= QSCALE_MLA;
        *(u32x4*)(O + (size_t)row * 1536 + col) = pack8(v); } };

#define XB_TMO      128
#define XB_XCNT(j)  (256  + 64 * (j))
#define XB_XSUB(j)  (1280 + 64 * (j))
#define XB_XGEN(j)  (2304 + 64 * (j))
#define XB_TOP      3328
#define XB_TOPGEN   3392
#define XCD_BAR_WORDS 3456
#define XB_SPIN_CAP (1u << 20)
__device__ __forceinline__ unsigned xb_ld(unsigned* p)              { return __hip_atomic_load(p, __ATOMIC_RELAXED, __HIP_MEMORY_SCOPE_AGENT); }
__device__ __forceinline__ unsigned xb_add(unsigned* p, unsigned v) { return __hip_atomic_fetch_add(p, v, __ATOMIC_RELAXED, __HIP_MEMORY_SCOPE_AGENT); }
__device__ __forceinline__ unsigned xb_xcc_id() { return (unsigned)__builtin_amdgcn_s_getreg((3 << 11) | 20) & 0xFu; }
#define XB_SPIN(cond, bar) do { unsigned _sp = 0; while (cond) { __builtin_amdgcn_s_sleep(1); \
    if ((++_sp & 255u) == 0u) { if (xb_ld(&(bar)[XB_TMO])) break; if (_sp > XB_SPIN_CAP) { atomicAdd(&(bar)[XB_TMO], 1u); break; } } } } while (0)
struct XcdBarrier { unsigned* bar; unsigned x; volatile LAS unsigned* st; };
__device__ __forceinline__ XcdBarrier xcd_barrier_post(unsigned* bar, volatile LAS unsigned* st) {
    XcdBarrier b; b.bar = bar; b.x = xb_xcc_id(); b.st = st;
    if (threadIdx.x == 0) (void)xb_add(&bar[XB_XCNT(b.x)], 1u);
    return b;
}
__device__ __forceinline__ void xcd_barrier_complete(unsigned* bar, unsigned x, unsigned& nloc, unsigned& nx) {
    const unsigned G = gridDim.x * gridDim.y * gridDim.z;
    unsigned sum, cnt, mine, sp = 0u;
    for (;;) {
        sum = 0u; cnt = 0u; mine = 0u;
#pragma unroll
        for (unsigned j = 0; j < 16; ++j) { const unsigned c = xb_ld(&bar[XB_XCNT(j)]); sum += c; cnt += (c > 0u) ? 1u : 0u; mine = (j == x) ? c : mine; }
        if (sum == G) break;
        __builtin_amdgcn_s_sleep(1);
        if ((++sp & 255u) == 0u) { if (xb_ld(&bar[XB_TMO])) break; if (sp > XB_SPIN_CAP) { atomicAdd(&bar[XB_TMO], 1u); break; } }
    }
    nloc = mine > 0u ? mine : 1u; nx = cnt > 0u ? cnt : 1u;
}
__device__ __forceinline__ void xcd_barrier(const XcdBarrier& b) {
    asm volatile("s_waitcnt vmcnt(0)" ::: "memory");
    __syncthreads();
    if (threadIdx.x == 0) {
        unsigned* bar = b.bar;
        __builtin_amdgcn_s_waitcnt(0);
        unsigned nloc = b.st[0], nx = b.st[1];
        if (nloc == 0u) { xcd_barrier_complete(bar, b.x, nloc, nx); b.st[0] = nloc; b.st[1] = nx; }
        const unsigned old = xb_add(&bar[XB_XSUB(b.x)], 1u);
        const unsigned gen = old / nloc;
        if (old + 1u == (gen + 1u) * nloc) {
            __builtin_amdgcn_fence(__ATOMIC_RELEASE, "agent");
            asm volatile("s_waitcnt vmcnt(0)" ::: "memory");
            const unsigned og = xb_add(&bar[XB_TOP], 1u);
            const unsigned tg = og / nx;
            if (og + 1u == (tg + 1u) * nx) xb_add(&bar[XB_TOPGEN], 1u);
            else XB_SPIN(xb_ld(&bar[XB_TOPGEN]) == tg, bar);
            __builtin_amdgcn_fence(__ATOMIC_ACQUIRE, "agent");
            xb_add(&bar[XB_XGEN(b.x)], 1u);
            asm volatile("s_waitcnt vmcnt(0)" ::: "memory");
        } else {
            XB_SPIN(xb_ld(&bar[XB_XGEN(b.x)]) == gen, bar);
            __builtin_amdgcn_fence(__ATOMIC_ACQUIRE, "agent");
            asm volatile("s_waitcnt vmcnt(0)" ::: "memory");
        }
    }
    __syncthreads();
}

struct Args { const float* in[N_IN]; float* out; unsigned char* ws; int lo, hi; };
typedef const __attribute__((address_space(4))) Args* ArgsP;
struct Frame {
    LAS unsigned char* lds;
    int tid, lane, wave, vcu, G, bx;
    unsigned char* ws;
    float* H;
};
#define WSP(type, off) ((type*)(F.ws + (off)))
#define WL(off) ((off) >= WO_FF1 ? WS_WFF + ((off) - WO_FF1) : WS_W + (size_t)(l & 1) * W_LSTRIDE + (off))

__constant__ int JK[11] = {2048, 2048, 256, 256, 2048, 2048, 2048, 2048, 512, 2048, 8192};
__constant__ int JN[11] = {4352, 64, 1024, 2048, 2048, 512, 512, 512, 2048, 8192, 2048};
__constant__ int JIN[11] = {I_WIN, I_WINV, I_GUP, I_WUKV, I_WOUT, I_WQM, I_WKM, I_WVM, I_WOM, I_FF1, I_FF2};
__constant__ unsigned JDST[11] = {(unsigned)(WO_IN / KiB), (unsigned)(WO_IN / KiB), (unsigned)(WO_GUP / KiB), (unsigned)(WO_UKV / KiB), (unsigned)(WO_OUT / KiB), (unsigned)(WO_QM / KiB),
                                  (unsigned)(WO_KM / KiB), (unsigned)(WO_VM / KiB), (unsigned)(WO_OM / KiB), (unsigned)(WO_FF1 / KiB), (unsigned)(WO_FF2 / KiB)};
__device__ __forceinline__ void p0_transpose_item(const float* W, int K, int N, bf16* WT, int ldk, int row_off, LAS float* scr, int item, int lane) {
    const int nblk = N / 32, kb = item / nblk, nb = item % nblk, k0 = 64 * kb, n0 = 32 * nb;
#pragma unroll 8
    for (int i = 0; i < 32; ++i) { const int kk = 2 * i + (lane >> 5); scr[kk * 33 + (lane & 31)] = W[(size_t)(k0 + kk) * N + n0 + (lane & 31)]; }
    asm volatile("s_waitcnt lgkmcnt(0)" ::: "memory");
    const int c = lane & 7;
#pragma unroll
    for (int j = 0; j < 4; ++j) { const int n = (lane >> 3) + 8 * j; const LAS float* s = scr + (8 * c) * 33 + n;
        u32x4 o; o.x = cvt_pk(s[0 * 33], s[1 * 33]); o.y = cvt_pk(s[2 * 33], s[3 * 33]); o.z = cvt_pk(s[4 * 33], s[5 * 33]); o.w = cvt_pk(s[6 * 33], s[7 * 33]);
        *(u32x4*)(WT + (size_t)(row_off + n0 + n) * ldk + k0 + 8 * c) = o; }
    asm volatile("s_waitcnt lgkmcnt(0)" ::: "memory");
}
__device__ __forceinline__ void rms_row_2048(const float* xrow, const float* g, bf16* orow, bf16* copy, int lane) {
    f32x4 v[8]; float ss = 0.f;
#pragma unroll
    for (int j = 0; j < 4; ++j) { v[2 * j] = *(const f32x4*)(xrow + lane * 8 + 512 * j); v[2 * j + 1] = *(const f32x4*)(xrow + lane * 8 + 512 * j + 4); }
#pragma unroll
    for (int j = 0; j < 8; ++j) ss += (v[j][0] * v[j][0] + v[j][1] * v[j][1]) + (v[j][2] * v[j][2] + v[j][3] * v[j][3]);
    const float rstd = rsqrtf(wave_sum(ss) * (1.f / 2048.f) + NORM_EPS);
#pragma unroll
    for (int j = 0; j < 4; ++j) { const int c = lane * 8 + 512 * j;
        if (copy) { u32x4 w; w.x = cvt_pk(v[2 * j][0], v[2 * j][1]); w.y = cvt_pk(v[2 * j][2], v[2 * j][3]); w.z = cvt_pk(v[2 * j + 1][0], v[2 * j + 1][1]); w.w = cvt_pk(v[2 * j + 1][2], v[2 * j + 1][3]); *(u32x4*)(copy + c) = w; }
        const f32x4 g0 = *(const f32x4*)(g + c), g1 = *(const f32x4*)(g + c + 4); const f32x4 a = v[2 * j] * rstd * g0, b = v[2 * j + 1] * rstd * g1;
        u32x4 w; w.x = cvt_pk(a[0], a[1]); w.y = cvt_pk(a[2], a[3]); w.z = cvt_pk(b[0], b[1]); w.w = cvt_pk(b[2], b[3]);
        *(u32x4*)(orow + c) = w; }
}
__device__ __forceinline__ void convert_layer(Frame& F, ArgsP A, int l, int part, int wrank, int wcount) {
    LAS float* scr = (LAS float*)(F.lds + F.wave * 16384);
    const int k_lo = (part == 2) ? 9 : (part == 3 ? 10 : 0), k_hi = (part == 1) ? 9 : (part == 2 ? 10 : 11);
    int base = 0;
    for (int k = k_lo; k < k_hi; ++k) {
        if (k == 1 && l == 0) continue;
        const int K = JK[k], N = JN[k], row_off = (k == 1) ? INW : 0; const int ldk = K;
        const float* W = A->in[JIN[k]] + (size_t)(k == 1 ? l - 1 : l) * K * N; const size_t dst = WL((size_t)JDST[k] * KiB);
        const int nitems = (K / 64) * (N / 32);
        int first = (wrank - base) % wcount; if (first < 0) first += wcount;
        for (int it = first; it < nitems; it += wcount) p0_transpose_item(W, K, N, WSP(bf16, dst), ldk, row_off, scr, it, F.lane);
        base = (base + nitems) % wcount;
    }
    if (part <= 1) {
        const long gt = (long)wrank * 64 + F.lane, NGT = (long)wcount * 64;
        { const float* W = A->in[I_WUP] + (size_t)l * 96 * 1024; bf16* O = WSP(bf16, WL(WO_UP));
          for (long i = gt; i < 1024 * 128; i += NGT) { const int n = (int)(i & 1023), kp = (int)(i >> 10); O[n * 128 + kp] = kp < 96 ? f2bf(W[kp * 1024 + n]) : (bf16)0; } }
        { const float* W = A->in[I_AUP] + (size_t)l * 96 * 1024; bf16* O = WSP(bf16, WL(WO_AUP));
          for (long i = gt; i < 1024 * 128; i += NGT) { const int n = (int)(i & 1023), kp = (int)(i >> 10); O[n * 128 + kp] = kp < 96 ? f2bf(W[kp * 1024 + n]) : (bf16)0; } }
        if (l > 0) { const float* W = A->in[I_VUP] + (size_t)(l - 1) * 64 * 1024; bf16* O = WSP(bf16, WL(WO_VUP));
          for (long i = gt; i < 1024 * 128; i += NGT) { const int n = (int)(i & 1023), kp = (int)(i >> 10); O[n * 128 + kp] = kp < 64 ? f2bf(W[kp * 1024 + n]) : (bf16)0; } }
        { const float* W = A->in[I_WUQ] + (size_t)l * 512 * 1536; bf16* O = WSP(bf16, WL(WO_UQ));
          for (long i = gt; i < 1536 * 512; i += NGT) { const int np = (int)(i % 1536), kk = (int)(i / 1536); const int hh = np / 192, cc = np % 192;
              const int n = cc < 128 ? np : hh * 192 + 128 + ((cc - 128) & 1) * 32 + ((cc - 128) >> 1);
              O[(size_t)np * 512 + kk] = f2bf(W[(size_t)kk * 1536 + n]); } }
        if (l > 0) { unsigned* O = (unsigned*)(WSP(bf16, WL(WO_IN)) + (size_t)(INW + 64) * D);
          for (long i = gt; i < 192 * D / 2; i += NGT) O[i] = 0u; }
    }
}
__device__ __forceinline__ void p0_prologue(Frame& F, ArgsP A) {
    const int gw = F.vcu * NWAVES + F.wave, NGW = F.G * NWAVES;
    const long gt = (long)F.vcu * NTHR + F.tid, NGT = (long)F.G * NTHR;
    convert_layer(F, A, 0, 1, gw, NGW);
    { float* cT = WSP(float, WS_COS); float* sT = WSP(float, WS_SIN);
      for (long i = gt; i < SEQ * 32; i += NGT) { const int pos = (int)(i >> 5), j = (int)(i & 31);
          const float invf = __builtin_amdgcn_exp2f(-13.287712379549449f * (float)j * (1.f / 32.f));
          const double rev = (double)pos * (double)invf * 0.15915494309189535; const float fr = (float)(rev - __builtin_rint(rev));
          cT[i] = __builtin_amdgcn_cosf(fr); sT[i] = __builtin_amdgcn_sinf(fr); } }
    for (int m = gw; m < T; m += NGW) rms_row_2048(A->in[I_X] + (size_t)m * D, A->in[I_MIXPRE], WSP(bf16, WS_U) + (size_t)m * D, (bf16*)F.H + (size_t)m * D, F.lane);
    for (int m = gw; m < NB * NMEM; m += NGW) rms_row_2048(A->in[I_MEM] + (size_t)m * D, A->in[I_MEMG], WSP(bf16, WS_MEMN) + (size_t)m * D, nullptr, F.lane);
}

__device__ __forceinline__ void prep_phase(Frame& F, ArgsP A, int l) {
    const int gw = F.vcu * NWAVES + F.wave, NGW = F.G * NWAVES, lane = F.lane;
    const bf16* PROJ = WSP(bf16, WS_PROJ);
    const float* mu = A->in[I_MU] + (size_t)l * RIN;
    const float* muv = A->in[I_MUV] + (size_t)(l > 0 ? l - 1 : 0) * 64;
    const float* qg = A->in[I_QNG] + (size_t)l * 512; const float* kvg = A->in[I_KVNG] + (size_t)l * 256;
    const float* cT = WSP(float, WS_COS); const float* sT = WSP(float, WS_SIN);
    for (int m = gw; m < T; m += NGW) {
        const bf16* cur = PROJ + (size_t)m * PROJ_LD; const bool first = (m & (SEQ - 1)) == 0; const bf16* prv = cur - PROJ_LD;
        bf16* lo = WSP(bf16, WS_LORA) + (size_t)m * LORA_LD;
#pragma unroll
        for (int i = 0; i < 10; ++i) { const int oc = lane + 64 * i; int sc = -1, kind = 0; float mv = 0.f;
            if (oc < 128) { if (oc < 96) { sc = 3072 + oc; kind = 1; } }
            else if (oc < 256) { if (oc < 224) { sc = 3168 + (oc - 128); kind = 0; } }
            else if (oc < 512) { sc = 3264 + (oc - 256); kind = 2; }
            else if (oc < 576) { if (l > 0) { sc = INW + (oc - 512); kind = 3; } }
            float val = 0.f;
            if (sc >= 0) { mv = kind == 3 ? muv[sc - INW] : mu[sc]; const float y = bf1(cur[sc]), yp = first ? 0.f : bf1(prv[sc]); const float c = y + (yp - y) * mv;
                val = kind == 1 ? tanhf_(c) : (kind == 2 ? sigmoidf_(c) : c); }
            lo[oc] = f2bf(val); }
        { float v[8]; unpack8(*(const u32x4*)(cur + RIN + lane * 8), v); float ss = 0.f;
#pragma unroll
          for (int i = 0; i < 8; ++i) ss += v[i] * v[i];
          const float rstd = rsqrtf(wave_sum(ss) * (1.f / 512.f) + NORM_EPS);
          const f32x4 g0 = *(const f32x4*)(qg + lane * 8), g1 = *(const f32x4*)(qg + lane * 8 + 4);
          u32x4 w; w.x = cvt_pk(v[0] * rstd * g0[0], v[1] * rstd * g0[1]); w.y = cvt_pk(v[2] * rstd * g0[2], v[3] * rstd * g0[3]);
          w.z = cvt_pk(v[4] * rstd * g1[0], v[5] * rstd * g1[1]); w.w = cvt_pk(v[6] * rstd * g1[2], v[7] * rstd * g1[3]);
          *(u32x4*)(WSP(bf16, WS_CQN) + (size_t)m * 512 + lane * 8) = w; }
        { const u32x2 raw = *(const u32x2*)(cur + RIN + 512 + lane * 4); const float v0 = bflo(raw.x), v1 = bfhi(raw.x), v2 = bflo(raw.y), v3 = bfhi(raw.y);
          const float rstd = rsqrtf(wave_sum(v0 * v0 + v1 * v1 + v2 * v2 + v3 * v3) * (1.f / 256.f) + NORM_EPS);
          const f32x4 g0 = *(const f32x4*)(kvg + lane * 4);
          u32x2 w; w.x = cvt_pk(v0 * rstd * g0[0], v1 * rstd * g0[1]); w.y = cvt_pk(v2 * rstd * g0[2], v3 * rstd * g0[3]);
          *(u32x2*)(WSP(bf16, WS_CKVN) + (size_t)m * 256 + lane * 4) = w; }
        if (lane < 32) { const float x1 = bf1(cur[RIN + 768 + lane]), x2 = bf1(cur[RIN + 768 + 32 + lane]); const int pos = m & (SEQ - 1);
          const float c = cT[pos * 32 + lane], s = sT[pos * 32 + lane];
          *(unsigned*)(WSP(bf16, WS_KR) + (size_t)m * 64 + 2 * lane) = cvt_pk(x1 * c - x2 * s, x1 * s + x2 * c); }
        if (l == 0) {
#pragma unroll
            for (int j = 0; j < 2; ++j) { const int c = lane * 8 + 512 * j; float a[8], p[8], o[8]; unpack8(*(const u32x4*)(cur + 2048 + c), a);
                if (!first) unpack8(*(const u32x4*)(prv + 2048 + c), p); else {
#pragma unroll
                    for (int i = 0; i < 8; ++i) p[i] = 0.f; }
                const f32x4 m0 = *(const f32x4*)(mu + 2048 + c), m1 = *(const f32x4*)(mu + 2048 + c + 4);
#pragma unroll
                for (int i = 0; i < 8; ++i) o[i] = a[i] + (p[i] - a[i]) * (i < 4 ? m0[i] : m1[i - 4]);
                *(u32x4*)(WSP(bf16, WS_VF) + (size_t)m * 1024 + c) = pack8(o); } }
    }
}

constexpr int CK = 32, NCHUNK = SEQ / CK;
constexpr int CS_TS = 144, CS_TILE = 32 * CS_TS, CS_PC = 5 * CS_TILE, CS_WAVE = 5 * CS_TILE + 256;
constexpr int CS_NW = 7;
constexpr size_t SCU_BYTES = 24576; constexpr int SCU_X = 8192, SCU_PSI = 12288, SCU_G2 = 20480;
constexpr int SQ_SLOT = 18432, SQ_NSLOT = 7;
static_assert(CS_NW * CS_WAVE <= RING_BYTES && SQ_NSLOT * SQ_SLOT <= RING_BYTES, "LDS budget");
#define MF32(a, b, c) __builtin_amdgcn_mfma_f32_32x32x16_bf16((a), (b), (c), 0, 0, 0)
__device__ __forceinline__ bf16x8 pack8f(float a0, float a1, float a2, float a3, float a4, float a5, float a6, float a7) {
    u32x4 w; w.x = cvt_pk(a0, a1); w.y = cvt_pk(a2, a3); w.z = cvt_pk(a4, a5); w.w = cvt_pk(a6, a7); return __builtin_bit_cast(bf16x8, w); }
#define PACKS(x, s) pack8f((x)[8 * (s)], (x)[8 * (s) + 1], (x)[8 * (s) + 2], (x)[8 * (s) + 3], (x)[8 * (s) + 4], (x)[8 * (s) + 5], (x)[8 * (s) + 6], (x)[8 * (s) + 7])
__device__ __forceinline__ bf16x8 trfrag(const LAS unsigned char* p) {
    const s16x4 lo = __builtin_bit_cast(s16x4, __builtin_amdgcn_ds_read_tr16_b64_v4i16((LAS v4i16_t*)p));
    const s16x4 hh = __builtin_bit_cast(s16x4, __builtin_amdgcn_ds_read_tr16_b64_v4i16((LAS v4i16_t*)(p + 8 * CS_TS)));
    return (bf16x8){lo[0], lo[1], lo[2], lo[3], hh[0], hh[1], hh[2], hh[3]}; }
__device__ __forceinline__ void st_init16(unsigned char* p, const f32x16& x) {
    u32x4 w0, w1; w0.x = cvt_pk(x[0], x[1]); w0.y = cvt_pk(x[2], x[3]); w0.z = cvt_pk(x[4], x[5]); w0.w = cvt_pk(x[6], x[7]);
    w1.x = cvt_pk(x[8], x[9]); w1.y = cvt_pk(x[10], x[11]); w1.z = cvt_pk(x[12], x[13]); w1.w = cvt_pk(x[14], x[15]);
    *(u32x4*)p = w0; *(u32x4*)(p + 16) = w1; }
__device__ __forceinline__ f32x16 ld_init16(const LAS unsigned char* p) {
    const u32x4 w0 = *(const LAS u32x4*)p, w1 = *(const LAS u32x4*)(p + 16); f32x16 x;
    x[0] = bflo(w0.x); x[1] = bfhi(w0.x); x[2] = bflo(w0.y); x[3] = bfhi(w0.y); x[4] = bflo(w0.z); x[5] = bfhi(w0.z); x[6] = bflo(w0.w); x[7] = bfhi(w0.w);
    x[8] = bflo(w1.x); x[9] = bfhi(w1.x); x[10] = bflo(w1.y); x[11] = bfhi(w1.y); x[12] = bflo(w1.z); x[13] = bfhi(w1.z); x[14] = bflo(w1.w); x[15] = bfhi(w1.w); return x; }

struct CsRaw { u32x4 r[4], k[4], a[4], e[4]; bf16 rp, kp; };
__device__ __forceinline__ void cs_load_raw(Frame& F, int l, int bh, int cc, CsRaw& R) {
    const int lane = F.lane, b = bh >> 4, h = bh & 15, pc = lane & 7;
    const size_t row0 = (size_t)b * SEQ + (size_t)cc * CK;
    const bf16* PROJ = WSP(bf16, WS_PROJ); const bf16* AIC = WSP(bf16, WS_AIC); const bf16* WLOG = WSP(bf16, WS_WLOG);
#pragma unroll
    for (int i = 0; i < 4; ++i) { const size_t gr = row0 + (lane >> 3) + 8 * i;
        R.r[i] = *(const u32x4*)(PROJ + gr * PROJ_LD + h * 64 + pc * 8); R.k[i] = *(const u32x4*)(PROJ + gr * PROJ_LD + 1024 + h * 64 + pc * 8);
        R.a[i] = *(const u32x4*)(AIC + gr * 1024 + h * 64 + pc * 8); R.e[i] = *(const u32x4*)(WLOG + gr * 1024 + h * 64 + pc * 8); }
    R.rp = 0; R.kp = 0;
    if (cc > 0) { R.rp = PROJ[(row0 - 1) * PROJ_LD + h * 64 + lane]; R.kp = PROJ[(row0 - 1) * PROJ_LD + 1024 + h * 64 + lane]; }
}
__device__ __forceinline__ void cs_elementwise(Frame& F, ArgsP A, int l, int bh, int cc, LAS unsigned char* wl, const CsRaw& R) {
    const int lane = F.lane, b = bh >> 4, h = bh & 15, ch = h * 64 + lane;
    const size_t row0 = (size_t)b * SEQ + (size_t)cc * CK;
    float* RKB = WSP(float, WS_RKB);
    const bf16* VV = (l == 0) ? WSP(bf16, WS_VF) : WSP(bf16, WS_VV);
    u32x4 vraw[4];
#pragma unroll
    for (int i = 0; i < 4; ++i) vraw[i] = *(const u32x4*)(VV + (row0 + (lane >> 3) + 8 * i) * 1024 + h * 64 + (lane & 7) * 8);
#pragma unroll
    for (int i = 0; i < 4; ++i) { LAS unsigned char* p = wl + ((lane >> 3) + 8 * i) * CS_TS + (lane & 7) * 16;
        *(LAS u32x4*)(p) = R.k[i]; *(LAS u32x4*)(p + CS_TILE) = R.a[i]; *(LAS u32x4*)(p + 2 * CS_TILE) = R.e[i]; *(LAS u32x4*)(p + 3 * CS_TILE) = R.r[i]; }
    const float mur = A->in[I_MU][(size_t)l * RIN + ch], muk = A->in[I_MU][(size_t)l * RIN + 1024 + ch];
    const float ckk = A->in[I_KK][(size_t)l * 1024 + ch], cka = A->in[I_KA][(size_t)l * 1024 + ch], crk = A->in[I_RK][(size_t)l * 1024 + ch];
    float rp = bf1(R.rp), kp_ = bf1(R.kp);
    float lp = 0.f, pexc = 1.f;
    constexpr float L2E = 1.4426950408889634f;
    asm volatile("s_waitcnt lgkmcnt(0)" ::: "memory");
#pragma unroll 8
    for (int tt = 0; tt < CK; ++tt) {
        LAS unsigned char* rowp = wl + tt * CS_TS + lane * 2;
        const float kc = bf1(*(const LAS bf16*)(rowp)), aa = bf1(*(const LAS bf16*)(rowp + CS_TILE)), ee = bf1(*(const LAS bf16*)(rowp + 2 * CS_TILE)), rc = bf1(*(const LAS bf16*)(rowp + 3 * CS_TILE));
        const float rs = rc + (rp - rc) * mur, ks = kc + (kp_ - kc) * muk; rp = rc; kp_ = kc;
        float kk = ks * ckk; const float ss = wave_sum(kk * kk); kk *= rsqrtf(fmaxf(ss, 1e-24f));
        const float kq = ks * (1.f + (aa - 1.f) * cka);
        const float rkb = wave_sum(rs * kq * crk);
        lp += ee;
        const float pinc = __builtin_amdgcn_exp2f(lp * L2E), pinv = __builtin_amdgcn_exp2f(-lp * L2E);
        *(LAS bf16*)(rowp) = f2bf(-kk * pexc);
        *(LAS bf16*)(rowp + CS_TILE) = f2bf(kk * aa * pinv);
        *(LAS bf16*)(rowp + 2 * CS_TILE) = f2bf(kq * pinv);
        *(LAS bf16*)(rowp + 3 * CS_TILE) = f2bf(rs * pinc);
        pexc = pinc;
        if (lane == 0) RKB[(row0 + tt) * 16 + h] = rkb;
    }
    ((LAS float*)(wl + CS_PC))[lane] = __builtin_amdgcn_exp2f(lp * L2E);
#pragma unroll
    for (int i = 0; i < 4; ++i) *(LAS u32x4*)(wl + 4 * CS_TILE + ((lane >> 3) + 8 * i) * CS_TS + (lane & 7) * 16) = vraw[i];
}
__device__ __forceinline__ void cs_mfma(Frame& F, const LAS unsigned char* wl, unsigned char* ub) {
    const int lane = F.lane, r32 = lane & 31, h = lane >> 5, q4 = (lane & 15) >> 2, pp = lane & 3, blk = (lane >> 4) & 1;
    const LAS unsigned char* tA = wl; const LAS unsigned char* tB = wl + CS_TILE; const LAS unsigned char* tK = wl + 2 * CS_TILE;
    const LAS unsigned char* tR = wl + 3 * CS_TILE; const LAS unsigned char* tV = wl + 4 * CS_TILE;
    const int rowoff = r32 * CS_TS + h * 16, troff = (4 * h + q4) * CS_TS + blk * 32 + pp * 8;
#define FROW(t, s) (*(const LAS bf16x8*)((t) + rowoff + (s) * 32))
#define FTR(t, ct, s) trfrag((t) + troff + (s) * 16 * CS_TS + (ct) * 64)
    const f32x16 Z = (f32x16){};
    f32x16 P = Z, PT = Z;
#pragma unroll
    for (int s = 0; s < 4; ++s) { const bf16x8 fa = FROW(tA, s), fb = FROW(tB, s); P = MF32(fb, fa, P); PT = MF32(fa, fb, PT); }
#pragma unroll
    for (int r = 0; r < 16; ++r) { const int cr = crow(r, h); if (!(cr < r32)) P[r] = 0.f; if (!(r32 < cr)) PT[r] = 0.f; }
    f32x16 TmT = PT;
#pragma unroll
    for (int r = 0; r < 16; ++r) if (crow(r, h) == r32) TmT[r] += 1.f;
    f32x16 Tm;
#pragma unroll
    for (int it = 0; it < 4; ++it) {
        const bf16x8 pP0 = PACKS(P, 0), pP1 = PACKS(P, 1), pT0 = PACKS(PT, 0), pT1 = PACKS(PT, 1);
        f32x16 Pn = MF32(pT0, pP0, Z); Pn = MF32(pT1, pP1, Pn);
        f32x16 Y = Pn;
#pragma unroll
        for (int r = 0; r < 16; ++r) if (crow(r, h) == r32) Y[r] += 1.f;
        const bf16x8 y0 = PACKS(Y, 0), y1 = PACKS(Y, 1), t0 = PACKS(TmT, 0), t1 = PACKS(TmT, 1);
        if (it < 3) {
            f32x16 PTn = MF32(pP0, pT0, Z); PTn = MF32(pP1, pT1, PTn);
            f32x16 Tn = MF32(y0, t0, Z); Tn = MF32(y1, t1, Tn);
            P = Pn; PT = PTn; TmT = Tn;
        } else { Tm = MF32(t0, y0, Z); Tm = MF32(t1, y1, Tm); }
    }
    f32x16 W1;
    { f32x16 NakT = Z;
#pragma unroll
      for (int s = 0; s < 4; ++s) NakT = MF32(FROW(tA, s), FROW(tK, s), NakT);
#pragma unroll
      for (int r = 0; r < 16; ++r) if (!(r32 < crow(r, h))) NakT[r] = 0.f;
      W1 = MF32(PACKS(NakT, 0), PACKS(Tm, 0), Z); W1 = MF32(PACKS(NakT, 1), PACKS(Tm, 1), W1); }
    f32x16 ATT[2], G1T[2];
    { const bf16x8 m0 = PACKS(Tm, 0), m1 = PACKS(Tm, 1), w0 = PACKS(W1, 0), w1 = PACKS(W1, 1);
#pragma unroll
      for (int ct = 0; ct < 2; ++ct) { ATT[ct] = MF32(m0, FTR(tA, ct, 0), Z); ATT[ct] = MF32(m1, FTR(tA, ct, 1), ATT[ct]);
                                       G1T[ct] = MF32(w0, FTR(tV, ct, 0), Z); G1T[ct] = MF32(w1, FTR(tV, ct, 1), G1T[ct]); } }
    f32x16 Mbr = Z, Mkr = Z;
#pragma unroll
    for (int s = 0; s < 4; ++s) { const bf16x8 fr = FROW(tR, s); Mbr = MF32(FROW(tB, s), fr, Mbr); Mkr = MF32(FROW(tK, s), fr, Mkr); }
#pragma unroll
    for (int r = 0; r < 16; ++r) if (!(crow(r, h) <= r32)) { Mbr[r] = 0.f; Mkr[r] = 0.f; }
    const bf16x8 b0 = PACKS(Mbr, 0), b1 = PACKS(Mbr, 1), k0 = PACKS(Mkr, 0), k1 = PACKS(Mkr, 1);
#pragma unroll
    for (int kt = 0; kt < 2; ++kt) {
        f32x16 X = MF32(PACKS(ATT[kt], 0), b0, Z); X = MF32(PACKS(ATT[kt], 1), b1, X);
#pragma unroll
        for (int g = 0; g < 4; ++g) { const u32x2 w = *(const LAS u32x2*)(tR + r32 * CS_TS + (32 * kt + 8 * g + 4 * h) * 2);
            X[4 * g] += bflo(w.x); X[4 * g + 1] += bfhi(w.x); X[4 * g + 2] += bflo(w.y); X[4 * g + 3] += bfhi(w.y); }
        *(bf16x8*)(ub + SCU_X + ((2 * kt) * 64 + lane) * 16) = PACKS(X, 0);
        *(bf16x8*)(ub + SCU_X + ((2 * kt + 1) * 64 + lane) * 16) = PACKS(X, 1);
    }
#pragma unroll
    for (int ct = 0; ct < 2; ++ct) {
        f32x16 G = MF32(b0, PACKS(G1T[ct], 0), Z); G = MF32(b1, PACKS(G1T[ct], 1), G);
        G = MF32(k0, FTR(tV, ct, 0), G); G = MF32(k1, FTR(tV, ct, 1), G);
        st_init16(ub + SCU_G2 + (ct * 64 + lane) * 32, G);
    }
    const LAS float* PC = (const LAS float*)(wl + CS_PC);
#pragma unroll
    for (int ct = 0; ct < 2; ++ct) {
        const float pc = PC[32 * ct + r32];
        const bf16x8 f0 = FTR(tB, ct, 0), f1 = FTR(tB, ct, 1);
#pragma unroll
        for (int kt = 0; kt < 2; ++kt) {
            f32x16 Ph = MF32(PACKS(ATT[kt], 0), f0, Z); Ph = MF32(PACKS(ATT[kt], 1), f1, Ph);
            if (kt == ct) {
#pragma unroll
                for (int r = 0; r < 16; ++r) if (crow(r, h) == r32) Ph[r] += 1.f; }
#pragma unroll
            for (int r = 0; r < 16; ++r) Ph[r] *= pc;
            *(bf16x8*)(ub + ((ct * 4 + 2 * kt) * 64 + lane) * 16) = PACKS(Ph, 0);
            *(bf16x8*)(ub + ((ct * 4 + 2 * kt + 1) * 64 + lane) * 16) = PACKS(Ph, 1);
        }
    }
#pragma unroll
    for (int mt = 0; mt < 2; ++mt) {
        const bf16x8 fb0 = FTR(tB, mt, 0), fb1 = FTR(tB, mt, 1), fk0 = FTR(tK, mt, 0), fk1 = FTR(tK, mt, 1);
        float pcr[16];
#pragma unroll
        for (int g = 0; g < 4; ++g) { const f32x4 v = *(const LAS f32x4*)(PC + 32 * mt + 8 * g + 4 * h); pcr[4 * g] = v[0]; pcr[4 * g + 1] = v[1]; pcr[4 * g + 2] = v[2]; pcr[4 * g + 3] = v[3]; }
#pragma unroll
        for (int ct = 0; ct < 2; ++ct) {
            f32x16 Ps = MF32(fb0, PACKS(G1T[ct], 0), Z); Ps = MF32(fb1, PACKS(G1T[ct], 1), Ps);
            Ps = MF32(fk0, FTR(tV, ct, 0), Ps); Ps = MF32(fk1, FTR(tV, ct, 1), Ps);
#pragma unroll
            for (int r = 0; r < 16; ++r) Ps[r] *= pcr[r];
            st_init16(ub + SCU_PSI + ((ct * 2 + mt) * 64 + lane) * 32, Ps);
        }
    }
#undef FROW
#undef FTR
}
__device__ __forceinline__ void cs_pre_phase(Frame& F, ArgsP A, int l) {
    volatile LAS unsigned* cnt = (volatile LAS unsigned*)(F.lds + LDSCTL_OFF);
    if (F.tid == 0) cnt[0] = 0u;
    __syncthreads();
    if (F.wave < CS_NW) {
        LAS unsigned char* wl = F.lds + F.wave * CS_WAVE;
        const int per = (64 * NCHUNK + F.G - 1) / F.G, ubase = F.vcu * per, uend = (ubase + per < 64 * NCHUNK) ? ubase + per : 64 * NCHUNK;
#define CS_NEXT(dst) do { unsigned v_ = 0u; if (F.lane == 0) v_ = __hip_atomic_fetch_add((LAS unsigned*)cnt, 1u, __ATOMIC_RELAXED, __HIP_MEMORY_SCOPE_WORKGROUP); dst = ubase + (int)__builtin_amdgcn_readfirstlane((int)v_); } while (0)
        int u; CS_NEXT(u);
        CsRaw R;
        if (u < uend) cs_load_raw(F, l, u >> 7, u & (NCHUNK - 1), R);
        while (u < uend) {
            cs_elementwise(F, A, l, u >> 7, u & (NCHUNK - 1), wl, R);
            int un; CS_NEXT(un);
            if (un < uend) cs_load_raw(F, l, un >> 7, un & (NCHUNK - 1), R);
            asm volatile("s_waitcnt lgkmcnt(0)" ::: "memory");
            cs_mfma(F, wl, F.ws + WS_SCAN + (size_t)u * SCU_BYTES);
            asm volatile("s_waitcnt lgkmcnt(0)" ::: "memory");
            u = un;
        }
#undef CS_NEXT
    }
}
__device__ __forceinline__ void cs_seq_unit(Frame& F, int bh, int ct) {
    const int lane = F.lane, wave = F.wave, r32 = lane & 31, h = lane >> 5;
    LAS unsigned char* L = F.lds;
    const unsigned char* ub = F.ws + WS_SCAN + (size_t)bh * NCHUNK * SCU_BYTES;
    if (wave > 0) {
        const int w = wave - 1;
        size_t so[3]; int np = 0;
#pragma unroll
        for (int k = 0; k < 3; ++k) { const int p = w + 7 * k; so[k] = p < 12 ? (size_t)p * 1024 : (p < 16 ? (size_t)SCU_PSI + ct * 4096 + (p - 12) * 1024 : (size_t)SCU_G2 + ct * 2048 + (p - 16) * 1024); if (p < 18) np = k + 1; }
#define SQ_ISSUE(c) do { const unsigned char* g_ = ub + (size_t)(c) * SCU_BYTES + lane * 16; LAS unsigned char* d_ = L + ((c) % SQ_NSLOT) * SQ_SLOT; \
        _Pragma("unroll") for (int k = 0; k < 3; ++k) if (k < np) __builtin_amdgcn_global_load_lds((const unsigned*)(g_ + so[k]), (LAS unsigned*)(d_ + (w + 7 * k) * 1024), 16, 0, 0); } while (0)
        for (int c = 0; c < 6; ++c) SQ_ISSUE(c);
        if (np == 3) asm volatile("s_waitcnt vmcnt(15)" ::: "memory"); else asm volatile("s_waitcnt vmcnt(10)" ::: "memory");
        asm volatile("s_barrier" ::: "memory");
        for (int c = 0; c < NCHUNK; ++c) {
            if (c + 6 < NCHUNK) { SQ_ISSUE(c + 6); if (np == 3) asm volatile("s_waitcnt vmcnt(15)" ::: "memory"); else asm volatile("s_waitcnt vmcnt(10)" ::: "memory"); }
            else asm volatile("s_waitcnt vmcnt(0)" ::: "memory");
            asm volatile("s_barrier" ::: "memory");
        }
#undef SQ_ISSUE
    } else {
        f32x16 S0 = (f32x16){}, S1 = (f32x16){};
        const int b = bh >> 4, hh = bh & 15;
        bf16* op = (bf16*)(F.ws + WS_Y) + ((size_t)b * SEQ) * 1024 + hh * 64 + 32 * ct + r32;
        asm volatile("s_barrier" ::: "memory");
        for (int c = 0; c < NCHUNK; ++c) {
            const LAS unsigned char* sl = L + (c % SQ_NSLOT) * SQ_SLOT;
            const bf16x8 bS0 = PACKS(S0, 0), bS1 = PACKS(S0, 1), bS2 = PACKS(S1, 0), bS3 = PACKS(S1, 1);
            f32x16 n0 = ld_init16(sl + 12288 + (0 * 64 + lane) * 32), n1 = ld_init16(sl + 12288 + (1 * 64 + lane) * 32);
            const f32x16 Z = (f32x16){};
            f32x16 m0 = MF32(*(const LAS bf16x8*)(sl + (2 * 64 + lane) * 16), bS2, Z), m1 = MF32(*(const LAS bf16x8*)(sl + (6 * 64 + lane) * 16), bS2, Z);
            n0 = MF32(*(const LAS bf16x8*)(sl + (0 * 64 + lane) * 16), bS0, n0); n1 = MF32(*(const LAS bf16x8*)(sl + (4 * 64 + lane) * 16), bS0, n1);
            m0 = MF32(*(const LAS bf16x8*)(sl + (3 * 64 + lane) * 16), bS3, m0); m1 = MF32(*(const LAS bf16x8*)(sl + (7 * 64 + lane) * 16), bS3, m1);
            n0 = MF32(*(const LAS bf16x8*)(sl + (1 * 64 + lane) * 16), bS1, n0); n1 = MF32(*(const LAS bf16x8*)(sl + (5 * 64 + lane) * 16), bS1, n1);
            f32x16 o = ld_init16(sl + 16384 + lane * 32);
            o = MF32(*(const LAS bf16x8*)(sl + 8192 + (0 * 64 + lane) * 16), bS0, o); o = MF32(*(const LAS bf16x8*)(sl + 8192 + (1 * 64 + lane) * 16), bS1, o);
            o = MF32(*(const LAS bf16x8*)(sl + 8192 + (2 * 64 + lane) * 16), bS2, o); o = MF32(*(const LAS bf16x8*)(sl + 8192 + (3 * 64 + lane) * 16), bS3, o);
            S0 = n0 + m0; S1 = n1 + m1;
#pragma unroll
            for (int r = 0; r < 16; ++r) op[(size_t)(c * CK + crow(r, h)) * 1024] = f2bf(o[r]);
            asm volatile("s_waitcnt lgkmcnt(0)\n\ts_barrier" ::: "memory");
        }
    }
    asm volatile("s_waitcnt vmcnt(0)" ::: "memory");
    __syncthreads();
}

__device__ __forceinline__ void rwkv_post_phase(Frame& F, ArgsP A, int l) {
    const int gw = F.vcu * NWAVES + F.wave, NGW = F.G * NWAVES, lane = F.lane, c0 = lane * 16, head = lane >> 2;
    const bf16* ORAW = WSP(bf16, WS_Y); const float* RKB = WSP(float, WS_RKB);
    const bf16* VV = (l == 0) ? WSP(bf16, WS_VF) : WSP(bf16, WS_VV); const bf16* GATE = WSP(bf16, WS_GATE);
    float lg[16], lb[16];
#pragma unroll
    for (int i = 0; i < 16; ++i) { lg[i] = A->in[I_LNG][(size_t)l * 1024 + c0 + i]; lb[i] = A->in[I_LNB][(size_t)l * 1024 + c0 + i]; }
    for (int m = gw; m < T; m += NGW) {
        float o[16];
#pragma unroll
        for (int j = 0; j < 2; ++j) { float t8[8]; unpack8(*(const u32x4*)(ORAW + (size_t)m * 1024 + c0 + 8 * j), t8);
#pragma unroll
            for (int i = 0; i < 8; ++i) o[8 * j + i] = t8[i]; }
        float s = 0.f;
#pragma unroll
        for (int i = 0; i < 16; ++i) s += o[i];
        s = sum4(s);
        const float mean = s * (1.f / 64.f); float q = 0.f;
#pragma unroll
        for (int i = 0; i < 16; ++i) { o[i] -= mean; q += o[i] * o[i]; }
        q = sum4(q);
        const float rstd = rsqrtf(q * (1.f / 64.f) + GN_EPS);
        const float rkb = RKB[(size_t)m * 16 + head];
        float vv[16], gg[16];
        { float t8[8]; unpack8(*(const u32x4*)(VV + (size_t)m * 1024 + c0), t8);
#pragma unroll
          for (int i = 0; i < 8; ++i) vv[i] = t8[i];
          unpack8(*(const u32x4*)(VV + (size_t)m * 1024 + c0 + 8), t8);
#pragma unroll
          for (int i = 0; i < 8; ++i) vv[8 + i] = t8[i];
          unpack8(*(const u32x4*)(GATE + (size_t)m * 1024 + c0), t8);
#pragma unroll
          for (int i = 0; i < 8; ++i) gg[i] = t8[i];
          unpack8(*(const u32x4*)(GATE + (size_t)m * 1024 + c0 + 8), t8);
#pragma unroll
          for (int i = 0; i < 8; ++i) gg[8 + i] = t8[i]; }
        float y[16];
#pragma unroll
        for (int i = 0; i < 16; ++i) y[i] = (o[i] * rstd * lg[i] + lb[i] + rkb * vv[i]) * gg[i];
        bf16* dst = WSP(bf16, WS_U) + (size_t)m * D + c0;
        u32x4 w0, w1; w0.x = cvt_pk(y[0], y[1]); w0.y = cvt_pk(y[2], y[3]); w0.z = cvt_pk(y[4], y[5]); w0.w = cvt_pk(y[6], y[7]);
        w1.x = cvt_pk(y[8], y[9]); w1.y = cvt_pk(y[10], y[11]); w1.z = cvt_pk(y[12], y[13]); w1.w = cvt_pk(y[14], y[15]);
        *(u32x4*)dst = w0; *(u32x4*)(dst + 8) = w1;
    }
}

__device__ __forceinline__ void ew_norm_phase(Frame& F, const float* gpost, const float* gpre, int e) {
    const int gw = F.vcu * NWAVES + F.wave, NGW = F.G * NWAVES, lane = F.lane;
    const bf16* Y = WSP(bf16, WS_Y); bf16* U = WSP(bf16, WS_U);
    const bf16* Hin = (e & 1) ? WSP(bf16, WS_HB) : (const bf16*)F.H;
    bf16* Hout = (e & 1) ? (bf16*)F.H : WSP(bf16, WS_HB);
    const bool last = (e == 3 * NL - 1);
    for (int m = gw; m < T; m += NGW) {
        float y[32]; float ss = 0.f;
#pragma unroll
        for (int j = 0; j < 4; ++j) { float t8[8]; unpack8(*(const u32x4*)(Y + (size_t)m * D + lane * 8 + 512 * j), t8);
#pragma unroll
            for (int i = 0; i < 8; ++i) { y[8 * j + i] = t8[i]; ss += t8[i] * t8[i]; } }
        const float rstd = rsqrtf(wave_sum(ss) * (1.f / 2048.f) + NORM_EPS);
        float hn[32]; float s2 = 0.f;
#pragma unroll
        for (int j = 0; j < 4; ++j) { const int c = lane * 8 + 512 * j;
            float h8[8]; unpack8(*(const u32x4*)(Hin + (size_t)m * D + c), h8);
            const f32x4 g0 = *(const f32x4*)(gpost + c), g1 = *(const f32x4*)(gpost + c + 4);
#pragma unroll
            for (int i = 0; i < 4; ++i) { hn[8 * j + i] = h8[i] + y[8 * j + i] * rstd * g0[i]; hn[8 * j + 4 + i] = h8[4 + i] + y[8 * j + 4 + i] * rstd * g1[i]; }
            if (last) { float* hp = F.H + (size_t)m * D + c; *(f32x4*)hp = (f32x4){hn[8 * j], hn[8 * j + 1], hn[8 * j + 2], hn[8 * j + 3]}; *(f32x4*)(hp + 4) = (f32x4){hn[8 * j + 4], hn[8 * j + 5], hn[8 * j + 6], hn[8 * j + 7]}; }
            else { u32x4 w; w.x = cvt_pk(hn[8 * j], hn[8 * j + 1]); w.y = cvt_pk(hn[8 * j + 2], hn[8 * j + 3]); w.z = cvt_pk(hn[8 * j + 4], hn[8 * j + 5]); w.w = cvt_pk(hn[8 * j + 6], hn[8 * j + 7]); *(u32x4*)(Hout + (size_t)m * D + c) = w; }
#pragma unroll
            for (int i = 0; i < 8; ++i) s2 += hn[8 * j + i] * hn[8 * j + i]; }
        if (gpre) {
            const float r2 = rsqrtf(wave_sum(s2) * (1.f / 2048.f) + NORM_EPS);
#pragma unroll
            for (int j = 0; j < 4; ++j) { const int c = lane * 8 + 512 * j; const f32x4 g0 = *(const f32x4*)(gpre + c), g1 = *(const f32x4*)(gpre + c + 4);
                u32x4 w; w.x = cvt_pk(hn[8 * j] * r2 * g0[0], hn[8 * j + 1] * r2 * g0[1]); w.y = cvt_pk(hn[8 * j + 2] * r2 * g0[2], hn[8 * j + 3] * r2 * g0[3]);
                w.z = cvt_pk(hn[8 * j + 4] * r2 * g1[0], hn[8 * j + 5] * r2 * g1[1]); w.w = cvt_pk(hn[8 * j + 6] * r2 * g1[2], hn[8 * j + 7] * r2 * g1[3]);
                *(u32x4*)(U + (size_t)m * D + c) = w; }
        }
    }
}

template <int DQK, bool CAUSAL>
__device__ __forceinline__ void attn_unit(LAS unsigned char* lds, const bf16* __restrict__ Q, int ldq, const bf16* __restrict__ K1, int ldk1, const bf16* __restrict__ K2, int ldk2,
                                          const bf16* __restrict__ V, int ldv, bf16* __restrict__ O, int ldo, int qpos0, int ntiles) {
    constexpr int KROW = DQK * 2, KT = 64 * KROW, VT = 16384, ND0 = DQK / 16, NKC = DQK / 64;
    int tid = threadIdx.x; asm volatile("" : "+v"(tid));
    const int lane = tid & 63, wid = __builtin_amdgcn_readfirstlane(tid >> 6), r32 = lane & 31, hi = lane >> 5;
    LAS unsigned char* Kl = lds; LAS unsigned char* Vl = lds + 2 * KT;
    bf16x8 qr[ND0];
    { const bf16* qrow = Q + (size_t)(wid * 32 + r32) * ldq;
#pragma unroll
      for (int d0 = 0; d0 < ND0; ++d0) qr[d0] = *(const bf16x8*)(qrow + d0 * 16 + hi * 8); }
    unsigned ksoff[NKC]; int kdst[NKC];
#pragma unroll
    for (int i = 0; i < NKC; ++i) { int row, cc;
        if (i < 2) { const int c = tid + 512 * i; row = c >> 4; cc = c & 15; ksoff[i] = (unsigned)(row * ldk1 + cc * 8) * 2u; }
        else { row = tid >> 3; cc = 16 + (tid & 7); ksoff[i] = (unsigned)(row * ldk2 + (cc - 16) * 8) * 2u; }
        const int cs = DQK == 192 ? ((cc & ~7) | ((cc ^ (row >> 1)) & 7)) : (cc ^ (row & 15));
        kdst[i] = row * KROW + cs * 16; }
    unsigned vsoff[2]; int vdst[2];
#pragma unroll
    for (int i = 0; i < 2; ++i) { const int c = tid + 512 * i, row = c >> 4, cc = c & 15; vsoff[i] = (unsigned)(row * ldv + cc * 8) * 2u; vdst[i] = row * 256 + ((cc * 16) ^ ((row & 3) << 6)); }
    constexpr int NKO = DQK == 192 ? 4 : 8;
    int koff[NKO];
#pragma unroll
    for (int j = 0; j < NKO; ++j) { const int cc = 2 * j + hi; const int cs = DQK == 192 ? ((cc ^ (r32 >> 1)) & 7) : (cc ^ (r32 & 15)); koff[j] = r32 * KROW + cs * 16; }
#define AT_KOFF(d0) (DQK == 192 ? koff[(d0) & 3] + ((d0) >> 2) * 128 : koff[(d0) & 7])
    const int q4 = (lane & 15) >> 2, pp = lane & 3, blk = (lane >> 4) & 1;
    int voff[4];
#pragma unroll
    for (int d0 = 0; d0 < 4; ++d0) voff[d0] = (4 * hi + q4) * 256 + (((d0 ^ q4) << 6) | (blk << 5) | (pp << 3));
    u32x4 ks[NKC], vs[2];
#define AT_LOAD(t) do { const char* k1b = (const char*)K1 + (size_t)(t) * 64 * ldk1 * 2; const char* k2b = (const char*)K2 + (size_t)(t) * 64 * ldk2 * 2; const char* vb = (const char*)V + (size_t)(t) * 64 * ldv * 2; \
        _Pragma("unroll") for (int i = 0; i < NKC; ++i) ks[i] = *(const u32x4*)((i < 2 ? k1b : k2b) + ksoff[i]); \
        _Pragma("unroll") for (int i = 0; i < 2; ++i) vs[i] = *(const u32x4*)(vb + vsoff[i]); } while (0)
#define AT_WRITE(bf) do { _Pragma("unroll") for (int i = 0; i < NKC; ++i) *(LAS u32x4*)(Kl + (bf) * KT + kdst[i]) = ks[i]; \
        _Pragma("unroll") for (int i = 0; i < 2; ++i) *(LAS u32x4*)(Vl + (bf) * VT + vdst[i]) = vs[i]; } while (0)
    float m_run = -1e30f, l_run = 0.f; f32x16 o[4];
#pragma unroll
    for (int d0 = 0; d0 < 4; ++d0) o[d0] = (f32x16){};
    AT_LOAD(0); AT_WRITE(0);
    __syncthreads();
    const int qpos = qpos0 + wid * 32 + r32;
    for (int t = 0; t < ntiles; ++t) {
        const int bf = t & 1;
        if (t + 1 < ntiles) AT_LOAD(t + 1);
        f32x16 p0 = (f32x16){}, p1 = (f32x16){};
#pragma unroll
        for (int d0 = 0; d0 < ND0; ++d0) {
            const bf16x8 a0 = *(const LAS bf16x8*)(Kl + bf * KT + AT_KOFF(d0));
            const bf16x8 a1 = *(const LAS bf16x8*)(Kl + bf * KT + AT_KOFF(d0) + 32 * KROW);
            p0 = __builtin_amdgcn_mfma_f32_32x32x16_bf16(a0, qr[d0], p0, 0, 0, 0);
            p1 = __builtin_amdgcn_mfma_f32_32x32x16_bf16(a1, qr[d0], p1, 0, 0, 0);
        }
        if (CAUSAL) { const int kv0 = t * 64;
            if (kv0 + 63 > qpos0 + wid * 32) { const float NEG = -__builtin_inff();
#pragma unroll
                for (int r = 0; r < 16; ++r) { const int key = kv0 + crow(r, hi); if (key > qpos) p0[r] = NEG; if (key + 32 > qpos) p1[r] = NEG; } } }
        float mx = p0[0];
#pragma unroll
        for (int r = 1; r < 16; ++r) mx = fmaxf(mx, p0[r]);
#pragma unroll
        for (int r = 0; r < 16; ++r) mx = fmaxf(mx, p1[r]);
        { auto rr = __builtin_amdgcn_permlane32_swap(__float_as_uint(mx), __float_as_uint(mx), false, false); mx = fmaxf(__uint_as_float(rr[0]), __uint_as_float(rr[1])); }
        if (__any(mx > m_run + 8.f)) {
            const float mn = fmaxf(m_run, mx), alpha = __builtin_amdgcn_exp2f(m_run - mn); m_run = mn; l_run *= alpha;
#pragma unroll
            for (int d0 = 0; d0 < 4; ++d0)
#pragma unroll
                for (int r = 0; r < 16; ++r) o[d0][r] *= alpha;
        }
        float ps = 0.f;
#pragma unroll
        for (int r = 0; r < 16; ++r) { p0[r] = __builtin_amdgcn_exp2f(p0[r] - m_run); p1[r] = __builtin_amdgcn_exp2f(p1[r] - m_run); ps += p0[r] + p1[r]; }
        l_run += ps;
        bf16x8 pa[4];
        { u32x4 w;
          w.x = cvt_pk(p0[0], p0[1]); w.y = cvt_pk(p0[2], p0[3]); w.z = cvt_pk(p0[4], p0[5]); w.w = cvt_pk(p0[6], p0[7]); pa[0] = __builtin_bit_cast(bf16x8, w);
          w.x = cvt_pk(p0[8], p0[9]); w.y = cvt_pk(p0[10], p0[11]); w.z = cvt_pk(p0[12], p0[13]); w.w = cvt_pk(p0[14], p0[15]); pa[1] = __builtin_bit_cast(bf16x8, w);
          w.x = cvt_pk(p1[0], p1[1]); w.y = cvt_pk(p1[2], p1[3]); w.z = cvt_pk(p1[4], p1[5]); w.w = cvt_pk(p1[6], p1[7]); pa[2] = __builtin_bit_cast(bf16x8, w);
          w.x = cvt_pk(p1[8], p1[9]); w.y = cvt_pk(p1[10], p1[11]); w.z = cvt_pk(p1[12], p1[13]); w.w = cvt_pk(p1[14], p1[15]); pa[3] = __builtin_bit_cast(bf16x8, w); }
#pragma unroll
        for (int d0 = 0; d0 < 4; ++d0)
#pragma unroll
            for (int s = 0; s < 4; ++s) {
                const LAS unsigned char* vp = Vl + bf * VT + voff[d0] + s * 4096;
                const s16x4 lo = __builtin_bit_cast(s16x4, __builtin_amdgcn_ds_read_tr16_b64_v4i16((LAS v4i16_t*)vp));
                const s16x4 hh = __builtin_bit_cast(s16x4, __builtin_amdgcn_ds_read_tr16_b64_v4i16((LAS v4i16_t*)(vp + 2048)));
                const bf16x8 vf = (bf16x8){lo[0], lo[1], lo[2], lo[3], hh[0], hh[1], hh[2], hh[3]};
                o[d0] = __builtin_amdgcn_mfma_f32_32x32x16_bf16(vf, pa[s], o[d0], 0, 0, 0);
            }
        if (t + 1 < ntiles) AT_WRITE(bf ^ 1);
        __syncthreads();
    }
    { auto rr = __builtin_amdgcn_permlane32_swap(__float_as_uint(l_run), __float_as_uint(l_run), false, false); l_run = __uint_as_float(rr[0]) + __uint_as_float(rr[1]); }
    const float inv = __builtin_amdgcn_rcpf(l_run);
    bf16* orow = O + (size_t)(wid * 32 + r32) * ldo;
#pragma unroll
    for (int d0 = 0; d0 < 4; ++d0)
#pragma unroll
        for (int g = 0; g < 4; ++g) { u32x2 w; w.x = cvt_pk(o[d0][4 * g] * inv, o[d0][4 * g + 1] * inv); w.y = cvt_pk(o[d0][4 * g + 2] * inv, o[d0][4 * g + 3] * inv);
            *(u32x2*)(orow + d0 * 32 + 8 * g + 4 * hi) = w; }
#undef AT_LOAD
#undef AT_WRITE
#undef AT_KOFF
}

__global__ void __launch_bounds__(NTHR, 2) fwd(Args args) {
    extern __shared__ __attribute__((aligned(16))) unsigned char lds_raw[];
    Frame F;
    F.lds = (LAS unsigned char*)lds_raw;
    F.tid = threadIdx.x; F.lane = F.tid & 63; F.wave = __builtin_amdgcn_readfirstlane(F.tid >> 6);
    F.G = gridDim.x; { const int bx = blockIdx.x; F.vcu = (F.G % 8 == 0) ? (bx % 8) * (F.G / 8) + bx / 8 : bx; }
    F.ws = args.ws; F.H = args.out;
    volatile LAS unsigned* MISC = (volatile LAS unsigned*)(F.lds + MISC_OFF);
    for (int u = F.tid; u < (LDS_BYTES - LDSCTL_OFF) / 4; u += NTHR) ((LAS unsigned*)(F.lds + LDSCTL_OFF))[u] = 0u;
    __syncthreads();
    unsigned* ctl = (unsigned*)(F.ws + WS_CTL);
    XcdBarrier bar; bar.bar = ctl + CW_BAR; bar.x = 0; bar.st = nullptr;
    if (ONE_LAUNCH) bar = xcd_barrier_post(ctl + CW_BAR, MISC + 8);
    const int lo = args.lo, hi = args.hi;
#ifndef PH_MASK
#define PH_MASK 0xfffffu
#endif
#define PHON(j) (((PH_MASK) >> (j)) & 1u)
#define IN(k) (lo <= (k) && (k) < hi)
#define PHASE_RELOAD() do { t_ = threadIdx.x; asm volatile("" : "+v"(t_)); F.tid = t_; F.lane = t_ & 63; F.wave = __builtin_amdgcn_readfirstlane(t_ >> 6); \
        A = (ArgsP)__builtin_amdgcn_kernarg_segment_ptr(); asm volatile("" : "+s"(A)); F.ws = A->ws; F.H = A->out; \
        { int g_ = gridDim.x, b_ = blockIdx.x; asm volatile("" : "+s"(g_), "+s"(b_)); F.G = g_; F.bx = b_; F.vcu = (g_ % 8 == 0) ? (b_ % 8) * (g_ / 8) + b_ / 8 : b_; } } while (0)
#define PHASE_BEGIN() int t_; ArgsP A; PHASE_RELOAD()
#define SEAM(k) do { if (IN(k) && IN((k) + 1)) { if (ONE_LAUNCH) xcd_barrier(bar); } } while (0)

    if (PHON(0) && IN(0)) { PHASE_BEGIN(); p0_prologue(F, A); SEAM(0); }

    for (int l = 0; l < NL; ++l) {
        const int pb = 1 + l * NPH;
        if (PHON(1) && IN(pb + 0)) { PHASE_BEGIN();
            const int N = (l == 0) ? INW : PROJ_LD;
            pg8::Gemm g{WSP(bf16, WS_U), WSP(bf16, WL(WO_IN)), T, N, D, D, D}; pg8::StaticOrder S; S.init(T, N, F.G, F.bx);
            pg8::Epi8<FPlain> E{{WSP(bf16, WS_PROJ), PROJ_LD, 1.f}};
            pg8::gemm_phase(F.lds, g, S, E);
            {
                PHASE_RELOAD();
                const int rem = ((T / 256) * (N / 256)) % F.G;
                if (rem != 0 && F.bx >= rem) convert_layer(F, A, l, 2, (F.bx - rem) * NWAVES + F.wave, (F.G - rem) * NWAVES);
                else if (rem == 0) convert_layer(F, A, l, 2, F.bx * NWAVES + F.wave, F.G * NWAVES);
            }
            SEAM(pb + 0);
        }
        if (PHON(2) && IN(pb + 1)) { PHASE_BEGIN(); prep_phase(F, A, l); SEAM(pb + 1); }
        if (PHON(3) && IN(pb + 2)) { PHASE_BEGIN();
            {
            { pg8::Gemm g{WSP(bf16, WS_LORA), WSP(bf16, WL(WO_UP)), T, 1024, 128, LORA_LD, 128}; pg8::StaticOrder S; S.init(T, 1024, F.G, F.bx);
              pg8::Epi8<FSig<0>> E{{WSP(bf16, WS_WLOG), 1024, A->in[I_W0] + (size_t)l * 1024}}; pg8::gemm_phase(F.lds, g, S, E); }
            PHASE_RELOAD();
            { pg8::Gemm g{WSP(bf16, WS_LORA) + 128, WSP(bf16, WL(WO_AUP)), T, 1024, 128, LORA_LD, 128}; pg8::StaticOrder S; S.init(T, 1024, F.G, F.bx);
              pg8::Epi8<FSig<1>> E{{WSP(bf16, WS_AIC), 1024, A->in[I_A0] + (size_t)l * 1024}}; pg8::gemm_phase(F.lds, g, S, E); }
            PHASE_RELOAD();
            { pg8::Gemm g{WSP(bf16, WS_LORA) + 256, WSP(bf16, WL(WO_GUP)), T, 1024, 256, LORA_LD, 256}; pg8::StaticOrder S; S.init(T, 1024, F.G, F.bx);
              pg8::Epi8<FPlain> E{{WSP(bf16, WS_GATE), 1024, 1.f}}; pg8::gemm_phase(F.lds, g, S, E); }
            PHASE_RELOAD();
            if (l > 0) { pg8::Gemm g{WSP(bf16, WS_LORA) + 512, WSP(bf16, WL(WO_VUP)), T, 1024, 128, LORA_LD, 128}; pg8::StaticOrder S; S.init(T, 1024, F.G, F.bx);
              pg8::Epi8<FVup> E{{WSP(bf16, WS_VV), A->in[I_V0] + (size_t)(l - 1) * 1024, A->in[I_MU] + (size_t)l * RIN + 2048, WSP(bf16, WS_PROJ), WSP(bf16, WS_VF)}}; pg8::gemm_phase(F.lds, g, S, E); }
            PHASE_RELOAD();
            { pg8::Gemm g{WSP(bf16, WS_CQN), WSP(bf16, WL(WO_UQ)), T, 1536, 512, 512, 512}; pg8::StaticOrder S; S.init(T, 1536, F.G, F.bx);
              pg8::Epi8<FQ> E{{WSP(bf16, WS_QB), WSP(float, WS_COS), WSP(float, WS_SIN)}}; pg8::gemm_phase(F.lds, g, S, E); }
            PHASE_RELOAD();
            { pg8::Gemm g{WSP(bf16, WS_CKVN), WSP(bf16, WL(WO_UKV)), T, 2048, 256, 256, 256}; pg8::StaticOrder S; S.init(T, 2048, F.G, F.bx);
              pg8::Epi8<FPlain> E{{WSP(bf16, WS_KV), 2048, 1.f}}; pg8::gemm_phase(F.lds, g, S, E); }
            }
            SEAM(pb + 2);
        }
        if (PHON(4) && IN(pb + 3)) { PHASE_BEGIN();
            cs_pre_phase(F, A, l);
            SEAM(pb + 3);
        }
        if (PHON(5) && IN(pb + 4)) { PHASE_BEGIN();
            for (int u = F.vcu; u < 128; u += F.G) cs_seq_unit(F, u >> 1, u & 1);
            if (F.G > 128 && F.vcu >= 128) convert_layer(F, A, l, 3, (F.vcu - 128) * NWAVES + F.wave, (F.G - 128) * NWAVES);
            else if (F.G <= 128) convert_layer(F, A, l, 3, F.vcu * NWAVES + F.wave, F.G * NWAVES);
            __syncthreads();
        }
        if (PHON(6) && IN(pb + 5)) { PHASE_BEGIN();
            for (int u = F.vcu; u < 256; u += F.G) {
                const int bh = u >> 3, s = u & 7, b = bh >> 3, hh = bh & 7;
#pragma unroll 1
                for (int pass = 0; pass < 2; ++pass) {
                    const int qb = pass == 0 ? s : 15 - s; const size_t r0 = (size_t)b * SEQ;
                    attn_unit<192, true>(F.lds, WSP(bf16, WS_QB) + (r0 + qb * 256) * 1536 + hh * 192, 1536,
                                         WSP(bf16, WS_KV) + r0 * 2048 + hh * 256, 2048, WSP(bf16, WS_KR) + r0 * 64, 64,
                                         WSP(bf16, WS_KV) + r0 * 2048 + hh * 256 + 128, 2048,
                                         WSP(bf16, WS_U) + (r0 + qb * 256) * D + 1024 + hh * 128, D, qb * 256, 4 * (qb + 1));
                }
            }
            SEAM(pb + 5);
        }
        if (PHON(7) && IN(pb + 6)) { PHASE_BEGIN(); rwkv_post_phase(F, A, l); SEAM(pb + 6); }
        if (PHON(8) && IN(pb + 7)) { PHASE_BEGIN();
            pg8::Gemm g{WSP(bf16, WS_U), WSP(bf16, WL(WO_OUT)), T, D, D, D, D}; pg8::StaticOrder S; S.init(T, D, F.G, F.bx);
            pg8::Epi8<FPlain> E{{WSP(bf16, WS_Y), D, 1.f}}; pg8::gemm_phase(F.lds, g, S, E);
            SEAM(pb + 7);
        }
        if (PHON(9) && IN(pb + 8)) { PHASE_BEGIN(); ew_norm_phase(F, A->in[I_MIXPOST] + (size_t)l * D, A->in[I_MEMPRE] + (size_t)l * D, 3 * l); SEAM(pb + 8); }
        if (PHON(10) && IN(pb + 9)) { PHASE_BEGIN();
            pg8::Gemm g{WSP(bf16, WS_U), WSP(bf16, WL(WO_QM)), T, 512, D, D, D}; pg8::StaticOrder S; S.init(T, 512, F.G, F.bx);
            pg8::Epi8<FPlain> E{{WSP(bf16, WS_QMEM), 512, QSCALE_MEM}}; pg8::gemm_phase(F.lds, g, S, E);
            PHASE_RELOAD();
            { pg8::Gemm g2{WSP(bf16, WS_MEMN), WSP(bf16, WL(WO_KM)), NB * NMEM, 512, D, D, D}; pg8::StaticOrder S2; S2.init(NB * NMEM, 512, F.G, (F.bx + F.G - 128 % F.G) % F.G);
              pg8::Epi8<FPlain> E2{{WSP(bf16, WS_MEMK), 512, 1.f}}; pg8::gemm_phase(F.lds, g2, S2, E2); }
            PHASE_RELOAD();
            { pg8::Gemm g2{WSP(bf16, WS_MEMN), WSP(bf16, WL(WO_VM)), NB * NMEM, 512, D, D, D}; pg8::StaticOrder S2; S2.init(NB * NMEM, 512, F.G, (F.bx + F.G - 136 % F.G) % F.G);
              pg8::Epi8<FPlain> E2{{WSP(bf16, WS_MEMV), 512, 1.f}}; pg8::gemm_phase(F.lds, g2, S2, E2); }
            if (l + 1 < NL) { PHASE_RELOAD();
                if (F.G > 144 && F.bx >= 144) convert_layer(F, A, l + 1, 1, (F.bx - 144) * NWAVES + F.wave, (F.G - 144) * NWAVES);
                else if (F.G <= 144) convert_layer(F, A, l + 1, 1, F.bx * NWAVES + F.wave, F.G * NWAVES); }
            SEAM(pb + 9);
        }
        if (PHON(11) && IN(pb + 10)) { PHASE_BEGIN();
            for (int u = F.vcu; u < 256; u += F.G) {
                const int bh = u >> 4, qb = u & 15, b = bh >> 2, hh = bh & 3; const size_t r0 = (size_t)b * SEQ + qb * 256;
                attn_unit<128, false>(F.lds, WSP(bf16, WS_QMEM) + r0 * 512 + hh * 128, 512,
                                      WSP(bf16, WS_MEMK) + (size_t)b * NMEM * 512 + hh * 128, 512, nullptr, 0,
                                      WSP(bf16, WS_MEMV) + (size_t)b * NMEM * 512 + hh * 128, 512,
                                      WSP(bf16, WS_OMEM) + r0 * 512 + hh * 128, 512, 0, NMEM / 64);
            }
            SEAM(pb + 10);
        }
        if (PHON(12) && IN(pb + 11)) { PHASE_BEGIN();
            pg8::Gemm g{WSP(bf16, WS_OMEM), WSP(bf16, WL(WO_OM)), T, D, 512, 512, 512}; pg8::StaticOrder S; S.init(T, D, F.G, F.bx);
            pg8::Epi8<FPlain> E{{WSP(bf16, WS_Y), D, 1.f}}; pg8::gemm_phase(F.lds, g, S, E);
            SEAM(pb + 11);
        }
        if (PHON(13) && IN(pb + 12)) { PHASE_BEGIN(); ew_norm_phase(F, A->in[I_MEMPOST] + (size_t)l * D, A->in[I_FFNPRE] + (size_t)l * D, 3 * l + 1); SEAM(pb + 12); }
        if (PHON(14) && IN(pb + 13)) { PHASE_BEGIN();
            pg8::Gemm g{WSP(bf16, WS_U), WSP(bf16, WL(WO_FF1)), T, FF, D, D, D}; pg8::StaticOrder S; S.init(T, FF, F.G, F.bx);
            pg8::Epi8<FRelu2> E{{WSP(bf16, WS_HID), FF}}; pg8::gemm_phase(F.lds, g, S, E);
            SEAM(pb + 13);
        }
        if (PHON(15) && IN(pb + 14)) { PHASE_BEGIN();
            pg8::Gemm g{WSP(bf16, WS_HID), WSP(bf16, WL(WO_FF2)), T, D, FF, FF, FF}; pg8::StaticOrder S; S.init(T, D, F.G, F.bx);
            pg8::Epi8<FPlain> E{{WSP(bf16, WS_Y), D, 1.f}}; pg8::gemm_phase(F.lds, g, S, E);
            SEAM(pb + 14);
        }
        if (PHON(16) && IN(pb + 15)) { PHASE_BEGIN(); ew_norm_phase(F, A->in[I_FFNPOST] + (size_t)l * D, l + 1 < NL ? A->in[I_MIXPRE] + (size_t)(l + 1) * D : nullptr, 3 * l + 2); SEAM(pb + 15); }
    }
#undef IN
#undef SEAM
}

extern "C" void kernel_launch(void* const* d_in, const int* in_sizes, int n_in, void* d_out, int out_size, void* d_ws, size_t ws_size, hipStream_t stream) {
    static int grid = 0;
    if (grid == 0) {
        if (n_in != N_IN || out_size != T * D || ws_size < WS_END) { fprintf(stderr, "kernel_launch: unexpected shapes (n_in %d, out %d, ws %zu)\n", n_in, out_size, ws_size); grid = -1; return; }
        int dev = 0, cus = 0;
        if (hipGetDevice(&dev) != hipSuccess || hipDeviceGetAttribute(&cus, hipDeviceAttributeMultiprocessorCount, dev) != hipSuccess) { grid = -1; return; }
        if (hipFuncSetAttribute((const void*)fwd, hipFuncAttributeMaxDynamicSharedMemorySize, LDS_BYTES) != hipSuccess) { fprintf(stderr, "kernel_launch: hipFuncSetAttribute failed\n"); grid = -1; return; }
        int per_cu = 0;
        if (hipOccupancyMaxActiveBlocksPerMultiprocessor(&per_cu, (const void*)fwd, NTHR, LDS_BYTES) != hipSuccess || per_cu < 1) fprintf(stderr, "kernel_launch: occupancy query says %d\n", per_cu);
        (void)hipGetLastError();
        grid = cus;
    }
    if (grid < 0) return;
    (void)hipMemsetAsync((char*)d_ws + WS_CTL, 0, CTL_BYTES, stream);
    Args a{};
    for (int i = 0; i < N_IN; ++i) a.in[i] = (const float*)d_in[i];
    a.out = (float*)d_out; a.ws = (unsigned char*)d_ws;
    const int nph = NPHASES < STOP_PHASE ? NPHASES : STOP_PHASE;
    if (ONE_LAUNCH) { a.lo = 0; a.hi = nph; hipLaunchKernelGGL(fwd, dim3(grid), dim3(NTHR), LDS_BYTES, stream, a); }
    else { for (int p = 0; p < nph; ++p) { a.lo = p; a.hi = p + 1; hipLaunchKernelGGL(fwd, dim3(grid), dim3(NTHR), LDS_BYTES, stream, a); } }
}
```

```cpp
#include <hip/hip_runtime.h>
#include <cstdio>
#include <cstdint>

#define GAS __attribute__((address_space(1)))
#define LAS __attribute__((address_space(3)))
typedef unsigned short bf16;
typedef short bf16x8 __attribute__((ext_vector_type(8)));
typedef short s16x4 __attribute__((ext_vector_type(4)));
typedef float f32x2 __attribute__((ext_vector_type(2)));
typedef float f32x4 __attribute__((ext_vector_type(4)));
typedef float f32x16 __attribute__((ext_vector_type(16)));
typedef unsigned u32x2 __attribute__((ext_vector_type(2)));
typedef unsigned u32x4 __attribute__((ext_vector_type(4)));
typedef __bf16 bf16x2_t __attribute__((ext_vector_type(2)));

#ifndef ONE_LAUNCH
#define ONE_LAUNCH 1
#endif
#ifndef STOP_PHASE
#define STOP_PHASE 1000
#endif

constexpr int T = 16384, SEQ = 4096, NB = 4, D = 2048, NL = 4, FF = 8192;
constexpr int RIN = 3520, INW = 4352, PROJ_LD = 4608;
constexpr int NMEM = 256;
constexpr float NORM_EPS = 1e-6f, GN_EPS = 64e-5f;
constexpr float QSCALE_MLA = 0.07216878364870323f * 1.4426950408889634f;
constexpr float QSCALE_MEM = 0.08838834764831845f * 1.4426950408889634f;
constexpr int NWAVES = 8, NTHR = 512;
constexpr int NPH = 16, NPHASES = 1 + NL * NPH;

enum { I_X = 0, I_MEM, I_MEMG, I_MIXPRE, I_WIN, I_WINV, I_MU, I_MUV, I_W0, I_WUP, I_A0, I_AUP, I_V0, I_VUP, I_GUP, I_KK, I_KA, I_RK, I_LNG, I_LNB,
       I_QNG, I_WUQ, I_KVNG, I_WUKV, I_WOUT, I_MIXPOST, I_MEMPRE, I_WQM, I_WKM, I_WVM, I_WOM, I_MEMPOST, I_FFNPRE, I_FF1, I_FF2, I_FFNPOST, N_IN };

constexpr size_t KiB = 1024, MiB = 1024 * 1024;
constexpr size_t WS_CTL = 0, CTL_BYTES = 1 * MiB;
constexpr size_t WS_COS = 1 * MiB, WS_SIN = 1 * MiB + 512 * KiB;
constexpr size_t WS_MEMN = 2 * MiB, WS_MEMK = 6 * MiB, WS_MEMV = 7 * MiB, WS_RKB = 8 * MiB;
constexpr size_t WS_W = 16 * MiB, W_LSTRIDE = 38 * MiB;
constexpr size_t WS_WFF = 92 * MiB;
constexpr size_t WS_HB = 156 * MiB;
constexpr size_t WS_SCAN = 220 * MiB;
constexpr size_t WO_IN = 0, WO_UP = 18 * MiB, WO_AUP = 18 * MiB + 256 * KiB, WO_GUP = 18 * MiB + 512 * KiB, WO_VUP = 19 * MiB, WO_UQ = 19 * MiB + 512 * KiB,
                 WO_UKV = 21 * MiB, WO_OUT = 22 * MiB, WO_QM = 30 * MiB, WO_KM = 32 * MiB, WO_VM = 34 * MiB, WO_OM = 36 * MiB, WO_FF1 = 38 * MiB, WO_FF2 = 70 * MiB;
constexpr size_t WS_U = 424 * MiB, WS_Y = 488 * MiB, WS_VF = 552 * MiB;
constexpr size_t WS_PROJ = 584 * MiB, WS_LORA = 728 * MiB, WS_WLOG = 748 * MiB, WS_AIC = 780 * MiB, WS_GATE = 812 * MiB, WS_VV = 844 * MiB,
                 WS_CQN = 876 * MiB, WS_CKVN = 892 * MiB, WS_KR = 900 * MiB, WS_QB = 902 * MiB, WS_KV = 950 * MiB, WS_END = 1014 * MiB;
constexpr size_t WS_HID = 584 * MiB, WS_QMEM = 840 * MiB, WS_OMEM = 856 * MiB;
constexpr int LORA_LD = 640;
constexpr int CW_TMO = 0, CW_BAR = 4096;

constexpr int RING_BYTES = 163328, LDSCTL_OFF = RING_BYTES, MISC_OFF = LDSCTL_OFF + 320, LDS_BYTES = 163840;

__device__ __forceinline__ unsigned cvt_pk(float lo, float hi) { f32x2 v = {lo, hi}; bf16x2_t b = __builtin_convertvector(v, bf16x2_t); return __builtin_bit_cast(unsigned, b); }
__device__ __forceinline__ float bflo(unsigned w) { return __uint_as_float(w << 16); }
__device__ __forceinline__ float bfhi(unsigned w) { return __uint_as_float(w & 0xffff0000u); }
__device__ __forceinline__ float bf1(bf16 b) { return __uint_as_float((unsigned)b << 16); }
__device__ __forceinline__ bf16 f2bf(float f) { return (bf16)(cvt_pk(f, 0.f) & 0xffffu); }
template <int CTRL> __device__ __forceinline__ float dpp_add(float x) { return x + __int_as_float(__builtin_amdgcn_update_dpp(0, __float_as_int(x), CTRL, 0xf, 0xf, true)); }
__device__ __forceinline__ float sum4(float x) { x = dpp_add<0xB1>(x); x = dpp_add<0x4E>(x); return x; }
__device__ __forceinline__ float sum8(float x) { x = sum4(x); x = dpp_add<0x141>(x); return x; }
__device__ __forceinline__ float sum16(float x) { x = sum8(x); x = dpp_add<0x140>(x); return x; }
__device__ __forceinline__ float wave_sum(float x) {
    x = sum16(x);
    { auto r = __builtin_amdgcn_permlane16_swap(__float_as_uint(x), __float_as_uint(x), false, false); x = __uint_as_float(r[0]) + __uint_as_float(r[1]); }
    { auto r = __builtin_amdgcn_permlane32_swap(__float_as_uint(x), __float_as_uint(x), false, false); x = __uint_as_float(r[0]) + __uint_as_float(r[1]); }
    return x;
}
__device__ __forceinline__ float sigmoidf_(float x) { return __builtin_amdgcn_rcpf(1.f + __builtin_amdgcn_exp2f(-1.4426950408889634f * x)); }
__device__ __forceinline__ float tanhf_(float x) { const float e = __builtin_amdgcn_exp2f(-2.f * 1.4426950408889634f * fabsf(x)); const float t = (1.f - e) * __builtin_amdgcn_rcpf(1.f + e); return x < 0.f ? -t : t; }
__device__ __forceinline__ void unpack8(u32x4 w, float (&f)[8]) {
    f[0] = bflo(w.x); f[1] = bfhi(w.x); f[2] = bflo(w.y); f[3] = bfhi(w.y); f[4] = bflo(w.z); f[5] = bfhi(w.z); f[6] = bflo(w.w); f[7] = bfhi(w.w);
}
__device__ __forceinline__ u32x4 pack8(const float (&f)[8]) { u32x4 w; w.x = cvt_pk(f[0], f[1]); w.y = cvt_pk(f[2], f[3]); w.z = cvt_pk(f[4], f[5]); w.w = cvt_pk(f[6], f[7]); return w; }

__device__ __forceinline__ int crow(int r, int hi) { return (r & 3) + 8 * (r >> 2) + 4 * hi; }
typedef short v4i16_t __attribute__((ext_vector_type(4)));

namespace pg8 {
#define PG8_LAS __attribute__((address_space(3)))
typedef unsigned short bf16_t;
constexpr int BM = 256, BK = 64, HALF = 128, HTB = HALF * BK * 2, STAGE_BYTES = 8 * HTB, NXCD = 8, WGM = 4;
__host__ __device__ __forceinline__ int lds_byte(int r, int c) { const int st = (r >> 4) * 2 + (c >> 5), rr = r & 15, cc = c & 31, ob = rr * 64 + cc * 2; return st * 1024 + (ob ^ (((ob >> 9) & 1) << 5)); }
__host__ __device__ __forceinline__ void stage_rc(int b, int& R, int& C) { const int st = b / 1024, sb = b % 1024, swz = sb ^ (((sb >> 9) & 1) << 5); R = (st >> 1) * 16 + swz / 64; C = (st & 1) * 32 + (swz % 64) / 2; }
__host__ __device__ __forceinline__ int perm32(int rho) { const int n = rho >> 4, i = rho & 15; return 8 * (i >> 2) + 4 * n + (i & 3); }
struct Unit { int pm, pn; };
struct Gemm { const bf16_t* A; const bf16_t* Bt; int M, N, K, lda, ldb; };
struct StaticOrder {
    int nM, nN, nwg, G, c;
    __host__ __device__ __forceinline__ void init(int M, int N, int G_, int c_) { nM = M / BM; nN = N / BM; nwg = nM * nN; G = G_; c = c_; }
    __host__ __device__ __forceinline__ bool next(int i, Unit& u) const {
        const long L = (long)i * G + c; if (L >= nwg) return false;
        int wgid = (int)L; { const int q = nwg / NXCD, r = nwg % NXCD, xcd = wgid % NXCD, off = wgid / NXCD; wgid = (xcd < r ? xcd * (q + 1) : r * (q + 1) + (xcd - r) * q) + off; }
        const int nig = WGM * nN, gid = wgid / nig, fm = gid * WGM, gsz = (nM - fm) < WGM ? (nM - fm) : WGM;
        u.pm = fm + ((wgid % nig) % gsz); u.pn = (wgid % nig) / gsz; return true;
    }
};
template <class F> struct Epi8 {
    F f;
    __device__ __forceinline__ void operator()(const f32x4 (&acc)[2][2][4][2], const Unit& u, int wr, int wc, int fr, int fq) const {
        const int row0 = u.pm * BM + wr * 64 + fr, col0 = u.pn * BM + wc * 32 + 8 * fq;
#pragma unroll
        for (int ai = 0; ai < 2; ++ai)
#pragma unroll
            for (int m = 0; m < 4; ++m)
#pragma unroll
                for (int bj = 0; bj < 2; ++bj) { f(row0 + ai * HALF + m * 16, col0 + bj * HALF, acc[ai][bj][m][0], acc[ai][bj][m][1]); if (F::HEAVY) __builtin_amdgcn_sched_barrier(0); }
    }
};

template <class Epi>
__device__ __forceinline__ void gemm_phase(PG8_LAS unsigned char* lds, const Gemm g, const StaticOrder& S, const Epi& E) {
    int tid = threadIdx.x; asm volatile("" : "+v"(tid));
    const int wid = __builtin_amdgcn_readfirstlane(tid >> 6), lane = tid & 63, wr = wid >> 2, wc = wid & 3, fr = lane & 15, fq = lane >> 4;
    int K = g.K; asm volatile("" : "+s"(K));
    const int nt = K / BK;
    unsigned voffA[2], voffB[2];
#pragma unroll
    for (int i = 0; i < 2; ++i) { int R, C; stage_rc(tid * 16 + i * 8192, R, C); const int Rb = (R & ~31) + perm32(R & 31);
        voffA[i] = (unsigned)(R * g.lda + C) * 2u; voffB[i] = (unsigned)(Rb * g.ldb + C) * 2u; }
    const size_t kstep = (size_t)(BK * 2);
    const size_t hsA = (size_t)HALF * g.lda * 2, hsB = (size_t)HALF * g.ldb * 2;
    const size_t tsA = 2 * hsA, tsB = 2 * hsB;
    const unsigned ldsw = (unsigned)wid * 1024u;
    const int aoff = lds_byte(wr * 64 + fr, fq * 8), boff = lds_byte(wc * 32 + fr, fq * 8);
#define PG8_SA(b, h) (((b) * 2 + (h)) * HTB)
#define PG8_SB(b, h) ((4 + (b) * 2 + (h)) * HTB)
#define PG8_STAGE(bufoff, gbase, voff) do { _Pragma("unroll") for (int _i = 0; _i < 2; ++_i) \
        __builtin_amdgcn_global_load_lds((const unsigned*)((const char*)(gbase) + (voff)[_i]), (PG8_LAS unsigned*)(lds + (bufoff) + ldsw + _i * 8192), 16, 0, 0); } while (0)
#define PG8_LDA(dst, b, h) do { _Pragma("unroll") for (int m = 0; m < 4; ++m) _Pragma("unroll") for (int k = 0; k < 2; ++k) dst[m][k] = *(const PG8_LAS bf16x8*)(lds + PG8_SA(b, h) + aoff + m * 2048 + k * 1024); } while (0)
#define PG8_LDB(dst, b, h) do { _Pragma("unroll") for (int n = 0; n < 2; ++n) _Pragma("unroll") for (int k = 0; k < 2; ++k) dst[n][k] = *(const PG8_LAS bf16x8*)(lds + PG8_SB(b, h) + boff + n * 2048 + k * 1024); } while (0)
#define PG8_MMA(ai, bj, At, Bt) do { __builtin_amdgcn_s_setprio(1); _Pragma("unroll") for (int m = 0; m < 4; ++m) _Pragma("unroll") for (int n = 0; n < 2; ++n) _Pragma("unroll") for (int k = 0; k < 2; ++k) \
        acc[ai][bj][m][n] = __builtin_amdgcn_mfma_f32_16x16x32_bf16(Bt[n][k], At[m][k], acc[ai][bj][m][n], 0, 0, 0); __builtin_amdgcn_s_setprio(0); } while (0)
#define PG8_WAIT_V(n) asm volatile("s_waitcnt vmcnt(" #n ")" ::: "memory")
#define PG8_WAIT_L(n) asm volatile("s_waitcnt lgkmcnt(" #n ")" ::: "memory")
#define PG8_BAR __builtin_amdgcn_s_barrier()
#define PG8_SCHED __builtin_amdgcn_sched_barrier(0)
    Unit cur, nxt; int ui = 0;
    if (!S.next(0, cur)) return;
    f32x4 acc[2][2][4][2];
#pragma unroll
    for (int a = 0; a < 2; ++a)
#pragma unroll
        for (int b = 0; b < 2; ++b)
#pragma unroll
            for (int m = 0; m < 4; ++m)
#pragma unroll
                for (int n = 0; n < 2; ++n) acc[a][b][m][n] = (f32x4){0.f, 0.f, 0.f, 0.f};
    bf16x8 At[4][2], B0[2][2], B1[2][2];
    const char* cA = (const char*)g.A + (size_t)cur.pm * tsA; const char* cB = (const char*)g.Bt + (size_t)cur.pn * tsB;
    PG8_STAGE(PG8_SB(0, 0), cB, voffB); PG8_STAGE(PG8_SB(0, 1), cB + hsB, voffB); PG8_STAGE(PG8_SA(0, 0), cA, voffA); PG8_STAGE(PG8_SA(0, 1), cA + hsA, voffA);
    if (wr == 1) PG8_BAR;
    PG8_WAIT_V(2); PG8_BAR;
    PG8_STAGE(PG8_SB(1, 0), cB + kstep, voffB); PG8_STAGE(PG8_SA(1, 0), cA + kstep, voffA); PG8_STAGE(PG8_SB(1, 1), cB + hsB + kstep, voffB);
    PG8_WAIT_V(6); PG8_BAR;
    for (;;) {
        const bool has_next = S.next(ui + 1, nxt);
        const char* nA = has_next ? (const char*)g.A + (size_t)nxt.pm * tsA : cA; const char* nB = has_next ? (const char*)g.Bt + (size_t)nxt.pn * tsB : cB;
        for (int t = 0; t < nt; t += 2) {
            const bool last = (t == nt - 2);
            const char* a1 = cA + (size_t)(t + 1) * kstep;
            const char* a2 = last ? nA : cA + (size_t)(t + 2) * kstep; const char* b2 = last ? nB : cB + (size_t)(t + 2) * kstep;
            const char* a3 = a2 + kstep; const char* b3 = b2 + kstep;
            PG8_LDB(B0, 0, 0); PG8_LDB(B1, 0, 1); PG8_SCHED; PG8_LDA(At, 0, 0); PG8_STAGE(PG8_SA(1, 1), a1 + hsA, voffA);
            PG8_WAIT_V(8); PG8_WAIT_L(0); PG8_BAR; PG8_MMA(0, 0, At, B0); PG8_MMA(0, 1, At, B1); PG8_BAR; PG8_SCHED;
            PG8_LDA(At, 0, 1); PG8_STAGE(PG8_SB(0, 0), b2, voffB); PG8_STAGE(PG8_SB(0, 1), b2 + hsB, voffB); PG8_STAGE(PG8_SA(0, 0), a2, voffA);
            PG8_WAIT_V(8); PG8_WAIT_L(0); PG8_BAR; PG8_MMA(1, 0, At, B0); PG8_MMA(1, 1, At, B1); PG8_BAR; PG8_SCHED;
            PG8_LDB(B0, 1, 0); PG8_LDB(B1, 1, 1); PG8_SCHED; PG8_LDA(At, 1, 0); PG8_STAGE(PG8_SA(0, 1), a2 + hsA, voffA);
            PG8_WAIT_V(8); PG8_WAIT_L(0); PG8_BAR; PG8_MMA(0, 0, At, B0); PG8_MMA(0, 1, At, B1); PG8_BAR; PG8_SCHED;
            PG8_LDA(At, 1, 1); PG8_STAGE(PG8_SB(1, 0), b3, voffB); PG8_STAGE(PG8_SB(1, 1), b3 + hsB, voffB); PG8_STAGE(PG8_SA(1, 0), a3, voffA);
            PG8_WAIT_V(8); PG8_WAIT_L(0); PG8_BAR; PG8_MMA(1, 0, At, B0); PG8_MMA(1, 1, At, B1); PG8_BAR; PG8_SCHED;
        }
        if (wr == 0) PG8_BAR;
        E(acc, cur, wr, wc, fr, fq);
        if (!has_next) break;
#pragma unroll
        for (int a = 0; a < 2; ++a)
#pragma unroll
            for (int b = 0; b < 2; ++b)
#pragma unroll
                for (int m = 0; m < 4; ++m)
#pragma unroll
                    for (int n = 0; n < 2; ++n) acc[a][b][m][n] = (f32x4){0.f, 0.f, 0.f, 0.f};
        cur = nxt; cA = nA; cB = nB; ++ui;
        if (wr == 1) PG8_BAR;
    }
    PG8_WAIT_V(0);
    PG8_BAR;
#undef PG8_SA
#undef PG8_SB
#undef PG8_STAGE
#undef PG8_LDA
#undef PG8_LDB
#undef PG8_MMA
#undef PG8_WAIT_V
#undef PG8_WAIT_L
#undef PG8_BAR
#undef PG8_SCHED
}
}

__device__ __forceinline__ void st16_wt(void* p, u32x4 w) { asm volatile("global_store_dwordx4 %0, %1, off sc1\n\ts_nop 1" :: "v"(p), "v"(w) : "memory"); }
struct FPlain { static constexpr bool HEAVY = false; bf16* O; int ld; float sc;
    __device__ __forceinline__ void operator()(int row, int col, f32x4 a, f32x4 b) const {
        u32x4 w; w.x = cvt_pk(a[0] * sc, a[1] * sc); w.y = cvt_pk(a[2] * sc, a[3] * sc); w.z = cvt_pk(b[0] * sc, b[1] * sc); w.w = cvt_pk(b[2] * sc, b[3] * sc);
        st16_wt(O + (size_t)row * ld + col, w); } };
struct FRelu2 { static constexpr bool HEAVY = false; bf16* O; int ld;
    __device__ __forceinline__ void operator()(int row, int col, f32x4 a, f32x4 b) const {
        float v[8] = {a[0], a[1], a[2], a[3], b[0], b[1], b[2], b[3]};
#pragma unroll
        for (int i = 0; i < 8; ++i) { const float r = fmaxf(v[i], 0.f); v[i] = r * r; }
        st16_wt(O + (size_t)row * ld + col, pack8(v)); } };
template <int MODE> struct FSig { static constexpr bool HEAVY = true; bf16* O; int ld; const float* bias;
    __device__ __forceinline__ void operator()(int row, int col, f32x4 a, f32x4 b) const {
        const f32x4 b0 = *(const f32x4*)(bias + col), b1 = *(const f32x4*)(bias + col + 4);
        float v[8] = {a[0] + b0[0], a[1] + b0[1], a[2] + b0[2], a[3] + b0[3], b[0] + b1[0], b[1] + b1[1], b[2] + b1[2], b[3] + b1[3]};
#pragma unroll
        for (int i = 0; i < 8; ++i) { const float s = sigmoidf_(v[i]); v[i] = MODE == 0 ? -0.6065306597126334f * s : s; }
        *(u32x4*)(O + (size_t)row * ld + col) = pack8(v); } };
struct FVup { static constexpr bool HEAVY = true; bf16* O; const float* v0; const float* mu; const bf16* proj; const bf16* vfirst;
    __device__ __forceinline__ void operator()(int row, int col, f32x4 a, f32x4 b) const {
        const f32x4 b0 = *(const f32x4*)(v0 + col), b1 = *(const f32x4*)(v0 + col + 4), m0 = *(const f32x4*)(mu + col), m1 = *(const f32x4*)(mu + col + 4);
        float cur[8], prv[8], vf[8];
        unpack8(*(const u32x4*)(proj + (size_t)row * PROJ_LD + 2048 + col), cur);
        if ((row & (SEQ - 1)) != 0) unpack8(*(const u32x4*)(proj + (size_t)(row - 1) * PROJ_LD + 2048 + col), prv);
        else {
#pragma unroll
            for (int i = 0; i < 8; ++i) prv[i] = 0.f; }
        unpack8(*(const u32x4*)(vfirst + (size_t)row * 1024 + col), vf);
        const float acc8[8] = {a[0] + b0[0], a[1] + b0[1], a[2] + b0[2], a[3] + b0[3], b[0] + b1[0], b[1] + b1[1], b[2] + b1[2], b[3] + b1[3]};
        const float mu8[8] = {m0[0], m0[1], m0[2], m0[3], m1[0], m1[1], m1[2], m1[3]};
        float v[8];
#pragma unroll
        for (int i = 0; i < 8; ++i) { const float vs = cur[i] + (prv[i] - cur[i]) * mu8[i]; v[i] = vs + (vf[i] - vs) * sigmoidf_(acc8[i]); }
        *(u32x4*)(O + (size_t)row * 1024 + col) = pack8(v); } };
struct FQ { static constexpr bool HEAVY = true; bf16* O; const float* cosT; const float* sinT;
    __device__ __forceinline__ void operator()(int row, int col, f32x4 a, f32x4 b) const {
        const int cc = col % 192;
        float v[8] = {a[0], a[1], a[2], a[3], b[0], b[1], b[2], b[3]};
        if (cc >= 128) { const int i0 = (cc - 128) >> 1, pos = row & (SEQ - 1);
            const f32x4 c = *(const f32x4*)(cosT + pos * 32 + i0), s = *(const f32x4*)(sinT + pos * 32 + i0);
#pragma unroll
            for (int i = 0; i < 4; ++i) { const float x1 = v[2 * i], x2 = v[2 * i + 1]; v[2 * i] = x1 * c[i] - x2 * s[i]; v[2 * i + 1] = x1 * s[i] + x2 * c[i]; } }
#pragma unroll
        for (int i = 0; i < 8; ++i) v[i] *= QSCALE_MLA;
        *(u32x4*)(O + (size_t)row * 1536 + col) = pack8(v); } };

#define XB_TMO      128
#define XB_XCNT(j)  (256  + 64 * (j))
#define XB_XSUB(j)  (1280 + 64 * (j))
#define XB_XGEN(j)  (2304 + 64 * (j))
#define XB_TOP      3328
#define XB_TOPGEN   3392
#define XCD_BAR_WORDS 3456
#define XB_SPIN_CAP (1u << 20)
__device__ __forceinline__ unsigned xb_ld(unsigned* p)              { return __hip_atomic_load(p, __ATOMIC_RELAXED, __HIP_MEMORY_SCOPE_AGENT); }
__device__ __forceinline__ unsigned xb_add(unsigned* p, unsigned v) { return __hip_atomic_fetch_add(p, v, __ATOMIC_RELAXED, __HIP_MEMORY_SCOPE_AGENT); }
__device__ __forceinline__ unsigned xb_xcc_id() { return (unsigned)__builtin_amdgcn_s_getreg((3 << 11) | 20) & 0xFu; }
#define XB_SPIN(cond, bar) do { unsigned _sp = 0; while (cond) { __builtin_amdgcn_s_sleep(1); \
    if ((++_sp & 255u) == 0u) { if (xb_ld(&(bar)[XB_TMO])) break; if (_sp > XB_SPIN_CAP) { atomicAdd(&(bar)[XB_TMO], 1u); break; } } } } while (0)
struct XcdBarrier { unsigned* bar; unsigned x; volatile LAS unsigned* st; };
__device__ __forceinline__ XcdBarrier xcd_barrier_post(unsigned* bar, volatile LAS unsigned* st) {
    XcdBarrier b; b.bar = bar; b.x = xb_xcc_id(); b.st = st;
    if (threadIdx.x == 0) (void)xb_add(&bar[XB_XCNT(b.x)], 1u);
    return b;
}
__device__ __forceinline__ void xcd_barrier_complete(unsigned* bar, unsigned x, unsigned& nloc, unsigned& nx) {
    const unsigned G = gridDim.x * gridDim.y * gridDim.z;
    unsigned sum, cnt, mine, sp = 0u;
    for (;;) {
        sum = 0u; cnt = 0u; mine = 0u;
#pragma unroll
        for (unsigned j = 0; j < 16; ++j) { const unsigned c = xb_ld(&bar[XB_XCNT(j)]); sum += c; cnt += (c > 0u) ? 1u : 0u; mine = (j == x) ? c : mine; }
        if (sum == G) break;
        __builtin_amdgcn_s_sleep(1);
        if ((++sp & 255u) == 0u) { if (xb_ld(&bar[XB_TMO])) break; if (sp > XB_SPIN_CAP) { atomicAdd(&bar[XB_TMO], 1u); break; } }
    }
    nloc = mine > 0u ? mine : 1u; nx = cnt > 0u ? cnt : 1u;
}
__device__ __forceinline__ void xcd_barrier(const XcdBarrier& b) {
    asm volatile("s_waitcnt vmcnt(0)" ::: "memory");
    __syncthreads();
    if (threadIdx.x == 0) {
        unsigned* bar = b.bar;
        __builtin_amdgcn_s_waitcnt(0);
        unsigned nloc = b.st[0], nx = b.st[1];
        if (nloc == 0u) { xcd_barrier_complete(bar, b.x, nloc, nx); b.st[0] = nloc; b.st[1] = nx; }
        const unsigned old = xb_add(&bar[XB_XSUB(b.x)], 1u);
        const unsigned gen = old / nloc;
        if (old + 1u == (gen + 1u) * nloc) {
            __builtin_amdgcn_fence(__ATOMIC_RELEASE, "agent");
            asm volatile("s_waitcnt vmcnt(0)" ::: "memory");
            const unsigned og = xb_add(&bar[XB_TOP], 1u);
            const unsigned tg = og / nx;
            if (og + 1u == (tg + 1u) * nx) xb_add(&bar[XB_TOPGEN], 1u);
            else XB_SPIN(xb_ld(&bar[XB_TOPGEN]) == tg, bar);
            __builtin_amdgcn_fence(__ATOMIC_ACQUIRE, "agent");
            xb_add(&bar[XB_XGEN(b.x)], 1u);
            asm volatile("s_waitcnt vmcnt(0)" ::: "memory");
        } else {
            XB_SPIN(xb_ld(&bar[XB_XGEN(b.x)]) == gen, bar);
            __builtin_amdgcn_fence(__ATOMIC_ACQUIRE, "agent");
            asm volatile("s_waitcnt vmcnt(0)" ::: "memory");
        }
    }
    __syncthreads();
}

struct Args { const float* in[N_IN]; float* out; unsigned char* ws; int lo, hi; };
typedef const __attribute__((address_space(4))) Args* ArgsP;
struct Frame {
    LAS unsigned char* lds;
    int tid, lane, wave, vcu, G, bx;
    unsigned char* ws;
    float* H;
};
#define WSP(type, off) ((type*)(F.ws + (off)))
#define WL(off) ((off) >= WO_FF1 ? WS_WFF + ((off) - WO_FF1) : WS_W + (size_t)(l & 1) * W_LSTRIDE + (off))

__constant__ int JK[11] = {2048, 2048, 256, 256, 2048, 2048, 2048, 2048, 512, 2048, 8192};
__constant__ int JN[11] = {4352, 64, 1024, 2048, 2048, 512, 512, 512, 2048, 8192, 2048};
__constant__ int JIN[11] = {I_WIN, I_WINV, I_GUP, I_WUKV, I_WOUT, I_WQM, I_WKM, I_WVM, I_WOM, I_FF1, I_FF2};
__constant__ unsigned JDST[11] = {(unsigned)(WO_IN / KiB), (unsigned)(WO_IN / KiB), (unsigned)(WO_GUP / KiB), (unsigned)(WO_UKV / KiB), (unsigned)(WO_OUT / KiB), (unsigned)(WO_QM / KiB),
                                  (unsigned)(WO_KM / KiB), (unsigned)(WO_VM / KiB), (unsigned)(WO_OM / KiB), (unsigned)(WO_FF1 / KiB), (unsigned)(WO_FF2 / KiB)};
__device__ __forceinline__ void p0_transpose_item(const float* W, int K, int N, bf16* WT, int ldk, int row_off, LAS float* scr, int item, int lane) {
    const int nblk = N / 32, kb = item / nblk, nb = item % nblk, k0 = 64 * kb, n0 = 32 * nb;
#pragma unroll 8
    for (int i = 0; i < 32; ++i) { const int kk = 2 * i + (lane >> 5); scr[kk * 33 + (lane & 31)] = W[(size_t)(k0 + kk) * N + n0 + (lane & 31)]; }
    asm volatile("s_waitcnt lgkmcnt(0)" ::: "memory");
    const int c = lane & 7;
#pragma unroll
    for (int j = 0; j < 4; ++j) { const int n = (lane >> 3) + 8 * j; const LAS float* s = scr + (8 * c) * 33 + n;
        u32x4 o; o.x = cvt_pk(s[0 * 33], s[1 * 33]); o.y = cvt_pk(s[2 * 33], s[3 * 33]); o.z = cvt_pk(s[4 * 33], s[5 * 33]); o.w = cvt_pk(s[6 * 33], s[7 * 33]);
        *(u32x4*)(WT + (size_t)(row_off + n0 + n) * ldk + k0 + 8 * c) = o; }
    asm volatile("s_waitcnt lgkmcnt(0)" ::: "memory");
}
__device__ __forceinline__ void rms_row_2048(const float* xrow, const float* g, bf16* orow, bf16* copy, int lane) {
    f32x4 v[8]; float ss = 0.f;
#pragma unroll
    for (int j = 0; j < 4; ++j) { v[2 * j] = *(const f32x4*)(xrow + lane * 8 + 512 * j); v[2 * j + 1] = *(const f32x4*)(xrow + lane * 8 + 512 * j + 4); }
#pragma unroll
    for (int j = 0; j < 8; ++j) ss += (v[j][0] * v[j][0] + v[j][1] * v[j][1]) + (v[j][2] * v[j][2] + v[j][3] * v[j][3]);
    const float rstd = rsqrtf(wave_sum(ss) * (1.f / 2048.f) + NORM_EPS);
#pragma unroll
    for (int j = 0; j < 4; ++j) { const int c = lane * 8 + 512 * j;
        if (copy) { u32x4 w; w.x = cvt_pk(v[2 * j][0], v[2 * j][1]); w.y = cvt_pk(v[2 * j][2], v[2 * j][3]); w.z = cvt_pk(v[2 * j + 1][0], v[2 * j + 1][1]); w.w = cvt_pk(v[2 * j + 1][2], v[2 * j + 1][3]); *(u32x4*)(copy + c) = w; }
        const f32x4 g0 = *(const f32x4*)(g + c), g1 = *(const f32x4*)(g + c + 4); const f32x4 a = v[2 * j] * rstd * g0, b = v[2 * j + 1] * rstd * g1;
        u32x4 w; w.x = cvt_pk(a[0], a[1]); w.y = cvt_pk(a[2], a[3]); w.z = cvt_pk(b[0], b[1]); w.w = cvt_pk(b[2], b[3]);
        *(u32x4*)(orow + c) = w; }
}
__device__ __forceinline__ void convert_layer(Frame& F, ArgsP A, int l, int part, int wrank, int wcount) {
    LAS float* scr = (LAS float*)(F.lds + F.wave * 16384);
    const int k_lo = (part == 2) ? 9 : (part == 3 ? 10 : 0), k_hi = (part == 1) ? 9 : (part == 2 ? 10 : 11);
    int base = 0;
    for (int k = k_lo; k < k_hi; ++k) {
        if (k == 1 && l == 0) continue;
        const int K = JK[k], N = JN[k], row_off = (k == 1) ? INW : 0; const int ldk = K;
        const float* W = A->in[JIN[k]] + (size_t)(k == 1 ? l - 1 : l) * K * N; const size_t dst = WL((size_t)JDST[k] * KiB);
        const int nitems = (K / 64) * (N / 32);
        int first = (wrank - base) % wcount; if (first < 0) first += wcount;
        for (int it = first; it < nitems; it += wcount) p0_transpose_item(W, K, N, WSP(bf16, dst), ldk, row_off, scr, it, F.lane);
        base = (base + nitems) % wcount;
    }
    if (part <= 1) {
        const long gt = (long)wrank * 64 + F.lane, NGT = (long)wcount * 64;
        { const float* W = A->in[I_WUP] + (size_t)l * 96 * 1024; bf16* O = WSP(bf16, WL(WO_UP));
          for (long i = gt; i < 1024 * 128; i += NGT) { const int n = (int)(i & 1023), kp = (int)(i >> 10); O[n * 128 + kp] = kp < 96 ? f2bf(W[kp * 1024 + n]) : (bf16)0; } }
        { const float* W = A->in[I_AUP] + (size_t)l * 96 * 1024; bf16* O = WSP(bf16, WL(WO_AUP));
          for (long i = gt; i < 1024 * 128; i += NGT) { const int n = (int)(i & 1023), kp = (int)(i >> 10); O[n * 128 + kp] = kp < 96 ? f2bf(W[kp * 1024 + n]) : (bf16)0; } }
        if (l > 0) { const float* W = A->in[I_VUP] + (size_t)(l - 1) * 64 * 1024; bf16* O = WSP(bf16, WL(WO_VUP));
          for (long i = gt; i < 1024 * 128; i += NGT) { const int n = (int)(i & 1023), kp = (int)(i >> 10); O[n * 128 + kp] = kp < 64 ? f2bf(W[kp * 1024 + n]) : (bf16)0; } }
        { const float* W = A->in[I_WUQ] + (size_t)l * 512 * 1536; bf16* O = WSP(bf16, WL(WO_UQ));
          for (long i = gt; i < 1536 * 512; i += NGT) { const int np = (int)(i % 1536), kk = (int)(i / 1536); const int hh = np / 192, cc = np % 192;
              const int n = cc < 128 ? np : hh * 192 + 128 + ((cc - 128) & 1) * 32 + ((cc - 128) >> 1);
              O[(size_t)np * 512 + kk] = f2bf(W[(size_t)kk * 1536 + n]); } }
        if (l > 0) { unsigned* O = (unsigned*)(WSP(bf16, WL(WO_IN)) + (size_t)(INW + 64) * D);
          for (long i = gt; i < 192 * D / 2; i += NGT) O[i] = 0u; }
    }
}
__device__ __forceinline__ void p0_prologue(Frame& F, ArgsP A) {
    const int gw = F.vcu * NWAVES + F.wave, NGW = F.G * NWAVES;
    const long gt = (long)F.vcu * NTHR + F.tid, NGT = (long)F.G * NTHR;
    convert_layer(F, A, 0, 1, gw, NGW);
    { float* cT = WSP(float, WS_COS); float* sT = WSP(float, WS_SIN);
      for (long i = gt; i < SEQ * 32; i += NGT) { const int pos = (int)(i >> 5), j = (int)(i & 31);
          const float invf = __builtin_amdgcn_exp2f(-13.287712379549449f * (float)j * (1.f / 32.f));
          const double rev = (double)pos * (double)invf * 0.15915494309189535; const float fr = (float)(rev - __builtin_rint(rev));
          cT[i] = __builtin_amdgcn_cosf(fr); sT[i] = __builtin_amdgcn_sinf(fr); } }
    for (int m = gw; m < T; m += NGW) rms_row_2048(A->in[I_X] + (size_t)m * D, A->in[I_MIXPRE], WSP(bf16, WS_U) + (size_t)m * D, (bf16*)F.H + (size_t)m * D, F.lane);
    for (int m = gw; m < NB * NMEM; m += NGW) rms_row_2048(A->in[I_MEM] + (size_t)m * D, A->in[I_MEMG], WSP(bf16, WS_MEMN) + (size_t)m * D, nullptr, F.lane);
}

__device__ __forceinline__ void prep_phase(Frame& F, ArgsP A, int l) {
    const int gw = F.vcu * NWAVES + F.wave, NGW = F.G * NWAVES, lane = F.lane;
    const bf16* PROJ = WSP(bf16, WS_PROJ);
    const float* mu = A->in[I_MU] + (size_t)l * RIN;
    const float* muv = A->in[I_MUV] + (size_t)(l > 0 ? l - 1 : 0) * 64;
    const float* qg = A->in[I_QNG] + (size_t)l * 512; const float* kvg = A->in[I_KVNG] + (size_t)l * 256;
    const float* cT = WSP(float, WS_COS); const float* sT = WSP(float, WS_SIN);
    for (int m = gw; m < T; m += NGW) {
        const bf16* cur = PROJ + (size_t)m * PROJ_LD; const bool first = (m & (SEQ - 1)) == 0; const bf16* prv = cur - PROJ_LD;
        bf16* lo = WSP(bf16, WS_LORA) + (size_t)m * LORA_LD;
#pragma unroll
        for (int i = 0; i < 10; ++i) { const int oc = lane + 64 * i; int sc = -1, kind = 0; float mv = 0.f;
            if (oc < 128) { if (oc < 96) { sc = 3072 + oc; kind = 1; } }
            else if (oc < 256) { if (oc < 224) { sc = 3168 + (oc - 128); kind = 0; } }
            else if (oc < 512) { sc = 3264 + (oc - 256); kind = 2; }
            else if (oc < 576) { if (l > 0) { sc = INW + (oc - 512); kind = 3; } }
            float val = 0.f;
            if (sc >= 0) { mv = kind == 3 ? muv[sc - INW] : mu[sc]; const float y = bf1(cur[sc]), yp = first ? 0.f : bf1(prv[sc]); const float c = y + (yp - y) * mv;
                val = kind == 1 ? tanhf_(c) : (kind == 2 ? sigmoidf_(c) : c); }
            lo[oc] = f2bf(val); }
        { float v[8]; unpack8(*(const u32x4*)(cur + RIN + lane * 8), v); float ss = 0.f;
#pragma unroll
          for (int i = 0; i < 8; ++i) ss += v[i] * v[i];
          const float rstd = rsqrtf(wave_sum(ss) * (1.f / 512.f) + NORM_EPS);
          const f32x4 g0 = *(const f32x4*)(qg + lane * 8), g1 = *(const f32x4*)(qg + lane * 8 + 4);
          u32x4 w; w.x = cvt_pk(v[0] * rstd * g0[0], v[1] * rstd * g0[1]); w.y = cvt_pk(v[2] * rstd * g0[2], v[3] * rstd * g0[3]);
          w.z = cvt_pk(v[4] * rstd * g1[0], v[5] * rstd * g1[1]); w.w = cvt_pk(v[6] * rstd * g1[2], v[7] * rstd * g1[3]);
          *(u32x4*)(WSP(bf16, WS_CQN) + (size_t)m * 512 + lane * 8) = w; }
        { const u32x2 raw = *(const u32x2*)(cur + RIN + 512 + lane * 4); const float v0 = bflo(raw.x), v1 = bfhi(raw.x), v2 = bflo(raw.y), v3 = bfhi(raw.y);
          const float rstd = rsqrtf(wave_sum(v0 * v0 + v1 * v1 + v2 * v2 + v3 * v3) * (1.f / 256.f) + NORM_EPS);
          const f32x4 g0 = *(const f32x4*)(kvg + lane * 4);
          u32x2 w; w.x = cvt_pk(v0 * rstd * g0[0], v1 * rstd * g0[1]); w.y = cvt_pk(v2 * rstd * g0[2], v3 * rstd * g0[3]);
          *(u32x2*)(WSP(bf16, WS_CKVN) + (size_t)m * 256 + lane * 4) = w; }
        if (lane < 32) { const float x1 = bf1(cur[RIN + 768 + lane]), x2 = bf1(cur[RIN + 768 + 32 + lane]); const int pos = m & (SEQ - 1);
          const float c = cT[pos * 32 + lane], s = sT[pos * 32 + lane];
          *(unsigned*)(WSP(bf16, WS_KR) + (size_t)m * 64 + 2 * lane) = cvt_pk(x1 * c - x2 * s, x1 * s + x2 * c); }
        if (l == 0) {
#pragma unroll
            for (int j = 0; j < 2; ++j) { const int c = lane * 8 + 512 * j; float a[8], p[8], o[8]; unpack8(*(const u32x4*)(cur + 2048 + c), a);
                if (!first) unpack8(*(const u32x4*)(prv + 2048 + c), p); else {
#pragma unroll
                    for (int i = 0; i < 8; ++i) p[i] = 0.f; }
                const f32x4 m0 = *(const f32x4*)(mu + 2048 + c), m1 = *(const f32x4*)(mu + 2048 + c + 4);
#pragma unroll
                for (int i = 0; i < 8; ++i) o[i] = a[i] + (p[i] - a[i]) * (i < 4 ? m0[i] : m1[i - 4]);
                *(u32x4*)(WSP(bf16, WS_VF) + (size_t)m * 1024 + c) = pack8(o); } }
    }
}

constexpr int CK = 32, NCHUNK = SEQ / CK;
constexpr int CS_TS = 144, CS_TILE = 32 * CS_TS, CS_PC = 5 * CS_TILE, CS_WAVE = 5 * CS_TILE + 256;
constexpr int CS_NW = 7;
constexpr size_t SCU_BYTES = 24576; constexpr int SCU_X = 8192, SCU_PSI = 12288, SCU_G2 = 20480;
constexpr int SQ_SLOT = 18432, SQ_NSLOT = 7;
static_assert(CS_NW * CS_WAVE <= RING_BYTES && SQ_NSLOT * SQ_SLOT <= RING_BYTES, "LDS budget");
#define MF32(a, b, c) __builtin_amdgcn_mfma_f32_32x32x16_bf16((a), (b), (c), 0, 0, 0)
__device__ __forceinline__ bf16x8 pack8f(float a0, float a1, float a2, float a3, float a4, float a5, float a6, float a7) {
    u32x4 w; w.x = cvt_pk(a0, a1); w.y = cvt_pk(a2, a3); w.z = cvt_pk(a4, a5); w.w = cvt_pk(a6, a7); return __builtin_bit_cast(bf16x8, w); }
#define PACKS(x, s) pack8f((x)[8 * (s)], (x)[8 * (s) + 1], (x)[8 * (s) + 2], (x)[8 * (s) + 3], (x)[8 * (s) + 4], (x)[8 * (s) + 5], (x)[8 * (s) + 6], (x)[8 * (s) + 7])
__device__ __forceinline__ bf16x8 trfrag(const LAS unsigned char* p) {
    const s16x4 lo = __builtin_bit_cast(s16x4, __builtin_amdgcn_ds_read_tr16_b64_v4i16((LAS v4i16_t*)p));
    const s16x4 hh = __builtin_bit_cast(s16x4, __builtin_amdgcn_ds_read_tr16_b64_v4i16((LAS v4i16_t*)(p + 8 * CS_TS)));
    return (bf16x8){lo[0], lo[1], lo[2], lo[3], hh[0], hh[1], hh[2], hh[3]}; }
__device__ __forceinline__ void st_init16(unsigned char* p, const f32x16& x) {
    u32x4 w0, w1; w0.x = cvt_pk(x[0], x[1]); w0.y = cvt_pk(x[2], x[3]); w0.z = cvt_pk(x[4], x[5]); w0.w = cvt_pk(x[6], x[7]);
    w1.x = cvt_pk(x[8], x[9]); w1.y = cvt_pk(x[10], x[11]); w1.z = cvt_pk(x[12], x[13]); w1.w = cvt_pk(x[14], x[15]);
    *(u32x4*)p = w0; *(u32x4*)(p + 16) = w1; }
__device__ __forceinline__ f32x16 ld_init16(const LAS unsigned char* p) {
    const u32x4 w0 = *(const LAS u32x4*)p, w1 = *(const LAS u32x4*)(p + 16); f32x16 x;
    x[0] = bflo(w0.x); x[1] = bfhi(w0.x); x[2] = bflo(w0.y); x[3] = bfhi(w0.y); x[4] = bflo(w0.z); x[5] = bfhi(w0.z); x[6] = bflo(w0.w); x[7] = bfhi(w0.w);
    x[8] = bflo(w1.x); x[9] = bfhi(w1.x); x[10] = bflo(w1.y); x[11] = bfhi(w1.y); x[12] = bflo(w1.z); x[13] = bfhi(w1.z); x[14] = bflo(w1.w); x[15] = bfhi(w1.w); return x; }

struct CsRaw { u32x4 r[4], k[4], a[4], e[4]; bf16 rp, kp; };
__device__ __forceinline__ void cs_load_raw(Frame& F, int l, int bh, int cc, CsRaw& R) {
    const int lane = F.lane, b = bh >> 4, h = bh & 15, pc = lane & 7;
    const size_t row0 = (size_t)b * SEQ + (size_t)cc * CK;
    const bf16* PROJ = WSP(bf16, WS_PROJ); const bf16* AIC = WSP(bf16, WS_AIC); const bf16* WLOG = WSP(bf16, WS_WLOG);
#pragma unroll
    for (int i = 0; i < 4; ++i) { const size_t gr = row0 + (lane >> 3) + 8 * i;
        R.r[i] = *(const u32x4*)(PROJ + gr * PROJ_LD + h * 64 + pc * 8); R.k[i] = *(const u32x4*)(PROJ + gr * PROJ_LD + 1024 + h * 64 + pc * 8);
        R.a[i] = *(const u32x4*)(AIC + gr * 1024 + h * 64 + pc * 8); R.e[i] = *(const u32x4*)(WLOG + gr * 1024 + h * 64 + pc * 8); }
    R.rp = 0; R.kp = 0;
    if (cc > 0) { R.rp = PROJ[(row0 - 1) * PROJ_LD + h * 64 + lane]; R.kp = PROJ[(row0 - 1) * PROJ_LD + 1024 + h * 64 + lane]; }
}
__device__ __forceinline__ void cs_elementwise(Frame& F, ArgsP A, int l, int bh, int cc, LAS unsigned char* wl, const CsRaw& R) {
    const int lane = F.lane, b = bh >> 4, h = bh & 15, ch = h * 64 + lane;
    const size_t row0 = (size_t)b * SEQ + (size_t)cc * CK;
    float* RKB = WSP(float, WS_RKB);
    const bf16* VV = (l == 0) ? WSP(bf16, WS_VF) : WSP(bf16, WS_VV);
    u32x4 vraw[4];
#pragma unroll
    for (int i = 0; i < 4; ++i) vraw[i] = *(const u32x4*)(VV + (row0 + (lane >> 3) + 8 * i) * 1024 + h * 64 + (lane & 7) * 8);
#pragma unroll
    for (int i = 0; i < 4; ++i) { LAS unsigned char* p = wl + ((lane >> 3) + 8 * i) * CS_TS + (lane & 7) * 16;
        *(LAS u32x4*)(p) = R.k[i]; *(LAS u32x4*)(p + CS_TILE) = R.a[i]; *(LAS u32x4*)(p + 2 * CS_TILE) = R.e[i]; *(LAS u32x4*)(p + 3 * CS_TILE) = R.r[i]; }
    const float mur = A->in[I_MU][(size_t)l * RIN + ch], muk = A->in[I_MU][(size_t)l * RIN + 1024 + ch];
    const float ckk = A->in[I_KK][(size_t)l * 1024 + ch], cka = A->in[I_KA][(size_t)l * 1024 + ch], crk = A->in[I_RK][(size_t)l * 1024 + ch];
    float rp = bf1(R.rp), kp_ = bf1(R.kp);
    float lp = 0.f, pexc = 1.f;
    constexpr float L2E = 1.4426950408889634f;
    asm volatile("s_waitcnt lgkmcnt(0)" ::: "memory");
#pragma unroll 8
    for (int tt = 0; tt < CK; ++tt) {
        LAS unsigned char* rowp = wl + tt * CS_TS + lane * 2;
        const float kc = bf1(*(const LAS bf16*)(rowp)), aa = bf1(*(const LAS bf16*)(rowp + CS_TILE)), ee = bf1(*(const LAS bf16*)(rowp + 2 * CS_TILE)), rc = bf1(*(const LAS bf16*)(rowp + 3 * CS_TILE));
        const float rs = rc + (rp - rc) * mur, ks = kc + (kp_ - kc) * muk; rp = rc; kp_ = kc;
        float kk = ks * ckk; const float ss = wave_sum(kk * kk); kk *= rsqrtf(fmaxf(ss, 1e-24f));
        const float kq = ks * (1.f + (aa - 1.f) * cka);
        const float rkb = wave_sum(rs * kq * crk);
        lp += ee;
        const float pinc = __builtin_amdgcn_exp2f(lp * L2E), pinv = __builtin_amdgcn_exp2f(-lp * L2E);
        *(LAS bf16*)(rowp) = f2bf(-kk * pexc);
        *(LAS bf16*)(rowp + CS_TILE) = f2bf(kk * aa * pinv);
        *(LAS bf16*)(rowp + 2 * CS_TILE) = f2bf(kq * pinv);
        *(LAS bf16*)(rowp + 3 * CS_TILE) = f2bf(rs * pinc);
        pexc = pinc;
        if (lane == 0) RKB[(row0 + tt) * 16 + h] = rkb;
    }
    ((LAS float*)(wl + CS_PC))[lane] = __builtin_amdgcn_exp2f(lp * L2E);
#pragma unroll
    for (int i = 0; i < 4; ++i) *(LAS u32x4*)(wl + 4 * CS_TILE + ((lane >> 3) + 8 * i) * CS_TS + (lane & 7) * 16) = vraw[i];
}
__device__ __forceinline__ void cs_mfma(Frame& F, const LAS unsigned char* wl, unsigned char* ub) {
    const int lane = F.lane, r32 = lane & 31, h = lane >> 5, q4 = (lane & 15) >> 2, pp = lane & 3, blk = (lane >> 4) & 1;
    const LAS unsigned char* tA = wl; const LAS unsigned char* tB = wl + CS_TILE; const LAS unsigned char* tK = wl + 2 * CS_TILE;
    const LAS unsigned char* tR = wl + 3 * CS_TILE; const LAS unsigned char* tV = wl + 4 * CS_TILE;
    const int rowoff = r32 * CS_TS + h * 16, troff = (4 * h + q4) * CS_TS + blk * 32 + pp * 8;
#define FROW(t, s) (*(const LAS bf16x8*)((t) + rowoff + (s) * 32))
#define FTR(t, ct, s) trfrag((t) + troff + (s) * 16 * CS_TS + (ct) * 64)
    const f32x16 Z = (f32x16){};
    f32x16 P = Z, PT = Z;
#pragma unroll
    for (int s = 0; s < 4; ++s) { const bf16x8 fa = FROW(tA, s), fb = FROW(tB, s); P = MF32(fb, fa, P); PT = MF32(fa, fb, PT); }
#pragma unroll
    for (int r = 0; r < 16; ++r) { const int cr = crow(r, h); if (!(cr < r32)) P[r] = 0.f; if (!(r32 < cr)) PT[r] = 0.f; }
    f32x16 TmT = PT;
#pragma unroll
    for (int r = 0; r < 16; ++r) if (crow(r, h) == r32) TmT[r] += 1.f;
    f32x16 Tm;
#pragma unroll
    for (int it = 0; it < 4; ++it) {
        const bf16x8 pP0 = PACKS(P, 0), pP1 = PACKS(P, 1), pT0 = PACKS(PT, 0), pT1 = PACKS(PT, 1);
        f32x16 Pn = MF32(pT0, pP0, Z); Pn = MF32(pT1, pP1, Pn);
        f32x16 Y = Pn;
#pragma unroll
        for (int r = 0; r < 16; ++r) if (crow(r, h) == r32) Y[r] += 1.f;
        const bf16x8 y0 = PACKS(Y, 0), y1 = PACKS(Y, 1), t0 = PACKS(TmT, 0), t1 = PACKS(TmT, 1);
        if (it < 3) {
            f32x16 PTn = MF32(pP0, pT0, Z); PTn = MF32(pP1, pT1, PTn);
            f32x16 Tn = MF32(y0, t0, Z); Tn = MF32(y1, t1, Tn);
            P = Pn; PT = PTn; TmT = Tn;
        } else { Tm = MF32(t0, y0, Z); Tm = MF32(t1, y1, Tm); }
    }
    f32x16 W1;
    { f32x16 NakT = Z;
#pragma unroll
      for (int s = 0; s < 4; ++s) NakT = MF32(FROW(tA, s), FROW(tK, s), NakT);
#pragma unroll
      for (int r = 0; r < 16; ++r) if (!(r32 < crow(r, h))) NakT[r] = 0.f;
      W1 = MF32(PACKS(NakT, 0), PACKS(Tm, 0), Z); W1 = MF32(PACKS(NakT, 1), PACKS(Tm, 1), W1); }
    f32x16 ATT[2], G1T[2];
    { const bf16x8 m0 = PACKS(Tm, 0), m1 = PACKS(Tm, 1), w0 = PACKS(W1, 0), w1 = PACKS(W1, 1);
#pragma unroll
      for (int ct = 0; ct < 2; ++ct) { ATT[ct] = MF32(m0, FTR(tA, ct, 0), Z); ATT[ct] = MF32(m1, FTR(tA, ct, 1), ATT[ct]);
                                       G1T[ct] = MF32(w0, FTR(tV, ct, 0), Z); G1T[ct] = MF32(w1, FTR(tV, ct, 1), G1T[ct]); } }
    f32x16 Mbr = Z, Mkr = Z;
#pragma unroll
    for (int s = 0; s < 4; ++s) { const bf16x8 fr = FROW(tR, s); Mbr = MF32(FROW(tB, s), fr, Mbr); Mkr = MF32(FROW(tK, s), fr, Mkr); }
#pragma unroll
    for (int r = 0; r < 16; ++r) if (!(crow(r, h) <= r32)) { Mbr[r] = 0.f; Mkr[r] = 0.f; }
    const bf16x8 b0 = PACKS(Mbr, 0), b1 = PACKS(Mbr, 1), k0 = PACKS(Mkr, 0), k1 = PACKS(Mkr, 1);
#pragma unroll
    for (int kt = 0; kt < 2; ++kt) {
        f32x16 X = MF32(PACKS(ATT[kt], 0), b0, Z); X = MF32(PACKS(ATT[kt], 1), b1, X);
#pragma unroll
        for (int g = 0; g < 4; ++g) { const u32x2 w = *(const LAS u32x2*)(tR + r32 * CS_TS + (32 * kt + 8 * g + 4 * h) * 2);
            X[4 * g] += bflo(w.x); X[4 * g + 1] += bfhi(w.x); X[4 * g + 2] += bflo(w.y); X[4 * g + 3] += bfhi(w.y); }
        *(bf16x8*)(ub + SCU_X + ((2 * kt) * 64 + lane) * 16) = PACKS(X, 0);
        *(bf16x8*)(ub + SCU_X + ((2 * kt + 1) * 64 + lane) * 16) = PACKS(X, 1);
    }
#pragma unroll
    for (int ct = 0; ct < 2; ++ct) {
        f32x16 G = MF32(b0, PACKS(G1T[ct], 0), Z); G = MF32(b1, PACKS(G1T[ct], 1), G);
        G = MF32(k0, FTR(tV, ct, 0), G); G = MF32(k1, FTR(tV, ct, 1), G);
        st_init16(ub + SCU_G2 + (ct * 64 + lane) * 32, G);
    }
    const LAS float* PC = (const LAS float*)(wl + CS_PC);
#pragma unroll
    for (int ct = 0; ct < 2; ++ct) {
        const float pc = PC[32 * ct + r32];
        const bf16x8 f0 = FTR(tB, ct, 0), f1 = FTR(tB, ct, 1);
#pragma unroll
        for (int kt = 0; kt < 2; ++kt) {
            f32x16 Ph = MF32(PACKS(ATT[kt], 0), f0, Z); Ph = MF32(PACKS(ATT[kt], 1), f1, Ph);
            if (kt == ct) {
#pragma unroll
                for (int r = 0; r < 16; ++r) if (crow(r, h) == r32) Ph[r] += 1.f; }
#pragma unroll
            for (int r = 0; r < 16; ++r) Ph[r] *= pc;
            *(bf16x8*)(ub + ((ct * 4 + 2 * kt) * 64 + lane) * 16) = PACKS(Ph, 0);
            *(bf16x8*)(ub + ((ct * 4 + 2 * kt + 1) * 64 + lane) * 16) = PACKS(Ph, 1);
        }
    }
#pragma unroll
    for (int mt = 0; mt < 2; ++mt) {
        const bf16x8 fb0 = FTR(tB, mt, 0), fb1 = FTR(tB, mt, 1), fk0 = FTR(tK, mt, 0), fk1 = FTR(tK, mt, 1);
        float pcr[16];
#pragma unroll
        for (int g = 0; g < 4; ++g) { const f32x4 v = *(const LAS f32x4*)(PC + 32 * mt + 8 * g + 4 * h); pcr[4 * g] = v[0]; pcr[4 * g + 1] = v[1]; pcr[4 * g + 2] = v[2]; pcr[4 * g + 3] = v[3]; }
#pragma unroll
        for (int ct = 0; ct < 2; ++ct) {
            f32x16 Ps = MF32(fb0, PACKS(G1T[ct], 0), Z); Ps = MF32(fb1, PACKS(G1T[ct], 1), Ps);
            Ps = MF32(fk0, FTR(tV, ct, 0), Ps); Ps = MF32(fk1, FTR(tV, ct, 1), Ps);
#pragma unroll
            for (int r = 0; r < 16; ++r) Ps[r] *= pcr[r];
            st_init16(ub + SCU_PSI + ((ct * 2 + mt) * 64 + lane) * 32, Ps);
        }
    }
#undef FROW
#undef FTR
}
__device__ __forceinline__ void cs_pre_phase(Frame& F, ArgsP A, int l) {
    volatile LAS unsigned* cnt = (volatile LAS unsigned*)(F.lds + LDSCTL_OFF);
    if (F.tid == 0) cnt[0] = 0u;
    __syncthreads();
    if (F.wave < CS_NW) {
        LAS unsigned char* wl = F.lds + F.wave * CS_WAVE;
        const int per = (64 * NCHUNK + F.G - 1) / F.G, ubase = F.vcu * per, uend = (ubase + per < 64 * NCHUNK) ? ubase + per : 64 * NCHUNK;
#define CS_NEXT(dst) do { unsigned v_ = 0u; if (F.lane == 0) v_ = __hip_atomic_fetch_add((LAS unsigned*)cnt, 1u, __ATOMIC_RELAXED, __HIP_MEMORY_SCOPE_WORKGROUP); dst = ubase + (int)__builtin_amdgcn_readfirstlane((int)v_); } while (0)
        int u; CS_NEXT(u);
        CsRaw R;
        if (u < uend) cs_load_raw(F, l, u >> 7, u & (NCHUNK - 1), R);
        while (u < uend) {
            cs_elementwise(F, A, l, u >> 7, u & (NCHUNK - 1), wl, R);
            int un; CS_NEXT(un);
            if (un < uend) cs_load_raw(F, l, un >> 7, un & (NCHUNK - 1), R);
            asm volatile("s_waitcnt lgkmcnt(0)" ::: "memory");
            cs_mfma(F, wl, F.ws + WS_SCAN + (size_t)u * SCU_BYTES);
            asm volatile("s_waitcnt lgkmcnt(0)" ::: "memory");
            u = un;
        }
#undef CS_NEXT
    }
}
__device__ __forceinline__ void cs_seq_unit(Frame& F, int bh, int ct) {
    const int lane = F.lane, wave = F.wave, r32 = lane & 31, h = lane >> 5;
    LAS unsigned char* L = F.lds;
    const unsigned char* ub = F.ws + WS_SCAN + (size_t)bh * NCHUNK * SCU_BYTES;
    if (wave > 0) {
        const int w = wave - 1;
        size_t so[3]; int np = 0;
#pragma unroll
        for (int k = 0; k < 3; ++k) { const int p = w + 7 * k; so[k] = p < 12 ? (size_t)p * 1024 : (p < 16 ? (size_t)SCU_PSI + ct * 4096 + (p - 12) * 1024 : (size_t)SCU_G2 + ct * 2048 + (p - 16) * 1024); if (p < 18) np = k + 1; }
#define SQ_ISSUE(c) do { const unsigned char* g_ = ub + (size_t)(c) * SCU_BYTES + lane * 16; LAS unsigned char* d_ = L + ((c) % SQ_NSLOT) * SQ_SLOT; \
        _Pragma("unroll") for (int k = 0; k < 3; ++k) if (k < np) __builtin_amdgcn_global_load_lds((const unsigned*)(g_ + so[k]), (LAS unsigned*)(d_ + (w + 7 * k) * 1024), 16, 0, 0); } while (0)
        for (int c = 0; c < 6; ++c) SQ_ISSUE(c);
        if (np == 3) asm volatile("s_waitcnt vmcnt(15)" ::: "memory"); else asm volatile("s_waitcnt vmcnt(10)" ::: "memory");
        asm volatile("s_barrier" ::: "memory");
        for (int c = 0; c < NCHUNK; ++c) {
            if (c + 6 < NCHUNK) { SQ_ISSUE(c + 6); if (np == 3) asm volatile("s_waitcnt vmcnt(15)" ::: "memory"); else asm volatile("s_waitcnt vmcnt(10)" ::: "memory"); }
            else asm volatile("s_waitcnt vmcnt(0)" ::: "memory");
            asm volatile("s_barrier" ::: "memory");
        }
#undef SQ_ISSUE
    } else {
        f32x16 S0 = (f32x16){}, S1 = (f32x16){};
        const int b = bh >> 4, hh = bh & 15;
        bf16* op = (bf16*)(F.ws + WS_Y) + ((size_t)b * SEQ) * 1024 + hh * 64 + 32 * ct + r32;
        asm volatile("s_barrier" ::: "memory");
        for (int c = 0; c < NCHUNK; ++c) {
            const LAS unsigned char* sl = L + (c % SQ_NSLOT) * SQ_SLOT;
            const bf16x8 bS0 = PACKS(S0, 0), bS1 = PACKS(S0, 1), bS2 = PACKS(S1, 0), bS3 = PACKS(S1, 1);
            f32x16 n0 = ld_init16(sl + 12288 + (0 * 64 + lane) * 32), n1 = ld_init16(sl + 12288 + (1 * 64 + lane) * 32);
            const f32x16 Z = (f32x16){};
            f32x16 m0 = MF32(*(const LAS bf16x8*)(sl + (2 * 64 + lane) * 16), bS2, Z), m1 = MF32(*(const LAS bf16x8*)(sl + (6 * 64 + lane) * 16), bS2, Z);
            n0 = MF32(*(const LAS bf16x8*)(sl + (0 * 64 + lane) * 16), bS0, n0); n1 = MF32(*(const LAS bf16x8*)(sl + (4 * 64 + lane) * 16), bS0, n1);
            m0 = MF32(*(const LAS bf16x8*)(sl + (3 * 64 + lane) * 16), bS3, m0); m1 = MF32(*(const LAS bf16x8*)(sl + (7 * 64 + lane) * 16), bS3, m1);
            n0 = MF32(*(const LAS bf16x8*)(sl + (1 * 64 + lane) * 16), bS1, n0); n1 = MF32(*(const LAS bf16x8*)(sl + (5 * 64 + lane) * 16), bS1, n1);
            f32x16 o = ld_init16(sl + 16384 + lane * 32);
            o = MF32(*(const LAS bf16x8*)(sl + 8192 + (0 * 64 + lane) * 16), bS0, o); o = MF32(*(const LAS bf16x8*)(sl + 8192 + (1 * 64 + lane) * 16), bS1, o);
            o = MF32(*(const LAS bf16x8*)(sl + 8192 + (2 * 64 + lane) * 16), bS2, o); o = MF32(*(const LAS bf16x8*)(sl + 8192 + (3 * 64 + lane) * 16), bS3, o);
            S0 = n0 + m0; S1 = n1 + m1;
#pragma unroll
            for (int r = 0; r < 16; ++r) op[(size_t)(c * CK + crow(r, h)) * 1024] = f2bf(o[r]);
            asm volatile("s_waitcnt lgkmcnt(0)\n\ts_barrier" ::: "memory");
        }
    }
    asm volatile("s_waitcnt vmcnt(0)" ::: "memory");
    __syncthreads();
}

__device__ __forceinline__ void rwkv_post_phase(Frame& F, ArgsP A, int l) {
    const int gw = F.vcu * NWAVES + F.wave, NGW = F.G * NWAVES, lane = F.lane, c0 = lane * 16, head = lane >> 2;
    const bf16* ORAW = WSP(bf16, WS_Y); const float* RKB = WSP(float, WS_RKB);
    const bf16* VV = (l == 0) ? WSP(bf16, WS_VF) : WSP(bf16, WS_VV); const bf16* GATE = WSP(bf16, WS_GATE);
    float lg[16], lb[16];
#pragma unroll
    for (int i = 0; i < 16; ++i) { lg[i] = A->in[I_LNG][(size_t)l * 1024 + c0 + i]; lb[i] = A->in[I_LNB][(size_t)l * 1024 + c0 + i]; }
    for (int m = gw; m < T; m += NGW) {
        float o[16];
#pragma unroll
        for (int j = 0; j < 2; ++j) { float t8[8]; unpack8(*(const u32x4*)(ORAW + (size_t)m * 1024 + c0 + 8 * j), t8);
#pragma unroll
            for (int i = 0; i < 8; ++i) o[8 * j + i] = t8[i]; }
        float s = 0.f;
#pragma unroll
        for (int i = 0; i < 16; ++i) s += o[i];
        s = sum4(s);
        const float mean = s * (1.f / 64.f); float q = 0.f;
#pragma unroll
        for (int i = 0; i < 16; ++i) { o[i] -= mean; q += o[i] * o[i]; }
        q = sum4(q);
        const float rstd = rsqrtf(q * (1.f / 64.f) + GN_EPS);
        const float rkb = RKB[(size_t)m * 16 + head];
        float vv[16], gg[16];
        { float t8[8]; unpack8(*(const u32x4*)(VV + (size_t)m * 1024 + c0), t8);
#pragma unroll
          for (int i = 0; i < 8; ++i) vv[i] = t8[i];
          unpack8(*(const u32x4*)(VV + (size_t)m * 1024 + c0 + 8), t8);
#pragma unroll
          for (int i = 0; i < 8; ++i) vv[8 + i] = t8[i];
          unpack8(*(const u32x4*)(GATE + (size_t)m * 1024 + c0), t8);
#pragma unroll
          for (int i = 0; i < 8; ++i) gg[i] = t8[i];
          unpack8(*(const u32x4*)(GATE + (size_t)m * 1024 + c0 + 8), t8);
#pragma unroll
          for (int i = 0; i < 8; ++i) gg[8 + i] = t8[i]; }
        float y[16];
#pragma unroll
        for (int i = 0; i < 16; ++i) y[i] = (o[i] * rstd * lg[i] + lb[i] + rkb * vv[i]) * gg[i];
        bf16* dst = WSP(bf16, WS_U) + (size_t)m * D + c0;
        u32x4 w0, w1; w0.x = cvt_pk(y[0], y[1]); w0.y = cvt_pk(y[2], y[3]); w0.z = cvt_pk(y[4], y[5]); w0.w = cvt_pk(y[6], y[7]);
        w1.x = cvt_pk(y[8], y[9]); w1.y = cvt_pk(y[10], y[11]); w1.z = cvt_pk(y[12], y[13]); w1.w = cvt_pk(y[14], y[15]);
        *(u32x4*)dst = w0; *(u32x4*)(dst + 8) = w1;
    }
}

__device__ __forceinline__ void ew_norm_phase(Frame& F, const float* gpost, const float* gpre, int e) {
    const int gw = F.vcu * NWAVES + F.wave, NGW = F.G * NWAVES, lane = F.lane;
    const bf16* Y = WSP(bf16, WS_Y); bf16* U = WSP(bf16, WS_U);
    const bf16* Hin = (e & 1) ? WSP(bf16, WS_HB) : (const bf16*)F.H;
    bf16* Hout = (e & 1) ? (bf16*)F.H : WSP(bf16, WS_HB);
    const bool last = (e == 3 * NL - 1);
    for (int m = gw; m < T; m += NGW) {
        float y[32]; float ss = 0.f;
#pragma unroll
        for (int j = 0; j < 4; ++j) { float t8[8]; unpack8(*(const u32x4*)(Y + (size_t)m * D + lane * 8 + 512 * j), t8);
#pragma unroll
            for (int i = 0; i < 8; ++i) { y[8 * j + i] = t8[i]; ss += t8[i] * t8[i]; } }
        const float rstd = rsqrtf(wave_sum(ss) * (1.f / 2048.f) + NORM_EPS);
        float hn[32]; float s2 = 0.f;
#pragma unroll
        for (int j = 0; j < 4; ++j) { const int c = lane * 8 + 512 * j;
            float h8[8]; unpack8(*(const u32x4*)(Hin + (size_t)m * D + c), h8);
            const f32x4 g0 = *(const f32x4*)(gpost + c), g1 = *(const f32x4*)(gpost + c + 4);
#pragma unroll
            for (int i = 0; i < 4; ++i) { hn[8 * j + i] = h8[i] + y[8 * j + i] * rstd * g0[i]; hn[8 * j + 4 + i] = h8[4 + i] + y[8 * j + 4 + i] * rstd * g1[i]; }
            if (last) { float* hp = F.H + (size_t)m * D + c; *(f32x4*)hp = (f32x4){hn[8 * j], hn[8 * j + 1], hn[8 * j + 2], hn[8 * j + 3]}; *(f32x4*)(hp + 4) = (f32x4){hn[8 * j + 4], hn[8 * j + 5], hn[8 * j + 6], hn[8 * j + 7]}; }
            else { u32x4 w; w.x = cvt_pk(hn[8 * j], hn[8 * j + 1]); w.y = cvt_pk(hn[8 * j + 2], hn[8 * j + 3]); w.z = cvt_pk(hn[8 * j + 4], hn[8 * j + 5]); w.w = cvt_pk(hn[8 * j + 6], hn[8 * j + 7]); *(u32x4*)(Hout + (size_t)m * D + c) = w; }
#pragma unroll
            for (int i = 0; i < 8; ++i) s2 += hn[8 * j + i] * hn[8 * j + i]; }
        if (gpre) {
            const float r2 = rsqrtf(wave_sum(s2) * (1.f / 2048.f) + NORM_EPS);
#pragma unroll
            for (int j = 0; j < 4; ++j) { const int c = lane * 8 + 512 * j; const f32x4 g0 = *(const f32x4*)(gpre + c), g1 = *(const f32x4*)(gpre + c + 4);
                u32x4 w; w.x = cvt_pk(hn[8 * j] * r2 * g0[0], hn[8 * j + 1] * r2 * g0[1]); w.y = cvt_pk(hn[8 * j + 2] * r2 * g0[2], hn[8 * j + 3] * r2 * g0[3]);
                w.z = cvt_pk(hn[8 * j + 4] * r2 * g1[0], hn[8 * j + 5] * r2 * g1[1]); w.w = cvt_pk(hn[8 * j + 6] * r2 * g1[2], hn[8 * j + 7] * r2 * g1[3]);
                *(u32x4*)(U + (size_t)m * D + c) = w; }
        }
    }
}

template <int DQK, bool CAUSAL>
__device__ __forceinline__ void attn_unit(LAS unsigned char* lds, const bf16* __restrict__ Q, int ldq, const bf16* __restrict__ K1, int ldk1, const bf16* __restrict__ K2, int ldk2,
                                          const bf16* __restrict__ V, int ldv, bf16* __restrict__ O, int ldo, int qpos0, int ntiles) {
    constexpr int KROW = DQK * 2, KT = 64 * KROW, VT = 16384, ND0 = DQK / 16, NKC = DQK / 64;
    int tid = threadIdx.x; asm volatile("" : "+v"(tid));
    const int lane = tid & 63, wid = __builtin_amdgcn_readfirstlane(tid >> 6), r32 = lane & 31, hi = lane >> 5;
    LAS unsigned char* Kl = lds; LAS unsigned char* Vl = lds + 2 * KT;
    bf16x8 qr[ND0];
    { const bf16* qrow = Q + (size_t)(wid * 32 + r32) * ldq;
#pragma unroll
      for (int d0 = 0; d0 < ND0; ++d0) qr[d0] = *(const bf16x8*)(qrow + d0 * 16 + hi * 8); }
    unsigned ksoff[NKC]; int kdst[NKC];
#pragma unroll
    for (int i = 0; i < NKC; ++i) { int row, cc;
        if (i < 2) { const int c = tid + 512 * i; row = c >> 4; cc = c & 15; ksoff[i] = (unsigned)(row * ldk1 + cc * 8) * 2u; }
        else { row = tid >> 3; cc = 16 + (tid & 7); ksoff[i] = (unsigned)(row * ldk2 + (cc - 16) * 8) * 2u; }
        const int cs = DQK == 192 ? ((cc & ~7) | ((cc ^ (row >> 1)) & 7)) : (cc ^ (row & 15));
        kdst[i] = row * KROW + cs * 16; }
    unsigned vsoff[2]; int vdst[2];
#pragma unroll
    for (int i = 0; i < 2; ++i) { const int c = tid + 512 * i, row = c >> 4, cc = c & 15; vsoff[i] = (unsigned)(row * ldv + cc * 8) * 2u; vdst[i] = row * 256 + ((cc * 16) ^ ((row & 3) << 6)); }
    constexpr int NKO = DQK == 192 ? 4 : 8;
    int koff[NKO];
#pragma unroll
    for (int j = 0; j < NKO; ++j) { const int cc = 2 * j + hi; const int cs = DQK == 192 ? ((cc ^ (r32 >> 1)) & 7) : (cc ^ (r32 & 15)); koff[j] = r32 * KROW + cs * 16; }
#define AT_KOFF(d0) (DQK == 192 ? koff[(d0) & 3] + ((d0) >> 2) * 128 : koff[(d0) & 7])
    const int q4 = (lane & 15) >> 2, pp = lane & 3, blk = (lane >> 4) & 1;
    int voff[4];
#pragma unroll
    for (int d0 = 0; d0 < 4; ++d0) voff[d0] = (4 * hi + q4) * 256 + (((d0 ^ q4) << 6) | (blk << 5) | (pp << 3));
    u32x4 ks[NKC], vs[2];
#define AT_LOAD(t) do { const char* k1b = (const char*)K1 + (size_t)(t) * 64 * ldk1 * 2; const char* k2b = (const char*)K2 + (size_t)(t) * 64 * ldk2 * 2; const char* vb = (const char*)V + (size_t)(t) * 64 * ldv * 2; \
        _Pragma("unroll") for (int i = 0; i < NKC; ++i) ks[i] = *(const u32x4*)((i < 2 ? k1b : k2b) + ksoff[i]); \
        _Pragma("unroll") for (int i = 0; i < 2; ++i) vs[i] = *(const u32x4*)(vb + vsoff[i]); } while (0)
#define AT_WRITE(bf) do { _Pragma("unroll") for (int i = 0; i < NKC; ++i) *(LAS u32x4*)(Kl + (bf) * KT + kdst[i]) = ks[i]; \
        _Pragma("unroll") for (int i = 0; i < 2; ++i) *(LAS u32x4*)(Vl + (bf) * VT + vdst[i]) = vs[i]; } while (0)
    float m_run = -1e30f, l_run = 0.f; f32x16 o[4];
#pragma unroll
    for (int d0 = 0; d0 < 4; ++d0) o[d0] = (f32x16){};
    AT_LOAD(0); AT_WRITE(0);
    __syncthreads();
    const int qpos = qpos0 + wid * 32 + r32;
    for (int t = 0; t < ntiles; ++t) {
        const int bf = t & 1;
        if (t + 1 < ntiles) AT_LOAD(t + 1);
        f32x16 p0 = (f32x16){}, p1 = (f32x16){};
#pragma unroll
        for (int d0 = 0; d0 < ND0; ++d0) {
            const bf16x8 a0 = *(const LAS bf16x8*)(Kl + bf * KT + AT_KOFF(d0));
            const bf16x8 a1 = *(const LAS bf16x8*)(Kl + bf * KT + AT_KOFF(d0) + 32 * KROW);
            p0 = __builtin_amdgcn_mfma_f32_32x32x16_bf16(a0, qr[d0], p0, 0, 0, 0);
            p1 = __builtin_amdgcn_mfma_f32_32x32x16_bf16(a1, qr[d0], p1, 0, 0, 0);
        }
        if (CAUSAL) { const int kv0 = t * 64;
            if (kv0 + 63 > qpos0 + wid * 32) { const float NEG = -__builtin_inff();
#pragma unroll
                for (int r = 0; r < 16; ++r) { const int key = kv0 + crow(r, hi); if (key > qpos) p0[r] = NEG; if (key + 32 > qpos) p1[r] = NEG; } } }
        float mx = p0[0];
#pragma unroll
        for (int r = 1; r < 16; ++r) mx = fmaxf(mx, p0[r]);
#pragma unroll
        for (int r = 0; r < 16; ++r) mx = fmaxf(mx, p1[r]);
        { auto rr = __builtin_amdgcn_permlane32_swap(__float_as_uint(mx), __float_as_uint(mx), false, false); mx = fmaxf(__uint_as_float(rr[0]), __uint_as_float(rr[1])); }
        if (__any(mx > m_run + 8.f)) {
            const float mn = fmaxf(m_run, mx), alpha = __builtin_amdgcn_exp2f(m_run - mn); m_run = mn; l_run *= alpha;
#pragma unroll
            for (int d0 = 0; d0 < 4; ++d0)
#pragma unroll
                for (int r = 0; r < 16; ++r) o[d0][r] *= alpha;
        }
        float ps = 0.f;
#pragma unroll
        for (int r = 0; r < 16; ++r) { p0[r] = __builtin_amdgcn_exp2f(p0[r] - m_run); p1[r] = __builtin_amdgcn_exp2f(p1[r] - m_run); ps += p0[r] + p1[r]; }
        l_run += ps;
        bf16x8 pa[4];
        { u32x4 w;
          w.x = cvt_pk(p0[0], p0[1]); w.y = cvt_pk(p0[2], p0[3]); w.z = cvt_pk(p0[4], p0[5]); w.w = cvt_pk(p0[6], p0[7]); pa[0] = __builtin_bit_cast(bf16x8, w);
          w.x = cvt_pk(p0[8], p0[9]); w.y = cvt_pk(p0[10], p0[11]); w.z = cvt_pk(p0[12], p0[13]); w.w = cvt_pk(p0[14], p0[15]); pa[1] = __builtin_bit_cast(bf16x8, w);
          w.x = cvt_pk(p1[0], p1[1]); w.y = cvt_pk(p1[2], p1[3]); w.z = cvt_pk(p1[4], p1[5]); w.w = cvt_pk(p1[6], p1[7]); pa[2] = __builtin_bit_cast(bf16x8, w);
          w.x = cvt_pk(p1[8], p1[9]); w.y = cvt_pk(p1[10], p1[11]); w.z = cvt_pk(p1[12], p1[13]); w.w = cvt_pk(p1[14], p1[15]); pa[3] = __builtin_bit_cast(bf16x8, w); }
#pragma unroll
        for (int d0 = 0; d0 < 4; ++d0)
#pragma unroll
            for (int s = 0; s < 4; ++s) {
                const LAS unsigned char* vp = Vl + bf * VT + voff[d0] + s * 4096;
                const s16x4 lo = __builtin_bit_cast(s16x4, __builtin_amdgcn_ds_read_tr16_b64_v4i16((LAS v4i16_t*)vp));
                const s16x4 hh = __builtin_bit_cast(s16x4, __builtin_amdgcn_ds_read_tr16_b64_v4i16((LAS v4i16_t*)(vp + 2048)));
                const bf16x8 vf = (bf16x8){lo[0], lo[1], lo[2], lo[3], hh[0], hh[1], hh[2], hh[3]};
                o[d0] = __builtin_amdgcn_mfma_f32_32x32x16_bf16(vf, pa[s], o[d0], 0, 0, 0);
            }
        if (t + 1 < ntiles) AT_WRITE(bf ^ 1);
        __syncthreads();
    }
    { auto rr = __builtin_amdgcn_permlane32_swap(__float_as_uint(l_run), __float_as_uint(l_run), false, false); l_run = __uint_as_float(rr[0]) + __uint_as_float(rr[1]); }
    const float inv = __builtin_amdgcn_rcpf(l_run);
    bf16* orow = O + (size_t)(wid * 32 + r32) * ldo;
#pragma unroll
    for (int d0 = 0; d0 < 4; ++d0)
#pragma unroll
        for (int g = 0; g < 4; ++g) { u32x2 w; w.x = cvt_pk(o[d0][4 * g] * inv, o[d0][4 * g + 1] * inv); w.y = cvt_pk(o[d0][4 * g + 2] * inv, o[d0][4 * g + 3] * inv);
            *(u32x2*)(orow + d0 * 32 + 8 * g + 4 * hi) = w; }
#undef AT_LOAD
#undef AT_WRITE
#undef AT_KOFF
}

__global__ void __launch_bounds__(NTHR, 2) fwd(Args args) {
    extern __shared__ __attribute__((aligned(16))) unsigned char lds_raw[];
    Frame F;
    F.lds = (LAS unsigned char*)lds_raw;
    F.tid = threadIdx.x; F.lane = F.tid & 63; F.wave = __builtin_amdgcn_readfirstlane(F.tid >> 6);
    F.G = gridDim.x; { const int bx = blockIdx.x; F.vcu = (F.G % 8 == 0) ? (bx % 8) * (F.G / 8) + bx / 8 : bx; }
    F.ws = args.ws; F.H = args.out;
    volatile LAS unsigned* MISC = (volatile LAS unsigned*)(F.lds + MISC_OFF);
    for (int u = F.tid; u < (LDS_BYTES - LDSCTL_OFF) / 4; u += NTHR) ((LAS unsigned*)(F.lds + LDSCTL_OFF))[u] = 0u;
    __syncthreads();
    unsigned* ctl = (unsigned*)(F.ws + WS_CTL);
    XcdBarrier bar; bar.bar = ctl + CW_BAR; bar.x = 0; bar.st = nullptr;
    if (ONE_LAUNCH) bar = xcd_barrier_post(ctl + CW_BAR, MISC + 8);
    const int lo = args.lo, hi = args.hi;
#ifndef PH_MASK
#define PH_MASK 0xfffffu
#endif
#define PHON(j) (((PH_MASK) >> (j)) & 1u)
#define IN(k) (lo <= (k) && (k) < hi)
#define PHASE_RELOAD() do { t_ = threadIdx.x; asm volatile("" : "+v"(t_)); F.tid = t_; F.lane = t_ & 63; F.wave = __builtin_amdgcn_readfirstlane(t_ >> 6); \
        A = (ArgsP)__builtin_amdgcn_kernarg_segment_ptr(); asm volatile("" : "+s"(A)); F.ws = A->ws; F.H = A->out; \
        { int g_ = gridDim.x, b_ = blockIdx.x; asm volatile("" : "+s"(g_), "+s"(b_)); F.G = g_; F.bx = b_; F.vcu = (g_ % 8 == 0) ? (b_ % 8) * (g_ / 8) + b_ / 8 : b_; } } while (0)
#define PHASE_BEGIN() int t_; ArgsP A; PHASE_RELOAD()
#define SEAM(k) do { if (IN(k) && IN((k) + 1)) { if (ONE_LAUNCH) xcd_barrier(bar); } } while (0)

    if (PHON(0) && IN(0)) { PHASE_BEGIN(); p0_prologue(F, A); SEAM(0); }

    for (int l = 0; l < NL; ++l) {
        const int pb = 1 + l * NPH;
        if (PHON(1) && IN(pb + 0)) { PHASE_BEGIN();
            const int N = (l == 0) ? INW : PROJ_LD;
            pg8::Gemm g{WSP(bf16, WS_U), WSP(bf16, WL(WO_IN)), T, N, D, D, D}; pg8::StaticOrder S; S.init(T, N, F.G, F.bx);
            pg8::Epi8<FPlain> E{{WSP(bf16, WS_PROJ), PROJ_LD, 1.f}};
            pg8::gemm_phase(F.lds, g, S, E);
            {
                PHASE_RELOAD();
                const int rem = ((T / 256) * (N / 256)) % F.G, nidle = F.G - rem;
                if (rem != 0 && nidle > 16) {
                    const int vr = (F.bx + F.G - rem) % F.G;
                    { pg8::Gemm g2{WSP(bf16, WS_MEMN), WSP(bf16, WL(WO_KM)), NB * NMEM, 512, D, D, D}; pg8::StaticOrder S2; S2.init(NB * NMEM, 512, F.G, vr);
                      pg8::Epi8<FPlain> E2{{WSP(bf16, WS_MEMK), 512, 1.f}}; pg8::gemm_phase(F.lds, g2, S2, E2); }
                    PHASE_RELOAD();
                    { pg8::Gemm g2{WSP(bf16, WS_MEMN), WSP(bf16, WL(WO_VM)), NB * NMEM, 512, D, D, D}; pg8::StaticOrder S2; S2.init(NB * NMEM, 512, F.G, (vr + F.G - 8) % F.G);
                      pg8::Epi8<FPlain> E2{{WSP(bf16, WS_MEMV), 512, 1.f}}; pg8::gemm_phase(F.lds, g2, S2, E2); }
                    PHASE_RELOAD();
                    if (F.bx >= rem + 16) convert_layer(F, A, l, 2, (F.bx - rem - 16) * NWAVES + F.wave, (nidle - 16) * NWAVES);
                } else {
                    { pg8::Gemm g2{WSP(bf16, WS_MEMN), WSP(bf16, WL(WO_KM)), NB * NMEM, 512, D, D, D}; pg8::StaticOrder S2; S2.init(NB * NMEM, 512, F.G, F.bx);
                      pg8::Epi8<FPlain> E2{{WSP(bf16, WS_MEMK), 512, 1.f}}; pg8::gemm_phase(F.lds, g2, S2, E2); }
                    PHASE_RELOAD();
                    { pg8::Gemm g2{WSP(bf16, WS_MEMN), WSP(bf16, WL(WO_VM)), NB * NMEM, 512, D, D, D}; pg8::StaticOrder S2; S2.init(NB * NMEM, 512, F.G, F.bx);
                      pg8::Epi8<FPlain> E2{{WSP(bf16, WS_MEMV), 512, 1.f}}; pg8::gemm_phase(F.lds, g2, S2, E2); }
                    PHASE_RELOAD();
                    convert_layer(F, A, l, 2, F.bx * NWAVES + F.wave, F.G * NWAVES);
                }
            }
            SEAM(pb + 0);
        }
        if (PHON(2) && IN(pb + 1)) { PHASE_BEGIN(); prep_phase(F, A, l); SEAM(pb + 1); }
        if (PHON(3) && IN(pb + 2)) { PHASE_BEGIN();
            {
            { pg8::Gemm g{WSP(bf16, WS_LORA), WSP(bf16, WL(WO_UP)), T, 1024, 128, LORA_LD, 128}; pg8::StaticOrder S; S.init(T, 1024, F.G, F.bx);
              pg8::Epi8<FSig<0>> E{{WSP(bf16, WS_WLOG), 1024, A->in[I_W0] + (size_t)l * 1024}}; pg8::gemm_phase(F.lds, g, S, E); }
            PHASE_RELOAD();
            { pg8::Gemm g{WSP(bf16, WS_LORA) + 128, WSP(bf16, WL(WO_AUP)), T, 1024, 128, LORA_LD, 128}; pg8::StaticOrder S; S.init(T, 1024, F.G, F.bx);
              pg8::Epi8<FSig<1>> E{{WSP(bf16, WS_AIC), 1024, A->in[I_A0] + (size_t)l * 1024}}; pg8::gemm_phase(F.lds, g, S, E); }
            PHASE_RELOAD();
            { pg8::Gemm g{WSP(bf16, WS_LORA) + 256, WSP(bf16, WL(WO_GUP)), T, 1024, 256, LORA_LD, 256}; pg8::StaticOrder S; S.init(T, 1024, F.G, F.bx);
              pg8::Epi8<FPlain> E{{WSP(bf16, WS_GATE), 1024, 1.f}}; pg8::gemm_phase(F.lds, g, S, E); }
            PHASE_RELOAD();
            if (l > 0) { pg8::Gemm g{WSP(bf16, WS_LORA) + 512, WSP(bf16, WL(WO_VUP)), T, 1024, 128, LORA_LD, 128}; pg8::StaticOrder S; S.init(T, 1024, F.G, F.bx);
              pg8::Epi8<FVup> E{{WSP(bf16, WS_VV), A->in[I_V0] + (size_t)(l - 1) * 1024, A->in[I_MU] + (size_t)l * RIN + 2048, WSP(bf16, WS_PROJ), WSP(bf16, WS_VF)}}; pg8::gemm_phase(F.lds, g, S, E); }
            PHASE_RELOAD();
            { pg8::Gemm g{WSP(bf16, WS_CQN), WSP(bf16, WL(WO_UQ)), T, 1536, 512, 512, 512}; pg8::StaticOrder S; S.init(T, 1536, F.G, F.bx);
              pg8::Epi8<FQ> E{{WSP(bf16, WS_QB), WSP(float, WS_COS), WSP(float, WS_SIN)}}; pg8::gemm_phase(F.lds, g, S, E); }
            PHASE_RELOAD();
            { pg8::Gemm g{WSP(bf16, WS_CKVN), WSP(bf16, WL(WO_UKV)), T, 2048, 256, 256, 256}; pg8::StaticOrder S; S.init(T, 2048, F.G, F.bx);
              pg8::Epi8<FPlain> E{{WSP(bf16, WS_KV), 2048, 1.f}}; pg8::gemm_phase(F.lds, g, S, E); }
            }
            SEAM(pb + 2);
        }
        if (PHON(4) && IN(pb + 3)) { PHASE_BEGIN();
            cs_pre_phase(F, A, l);
            SEAM(pb + 3);
        }
        if (PHON(5) && IN(pb + 4)) { PHASE_BEGIN();
            for (int u = F.vcu; u < 128; u += F.G) cs_seq_unit(F, u >> 1, u & 1);
            if (F.G > 128 && F.vcu >= 128) convert_layer(F, A, l, 3, (F.vcu - 128) * NWAVES + F.wave, (F.G - 128) * NWAVES);
            else if (F.G <= 128) convert_layer(F, A, l, 3, F.vcu * NWAVES + F.wave, F.G * NWAVES);
            __syncthreads();
        }
        if (PHON(6) && IN(pb + 5)) { PHASE_BEGIN();
            for (int u = F.vcu; u < 256; u += F.G) {
                const int bh = u >> 3, s = u & 7, b = bh >> 3, hh = bh & 7;
#pragma unroll 1
                for (int pass = 0; pass < 2; ++pass) {
                    const int qb = pass == 0 ? s : 15 - s; const size_t r0 = (size_t)b * SEQ;
                    attn_unit<192, true>(F.lds, WSP(bf16, WS_QB) + (r0 + qb * 256) * 1536 + hh * 192, 1536,
                                         WSP(bf16, WS_KV) + r0 * 2048 + hh * 256, 2048, WSP(bf16, WS_KR) + r0 * 64, 64,
                                         WSP(bf16, WS_KV) + r0 * 2048 + hh * 256 + 128, 2048,
                                         WSP(bf16, WS_U) + (r0 + qb * 256) * D + 1024 + hh * 128, D, qb * 256, 4 * (qb + 1));
                }
            }
            SEAM(pb + 5);
        }
        if (PHON(7) && IN(pb + 6)) { PHASE_BEGIN(); rwkv_post_phase(F, A, l); SEAM(pb + 6); }
        if (PHON(8) && IN(pb + 7)) { PHASE_BEGIN();
            pg8::Gemm g{WSP(bf16, WS_U), WSP(bf16, WL(WO_OUT)), T, D, D, D, D}; pg8::StaticOrder S; S.init(T, D, F.G, F.bx);
            pg8::Epi8<FPlain> E{{WSP(bf16, WS_Y), D, 1.f}}; pg8::gemm_phase(F.lds, g, S, E);
            SEAM(pb + 7);
        }
        if (PHON(9) && IN(pb + 8)) { PHASE_BEGIN(); ew_norm_phase(F, A->in[I_MIXPOST] + (size_t)l * D, A->in[I_MEMPRE] + (size_t)l * D, 3 * l); SEAM(pb + 8); }
        if (PHON(10) && IN(pb + 9)) { PHASE_BEGIN();
            pg8::Gemm g{WSP(bf16, WS_U), WSP(bf16, WL(WO_QM)), T, 512, D, D, D}; pg8::StaticOrder S; S.init(T, 512, F.G, F.bx);
            pg8::Epi8<FPlain> E{{WSP(bf16, WS_QMEM), 512, QSCALE_MEM}}; pg8::gemm_phase(F.lds, g, S, E);
            PHASE_RELOAD();
            asm volatile("s_waitcnt vmcnt(0)" ::: "memory");
            __syncthreads();
            { pg8::StaticOrder S3; S3.init(T, 512, F.G, F.bx); pg8::Unit uq;
              for (int i = 0; S3.next(i, uq); ++i) {
#pragma unroll 1
                for (int hp = 0; hp < 2; ++hp) { const int b = uq.pm >> 4, hh = uq.pn * 2 + hp; const size_t r0 = (size_t)uq.pm * 256;
                    attn_unit<128, false>(F.lds, WSP(bf16, WS_QMEM) + r0 * 512 + hh * 128, 512,
                                          WSP(bf16, WS_MEMK) + (size_t)b * NMEM * 512 + hh * 128, 512, nullptr, 0,
                                          WSP(bf16, WS_MEMV) + (size_t)b * NMEM * 512 + hh * 128, 512,
                                          WSP(bf16, WS_OMEM) + r0 * 512 + hh * 128, 512, 0, NMEM / 64); } } }
            if (l + 1 < NL) { PHASE_RELOAD();
                if (F.G > 128 && F.bx >= 128) convert_layer(F, A, l + 1, 1, (F.bx - 128) * NWAVES + F.wave, (F.G - 128) * NWAVES);
                else if (F.G <= 128) convert_layer(F, A, l + 1, 1, F.bx * NWAVES + F.wave, F.G * NWAVES); }
            SEAM(pb + 9);
        }
        if (PHON(12) && IN(pb + 11)) { PHASE_BEGIN();
            pg8::Gemm g{WSP(bf16, WS_OMEM), WSP(bf16, WL(WO_OM)), T, D, 512, 512, 512}; pg8::StaticOrder S; S.init(T, D, F.G, F.bx);
            pg8::Epi8<FPlain> E{{WSP(bf16, WS_Y), D, 1.f}}; pg8::gemm_phase(F.lds, g, S, E);
            SEAM(pb + 11);
        }
        if (PHON(13) && IN(pb + 12)) { PHASE_BEGIN(); ew_norm_phase(F, A->in[I_MEMPOST] + (size_t)l * D, A->in[I_FFNPRE] + (size_t)l * D, 3 * l + 1); SEAM(pb + 12); }
        if (PHON(14) && IN(pb + 13)) { PHASE_BEGIN();
            pg8::Gemm g{WSP(bf16, WS_U), WSP(bf16, WL(WO_FF1)), T, FF, D, D, D}; pg8::StaticOrder S; S.init(T, FF, F.G, F.bx);
            pg8::Epi8<FRelu2> E{{WSP(bf16, WS_HID), FF}}; pg8::gemm_phase(F.lds, g, S, E);
            SEAM(pb + 13);
        }
        if (PHON(15) && IN(pb + 14)) { PHASE_BEGIN();
            pg8::Gemm g{WSP(bf16, WS_HID), WSP(bf16, WL(WO_FF2)), T, D, FF, FF, FF}; pg8::StaticOrder S; S.init(T, D, F.G, F.bx);
            pg8::Epi8<FPlain> E{{WSP(bf16, WS_Y), D, 1.f}}; pg8::gemm_phase(F.lds, g, S, E);
            SEAM(pb + 14);
        }
        if (PHON(16) && IN(pb + 15)) { PHASE_BEGIN(); ew_norm_phase(F, A->in[I_FFNPOST] + (size_t)l * D, l + 1 < NL ? A->in[I_MIXPRE] + (size_t)(l + 1) * D : nullptr, 3 * l + 2); SEAM(pb + 15); }
    }
#undef IN
#undef SEAM
}

extern "C" void kernel_launch(void* const* d_in, const int* in_sizes, int n_in, void* d_out, int out_size, void* d_ws, size_t ws_size, hipStream_t stream) {
    static int grid = 0;
    if (grid == 0) {
        if (n_in != N_IN || out_size != T * D || ws_size < WS_END) { fprintf(stderr, "kernel_launch: unexpected shapes (n_in %d, out %d, ws %zu)\n", n_in, out_size, ws_size); grid = -1; return; }
        int dev = 0, cus = 0;
        if (hipGetDevice(&dev) != hipSuccess || hipDeviceGetAttribute(&cus, hipDeviceAttributeMultiprocessorCount, dev) != hipSuccess) { grid = -1; return; }
        if (hipFuncSetAttribute((const void*)fwd, hipFuncAttributeMaxDynamicSharedMemorySize, LDS_BYTES) != hipSuccess) { fprintf(stderr, "kernel_launch: hipFuncSetAttribute failed\n"); grid = -1; return; }
        int per_cu = 0;
        if (hipOccupancyMaxActiveBlocksPerMultiprocessor(&per_cu, (const void*)fwd, NTHR, LDS_BYTES) != hipSuccess || per_cu < 1) fprintf(stderr, "kernel_launch: occupancy query says %d\n", per_cu);
        (void)hipGetLastError();
        grid = cus;
    }
    if (grid < 0) return;
    (void)hipMemsetAsync((char*)d_ws + WS_CTL, 0, CTL_BYTES, stream);
    Args a{};
    for (int i = 0; i < N_IN; ++i) a.in[i] = (const float*)d_in[i];
    a.out = (float*)d_out; a.ws = (unsigned char*)d_ws;
    const int nph = NPHASES < STOP_PHASE ? NPHASES : STOP_PHASE;
    if (ONE_LAUNCH) { a.lo = 0; a.hi = nph; hipLaunchKernelGGL(fwd, dim3(grid), dim3(NTHR), LDS_BYTES, stream, a); }
    else { for (int p = 0; p < nph; ++p) { a.lo = p; a.hi = p + 1; hipLaunchKernelGGL(fwd, dim3(grid), dim3(NTHR), LDS_BYTES, stream, a); } }
}
```

```cpp
#include <hip/hip_runtime.h>
#include <cstdio>
#include <cstdint>

#define GAS __attribute__((address_space(1)))
#define LAS __attribute__((address_space(3)))
typedef unsigned short bf16;
typedef short bf16x8 __attribute__((ext_vector_type(8)));
typedef short s16x4 __attribute__((ext_vector_type(4)));
typedef float f32x2 __attribute__((ext_vector_type(2)));
typedef float f32x4 __attribute__((ext_vector_type(4)));
typedef float f32x16 __attribute__((ext_vector_type(16)));
typedef unsigned u32x2 __attribute__((ext_vector_type(2)));
typedef unsigned u32x4 __attribute__((ext_vector_type(4)));
typedef __bf16 bf16x2_t __attribute__((ext_vector_type(2)));

#ifndef ONE_LAUNCH
#define ONE_LAUNCH 1
#endif
#ifndef STOP_PHASE
#define STOP_PHASE 1000
#endif

constexpr int T = 16384, SEQ = 4096, NB = 4, D = 2048, NL = 4, FF = 8192;
constexpr int RIN = 3520, INW = 4352, PROJ_LD = 4608;
constexpr int NMEM = 256;
constexpr float NORM_EPS = 1e-6f, GN_EPS = 64e-5f;
constexpr float QSCALE_MLA = 0.07216878364870323f * 1.4426950408889634f;
constexpr float QSCALE_MEM = 0.08838834764831845f * 1.4426950408889634f;
constexpr int NWAVES = 8, NTHR = 512;
constexpr int NPH = 16, NPHASES = 1 + NL * NPH;

enum { I_X = 0, I_MEM, I_MEMG, I_MIXPRE, I_WIN, I_WINV, I_MU, I_MUV, I_W0, I_WUP, I_A0, I_AUP, I_V0, I_VUP, I_GUP, I_KK, I_KA, I_RK, I_LNG, I_LNB,
       I_QNG, I_WUQ, I_KVNG, I_WUKV, I_WOUT, I_MIXPOST, I_MEMPRE, I_WQM, I_WKM, I_WVM, I_WOM, I_MEMPOST, I_FFNPRE, I_FF1, I_FF2, I_FFNPOST, N_IN };

constexpr size_t KiB = 1024, MiB = 1024 * 1024;
constexpr size_t WS_CTL = 0, CTL_BYTES = 1 * MiB;
constexpr size_t WS_COS = 1 * MiB, WS_SIN = 1 * MiB + 512 * KiB;
constexpr size_t WS_MEMN = 2 * MiB, WS_MEMK = 6 * MiB, WS_MEMV = 7 * MiB, WS_RKB = 8 * MiB;
constexpr size_t WS_W = 16 * MiB, W_LSTRIDE = 38 * MiB;
constexpr size_t WS_WFF = 92 * MiB;
constexpr size_t WS_HB = 156 * MiB;
constexpr size_t WS_SCAN = 220 * MiB;
constexpr size_t WO_IN = 0, WO_UP = 18 * MiB, WO_AUP = 18 * MiB + 256 * KiB, WO_GUP = 18 * MiB + 512 * KiB, WO_VUP = 19 * MiB, WO_UQ = 19 * MiB + 512 * KiB,
                 WO_UKV = 21 * MiB, WO_OUT = 22 * MiB, WO_QM = 30 * MiB, WO_KM = 32 * MiB, WO_VM = 34 * MiB, WO_OM = 36 * MiB, WO_FF1 = 38 * MiB, WO_FF2 = 70 * MiB;
constexpr size_t WS_U = 424 * MiB, WS_Y = 488 * MiB, WS_VF = 552 * MiB;
constexpr size_t WS_PROJ = 584 * MiB, WS_LORA = 728 * MiB, WS_WLOG = 748 * MiB, WS_AIC = 780 * MiB, WS_GATE = 812 * MiB, WS_VV = 844 * MiB,
                 WS_CQN = 876 * MiB, WS_CKVN = 892 * MiB, WS_KR = 900 * MiB, WS_QB = 902 * MiB, WS_KV = 950 * MiB, WS_END = 1014 * MiB;
constexpr size_t WS_HID = 584 * MiB, WS_QMEM = 840 * MiB, WS_OMEM = 856 * MiB;
constexpr int LORA_LD = 640;
constexpr int CW_TMO = 0, CW_BAR = 4096;

constexpr int RING_BYTES = 163328, LDSCTL_OFF = RING_BYTES, MISC_OFF = LDSCTL_OFF + 320, LDS_BYTES = 163840;

__device__ __forceinline__ unsigned cvt_pk(float lo, float hi) { f32x2 v = {lo, hi}; bf16x2_t b = __builtin_convertvector(v, bf16x2_t); return __builtin_bit_cast(unsigned, b); }
__device__ __forceinline__ float bflo(unsigned w) { return __uint_as_float(w << 16); }
__device__ __forceinline__ float bfhi(unsigned w) { return __uint_as_float(w & 0xffff0000u); }
__device__ __forceinline__ float bf1(bf16 b) { return __uint_as_float((unsigned)b << 16); }
__device__ __forceinline__ bf16 f2bf(float f) { return (bf16)(cvt_pk(f, 0.f) & 0xffffu); }
template <int CTRL> __device__ __forceinline__ float dpp_add(float x) { return x + __int_as_float(__builtin_amdgcn_update_dpp(0, __float_as_int(x), CTRL, 0xf, 0xf, true)); }
__device__ __forceinline__ float sum4(float x) { x = dpp_add<0xB1>(x); x = dpp_add<0x4E>(x); return x; }
__device__ __forceinline__ float sum8(float x) { x = sum4(x); x = dpp_add<0x141>(x); return x; }
__device__ __forceinline__ float sum16(float x) { x = sum8(x); x = dpp_add<0x140>(x); return x; }
__device__ __forceinline__ float wave_sum(float x) {
    x = sum16(x);
    { auto r = __builtin_amdgcn_permlane16_swap(__float_as_uint(x), __float_as_uint(x), false, false); x = __uint_as_float(r[0]) + __uint_as_float(r[1]); }
    { auto r = __builtin_amdgcn_permlane32_swap(__float_as_uint(x), __float_as_uint(x), false, false); x = __uint_as_float(r[0]) + __uint_as_float(r[1]); }
    return x;
}
__device__ __forceinline__ float sigmoidf_(float x) { return __builtin_amdgcn_rcpf(1.f + __builtin_amdgcn_exp2f(-1.4426950408889634f * x)); }
__device__ __forceinline__ float tanhf_(float x) { const float e = __builtin_amdgcn_exp2f(-2.f * 1.4426950408889634f * fabsf(x)); const float t = (1.f - e) * __builtin_amdgcn_rcpf(1.f + e); return x < 0.f ? -t : t; }
__device__ __forceinline__ void unpack8(u32x4 w, float (&f)[8]) {
    f[0] = bflo(w.x); f[1] = bfhi(w.x); f[2] = bflo(w.y); f[3] = bfhi(w.y); f[4] = bflo(w.z); f[5] = bfhi(w.z); f[6] = bflo(w.w); f[7] = bfhi(w.w);
}
__device__ __forceinline__ u32x4 pack8(const float (&f)[8]) { u32x4 w; w.x = cvt_pk(f[0], f[1]); w.y = cvt_pk(f[2], f[3]); w.z = cvt_pk(f[4], f[5]); w.w = cvt_pk(f[6], f[7]); return w; }

__device__ __forceinline__ int crow(int r, int hi) { return (r & 3) + 8 * (r >> 2) + 4 * hi; }
typedef short v4i16_t __attribute__((ext_vector_type(4)));

namespace pg8 {
#define PG8_LAS __attribute__((address_space(3)))
typedef unsigned short bf16_t;
constexpr int BM = 256, BK = 64, HALF = 128, HTB = HALF * BK * 2, STAGE_BYTES = 8 * HTB, NXCD = 8, WGM = 8;
__host__ __device__ __forceinline__ int lds_byte(int r, int c) { const int st = (r >> 4) * 2 + (c >> 5), rr = r & 15, cc = c & 31, ob = rr * 64 + cc * 2; return st * 1024 + (ob ^ (((ob >> 9) & 1) << 5)); }
__host__ __device__ __forceinline__ void stage_rc(int b, int& R, int& C) { const int st = b / 1024, sb = b % 1024, swz = sb ^ (((sb >> 9) & 1) << 5); R = (st >> 1) * 16 + swz / 64; C = (st & 1) * 32 + (swz % 64) / 2; }
__host__ __device__ __forceinline__ int perm32(int rho) { const int n = rho >> 4, i = rho & 15; return 8 * (i >> 2) + 4 * n + (i & 3); }
struct Unit { int pm, pn; };
struct Gemm { const bf16_t* A; const bf16_t* Bt; int M, N, K, lda, ldb; };
struct StaticOrder {
    int nM, nN, nwg, G, c;
    __host__ __device__ void init(int M, int N, int G_, int c_) { nM = M / BM; nN = N / BM; nwg = nM * nN; G = G_; c = c_; }
    __host__ __device__ bool next(int i, Unit& u) const {
        const long L = (long)i * G + c; if (L >= nwg) return false;
        int wgid = (int)L; { const int q = nwg / NXCD, r = nwg % NXCD, xcd = wgid % NXCD, off = wgid / NXCD; wgid = (xcd < r ? xcd * (q + 1) : r * (q + 1) + (xcd - r) * q) + off; }
        const int nig = WGM * nN, gid = wgid / nig, fm = gid * WGM, gsz = (nM - fm) < WGM ? (nM - fm) : WGM;
        u.pm = fm + ((wgid % nig) % gsz); u.pn = (wgid % nig) / gsz; return true;
    }
};
template <class F> struct Epi8 {
    F f;
    __device__ __forceinline__ void operator()(const f32x4 (&acc)[2][2][4][2], const Unit& u, int wr, int wc, int fr, int fq) const {
        const int row0 = u.pm * BM + wr * 64 + fr, col0 = u.pn * BM + wc * 32 + 8 * fq;
#pragma unroll
        for (int ai = 0; ai < 2; ++ai)
#pragma unroll
            for (int m = 0; m < 4; ++m)
#pragma unroll
                for (int bj = 0; bj < 2; ++bj) { f(row0 + ai * HALF + m * 16, col0 + bj * HALF, acc[ai][bj][m][0], acc[ai][bj][m][1]); if (F::HEAVY) __builtin_amdgcn_sched_barrier(0); }
    }
};

template <class Epi>
__device__ __forceinline__ void gemm_phase(PG8_LAS unsigned char* lds, const Gemm g, const StaticOrder& S, const Epi& E) {
    int tid = threadIdx.x; asm volatile("" : "+v"(tid));
    const int wid = __builtin_amdgcn_readfirstlane(tid >> 6), lane = tid & 63, wr = wid >> 2, wc = wid & 3, fr = lane & 15, fq = lane >> 4;
    int K = g.K; asm volatile("" : "+s"(K));
    const int nt = K / BK;
    unsigned voffA[2], voffB[2];
#pragma unroll
    for (int i = 0; i < 2; ++i) { int R, C; stage_rc(tid * 16 + i * 8192, R, C); const int Rb = (R & ~31) + perm32(R & 31);
        voffA[i] = (unsigned)(R * g.lda + C) * 2u; voffB[i] = (unsigned)(Rb * g.ldb + C) * 2u; }
    const size_t kstep = (size_t)(BK * 2);
    const size_t hsA = (size_t)HALF * g.lda * 2, hsB = (size_t)HALF * g.ldb * 2;
    const size_t tsA = 2 * hsA, tsB = 2 * hsB;
    const unsigned ldsw = (unsigned)wid * 1024u;
    const int aoff = lds_byte(wr * 64 + fr, fq * 8), boff = lds_byte(wc * 32 + fr, fq * 8);
#define PG8_SA(b, h) (((b) * 2 + (h)) * HTB)
#define PG8_SB(b, h) ((4 + (b) * 2 + (h)) * HTB)
#define PG8_STAGE(bufoff, gbase, voff) do { _Pragma("unroll") for (int _i = 0; _i < 2; ++_i) \
        __builtin_amdgcn_global_load_lds((const unsigned*)((const char*)(gbase) + (voff)[_i]), (PG8_LAS unsigned*)(lds + (bufoff) + ldsw + _i * 8192), 16, 0, 0); } while (0)
#define PG8_LDA(dst, b, h) do { _Pragma("unroll") for (int m = 0; m < 4; ++m) _Pragma("unroll") for (int k = 0; k < 2; ++k) dst[m][k] = *(const PG8_LAS bf16x8*)(lds + PG8_SA(b, h) + aoff + m * 2048 + k * 1024); } while (0)
#define PG8_LDB(dst, b, h) do { _Pragma("unroll") for (int n = 0; n < 2; ++n) _Pragma("unroll") for (int k = 0; k < 2; ++k) dst[n][k] = *(const PG8_LAS bf16x8*)(lds + PG8_SB(b, h) + boff + n * 2048 + k * 1024); } while (0)
#define PG8_MMA(ai, bj, At, Bt) do { __builtin_amdgcn_s_setprio(1); _Pragma("unroll") for (int m = 0; m < 4; ++m) _Pragma("unroll") for (int n = 0; n < 2; ++n) _Pragma("unroll") for (int k = 0; k < 2; ++k) \
        acc[ai][bj][m][n] = __builtin_amdgcn_mfma_f32_16x16x32_bf16(Bt[n][k], At[m][k], acc[ai][bj][m][n], 0, 0, 0); __builtin_amdgcn_s_setprio(0); } while (0)
#define PG8_WAIT_V(n) asm volatile("s_waitcnt vmcnt(" #n ")" ::: "memory")
#define PG8_WAIT_L(n) asm volatile("s_waitcnt lgkmcnt(" #n ")" ::: "memory")
#define PG8_BAR __builtin_amdgcn_s_barrier()
#define PG8_SCHED __builtin_amdgcn_sched_barrier(0)
    Unit cur, nxt; int ui = 0;
    if (!S.next(0, cur)) return;
    f32x4 acc[2][2][4][2];
#pragma unroll
    for (int a = 0; a < 2; ++a)
#pragma unroll
        for (int b = 0; b < 2; ++b)
#pragma unroll
            for (int m = 0; m < 4; ++m)
#pragma unroll
                for (int n = 0; n < 2; ++n) acc[a][b][m][n] = (f32x4){0.f, 0.f, 0.f, 0.f};
    bf16x8 At[4][2], B0[2][2], B1[2][2];
    const char* cA = (const char*)g.A + (size_t)cur.pm * tsA; const char* cB = (const char*)g.Bt + (size_t)cur.pn * tsB;
    PG8_STAGE(PG8_SB(0, 0), cB, voffB); PG8_STAGE(PG8_SB(0, 1), cB + hsB, voffB); PG8_STAGE(PG8_SA(0, 0), cA, voffA); PG8_STAGE(PG8_SA(0, 1), cA + hsA, voffA);
    if (wr == 1) PG8_BAR;
    PG8_WAIT_V(2); PG8_BAR;
    PG8_STAGE(PG8_SB(1, 0), cB + kstep, voffB); PG8_STAGE(PG8_SA(1, 0), cA + kstep, voffA); PG8_STAGE(PG8_SB(1, 1), cB + hsB + kstep, voffB);
    PG8_WAIT_V(6); PG8_BAR;
    for (;;) {
        const bool has_next = S.next(ui + 1, nxt);
        const char* nA = has_next ? (const char*)g.A + (size_t)nxt.pm * tsA : cA; const char* nB = has_next ? (const char*)g.Bt + (size_t)nxt.pn * tsB : cB;
        for (int t = 0; t < nt; t += 2) {
            const bool last = (t == nt - 2);
            const char* a1 = cA + (size_t)(t + 1) * kstep;
            const char* a2 = last ? nA : cA + (size_t)(t + 2) * kstep; const char* b2 = last ? nB : cB + (size_t)(t + 2) * kstep;
            const char* a3 = a2 + kstep; const char* b3 = b2 + kstep;
            PG8_LDB(B0, 0, 0); PG8_LDB(B1, 0, 1); PG8_SCHED; PG8_LDA(At, 0, 0); PG8_STAGE(PG8_SA(1, 1), a1 + hsA, voffA);
            PG8_WAIT_V(8); PG8_WAIT_L(0); PG8_BAR; PG8_MMA(0, 0, At, B0); PG8_MMA(0, 1, At, B1); PG8_BAR; PG8_SCHED;
            PG8_LDA(At, 0, 1); PG8_STAGE(PG8_SB(0, 0), b2, voffB); PG8_STAGE(PG8_SB(0, 1), b2 + hsB, voffB); PG8_STAGE(PG8_SA(0, 0), a2, voffA);
            PG8_WAIT_V(8); PG8_WAIT_L(0); PG8_BAR; PG8_MMA(1, 0, At, B0); PG8_MMA(1, 1, At, B1); PG8_BAR; PG8_SCHED;
            PG8_LDB(B0, 1, 0); PG8_LDB(B1, 1, 1); PG8_SCHED; PG8_LDA(At, 1, 0); PG8_STAGE(PG8_SA(0, 1), a2 + hsA, voffA);
            PG8_WAIT_V(8); PG8_WAIT_L(0); PG8_BAR; PG8_MMA(0, 0, At, B0); PG8_MMA(0, 1, At, B1); PG8_BAR; PG8_SCHED;
            PG8_LDA(At, 1, 1); PG8_STAGE(PG8_SB(1, 0), b3, voffB); PG8_STAGE(PG8_SB(1, 1), b3 + hsB, voffB); PG8_STAGE(PG8_SA(1, 0), a3, voffA);
            PG8_WAIT_V(8); PG8_WAIT_L(0); PG8_BAR; PG8_MMA(1, 0, At, B0); PG8_MMA(1, 1, At, B1); PG8_BAR; PG8_SCHED;
        }
        if (wr == 0) PG8_BAR;
        E(acc, cur, wr, wc, fr, fq);
        if (!has_next) break;
#pragma unroll
        for (int a = 0; a < 2; ++a)
#pragma unroll
            for (int b = 0; b < 2; ++b)
#pragma unroll
                for (int m = 0; m < 4; ++m)
#pragma unroll
                    for (int n = 0; n < 2; ++n) acc[a][b][m][n] = (f32x4){0.f, 0.f, 0.f, 0.f};
        cur = nxt; cA = nA; cB = nB; ++ui;
        if (wr == 1) PG8_BAR;
    }
    PG8_WAIT_V(0);
    PG8_BAR;
#undef PG8_SA
#undef PG8_SB
#undef PG8_STAGE
#undef PG8_LDA
#undef PG8_LDB
#undef PG8_MMA
#undef PG8_WAIT_V
#undef PG8_WAIT_L
#undef PG8_BAR
#undef PG8_SCHED
}
}

__device__ __forceinline__ void st16_wt(void* p, u32x4 w) { asm volatile("global_store_dwordx4 %0, %1, off sc1\n\ts_nop 1" :: "v"(p), "v"(w) : "memory"); }
struct FPlain { static constexpr bool HEAVY = false; bf16* O; int ld; float sc;
    __device__ __forceinline__ void operator()(int row, int col, f32x4 a, f32x4 b) const {
        u32x4 w; w.x = cvt_pk(a[0] * sc, a[1] * sc); w.y = cvt_pk(a[2] * sc, a[3] * sc); w.z = cvt_pk(b[0] * sc, b[1] * sc); w.w = cvt_pk(b[2] * sc, b[3] * sc);
        st16_wt(O + (size_t)row * ld + col, w); } };
struct FRelu2 { static constexpr bool HEAVY = false; bf16* O; int ld;
    __device__ __forceinline__ void operator()(int row, int col, f32x4 a, f32x4 b) const {
        float v[8] = {a[0], a[1], a[2], a[3], b[0], b[1], b[2], b[3]};
#pragma unroll
        for (int i = 0; i < 8; ++i) { const float r = fmaxf(v[i], 0.f); v[i] = r * r; }
        st16_wt(O + (size_t)row * ld + col, pack8(v)); } };
template <int MODE> struct FSig { static constexpr bool HEAVY = true; bf16* O; int ld; const float* bias;
    __device__ __forceinline__ void operator()(int row, int col, f32x4 a, f32x4 b) const {
        const f32x4 b0 = *(const f32x4*)(bias + col), b1 = *(const f32x4*)(bias + col + 4);
        float v[8] = {a[0] + b0[0], a[1] + b0[1], a[2] + b0[2], a[3] + b0[3], b[0] + b1[0], b[1] + b1[1], b[2] + b1[2], b[3] + b1[3]};
#pragma unroll
        for (int i = 0; i < 8; ++i) { const float s = sigmoidf_(v[i]); v[i] = MODE == 0 ? -0.6065306597126334f * s : s; }
        *(u32x4*)(O + (size_t)row * ld + col) = pack8(v); } };
struct FVup { static constexpr bool HEAVY = true; bf16* O; const float* v0; const float* mu; const bf16* proj; const bf16* vfirst;
    __device__ __forceinline__ void operator()(int row, int col, f32x4 a, f32x4 b) const {
        const f32x4 b0 = *(const f32x4*)(v0 + col), b1 = *(const f32x4*)(v0 + col + 4), m0 = *(const f32x4*)(mu + col), m1 = *(const f32x4*)(mu + col + 4);
        float cur[8], prv[8], vf[8];
        unpack8(*(const u32x4*)(proj + (size_t)row * PROJ_LD + 2048 + col), cur);
        if ((row & (SEQ - 1)) != 0) unpack8(*(const u32x4*)(proj + (size_t)(row - 1) * PROJ_LD + 2048 + col), prv);
        else {
#pragma unroll
            for (int i = 0; i < 8; ++i) prv[i] = 0.f; }
        unpack8(*(const u32x4*)(vfirst + (size_t)row * 1024 + col), vf);
        const float acc8[8] = {a[0] + b0[0], a[1] + b0[1], a[2] + b0[2], a[3] + b0[3], b[0] + b1[0], b[1] + b1[1], b[2] + b1[2], b[3] + b1[3]};
        const float mu8[8] = {m0[0], m0[1], m0[2], m0[3], m1[0], m1[1], m1[2], m1[3]};
        float v[8];
#pragma unroll
        for (int i = 0; i < 8; ++i) { const float vs = cur[i] + (prv[i] - cur[i]) * mu8[i]; v[i] = vs + (vf[i] - vs) * sigmoidf_(acc8[i]); }
        *(u32x4*)(O + (size_t)row * 1024 + col) = pack8(v); } };
struct FQ { static constexpr bool HEAVY = true; bf16* O; const float* cosT; const float* sinT;
    __device__ __forceinline__ void operator()(int row, int col, f32x4 a, f32x4 b) const {
        const int cc = col % 192;
        float v[8] = {a[0], a[1], a[2], a[3], b[0], b[1], b[2], b[3]};
        if (cc >= 128) { const int i0 = (cc - 128) >> 1, pos = row & (SEQ - 1);
            const f32x4 c = *(const f32x4*)(cosT + pos * 32 + i0), s = *(const f32x4*)(sinT + pos * 32 + i0);
#pragma unroll
            for (int i = 0; i < 4; ++i) { const float x1 = v[2 * i], x2 = v[2 * i + 1]; v[2 * i] = x1 * c[i] - x2 * s[i]; v[2 * i + 1] = x1 * s[i] + x2 * c[i]; } }
#pragma unroll
        for (int i = 0; i < 8; ++i) v[i] *= QSCALE_MLA;
        *(u32x4*)(O + (size_t)row * 1536 + col) = pack8(v); } };

#define XB_TMO      128
#define XB_XCNT(j)  (256  + 64 * (j))
#define XB_XSUB(j)  (1280 + 64 * (j))
#define XB_XGEN(j)  (2304 + 64 * (j))
#define XB_TOP      3328
#define XB_TOPGEN   3392
#define XCD_BAR_WORDS 3456
#define XB_SPIN_CAP (1u << 20)
__device__ __forceinline__ unsigned xb_ld(unsigned* p)              { return __hip_atomic_load(p, __ATOMIC_RELAXED, __HIP_MEMORY_SCOPE_AGENT); }
__device__ __forceinline__ unsigned xb_add(unsigned* p, unsigned v) { return __hip_atomic_fetch_add(p, v, __ATOMIC_RELAXED, __HIP_MEMORY_SCOPE_AGENT); }
__device__ __forceinline__ unsigned xb_xcc_id() { return (unsigned)__builtin_amdgcn_s_getreg((3 << 11) | 20) & 0xFu; }
#define XB_SPIN(cond, bar) do { unsigned _sp = 0; while (cond) { __builtin_amdgcn_s_sleep(1); \
    if ((++_sp & 255u) == 0u) { if (xb_ld(&(bar)[XB_TMO])) break; if (_sp > XB_SPIN_CAP) { atomicAdd(&(bar)[XB_TMO], 1u); break; } } } } while (0)
struct XcdBarrier { unsigned* bar; unsigned x; volatile LAS unsigned* st; };
__device__ __forceinline__ XcdBarrier xcd_barrier_post(unsigned* bar, volatile LAS unsigned* st) {
    XcdBarrier b; b.bar = bar; b.x = xb_xcc_id(); b.st = st;
    if (threadIdx.x == 0) (void)xb_add(&bar[XB_XCNT(b.x)], 1u);
    return b;
}
__device__ __forceinline__ void xcd_barrier_complete(unsigned* bar, unsigned x, unsigned& nloc, unsigned& nx) {
    const unsigned G = gridDim.x * gridDim.y * gridDim.z;
    unsigned sum, cnt, mine, sp = 0u;
    for (;;) {
        sum = 0u; cnt = 0u; mine = 0u;
#pragma unroll
        for (unsigned j = 0; j < 16; ++j) { const unsigned c = xb_ld(&bar[XB_XCNT(j)]); sum += c; cnt += (c > 0u) ? 1u : 0u; mine = (j == x) ? c : mine; }
        if (sum == G) break;
        __builtin_amdgcn_s_sleep(1);
        if ((++sp & 255u) == 0u) { if (xb_ld(&bar[XB_TMO])) break; if (sp > XB_SPIN_CAP) { atomicAdd(&bar[XB_TMO], 1u); break; } }
    }
    nloc = mine > 0u ? mine : 1u; nx = cnt > 0u ? cnt : 1u;
}
__device__ __forceinline__ void xcd_barrier(const XcdBarrier& b) {
    asm volatile("s_waitcnt vmcnt(0)" ::: "memory");
    __syncthreads();
    if (threadIdx.x == 0) {
        unsigned* bar = b.bar;
        __builtin_amdgcn_s_waitcnt(0);
        unsigned nloc = b.st[0], nx = b.st[1];
        if (nloc == 0u) { xcd_barrier_complete(bar, b.x, nloc, nx); b.st[0] = nloc; b.st[1] = nx; }
        const unsigned old = xb_add(&bar[XB_XSUB(b.x)], 1u);
        const unsigned gen = old / nloc;
        if (old + 1u == (gen + 1u) * nloc) {
            __builtin_amdgcn_fence(__ATOMIC_RELEASE, "agent");
            asm volatile("s_waitcnt vmcnt(0)" ::: "memory");
            const unsigned og = xb_add(&bar[XB_TOP], 1u);
            const unsigned tg = og / nx;
            if (og + 1u == (tg + 1u) * nx) xb_add(&bar[XB_TOPGEN], 1u);
            else XB_SPIN(xb_ld(&bar[XB_TOPGEN]) == tg, bar);
            __builtin_amdgcn_fence(__ATOMIC_ACQUIRE, "agent");
            xb_add(&bar[XB_XGEN(b.x)], 1u);
            asm volatile("s_waitcnt vmcnt(0)" ::: "memory");
        } else {
            XB_SPIN(xb_ld(&bar[XB_XGEN(b.x)]) == gen, bar);
            __builtin_amdgcn_fence(__ATOMIC_ACQUIRE, "agent");
            asm volatile("s_waitcnt vmcnt(0)" ::: "memory");
        }
    }
    __syncthreads();
}

struct Args { const float* in[N_IN]; float* out; unsigned char* ws; int lo, hi; };
typedef const __attribute__((address_space(4))) Args* ArgsP;
struct Frame {
    LAS unsigned char* lds;
    int tid, lane, wave, vcu, G, bx;
    unsigned char* ws;
    float* H;
};
#define WSP(type, off) ((type*)(F.ws + (off)))
#define WL(off) ((off) >= WO_FF1 ? WS_WFF + ((off) - WO_FF1) : WS_W + (size_t)(l & 1) * W_LSTRIDE + (off))

__constant__ int JK[15]  = {2048, 2048, 256, 256, 2048, 2048, 2048, 2048, 512, 96, 96, 64, 512, 2048, 8192};
__constant__ int JKP[15] = {2048, 2048, 256, 256, 2048, 2048, 2048, 2048, 512, 128, 128, 128, 512, 2048, 8192};
__constant__ int JN[15]  = {4352, 64, 1024, 2048, 2048, 512, 512, 512, 2048, 1024, 1024, 1024, 1536, 8192, 2048};
__constant__ int JIN[15] = {I_WIN, I_WINV, I_GUP, I_WUKV, I_WOUT, I_WQM, I_WKM, I_WVM, I_WOM, I_WUP, I_AUP, I_VUP, I_WUQ, I_FF1, I_FF2};
__constant__ unsigned JDST[15] = {(unsigned)(WO_IN / KiB), (unsigned)(WO_IN / KiB), (unsigned)(WO_GUP / KiB), (unsigned)(WO_UKV / KiB), (unsigned)(WO_OUT / KiB), (unsigned)(WO_QM / KiB),
                                  (unsigned)(WO_KM / KiB), (unsigned)(WO_VM / KiB), (unsigned)(WO_OM / KiB), (unsigned)(WO_UP / KiB), (unsigned)(WO_AUP / KiB), (unsigned)(WO_VUP / KiB),
                                  (unsigned)(WO_UQ / KiB), (unsigned)(WO_FF1 / KiB), (unsigned)(WO_FF2 / KiB)};
__device__ __forceinline__ void p0_transpose_item(const float* W, int Kreal, int N, bf16* WT, int ldk, int row_off, LAS unsigned* scr, int item, int lane, bool rope) {
    const int nblk = N / 64, kb = item / nblk, nb = item % nblk, k0 = 64 * kb, n0 = 64 * nb;
    const int m = lane & 15, q = lane >> 4;
    f32x4 v[16];
#pragma unroll
    for (int i = 0; i < 16; ++i) { const int k = k0 + 8 * (i >> 1) + 2 * q + (i & 1); const int kc = k < Kreal ? k : Kreal - 1;
        v[i] = __builtin_nontemporal_load((const f32x4*)(W + (size_t)kc * N + n0 + 4 * m)); }
    if (k0 + 64 > Kreal) {
#pragma unroll
        for (int i = 0; i < 16; ++i) { const int k = k0 + 8 * (i >> 1) + 2 * q + (i & 1); if (k >= Kreal) v[i] = (f32x4){0.f, 0.f, 0.f, 0.f}; }
    }
#pragma unroll
    for (int j = 0; j < 8; ++j)
#pragma unroll
        for (int c = 0; c < 4; ++c) scr[(4 * m + c) * 32 + ((4 * j + q) ^ (4 * (m & 7)))] = cvt_pk(v[2 * j][c], v[2 * j + 1][c]);
    asm volatile("s_waitcnt lgkmcnt(0)" ::: "memory");
    const int x = lane & 7, r = lane >> 3;
#pragma unroll
    for (int t = 0; t < 8; ++t) { const int n = r + 8 * t; const u32x4 o = *(const LAS u32x4*)(scr + n * 32 + 4 * (x ^ ((n >> 2) & 7)));
        const int nd = rope ? 2 * (n & 31) + (n >> 5) : n;
        *(u32x4*)(WT + (size_t)(row_off + n0 + nd) * ldk + k0 + 8 * x) = o; }
    asm volatile("s_waitcnt lgkmcnt(0)" ::: "memory");
}
__device__ __forceinline__ void rms_row_2048(const float* xrow, const float* g, bf16* orow, bf16* copy, int lane) {
    f32x4 v[8]; float ss = 0.f;
#pragma unroll
    for (int j = 0; j < 4; ++j) { v[2 * j] = *(const f32x4*)(xrow + lane * 8 + 512 * j); v[2 * j + 1] = *(const f32x4*)(xrow + lane * 8 + 512 * j + 4); }
#pragma unroll
    for (int j = 0; j < 8; ++j) ss += (v[j][0] * v[j][0] + v[j][1] * v[j][1]) + (v[j][2] * v[j][2] + v[j][3] * v[j][3]);
    const float rstd = rsqrtf(wave_sum(ss) * (1.f / 2048.f) + NORM_EPS);
#pragma unroll
    for (int j = 0; j < 4; ++j) { const int c = lane * 8 + 512 * j;
        if (copy) { u32x4 w; w.x = cvt_pk(v[2 * j][0], v[2 * j][1]); w.y = cvt_pk(v[2 * j][2], v[2 * j][3]); w.z = cvt_pk(v[2 * j + 1][0], v[2 * j + 1][1]); w.w = cvt_pk(v[2 * j + 1][2], v[2 * j + 1][3]); *(u32x4*)(copy + c) = w; }
        const f32x4 g0 = *(const f32x4*)(g + c), g1 = *(const f32x4*)(g + c + 4); const f32x4 a = v[2 * j] * rstd * g0, b = v[2 * j + 1] * rstd * g1;
        u32x4 w; w.x = cvt_pk(a[0], a[1]); w.y = cvt_pk(a[2], a[3]); w.z = cvt_pk(b[0], b[1]); w.w = cvt_pk(b[2], b[3]);
        *(u32x4*)(orow + c) = w; }
}
__device__ __forceinline__ void convert_layer(Frame& F, ArgsP A, int l, int part, int wrank, int wcount) {
    LAS unsigned* scr = (LAS unsigned*)(F.lds + F.wave * 16384);
    const int k_lo = (part == 2) ? 13 : (part == 3 ? 14 : 0), k_hi = (part == 1) ? 13 : (part == 2 ? 14 : 15);
    int base = 0;
    for (int k = k_lo; k < k_hi; ++k) {
        const bool prev = (k == 1 || k == 11);
        if (prev && l == 0) continue;
        const int K = JK[k], KP = JKP[k], N = JN[k], row_off = (k == 1) ? INW : 0;
        const float* W = A->in[JIN[k]] + (size_t)(prev ? l - 1 : l) * K * N; const size_t dst = WL((size_t)JDST[k] * KiB);
        const int nitems = (KP / 64) * (N / 64);
        int first = (wrank - base) % wcount; if (first < 0) first += wcount;
        for (int it = first; it < nitems; it += wcount) p0_transpose_item(W, K, N, WSP(bf16, dst), KP, row_off, scr, it, F.lane, k == 12 && (it % (N / 64)) % 3 == 2);
        base = (base + nitems) % wcount;
    }
    if (part <= 1 && l > 0) {
        const long gt = (long)wrank * 64 + F.lane, NGT = (long)wcount * 64;
        unsigned* O = (unsigned*)(WSP(bf16, WL(WO_IN)) + (size_t)(INW + 64) * D);
        for (long i = gt; i < 192 * D / 2; i += NGT) O[i] = 0u;
    }
}
__device__ __forceinline__ void p0_prologue(Frame& F, ArgsP A) {
    const int gw = F.vcu * NWAVES + F.wave, NGW = F.G * NWAVES;
    const long gt = (long)F.vcu * NTHR + F.tid, NGT = (long)F.G * NTHR;
    convert_layer(F, A, 0, 1, gw, NGW);
    { float* cT = WSP(float, WS_COS); float* sT = WSP(float, WS_SIN);
      for (long i = gt; i < SEQ * 32; i += NGT) { const int pos = (int)(i >> 5), j = (int)(i & 31);
          const float invf = __builtin_amdgcn_exp2f(-13.287712379549449f * (float)j * (1.f / 32.f));
          const double rev = (double)pos * (double)invf * 0.15915494309189535; const float fr = (float)(rev - __builtin_rint(rev));
          cT[i] = __builtin_amdgcn_cosf(fr); sT[i] = __builtin_amdgcn_sinf(fr); } }
    for (int m = gw; m < T; m += NGW) rms_row_2048(A->in[I_X] + (size_t)m * D, A->in[I_MIXPRE], WSP(bf16, WS_U) + (size_t)m * D, (bf16*)F.H + (size_t)m * D, F.lane);
    for (int m = gw; m < NB * NMEM; m += NGW) rms_row_2048(A->in[I_MEM] + (size_t)m * D, A->in[I_MEMG], WSP(bf16, WS_MEMN) + (size_t)m * D, nullptr, F.lane);
}

__device__ __forceinline__ void prep_phase(Frame& F, ArgsP A, int l) {
    const int gw = F.vcu * NWAVES + F.wave, NGW = F.G * NWAVES, lane = F.lane;
    const bf16* PROJ = WSP(bf16, WS_PROJ);
    const float* mu = A->in[I_MU] + (size_t)l * RIN;
    const float* muv = A->in[I_MUV] + (size_t)(l > 0 ? l - 1 : 0) * 64;
    const float* qg = A->in[I_QNG] + (size_t)l * 512; const float* kvg = A->in[I_KVNG] + (size_t)l * 256;
    const float* cT = WSP(float, WS_COS); const float* sT = WSP(float, WS_SIN);
    for (int m = gw; m < T; m += NGW) {
        const bf16* cur = PROJ + (size_t)m * PROJ_LD; const bool first = (m & (SEQ - 1)) == 0; const bf16* prv = cur - PROJ_LD;
        bf16* lo = WSP(bf16, WS_LORA) + (size_t)m * LORA_LD;
#pragma unroll
        for (int i = 0; i < 10; ++i) { const int oc = lane + 64 * i; int sc = -1, kind = 0; float mv = 0.f;
            if (oc < 128) { if (oc < 96) { sc = 3072 + oc; kind = 1; } }
            else if (oc < 256) { if (oc < 224) { sc = 3168 + (oc - 128); kind = 0; } }
            else if (oc < 512) { sc = 3264 + (oc - 256); kind = 2; }
            else if (oc < 576) { if (l > 0) { sc = INW + (oc - 512); kind = 3; } }
            float val = 0.f;
            if (sc >= 0) { mv = kind == 3 ? muv[sc - INW] : mu[sc]; const float y = bf1(cur[sc]), yp = first ? 0.f : bf1(prv[sc]); const float c = y + (yp - y) * mv;
                val = kind == 1 ? tanhf_(c) : (kind == 2 ? sigmoidf_(c) : c); }
            lo[oc] = f2bf(val); }
        { float v[8]; unpack8(*(const u32x4*)(cur + RIN + lane * 8), v); float ss = 0.f;
#pragma unroll
          for (int i = 0; i < 8; ++i) ss += v[i] * v[i];
          const float rstd = rsqrtf(wave_sum(ss) * (1.f / 512.f) + NORM_EPS);
          const f32x4 g0 = *(const f32x4*)(qg + lane * 8), g1 = *(const f32x4*)(qg + lane * 8 + 4);
          u32x4 w; w.x = cvt_pk(v[0] * rstd * g0[0], v[1] * rstd * g0[1]); w.y = cvt_pk(v[2] * rstd * g0[2], v[3] * rstd * g0[3]);
          w.z = cvt_pk(v[4] * rstd * g1[0], v[5] * rstd * g1[1]); w.w = cvt_pk(v[6] * rstd * g1[2], v[7] * rstd * g1[3]);
          *(u32x4*)(WSP(bf16, WS_CQN) + (size_t)m * 512 + lane * 8) = w; }
        { const u32x2 raw = *(const u32x2*)(cur + RIN + 512 + lane * 4); const float v0 = bflo(raw.x), v1 = bfhi(raw.x), v2 = bflo(raw.y), v3 = bfhi(raw.y);
          const float rstd = rsqrtf(wave_sum(v0 * v0 + v1 * v1 + v2 * v2 + v3 * v3) * (1.f / 256.f) + NORM_EPS);
          const f32x4 g0 = *(const f32x4*)(kvg + lane * 4);
          u32x2 w; w.x = cvt_pk(v0 * rstd * g0[0], v1 * rstd * g0[1]); w.y = cvt_pk(v2 * rstd * g0[2], v3 * rstd * g0[3]);
          *(u32x2*)(WSP(bf16, WS_CKVN) + (size_t)m * 256 + lane * 4) = w; }
        if (lane < 32) { const float x1 = bf1(cur[RIN + 768 + lane]), x2 = bf1(cur[RIN + 768 + 32 + lane]); const int pos = m & (SEQ - 1);
          const float c = cT[pos * 32 + lane], s = sT[pos * 32 + lane];
          *(unsigned*)(WSP(bf16, WS_KR) + (size_t)m * 64 + 2 * lane) = cvt_pk(x1 * c - x2 * s, x1 * s + x2 * c); }
        if (l == 0) {
#pragma unroll
            for (int j = 0; j < 2; ++j) { const int c = lane * 8 + 512 * j; float a[8], p[8], o[8]; unpack8(*(const u32x4*)(cur + 2048 + c), a);
                if (!first) unpack8(*(const u32x4*)(prv + 2048 + c), p); else {
#pragma unroll
                    for (int i = 0; i < 8; ++i) p[i] = 0.f; }
                const f32x4 m0 = *(const f32x4*)(mu + 2048 + c), m1 = *(const f32x4*)(mu + 2048 + c + 4);
#pragma unroll
                for (int i = 0; i < 8; ++i) o[i] = a[i] + (p[i] - a[i]) * (i < 4 ? m0[i] : m1[i - 4]);
                *(u32x4*)(WSP(bf16, WS_VF) + (size_t)m * 1024 + c) = pack8(o); } }
    }
}

constexpr int CK = 32, NCHUNK = SEQ / CK;
constexpr int CS_TS = 144, CS_TILE = 32 * CS_TS, CS_PC = 5 * CS_TILE, CS_WAVE = 5 * CS_TILE + 256;
constexpr int CS_NW = 7;
constexpr size_t SCU_BYTES = 24576; constexpr int SCU_X = 8192, SCU_PSI = 12288, SCU_G2 = 20480;
constexpr int SQ_SLOT = 18432, SQ_NSLOT = 7;
static_assert(CS_NW * CS_WAVE <= RING_BYTES && SQ_NSLOT * SQ_SLOT <= RING_BYTES, "LDS budget");
#define MF32(a, b, c) __builtin_amdgcn_mfma_f32_32x32x16_bf16((a), (b), (c), 0, 0, 0)
__device__ __forceinline__ bf16x8 pack8f(float a0, float a1, float a2, float a3, float a4, float a5, float a6, float a7) {
    u32x4 w; w.x = cvt_pk(a0, a1); w.y = cvt_pk(a2, a3); w.z = cvt_pk(a4, a5); w.w = cvt_pk(a6, a7); return __builtin_bit_cast(bf16x8, w); }
#define PACKS(x, s) pack8f((x)[8 * (s)], (x)[8 * (s) + 1], (x)[8 * (s) + 2], (x)[8 * (s) + 3], (x)[8 * (s) + 4], (x)[8 * (s) + 5], (x)[8 * (s) + 6], (x)[8 * (s) + 7])
__device__ __forceinline__ bf16x8 trfrag(const LAS unsigned char* p) {
    const s16x4 lo = __builtin_bit_cast(s16x4, __builtin_amdgcn_ds_read_tr16_b64_v4i16((LAS v4i16_t*)p));
    const s16x4 hh = __builtin_bit_cast(s16x4, __builtin_amdgcn_ds_read_tr16_b64_v4i16((LAS v4i16_t*)(p + 8 * CS_TS)));
    return (bf16x8){lo[0], lo[1], lo[2], lo[3], hh[0], hh[1], hh[2], hh[3]}; }
__device__ __forceinline__ void st_init16(unsigned char* p, const f32x16& x) {
    u32x4 w0, w1; w0.x = cvt_pk(x[0], x[1]); w0.y = cvt_pk(x[2], x[3]); w0.z = cvt_pk(x[4], x[5]); w0.w = cvt_pk(x[6], x[7]);
    w1.x = cvt_pk(x[8], x[9]); w1.y = cvt_pk(x[10], x[11]); w1.z = cvt_pk(x[12], x[13]); w1.w = cvt_pk(x[14], x[15]);
    *(u32x4*)p = w0; *(u32x4*)(p + 16) = w1; }
__device__ __forceinline__ f32x16 ld_init16(const LAS unsigned char* p) {
    const u32x4 w0 = *(const LAS u32x4*)p, w1 = *(const LAS u32x4*)(p + 16); f32x16 x;
    x[0] = bflo(w0.x); x[1] = bfhi(w0.x); x[2] = bflo(w0.y); x[3] = bfhi(w0.y); x[4] = bflo(w0.z); x[5] = bfhi(w0.z); x[6] = bflo(w0.w); x[7] = bfhi(w0.w);
    x[8] = bflo(w1.x); x[9] = bfhi(w1.x); x[10] = bflo(w1.y); x[11] = bfhi(w1.y); x[12] = bflo(w1.z); x[13] = bfhi(w1.z); x[14] = bflo(w1.w); x[15] = bfhi(w1.w); return x; }

struct CsRaw { u32x4 r[4], k[4], a[4], e[4]; bf16 rp, kp; };
__device__ __forceinline__ void cs_load_raw(Frame& F, int l, int bh, int cc, CsRaw& R) {
    const int lane = F.lane, b = bh >> 4, h = bh & 15, pc = lane & 7;
    const size_t row0 = (size_t)b * SEQ + (size_t)cc * CK;
    const bf16* PROJ = WSP(bf16, WS_PROJ); const bf16* AIC = WSP(bf16, WS_AIC); const bf16* WLOG = WSP(bf16, WS_WLOG);
#pragma unroll
    for (int i = 0; i < 4; ++i) { const size_t gr = row0 + (lane >> 3) + 8 * i;
        R.r[i] = *(const u32x4*)(PROJ + gr * PROJ_LD + h * 64 + pc * 8); R.k[i] = *(const u32x4*)(PROJ + gr * PROJ_LD + 1024 + h * 64 + pc * 8);
        R.a[i] = *(const u32x4*)(AIC + gr * 1024 + h * 64 + pc * 8); R.e[i] = *(const u32x4*)(WLOG + gr * 1024 + h * 64 + pc * 8); }
    R.rp = 0; R.kp = 0;
    if (cc > 0) { R.rp = PROJ[(row0 - 1) * PROJ_LD + h * 64 + lane]; R.kp = PROJ[(row0 - 1) * PROJ_LD + 1024 + h * 64 + lane]; }
}
__device__ __forceinline__ void cs_elementwise(Frame& F, ArgsP A, int l, int bh, int cc, LAS unsigned char* wl, const CsRaw& R) {
    const int lane = F.lane, b = bh >> 4, h = bh & 15, ch = h * 64 + lane;
    const size_t row0 = (size_t)b * SEQ + (size_t)cc * CK;
    float* RKB = WSP(float, WS_RKB);
    const bf16* VV = (l == 0) ? WSP(bf16, WS_VF) : WSP(bf16, WS_VV);
    u32x4 vraw[4];
#pragma unroll
    for (int i = 0; i < 4; ++i) vraw[i] = *(const u32x4*)(VV + (row0 + (lane >> 3) + 8 * i) * 1024 + h * 64 + (lane & 7) * 8);
#pragma unroll
    for (int i = 0; i < 4; ++i) { LAS unsigned char* p = wl + ((lane >> 3) + 8 * i) * CS_TS + (lane & 7) * 16;
        *(LAS u32x4*)(p) = R.k[i]; *(LAS u32x4*)(p + CS_TILE) = R.a[i]; *(LAS u32x4*)(p + 2 * CS_TILE) = R.e[i]; *(LAS u32x4*)(p + 3 * CS_TILE) = R.r[i]; }
    const float mur = A->in[I_MU][(size_t)l * RIN + ch], muk = A->in[I_MU][(size_t)l * RIN + 1024 + ch];
    const float ckk = A->in[I_KK][(size_t)l * 1024 + ch], cka = A->in[I_KA][(size_t)l * 1024 + ch], crk = A->in[I_RK][(size_t)l * 1024 + ch];
    float rp = bf1(R.rp), kp_ = bf1(R.kp);
    float lp = 0.f, pexc = 1.f;
    constexpr float L2E = 1.4426950408889634f;
    asm volatile("s_waitcnt lgkmcnt(0)" ::: "memory");
#pragma unroll 8
    for (int tt = 0; tt < CK; ++tt) {
        LAS unsigned char* rowp = wl + tt * CS_TS + lane * 2;
        const float kc = bf1(*(const LAS bf16*)(rowp)), aa = bf1(*(const LAS bf16*)(rowp + CS_TILE)), ee = bf1(*(const LAS bf16*)(rowp + 2 * CS_TILE)), rc = bf1(*(const LAS bf16*)(rowp + 3 * CS_TILE));
        const float rs = rc + (rp - rc) * mur, ks = kc + (kp_ - kc) * muk; rp = rc; kp_ = kc;
        float kk = ks * ckk; const float ss = wave_sum(kk * kk); kk *= rsqrtf(fmaxf(ss, 1e-24f));
        const float kq = ks * (1.f + (aa - 1.f) * cka);
        const float rkb = wave_sum(rs * kq * crk);
        lp += ee;
        const float pinc = __builtin_amdgcn_exp2f(lp * L2E), pinv = __builtin_amdgcn_exp2f(-lp * L2E);
        *(LAS bf16*)(rowp) = f2bf(-kk * pexc);
        *(LAS bf16*)(rowp + CS_TILE) = f2bf(kk * aa * pinv);
        *(LAS bf16*)(rowp + 2 * CS_TILE) = f2bf(kq * pinv);
        *(LAS bf16*)(rowp + 3 * CS_TILE) = f2bf(rs * pinc);
        pexc = pinc;
        if (lane == 0) RKB[(row0 + tt) * 16 + h] = rkb;
    }
    ((LAS float*)(wl + CS_PC))[lane] = __builtin_amdgcn_exp2f(lp * L2E);
#pragma unroll
    for (int i = 0; i < 4; ++i) *(LAS u32x4*)(wl + 4 * CS_TILE + ((lane >> 3) + 8 * i) * CS_TS + (lane & 7) * 16) = vraw[i];
}
__device__ __forceinline__ void cs_mfma(Frame& F, const LAS unsigned char* wl, unsigned char* ub) {
    const int lane = F.lane, r32 = lane & 31, h = lane >> 5, q4 = (lane & 15) >> 2, pp = lane & 3, blk = (lane >> 4) & 1;
    const LAS unsigned char* tA = wl; const LAS unsigned char* tB = wl + CS_TILE; const LAS unsigned char* tK = wl + 2 * CS_TILE;
    const LAS unsigned char* tR = wl + 3 * CS_TILE; const LAS unsigned char* tV = wl + 4 * CS_TILE;
    const int rowoff = r32 * CS_TS + h * 16, troff = (4 * h + q4) * CS_TS + blk * 32 + pp * 8;
#define FROW(t, s) (*(const LAS bf16x8*)((t) + rowoff + (s) * 32))
#define FTR(t, ct, s) trfrag((t) + troff + (s) * 16 * CS_TS + (ct) * 64)
    const f32x16 Z = (f32x16){};
    f32x16 P = Z, PT = Z;
#pragma unroll
    for (int s = 0; s < 4; ++s) { const bf16x8 fa = FROW(tA, s), fb = FROW(tB, s); P = MF32(fb, fa, P); PT = MF32(fa, fb, PT); }
#pragma unroll
    for (int r = 0; r < 16; ++r) { const int cr = crow(r, h); if (!(cr < r32)) P[r] = 0.f; if (!(r32 < cr)) PT[r] = 0.f; }
    f32x16 TmT = PT;
#pragma unroll
    for (int r = 0; r < 16; ++r) if (crow(r, h) == r32) TmT[r] += 1.f;
    f32x16 Tm;
#pragma unroll
    for (int it = 0; it < 4; ++it) {
        const bf16x8 pP0 = PACKS(P, 0), pP1 = PACKS(P, 1), pT0 = PACKS(PT, 0), pT1 = PACKS(PT, 1);
        f32x16 Pn = MF32(pT0, pP0, Z); Pn = MF32(pT1, pP1, Pn);
        f32x16 Y = Pn;
#pragma unroll
        for (int r = 0; r < 16; ++r) if (crow(r, h) == r32) Y[r] += 1.f;
        const bf16x8 y0 = PACKS(Y, 0), y1 = PACKS(Y, 1), t0 = PACKS(TmT, 0), t1 = PACKS(TmT, 1);
        if (it < 3) {
            f32x16 PTn = MF32(pP0, pT0, Z); PTn = MF32(pP1, pT1, PTn);
            f32x16 Tn = MF32(y0, t0, Z); Tn = MF32(y1, t1, Tn);
            P = Pn; PT = PTn; TmT = Tn;
        } else { Tm = MF32(t0, y0, Z); Tm = MF32(t1, y1, Tm); }
    }
    f32x16 W1;
    { f32x16 NakT = Z;
#pragma unroll
      for (int s = 0; s < 4; ++s) NakT = MF32(FROW(tA, s), FROW(tK, s), NakT);
#pragma unroll
      for (int r = 0; r < 16; ++r) if (!(r32 < crow(r, h))) NakT[r] = 0.f;
      W1 = MF32(PACKS(NakT, 0), PACKS(Tm, 0), Z); W1 = MF32(PACKS(NakT, 1), PACKS(Tm, 1), W1); }
    f32x16 ATT[2], G1T[2];
    { const bf16x8 m0 = PACKS(Tm, 0), m1 = PACKS(Tm, 1), w0 = PACKS(W1, 0), w1 = PACKS(W1, 1);
#pragma unroll
      for (int ct = 0; ct < 2; ++ct) { ATT[ct] = MF32(m0, FTR(tA, ct, 0), Z); ATT[ct] = MF32(m1, FTR(tA, ct, 1), ATT[ct]);
                                       G1T[ct] = MF32(w0, FTR(tV, ct, 0), Z); G1T[ct] = MF32(w1, FTR(tV, ct, 1), G1T[ct]); } }
    f32x16 Mbr = Z, Mkr = Z;
#pragma unroll
    for (int s = 0; s < 4; ++s) { const bf16x8 fr = FROW(tR, s); Mbr = MF32(FROW(tB, s), fr, Mbr); Mkr = MF32(FROW(tK, s), fr, Mkr); }
#pragma unroll
    for (int r = 0; r < 16; ++r) if (!(crow(r, h) <= r32)) { Mbr[r] = 0.f; Mkr[r] = 0.f; }
    const bf16x8 b0 = PACKS(Mbr, 0), b1 = PACKS(Mbr, 1), k0 = PACKS(Mkr, 0), k1 = PACKS(Mkr, 1);
#pragma unroll
    for (int kt = 0; kt < 2; ++kt) {
        f32x16 X = MF32(PACKS(ATT[kt], 0), b0, Z); X = MF32(PACKS(ATT[kt], 1), b1, X);
#pragma unroll
        for (int g = 0; g < 4; ++g) { const u32x2 w = *(const LAS u32x2*)(tR + r32 * CS_TS + (32 * kt + 8 * g + 4 * h) * 2);
            X[4 * g] += bflo(w.x); X[4 * g + 1] += bfhi(w.x); X[4 * g + 2] += bflo(w.y); X[4 * g + 3] += bfhi(w.y); }
        *(bf16x8*)(ub + SCU_X + ((2 * kt) * 64 + lane) * 16) = PACKS(X, 0);
        *(bf16x8*)(ub + SCU_X + ((2 * kt + 1) * 64 + lane) * 16) = PACKS(X, 1);
    }
#pragma unroll
    for (int ct = 0; ct < 2; ++ct) {
        f32x16 G = MF32(b0, PACKS(G1T[ct], 0), Z); G = MF32(b1, PACKS(G1T[ct], 1), G);
        G = MF32(k0, FTR(tV, ct, 0), G); G = MF32(k1, FTR(tV, ct, 1), G);
        st_init16(ub + SCU_G2 + (ct * 64 + lane) * 32, G);
    }
    const LAS float* PC = (const LAS float*)(wl + CS_PC);
#pragma unroll
    for (int ct = 0; ct < 2; ++ct) {
        const float pc = PC[32 * ct + r32];
        const bf16x8 f0 = FTR(tB, ct, 0), f1 = FTR(tB, ct, 1);
#pragma unroll
        for (int kt = 0; kt < 2; ++kt) {
            f32x16 Ph = MF32(PACKS(ATT[kt], 0), f0, Z); Ph = MF32(PACKS(ATT[kt], 1), f1, Ph);
            if (kt == ct) {
#pragma unroll
                for (int r = 0; r < 16; ++r) if (crow(r, h) == r32) Ph[r] += 1.f; }
#pragma unroll
            for (int r = 0; r < 16; ++r) Ph[r] *= pc;
            *(bf16x8*)(ub + ((ct * 4 + 2 * kt) * 64 + lane) * 16) = PACKS(Ph, 0);
            *(bf16x8*)(ub + ((ct * 4 + 2 * kt + 1) * 64 + lane) * 16) = PACKS(Ph, 1);
        }
    }
#pragma unroll
    for (int mt = 0; mt < 2; ++mt) {
        const bf16x8 fb0 = FTR(tB, mt, 0), fb1 = FTR(tB, mt, 1), fk0 = FTR(tK, mt, 0), fk1 = FTR(tK, mt, 1);
        float pcr[16];
#pragma unroll
        for (int g = 0; g < 4; ++g) { const f32x4 v = *(const LAS f32x4*)(PC + 32 * mt + 8 * g + 4 * h); pcr[4 * g] = v[0]; pcr[4 * g + 1] = v[1]; pcr[4 * g + 2] = v[2]; pcr[4 * g + 3] = v[3]; }
#pragma unroll
        for (int ct = 0; ct < 2; ++ct) {
            f32x16 Ps = MF32(fb0, PACKS(G1T[ct], 0), Z); Ps = MF32(fb1, PACKS(G1T[ct], 1), Ps);
            Ps = MF32(fk0, FTR(tV, ct, 0), Ps); Ps = MF32(fk1, FTR(tV, ct, 1), Ps);
#pragma unroll
            for (int r = 0; r < 16; ++r) Ps[r] *= pcr[r];
            st_init16(ub + SCU_PSI + ((ct * 2 + mt) * 64 + lane) * 32, Ps);
        }
    }
#undef FROW
#undef FTR
}
__device__ __forceinline__ void cs_pre_phase(Frame& F, ArgsP A, int l) {
    volatile LAS unsigned* cnt = (volatile LAS unsigned*)(F.lds + LDSCTL_OFF);
    if (F.tid == 0) cnt[0] = 0u;
    __syncthreads();
    if (F.wave < CS_NW) {
        LAS unsigned char* wl = F.lds + F.wave * CS_WAVE;
        const int per = (64 * NCHUNK + F.G - 1) / F.G, ubase = F.vcu * per, uend = (ubase + per < 64 * NCHUNK) ? ubase + per : 64 * NCHUNK;
#define CS_NEXT(dst) do { unsigned v_ = 0u; if (F.lane == 0) v_ = __hip_atomic_fetch_add((LAS unsigned*)cnt, 1u, __ATOMIC_RELAXED, __HIP_MEMORY_SCOPE_WORKGROUP); dst = ubase + (int)__builtin_amdgcn_readfirstlane((int)v_); } while (0)
        int u; CS_NEXT(u);
        CsRaw R;
        if (u < uend) cs_load_raw(F, l, u >> 7, u & (NCHUNK - 1), R);
        while (u < uend) {
            cs_elementwise(F, A, l, u >> 7, u & (NCHUNK - 1), wl, R);
            int un; CS_NEXT(un);
            if (un < uend) cs_load_raw(F, l, un >> 7, un & (NCHUNK - 1), R);
            asm volatile("s_waitcnt lgkmcnt(0)" ::: "memory");
            cs_mfma(F, wl, F.ws + WS_SCAN + (size_t)u * SCU_BYTES);
            asm volatile("s_waitcnt lgkmcnt(0)" ::: "memory");
            u = un;
        }
#undef CS_NEXT
    }
}
__device__ __forceinline__ void cs_seq_unit(Frame& F, int bh, int ct) {
    const int lane = F.lane, wave = F.wave, r32 = lane & 31, h = lane >> 5;
    LAS unsigned char* L = F.lds;
    const unsigned char* ub = F.ws + WS_SCAN + (size_t)bh * NCHUNK * SCU_BYTES;
    if (wave > 0) {
        const int w = wave - 1;
        size_t so[3]; int np = 0;
#pragma unroll
        for (int k = 0; k < 3; ++k) { const int p = w + 7 * k; so[k] = p < 12 ? (size_t)p * 1024 : (p < 16 ? (size_t)SCU_PSI + ct * 4096 + (p - 12) * 1024 : (size_t)SCU_G2 + ct * 2048 + (p - 16) * 1024); if (p < 18) np = k + 1; }
#define SQ_ISSUE(c) do { const unsigned char* g_ = ub + (size_t)(c) * SCU_BYTES + lane * 16; LAS unsigned char* d_ = L + ((c) % SQ_NSLOT) * SQ_SLOT; \
        _Pragma("unroll") for (int k = 0; k < 3; ++k) if (k < np) __builtin_amdgcn_global_load_lds((const unsigned*)(g_ + so[k]), (LAS unsigned*)(d_ + (w + 7 * k) * 1024), 16, 0, 0); } while (0)
        for (int c = 0; c < 6; ++c) SQ_ISSUE(c);
        if (np == 3) asm volatile("s_waitcnt vmcnt(15)" ::: "memory"); else asm volatile("s_waitcnt vmcnt(10)" ::: "memory");
        asm volatile("s_barrier" ::: "memory");
        for (int c = 0; c < NCHUNK; ++c) {
            if (c + 6 < NCHUNK) { SQ_ISSUE(c + 6); if (np == 3) asm volatile("s_waitcnt vmcnt(15)" ::: "memory"); else asm volatile("s_waitcnt vmcnt(10)" ::: "memory"); }
            else asm volatile("s_waitcnt vmcnt(0)" ::: "memory");
            asm volatile("s_barrier" ::: "memory");
        }
#undef SQ_ISSUE
    } else {
        f32x16 S0 = (f32x16){}, S1 = (f32x16){};
        const int b = bh >> 4, hh = bh & 15;
        bf16* op = (bf16*)(F.ws + WS_Y) + ((size_t)b * SEQ) * 1024 + hh * 64 + 32 * ct + r32;
        asm volatile("s_barrier" ::: "memory");
        for (int c = 0; c < NCHUNK; ++c) {
            const LAS unsigned char* sl = L + (c % SQ_NSLOT) * SQ_SLOT;
            const bf16x8 bS0 = PACKS(S0, 0), bS1 = PACKS(S0, 1), bS2 = PACKS(S1, 0), bS3 = PACKS(S1, 1);
            f32x16 n0 = ld_init16(sl + 12288 + (0 * 64 + lane) * 32), n1 = ld_init16(sl + 12288 + (1 * 64 + lane) * 32);
            const f32x16 Z = (f32x16){};
            f32x16 m0 = MF32(*(const LAS bf16x8*)(sl + (2 * 64 + lane) * 16), bS2, Z), m1 = MF32(*(const LAS bf16x8*)(sl + (6 * 64 + lane) * 16), bS2, Z);
            n0 = MF32(*(const LAS bf16x8*)(sl + (0 * 64 + lane) * 16), bS0, n0); n1 = MF32(*(const LAS bf16x8*)(sl + (4 * 64 + lane) * 16), bS0, n1);
            m0 = MF32(*(const LAS bf16x8*)(sl + (3 * 64 + lane) * 16), bS3, m0); m1 = MF32(*(const LAS bf16x8*)(sl + (7 * 64 + lane) * 16), bS3, m1);
            n0 = MF32(*(const LAS bf16x8*)(sl + (1 * 64 + lane) * 16), bS1, n0); n1 = MF32(*(const LAS bf16x8*)(sl + (5 * 64 + lane) * 16), bS1, n1);
            f32x16 o = ld_init16(sl + 16384 + lane * 32);
            o = MF32(*(const LAS bf16x8*)(sl + 8192 + (0 * 64 + lane) * 16), bS0, o); o = MF32(*(const LAS bf16x8*)(sl + 8192 + (1 * 64 + lane) * 16), bS1, o);
            o = MF32(*(const LAS bf16x8*)(sl + 8192 + (2 * 64 + lane) * 16), bS2, o); o = MF32(*(const LAS bf16x8*)(sl + 8192 + (3 * 64 + lane) * 16), bS3, o);
            S0 = n0 + m0; S1 = n1 + m1;
#pragma unroll
            for (int r = 0; r < 16; ++r) op[(size_t)(c * CK + crow(r, h)) * 1024] = f2bf(o[r]);
            asm volatile("s_waitcnt lgkmcnt(0)\n\ts_barrier" ::: "memory");
        }
    }
    asm volatile("s_waitcnt vmcnt(0)" ::: "memory");
    __syncthreads();
}

__device__ __forceinline__ void rwkv_post_phase(Frame& F, ArgsP A, int l) {
    const int gw = F.vcu * NWAVES + F.wave, NGW = F.G * NWAVES, lane = F.lane, c0 = lane * 16, head = lane >> 2;
    const bf16* ORAW = WSP(bf16, WS_Y); const float* RKB = WSP(float, WS_RKB);
    const bf16* VV = (l == 0) ? WSP(bf16, WS_VF) : WSP(bf16, WS_VV); const bf16* GATE = WSP(bf16, WS_GATE);
    float lg[16], lb[16];
#pragma unroll
    for (int i = 0; i < 16; ++i) { lg[i] = A->in[I_LNG][(size_t)l * 1024 + c0 + i]; lb[i] = A->in[I_LNB][(size_t)l * 1024 + c0 + i]; }
    for (int m = gw; m < T; m += NGW) {
        float o[16];
#pragma unroll
        for (int j = 0; j < 2; ++j) { float t8[8]; unpack8(*(const u32x4*)(ORAW + (size_t)m * 1024 + c0 + 8 * j), t8);
#pragma unroll
            for (int i = 0; i < 8; ++i) o[8 * j + i] = t8[i]; }
        float s = 0.f;
#pragma unroll
        for (int i = 0; i < 16; ++i) s += o[i];
        s = sum4(s);
        const float mean = s * (1.f / 64.f); float q = 0.f;
#pragma unroll
        for (int i = 0; i < 16; ++i) { o[i] -= mean; q += o[i] * o[i]; }
        q = sum4(q);
        const float rstd = rsqrtf(q * (1.f / 64.f) + GN_EPS);
        const float rkb = RKB[(size_t)m * 16 + head];
        float vv[16], gg[16];
        { float t8[8]; unpack8(*(const u32x4*)(VV + (size_t)m * 1024 + c0), t8);
#pragma unroll
          for (int i = 0; i < 8; ++i) vv[i] = t8[i];
          unpack8(*(const u32x4*)(VV + (size_t)m * 1024 + c0 + 8), t8);
#pragma unroll
          for (int i = 0; i < 8; ++i) vv[8 + i] = t8[i];
          unpack8(*(const u32x4*)(GATE + (size_t)m * 1024 + c0), t8);
#pragma unroll
          for (int i = 0; i < 8; ++i) gg[i] = t8[i];
          unpack8(*(const u32x4*)(GATE + (size_t)m * 1024 + c0 + 8), t8);
#pragma unroll
          for (int i = 0; i < 8; ++i) gg[8 + i] = t8[i]; }
        float y[16];
#pragma unroll
        for (int i = 0; i < 16; ++i) y[i] = (o[i] * rstd * lg[i] + lb[i] + rkb * vv[i]) * gg[i];
        bf16* dst = WSP(bf16, WS_U) + (size_t)m * D + c0;
        u32x4 w0, w1; w0.x = cvt_pk(y[0], y[1]); w0.y = cvt_pk(y[2], y[3]); w0.z = cvt_pk(y[4], y[5]); w0.w = cvt_pk(y[6], y[7]);
        w1.x = cvt_pk(y[8], y[9]); w1.y = cvt_pk(y[10], y[11]); w1.z = cvt_pk(y[12], y[13]); w1.w = cvt_pk(y[14], y[15]);
        *(u32x4*)dst = w0; *(u32x4*)(dst + 8) = w1;
    }
}

__device__ __forceinline__ void ew_norm_phase(Frame& F, const float* gpost, const float* gpre, int e) {
    const int gw = F.vcu * NWAVES + F.wave, NGW = F.G * NWAVES, lane = F.lane;
    const bf16* Y = WSP(bf16, WS_Y); bf16* U = WSP(bf16, WS_U);
    const bf16* Hin = (e & 1) ? WSP(bf16, WS_HB) : (const bf16*)F.H;
    bf16* Hout = (e & 1) ? (bf16*)F.H : WSP(bf16, WS_HB);
    const bool last = (e == 3 * NL - 1);
    for (int m = gw; m < T; m += NGW) {
        float y[32]; float ss = 0.f;
#pragma unroll
        for (int j = 0; j < 4; ++j) { float t8[8]; unpack8(*(const u32x4*)(Y + (size_t)m * D + lane * 8 + 512 * j), t8);
#pragma unroll
            for (int i = 0; i < 8; ++i) { y[8 * j + i] = t8[i]; ss += t8[i] * t8[i]; } }
        const float rstd = rsqrtf(wave_sum(ss) * (1.f / 2048.f) + NORM_EPS);
        float hn[32]; float s2 = 0.f;
#pragma unroll
        for (int j = 0; j < 4; ++j) { const int c = lane * 8 + 512 * j;
            float h8[8]; unpack8(*(const u32x4*)(Hin + (size_t)m * D + c), h8);
            const f32x4 g0 = *(const f32x4*)(gpost + c), g1 = *(const f32x4*)(gpost + c + 4);
#pragma unroll
            for (int i = 0; i < 4; ++i) { hn[8 * j + i] = h8[i] + y[8 * j + i] * rstd * g0[i]; hn[8 * j + 4 + i] = h8[4 + i] + y[8 * j + 4 + i] * rstd * g1[i]; }
            if (last) { float* hp = F.H + (size_t)m * D + c; *(f32x4*)hp = (f32x4){hn[8 * j], hn[8 * j + 1], hn[8 * j + 2], hn[8 * j + 3]}; *(f32x4*)(hp + 4) = (f32x4){hn[8 * j + 4], hn[8 * j + 5], hn[8 * j + 6], hn[8 * j + 7]}; }
            else { u32x4 w; w.x = cvt_pk(hn[8 * j], hn[8 * j + 1]); w.y = cvt_pk(hn[8 * j + 2], hn[8 * j + 3]); w.z = cvt_pk(hn[8 * j + 4], hn[8 * j + 5]); w.w = cvt_pk(hn[8 * j + 6], hn[8 * j + 7]); *(u32x4*)(Hout + (size_t)m * D + c) = w; }
#pragma unroll
            for (int i = 0; i < 8; ++i) s2 += hn[8 * j + i] * hn[8 * j + i]; }
        if (gpre) {
            const float r2 = rsqrtf(wave_sum(s2) * (1.f / 2048.f) + NORM_EPS);
#pragma unroll
            for (int j = 0; j < 4; ++j) { const int c = lane * 8 + 512 * j; const f32x4 g0 = *(const f32x4*)(gpre + c), g1 = *(const f32x4*)(gpre + c + 4);
                u32x4 w; w.x = cvt_pk(hn[8 * j] * r2 * g0[0], hn[8 * j + 1] * r2 * g0[1]); w.y = cvt_pk(hn[8 * j + 2] * r2 * g0[2], hn[8 * j + 3] * r2 * g0[3]);
                w.z = cvt_pk(hn[8 * j + 4] * r2 * g1[0], hn[8 * j + 5] * r2 * g1[1]); w.w = cvt_pk(hn[8 * j + 6] * r2 * g1[2], hn[8 * j + 7] * r2 * g1[3]);
                *(u32x4*)(U + (size_t)m * D + c) = w; }
        }
    }
}

template <int DQK, bool CAUSAL>
__device__ __forceinline__ void attn_unit(LAS unsigned char* lds, const bf16* __restrict__ Q, int ldq, const bf16* __restrict__ K1, int ldk1, const bf16* __restrict__ K2, int ldk2,
                                          const bf16* __restrict__ V, int ldv, bf16* __restrict__ O, int ldo, int qpos0, int ntiles) {
    constexpr int KROW = DQK * 2, KT = 64 * KROW, VT = 16384, ND0 = DQK / 16, NKC = DQK / 64;
    int tid = threadIdx.x; asm volatile("" : "+v"(tid));
    const int lane = tid & 63, wid = __builtin_amdgcn_readfirstlane(tid >> 6), r32 = lane & 31, hi = lane >> 5;
    LAS unsigned char* Kl = lds; LAS unsigned char* Vl = lds + 2 * KT;
    bf16x8 qr[ND0];
    { const bf16* qrow = Q + (size_t)(wid * 32 + r32) * ldq;
#pragma unroll
      for (int d0 = 0; d0 < ND0; ++d0) qr[d0] = *(const bf16x8*)(qrow + d0 * 16 + hi * 8); }
    unsigned ksoff[NKC]; int kdst[NKC];
#pragma unroll
    for (int i = 0; i < NKC; ++i) { int row, cc;
        if (i < 2) { const int c = tid + 512 * i; row = c >> 4; cc = c & 15; ksoff[i] = (unsigned)(row * ldk1 + cc * 8) * 2u; }
        else { row = tid >> 3; cc = 16 + (tid & 7); ksoff[i] = (unsigned)(row * ldk2 + (cc - 16) * 8) * 2u; }
        const int cs = DQK == 192 ? ((cc & ~7) | ((cc ^ (row >> 1)) & 7)) : (cc ^ (row & 15));
        kdst[i] = row * KROW + cs * 16; }
    unsigned vsoff[2]; int vdst[2];
#pragma unroll
    for (int i = 0; i < 2; ++i) { const int c = tid + 512 * i, row = c >> 4, cc = c & 15; vsoff[i] = (unsigned)(row * ldv + cc * 8) * 2u; vdst[i] = row * 256 + ((cc * 16) ^ ((row & 3) << 6)); }
    constexpr int NKO = DQK == 192 ? 4 : 8;
    int koff[NKO];
#pragma unroll
    for (int j = 0; j < NKO; ++j) { const int cc = 2 * j + hi; const int cs = DQK == 192 ? ((cc ^ (r32 >> 1)) & 7) : (cc ^ (r32 & 15)); koff[j] = r32 * KROW + cs * 16; }
#define AT_KOFF(d0) (DQK == 192 ? koff[(d0) & 3] + ((d0) >> 2) * 128 : koff[(d0) & 7])
    const int q4 = (lane & 15) >> 2, pp = lane & 3, blk = (lane >> 4) & 1;
    int voff[4];
#pragma unroll
    for (int d0 = 0; d0 < 4; ++d0) voff[d0] = (4 * hi + q4) * 256 + (((d0 ^ q4) << 6) | (blk << 5) | (pp << 3));
    u32x4 ks[NKC], vs[2];
#define AT_LOAD(t) do { const char* k1b = (const char*)K1 + (size_t)(t) * 64 * ldk1 * 2; const char* k2b = (const char*)K2 + (size_t)(t) * 64 * ldk2 * 2; const char* vb = (const char*)V + (size_t)(t) * 64 * ldv * 2; \
        _Pragma("unroll") for (int i = 0; i < NKC; ++i) ks[i] = *(const u32x4*)((i < 2 ? k1b : k2b) + ksoff[i]); \
        _Pragma("unroll") for (int i = 0; i < 2; ++i) vs[i] = *(const u32x4*)(vb + vsoff[i]); } while (0)
#define AT_WRITE(bf) do { _Pragma("unroll") for (int i = 0; i < NKC; ++i) *(LAS u32x4*)(Kl + (bf) * KT + kdst[i]) = ks[i]; \
        _Pragma("unroll") for (int i = 0; i < 2; ++i) *(LAS u32x4*)(Vl + (bf) * VT + vdst[i]) = vs[i]; } while (0)
    float m_run = -1e30f, l_run = 0.f; f32x16 o[4];
#pragma unroll
    for (int d0 = 0; d0 < 4; ++d0) o[d0] = (f32x16){};
    AT_LOAD(0); AT_WRITE(0);
    __syncthreads();
    const int qpos = qpos0 + wid * 32 + r32;
    for (int t = 0; t < ntiles; ++t) {
        const int bf = t & 1;
        if (t + 1 < ntiles) AT_LOAD(t + 1);
        f32x16 p0 = (f32x16){}, p1 = (f32x16){};
#pragma unroll
        for (int d0 = 0; d0 < ND0; ++d0) {
            const bf16x8 a0 = *(const LAS bf16x8*)(Kl + bf * KT + AT_KOFF(d0));
            const bf16x8 a1 = *(const LAS bf16x8*)(Kl + bf * KT + AT_KOFF(d0) + 32 * KROW);
            p0 = __builtin_amdgcn_mfma_f32_32x32x16_bf16(a0, qr[d0], p0, 0, 0, 0);
            p1 = __builtin_amdgcn_mfma_f32_32x32x16_bf16(a1, qr[d0], p1, 0, 0, 0);
        }
        if (CAUSAL) { const int kv0 = t * 64;
            if (kv0 + 63 > qpos0 + wid * 32) { const float NEG = -__builtin_inff();
#pragma unroll
                for (int r = 0; r < 16; ++r) { const int key = kv0 + crow(r, hi); if (key > qpos) p0[r] = NEG; if (key + 32 > qpos) p1[r] = NEG; } } }
        float mx = p0[0];
#pragma unroll
        for (int r = 1; r < 16; ++r) mx = fmaxf(mx, p0[r]);
#pragma unroll
        for (int r = 0; r < 16; ++r) mx = fmaxf(mx, p1[r]);
        { auto rr = __builtin_amdgcn_permlane32_swap(__float_as_uint(mx), __float_as_uint(mx), false, false); mx = fmaxf(__uint_as_float(rr[0]), __uint_as_float(rr[1])); }
        if (__any(mx > m_run + 8.f)) {
            const float mn = fmaxf(m_run, mx), alpha = __builtin_amdgcn_exp2f(m_run - mn); m_run = mn; l_run *= alpha;
#pragma unroll
            for (int d0 = 0; d0 < 4; ++d0)
#pragma unroll
                for (int r = 0; r < 16; ++r) o[d0][r] *= alpha;
        }
        float ps = 0.f;
#pragma unroll
        for (int r = 0; r < 16; ++r) { p0[r] = __builtin_amdgcn_exp2f(p0[r] - m_run); p1[r] = __builtin_amdgcn_exp2f(p1[r] - m_run); ps += p0[r] + p1[r]; }
        l_run += ps;
        bf16x8 pa[4];
        { u32x4 w;
          w.x = cvt_pk(p0[0], p0[1]); w.y = cvt_pk(p0[2], p0[3]); w.z = cvt_pk(p0[4], p0[5]); w.w = cvt_pk(p0[6], p0[7]); pa[0] = __builtin_bit_cast(bf16x8, w);
          w.x = cvt_pk(p0[8], p0[9]); w.y = cvt_pk(p0[10], p0[11]); w.z = cvt_pk(p0[12], p0[13]); w.w = cvt_pk(p0[14], p0[15]); pa[1] = __builtin_bit_cast(bf16x8, w);
          w.x = cvt_pk(p1[0], p1[1]); w.y = cvt_pk(p1[2], p1[3]); w.z = cvt_pk(p1[4], p1[5]); w.w = cvt_pk(p1[6], p1[7]); pa[2] = __builtin_bit_cast(bf16x8, w);
          w.x = cvt_pk(p1[8], p1[9]); w.y = cvt_pk(p1[10], p1[11]); w.z = cvt_pk(p1[12], p1[13]); w.w = cvt_pk(p1[14], p1[15]); pa[3] = __builtin_bit_cast(bf16x8, w); }
#pragma unroll
        for (int d0 = 0; d0 < 4; ++d0)
#pragma unroll
            for (int s = 0; s < 4; ++s) {
                const LAS unsigned char* vp = Vl + bf * VT + voff[d0] + s * 4096;
                const s16x4 lo = __builtin_bit_cast(s16x4, __builtin_amdgcn_ds_read_tr16_b64_v4i16((LAS v4i16_t*)vp));
                const s16x4 hh = __builtin_bit_cast(s16x4, __builtin_amdgcn_ds_read_tr16_b64_v4i16((LAS v4i16_t*)(vp + 2048)));
                const bf16x8 vf = (bf16x8){lo[0], lo[1], lo[2], lo[3], hh[0], hh[1], hh[2], hh[3]};
                o[d0] = __builtin_amdgcn_mfma_f32_32x32x16_bf16(vf, pa[s], o[d0], 0, 0, 0);
            }
        if (t + 1 < ntiles) AT_WRITE(bf ^ 1);
        __syncthreads();
    }
    { auto rr = __builtin_amdgcn_permlane32_swap(__float_as_uint(l_run), __float_as_uint(l_run), false, false); l_run = __uint_as_float(rr[0]) + __uint_as_float(rr[1]); }
    const float inv = __builtin_amdgcn_rcpf(l_run);
    bf16* orow = O + (size_t)(wid * 32 + r32) * ldo;
#pragma unroll
    for (int d0 = 0; d0 < 4; ++d0)
#pragma unroll
        for (int g = 0; g < 4; ++g) { u32x2 w; w.x = cvt_pk(o[d0][4 * g] * inv, o[d0][4 * g + 1] * inv); w.y = cvt_pk(o[d0][4 * g + 2] * inv, o[d0][4 * g + 3] * inv);
            *(u32x2*)(orow + d0 * 32 + 8 * g + 4 * hi) = w; }
#undef AT_LOAD
#undef AT_WRITE
#undef AT_KOFF
}

__global__ void __launch_bounds__(NTHR, 2) fwd(Args args) {
    extern __shared__ __attribute__((aligned(16))) unsigned char lds_raw[];
    Frame F;
    F.lds = (LAS unsigned char*)lds_raw;
    F.tid = threadIdx.x; F.lane = F.tid & 63; F.wave = __builtin_amdgcn_readfirstlane(F.tid >> 6);
    F.G = gridDim.x; { const int bx = blockIdx.x; F.vcu = (F.G % 8 == 0) ? (bx % 8) * (F.G / 8) + bx / 8 : bx; }
    F.ws = args.ws; F.H = args.out;
    volatile LAS unsigned* MISC = (volatile LAS unsigned*)(F.lds + MISC_OFF);
    for (int u = F.tid; u < (LDS_BYTES - LDSCTL_OFF) / 4; u += NTHR) ((LAS unsigned*)(F.lds + LDSCTL_OFF))[u] = 0u;
    __syncthreads();
    unsigned* ctl = (unsigned*)(F.ws + WS_CTL);
    XcdBarrier bar; bar.bar = ctl + CW_BAR; bar.x = 0; bar.st = nullptr;
    if (ONE_LAUNCH) bar = xcd_barrier_post(ctl + CW_BAR, MISC + 8);
    const int lo = args.lo, hi = args.hi;
#ifndef PH_MASK
#define PH_MASK 0xfffffu
#endif
#define PHON(j) (((PH_MASK) >> (j)) & 1u)
#define IN(k) (lo <= (k) && (k) < hi)
#define PHASE_RELOAD() do { t_ = threadIdx.x; asm volatile("" : "+v"(t_)); F.tid = t_; F.lane = t_ & 63; F.wave = __builtin_amdgcn_readfirstlane(t_ >> 6); \
        A = (ArgsP)__builtin_amdgcn_kernarg_segment_ptr(); asm volatile("" : "+s"(A)); F.ws = A->ws; F.H = A->out; \
        { int g_ = gridDim.x, b_ = blockIdx.x; asm volatile("" : "+s"(g_), "+s"(b_)); F.G = g_; F.bx = b_; F.vcu = (g_ % 8 == 0) ? (b_ % 8) * (g_ / 8) + b_ / 8 : b_; } } while (0)
#define PHASE_BEGIN() int t_; ArgsP A; PHASE_RELOAD()
#define SEAM(k) do { if (IN(k) && IN((k) + 1)) { if (ONE_LAUNCH) xcd_barrier(bar); } } while (0)

    if (PHON(0) && IN(0)) { PHASE_BEGIN(); p0_prologue(F, A); SEAM(0); }

    for (int l = 0; l < NL; ++l) {
        const int pb = 1 + l * NPH;
        if (PHON(1) && IN(pb + 0)) { PHASE_BEGIN();
            const int N = (l == 0) ? INW : PROJ_LD;
            pg8::Gemm g{WSP(bf16, WS_U), WSP(bf16, WL(WO_IN)), T, N, D, D, D}; pg8::StaticOrder S; S.init(T, N, F.G, F.bx);
            pg8::Epi8<FPlain> E{{WSP(bf16, WS_PROJ), PROJ_LD, 1.f}};
            pg8::gemm_phase(F.lds, g, S, E);
            {
                PHASE_RELOAD();
                const int rem = ((T / 256) * (N / 256)) % F.G;
                if (rem != 0 && F.bx >= rem) convert_layer(F, A, l, 2, (F.bx - rem) * NWAVES + F.wave, (F.G - rem) * NWAVES);
                else if (rem == 0) convert_layer(F, A, l, 2, F.bx * NWAVES + F.wave, F.G * NWAVES);
            }
            SEAM(pb + 0);
        }
        if (PHON(2) && IN(pb + 1)) { PHASE_BEGIN(); prep_phase(F, A, l); SEAM(pb + 1); }
        if (PHON(3) && IN(pb + 2)) { PHASE_BEGIN();
            {
            { pg8::Gemm g{WSP(bf16, WS_LORA), WSP(bf16, WL(WO_UP)), T, 1024, 128, LORA_LD, 128}; pg8::StaticOrder S; S.init(T, 1024, F.G, F.bx);
              pg8::Epi8<FSig<0>> E{{WSP(bf16, WS_WLOG), 1024, A->in[I_W0] + (size_t)l * 1024}}; pg8::gemm_phase(F.lds, g, S, E); }
            PHASE_RELOAD();
            { pg8::Gemm g{WSP(bf16, WS_LORA) + 128, WSP(bf16, WL(WO_AUP)), T, 1024, 128, LORA_LD, 128}; pg8::StaticOrder S; S.init(T, 1024, F.G, F.bx);
              pg8::Epi8<FSig<1>> E{{WSP(bf16, WS_AIC), 1024, A->in[I_A0] + (size_t)l * 1024}}; pg8::gemm_phase(F.lds, g, S, E); }
            PHASE_RELOAD();
            { pg8::Gemm g{WSP(bf16, WS_LORA) + 256, WSP(bf16, WL(WO_GUP)), T, 1024, 256, LORA_LD, 256}; pg8::StaticOrder S; S.init(T, 1024, F.G, F.bx);
              pg8::Epi8<FPlain> E{{WSP(bf16, WS_GATE), 1024, 1.f}}; pg8::gemm_phase(F.lds, g, S, E); }
            PHASE_RELOAD();
            if (l > 0) { pg8::Gemm g{WSP(bf16, WS_LORA) + 512, WSP(bf16, WL(WO_VUP)), T, 1024, 128, LORA_LD, 128}; pg8::StaticOrder S; S.init(T, 1024, F.G, F.bx);
              pg8::Epi8<FVup> E{{WSP(bf16, WS_VV), A->in[I_V0] + (size_t)(l - 1) * 1024, A->in[I_MU] + (size_t)l * RIN + 2048, WSP(bf16, WS_PROJ), WSP(bf16, WS_VF)}}; pg8::gemm_phase(F.lds, g, S, E); }
            PHASE_RELOAD();
            { pg8::Gemm g{WSP(bf16, WS_CQN), WSP(bf16, WL(WO_UQ)), T, 1536, 512, 512, 512}; pg8::StaticOrder S; S.init(T, 1536, F.G, F.bx);
              pg8::Epi8<FQ> E{{WSP(bf16, WS_QB), WSP(float, WS_COS), WSP(float, WS_SIN)}}; pg8::gemm_phase(F.lds, g, S, E); }
            PHASE_RELOAD();
            { pg8::Gemm g{WSP(bf16, WS_CKVN), WSP(bf16, WL(WO_UKV)), T, 2048, 256, 256, 256}; pg8::StaticOrder S; S.init(T, 2048, F.G, F.bx);
              pg8::Epi8<FPlain> E{{WSP(bf16, WS_KV), 2048, 1.f}}; pg8::gemm_phase(F.lds, g, S, E); }
            }
            SEAM(pb + 2);
        }
        if (PHON(4) && IN(pb + 3)) { PHASE_BEGIN();
            cs_pre_phase(F, A, l);
            SEAM(pb + 3);
        }
        if (PHON(5) && IN(pb + 4)) { PHASE_BEGIN();
            for (int u = F.vcu; u < 128; u += F.G) cs_seq_unit(F, u >> 1, u & 1);
            if (F.G > 128 && F.vcu >= 128) convert_layer(F, A, l, 3, (F.vcu - 128) * NWAVES + F.wave, (F.G - 128) * NWAVES);
            else if (F.G <= 128) convert_layer(F, A, l, 3, F.vcu * NWAVES + F.wave, F.G * NWAVES);
            __syncthreads();
        }
        if (PHON(6) && IN(pb + 5)) { PHASE_BEGIN();
            for (int u = F.vcu; u < 256; u += F.G) {
                const int bh = u >> 3, s = u & 7, b = bh >> 3, hh = bh & 7;
#pragma unroll 1
                for (int pass = 0; pass < 2; ++pass) {
                    const int qb = pass == 0 ? s : 15 - s; const size_t r0 = (size_t)b * SEQ;
                    attn_unit<192, true>(F.lds, WSP(bf16, WS_QB) + (r0 + qb * 256) * 1536 + hh * 192, 1536,
                                         WSP(bf16, WS_KV) + r0 * 2048 + hh * 256, 2048, WSP(bf16, WS_KR) + r0 * 64, 64,
                                         WSP(bf16, WS_KV) + r0 * 2048 + hh * 256 + 128, 2048,
                                         WSP(bf16, WS_U) + (r0 + qb * 256) * D + 1024 + hh * 128, D, qb * 256, 4 * (qb + 1));
                }
            }
            SEAM(pb + 5);
        }
        if (PHON(7) && IN(pb + 6)) { PHASE_BEGIN(); rwkv_post_phase(F, A, l); SEAM(pb + 6); }
        if (PHON(8) && IN(pb + 7)) { PHASE_BEGIN();
            pg8::Gemm g{WSP(bf16, WS_U), WSP(bf16, WL(WO_OUT)), T, D, D, D, D}; pg8::StaticOrder S; S.init(T, D, F.G, F.bx);
            pg8::Epi8<FPlain> E{{WSP(bf16, WS_Y), D, 1.f}}; pg8::gemm_phase(F.lds, g, S, E);
            SEAM(pb + 7);
        }
        if (PHON(9) && IN(pb + 8)) { PHASE_BEGIN(); ew_norm_phase(F, A->in[I_MIXPOST] + (size_t)l * D, A->in[I_MEMPRE] + (size_t)l * D, 3 * l); SEAM(pb + 8); }
        if (PHON(10) && IN(pb + 9)) { PHASE_BEGIN();
            pg8::Gemm g{WSP(bf16, WS_U), WSP(bf16, WL(WO_QM)), T, 512, D, D, D}; pg8::StaticOrder S; S.init(T, 512, F.G, F.bx);
            pg8::Epi8<FPlain> E{{WSP(bf16, WS_QMEM), 512, QSCALE_MEM}}; pg8::gemm_phase(F.lds, g, S, E);
            PHASE_RELOAD();
            { pg8::Gemm g2{WSP(bf16, WS_MEMN), WSP(bf16, WL(WO_KM)), NB * NMEM, 512, D, D, D}; pg8::StaticOrder S2; S2.init(NB * NMEM, 512, F.G, (F.bx + F.G - 128 % F.G) % F.G);
              pg8::Epi8<FPlain> E2{{WSP(bf16, WS_MEMK), 512, 1.f}}; pg8::gemm_phase(F.lds, g2, S2, E2); }
            PHASE_RELOAD();
            { pg8::Gemm g2{WSP(bf16, WS_MEMN), WSP(bf16, WL(WO_VM)), NB * NMEM, 512, D, D, D}; pg8::StaticOrder S2; S2.init(NB * NMEM, 512, F.G, (F.bx + F.G - 136 % F.G) % F.G);
              pg8::Epi8<FPlain> E2{{WSP(bf16, WS_MEMV), 512, 1.f}}; pg8::gemm_phase(F.lds, g2, S2, E2); }
            if (l + 1 < NL) { PHASE_RELOAD();
                if (F.G > 144 && F.bx >= 144) convert_layer(F, A, l + 1, 1, (F.bx - 144) * NWAVES + F.wave, (F.G - 144) * NWAVES);
                else if (F.G <= 144) convert_layer(F, A, l + 1, 1, F.bx * NWAVES + F.wave, F.G * NWAVES); }
            SEAM(pb + 9);
        }
        if (PHON(11) && IN(pb + 10)) { PHASE_BEGIN();
            for (int u = F.vcu; u < 256; u += F.G) {
                const int bh = u >> 4, qb = u & 15, b = bh >> 2, hh = bh & 3; const size_t r0 = (size_t)b * SEQ + qb * 256;
                attn_unit<128, false>(F.lds, WSP(bf16, WS_QMEM) + r0 * 512 + hh * 128, 512,
                                      WSP(bf16, WS_MEMK) + (size_t)b * NMEM * 512 + hh * 128, 512, nullptr, 0,
                                      WSP(bf16, WS_MEMV) + (size_t)b * NMEM * 512 + hh * 128, 512,
                                      WSP(bf16, WS_OMEM) + r0 * 512 + hh * 128, 512, 0, NMEM / 64);
            }
            SEAM(pb + 10);
        }
        if (PHON(12) && IN(pb + 11)) { PHASE_BEGIN();
            pg8::Gemm g{WSP(bf16, WS_OMEM), WSP(bf16, WL(WO_OM)), T, D, 512, 512, 512}; pg8::StaticOrder S; S.init(T, D, F.G, F.bx);
            pg8::Epi8<FPlain> E{{WSP(bf16, WS_Y), D, 1.f}}; pg8::gemm_phase(F.lds, g, S, E);
            SEAM(pb + 11);
        }
        if (PHON(13) && IN(pb + 12)) { PHASE_BEGIN(); ew_norm_phase(F, A->in[I_MEMPOST] + (size_t)l * D, A->in[I_FFNPRE] + (size_t)l * D, 3 * l + 1); SEAM(pb + 12); }
        if (PHON(14) && IN(pb + 13)) { PHASE_BEGIN();
            pg8::Gemm g{WSP(bf16, WS_U), WSP(bf16, WL(WO_FF1)), T, FF, D, D, D}; pg8::StaticOrder S; S.init(T, FF, F.G, F.bx);
            pg8::Epi8<FRelu2> E{{WSP(bf16, WS_HID), FF}}; pg8::gemm_phase(F.lds, g, S, E);
            SEAM(pb + 13);
        }
        if (PHON(15) && IN(pb + 14)) { PHASE_BEGIN();
            pg8::Gemm g{WSP(bf16, WS_HID), WSP(bf16, WL(WO_FF2)), T, D, FF, FF, FF}; pg8::StaticOrder S; S.init(T, D, F.G, F.bx);
            pg8::Epi8<FPlain> E{{WSP(bf16, WS_Y), D, 1.f}}; pg8::gemm_phase(F.lds, g, S, E);
            SEAM(pb + 14);
        }
        if (PHON(16) && IN(pb + 15)) { PHASE_BEGIN(); ew_norm_phase(F, A->in[I_FFNPOST] + (size_t)l * D, l + 1 < NL ? A->in[I_MIXPRE] + (size_t)(l + 1) * D : nullptr, 3 * l + 2); SEAM(pb + 15); }
    }
#undef IN
#undef SEAM
}

extern "C" void kernel_launch(void* const* d_in, const int* in_sizes, int n_in, void* d_out, int out_size, void* d_ws, size_t ws_size, hipStream_t stream) {
    static int grid = 0;
    if (grid == 0) {
        if (n_in != N_IN || out_size != T * D || ws_size < WS_END) { fprintf(stderr, "kernel_launch: unexpected shapes (n_in %d, out %d, ws %zu)\n", n_in, out_size, ws_size); grid = -1; return; }
        int dev = 0, cus = 0;
        if (hipGetDevice(&dev) != hipSuccess || hipDeviceGetAttribute(&cus, hipDeviceAttributeMultiprocessorCount, dev) != hipSuccess) { grid = -1; return; }
        if (hipFuncSetAttribute((const void*)fwd, hipFuncAttributeMaxDynamicSharedMemorySize, LDS_BYTES) != hipSuccess) { fprintf(stderr, "kernel_launch: hipFuncSetAttribute failed\n"); grid = -1; return; }
        int per_cu = 0;
        if (hipOccupancyMaxActiveBlocksPerMultiprocessor(&per_cu, (const void*)fwd, NTHR, LDS_BYTES) != hipSuccess || per_cu < 1) fprintf(stderr, "kernel_launch: occupancy query says %d\n", per_cu);
        (void)hipGetLastError();
        grid = cus;
    }
    if (grid < 0) return;
    (void)hipMemsetAsync((char*)d_ws + WS_CTL, 0, CTL_BYTES, stream);
    Args a{};
    for (int i = 0; i < N_IN; ++i) a.in[i] = (const float*)d_in[i];
    a.out = (float*)d_out; a.ws = (unsigned char*)d_ws;
    const int nph = NPHASES < STOP_PHASE ? NPHASES : STOP_PHASE;
    if (ONE_LAUNCH) { a.lo = 0; a.hi = nph; hipLaunchKernelGGL(fwd, dim3(grid), dim3(NTHR), LDS_BYTES, stream, a); }
    else { for (int p = 0; p < nph; ++p) { a.lo = p; a.hi = p + 1; hipLaunchKernelGGL(fwd, dim3(grid), dim3(NTHR), LDS_BYTES, stream, a); } }
}
```

```cpp
#include <hip/hip_runtime.h>
#include <cstdio>
#include <cstdint>

#define GAS __attribute__((address_space(1)))
#define LAS __attribute__((address_space(3)))
typedef unsigned short bf16;
typedef short bf16x8 __attribute__((ext_vector_type(8)));
typedef short s16x4 __attribute__((ext_vector_type(4)));
typedef float f32x2 __attribute__((ext_vector_type(2)));
typedef float f32x4 __attribute__((ext_vector_type(4)));
typedef float f32x16 __attribute__((ext_vector_type(16)));
typedef unsigned u32x2 __attribute__((ext_vector_type(2)));
typedef unsigned u32x4 __attribute__((ext_vector_type(4)));
typedef __bf16 bf16x2_t __attribute__((ext_vector_type(2)));

#ifndef ONE_LAUNCH
#define ONE_LAUNCH 1
#endif
#ifndef STOP_PHASE
#define STOP_PHASE 1000
#endif

constexpr int T = 16384, SEQ = 4096, NB = 4, D = 2048, NL = 4, FF = 8192;
constexpr int RIN = 3520, INW = 4352, PROJ_LD = 4608;
constexpr int NMEM = 256;
constexpr float NORM_EPS = 1e-6f, GN_EPS = 64e-5f;
constexpr float QSCALE_MLA = 0.07216878364870323f * 1.4426950408889634f;
constexpr float QSCALE_MEM = 0.08838834764831845f * 1.4426950408889634f;
constexpr int NWAVES = 8, NTHR = 512;
constexpr int NPH = 16, NPHASES = 1 + NL * NPH;

enum { I_X = 0, I_MEM, I_MEMG, I_MIXPRE, I_WIN, I_WINV, I_MU, I_MUV, I_W0, I_WUP, I_A0, I_AUP, I_V0, I_VUP, I_GUP, I_KK, I_KA, I_RK, I_LNG, I_LNB,
       I_QNG, I_WUQ, I_KVNG, I_WUKV, I_WOUT, I_MIXPOST, I_MEMPRE, I_WQM, I_WKM, I_WVM, I_WOM, I_MEMPOST, I_FFNPRE, I_FF1, I_FF2, I_FFNPOST, N_IN };

constexpr size_t KiB = 1024, MiB = 1024 * 1024;
constexpr size_t WS_CTL = 0, CTL_BYTES = 1 * MiB;
constexpr size_t WS_COS = 1 * MiB, WS_SIN = 1 * MiB + 512 * KiB;
constexpr size_t WS_MEMN = 2 * MiB, WS_MEMK = 6 * MiB, WS_MEMV = 7 * MiB, WS_RKB = 8 * MiB;
constexpr size_t WS_W = 16 * MiB, W_LSTRIDE = 38 * MiB;
constexpr size_t WS_WFF = 92 * MiB;
constexpr size_t WS_HB = 156 * MiB;
constexpr size_t WS_SCAN = 220 * MiB;
constexpr size_t WO_IN = 0, WO_UP = 18 * MiB, WO_AUP = 18 * MiB + 256 * KiB, WO_GUP = 18 * MiB + 512 * KiB, WO_VUP = 19 * MiB, WO_UQ = 19 * MiB + 512 * KiB,
                 WO_UKV = 21 * MiB, WO_OUT = 22 * MiB, WO_QM = 30 * MiB, WO_KM = 32 * MiB, WO_VM = 34 * MiB, WO_OM = 36 * MiB, WO_FF1 = 38 * MiB, WO_FF2 = 70 * MiB;
constexpr size_t WS_U = 424 * MiB, WS_Y = 488 * MiB, WS_VF = 552 * MiB;
constexpr size_t WS_PROJ = 584 * MiB, WS_LORA = 728 * MiB, WS_WLOG = 748 * MiB, WS_AIC = 780 * MiB, WS_GATE = 812 * MiB, WS_VV = 844 * MiB,
                 WS_CQN = 876 * MiB, WS_CKVN = 892 * MiB, WS_KR = 900 * MiB, WS_QB = 902 * MiB, WS_KV = 950 * MiB, WS_END = 1014 * MiB;
constexpr size_t WS_HID = 584 * MiB, WS_QMEM = 840 * MiB, WS_OMEM = 856 * MiB;
constexpr int LORA_LD = 640;
constexpr int CW_TMO = 0, CW_BAR = 4096;

constexpr int RING_BYTES = 163328, LDSCTL_OFF = RING_BYTES, MISC_OFF = LDSCTL_OFF + 320, LDS_BYTES = 163840;

__device__ __forceinline__ unsigned cvt_pk(float lo, float hi) { f32x2 v = {lo, hi}; bf16x2_t b = __builtin_convertvector(v, bf16x2_t); return __builtin_bit_cast(unsigned, b); }
__device__ __forceinline__ float bflo(unsigned w) { return __uint_as_float(w << 16); }
__device__ __forceinline__ float bfhi(unsigned w) { return __uint_as_float(w & 0xffff0000u); }
__device__ __forceinline__ float bf1(bf16 b) { return __uint_as_float((unsigned)b << 16); }
__device__ __forceinline__ bf16 f2bf(float f) { return (bf16)(cvt_pk(f, 0.f) & 0xffffu); }
template <int CTRL> __device__ __forceinline__ float dpp_add(float x) { return x + __int_as_float(__builtin_amdgcn_update_dpp(0, __float_as_int(x), CTRL, 0xf, 0xf, true)); }
__device__ __forceinline__ float sum4(float x) { x = dpp_add<0xB1>(x); x = dpp_add<0x4E>(x); return x; }
__device__ __forceinline__ float sum8(float x) { x = sum4(x); x = dpp_add<0x141>(x); return x; }
__device__ __forceinline__ float sum16(float x) { x = sum8(x); x = dpp_add<0x140>(x); return x; }
__device__ __forceinline__ float wave_sum(float x) {
    x = sum16(x);
    { auto r = __builtin_amdgcn_permlane16_swap(__float_as_uint(x), __float_as_uint(x), false, false); x = __uint_as_float(r[0]) + __uint_as_float(r[1]); }
    { auto r = __builtin_amdgcn_permlane32_swap(__float_as_uint(x), __float_as_uint(x), false, false); x = __uint_as_float(r[0]) + __uint_as_float(r[1]); }
    return x;
}
__device__ __forceinline__ float sigmoidf_(float x) { return __builtin_amdgcn_rcpf(1.f + __builtin_amdgcn_exp2f(-1.4426950408889634f * x)); }
__device__ __forceinline__ float tanhf_(float x) { const float e = __builtin_amdgcn_exp2f(-2.f * 1.4426950408889634f * fabsf(x)); const float t = (1.f - e) * __builtin_amdgcn_rcpf(1.f + e); return x < 0.f ? -t : t; }
__device__ __forceinline__ void unpack8(u32x4 w, float (&f)[8]) {
    f[0] = bflo(w.x); f[1] = bfhi(w.x); f[2] = bflo(w.y); f[3] = bfhi(w.y); f[4] = bflo(w.z); f[5] = bfhi(w.z); f[6] = bflo(w.w); f[7] = bfhi(w.w);
}
__device__ __forceinline__ u32x4 pack8(const float (&f)[8]) { u32x4 w; w.x = cvt_pk(f[0], f[1]); w.y = cvt_pk(f[2], f[3]); w.z = cvt_pk(f[4], f[5]); w.w = cvt_pk(f[6], f[7]); return w; }

__device__ __forceinline__ int crow(int r, int hi) { return (r & 3) + 8 * (r >> 2) + 4 * hi; }
typedef short v4i16_t __attribute__((ext_vector_type(4)));

namespace pg8 {
#define PG8_LAS __attribute__((address_space(3)))
typedef unsigned short bf16_t;
constexpr int BM = 256, BK = 64, HALF = 128, HTB = HALF * BK * 2, STAGE_BYTES = 8 * HTB, NXCD = 8, WGM = 8;
__host__ __device__ __forceinline__ int lds_byte(int r, int c) { const int st = (r >> 4) * 2 + (c >> 5), rr = r & 15, cc = c & 31, ob = rr * 64 + cc * 2; return st * 1024 + (ob ^ (((ob >> 9) & 1) << 5)); }
__host__ __device__ __forceinline__ void stage_rc(int b, int& R, int& C) { const int st = b / 1024, sb = b % 1024, swz = sb ^ (((sb >> 9) & 1) << 5); R = (st >> 1) * 16 + swz / 64; C = (st & 1) * 32 + (swz % 64) / 2; }
__host__ __device__ __forceinline__ int perm32(int rho) { const int n = rho >> 4, i = rho & 15; return 8 * (i >> 2) + 4 * n + (i & 3); }
struct Unit { int pm, pn; };
struct Gemm { const bf16_t* A; const bf16_t* Bt; int M, N, K, lda, ldb; };
struct StaticOrder {
    int nM, nN, nwg, G, c;
    __host__ __device__ void init(int M, int N, int G_, int c_) { nM = M / BM; nN = N / BM; nwg = nM * nN; G = G_; c = c_; }
    __host__ __device__ bool next(int i, Unit& u) const {
        const long L = (long)i * G + c; if (L >= nwg) return false;
        int wgid = (int)L; { const int q = nwg / NXCD, r = nwg % NXCD, xcd = wgid % NXCD, off = wgid / NXCD; wgid = (xcd < r ? xcd * (q + 1) : r * (q + 1) + (xcd - r) * q) + off; }
        const int nig = WGM * nN, gid = wgid / nig, fm = gid * WGM, gsz = (nM - fm) < WGM ? (nM - fm) : WGM;
        u.pm = fm + ((wgid % nig) % gsz); u.pn = (wgid % nig) / gsz; return true;
    }
};
template <class F> struct Epi8 {
    F f;
    __device__ __forceinline__ void operator()(const f32x4 (&acc)[2][2][4][2], const Unit& u, int wr, int wc, int fr, int fq) const {
        const int row0 = u.pm * BM + wr * 64 + fr, col0 = u.pn * BM + wc * 32 + 8 * fq;
#pragma unroll
        for (int ai = 0; ai < 2; ++ai)
#pragma unroll
            for (int m = 0; m < 4; ++m)
#pragma unroll
                for (int bj = 0; bj < 2; ++bj) { f(row0 + ai * HALF + m * 16, col0 + bj * HALF, acc[ai][bj][m][0], acc[ai][bj][m][1]); if (F::HEAVY) __builtin_amdgcn_sched_barrier(0); }
    }
};

template <class Epi>
__device__ __forceinline__ void gemm_phase(PG8_LAS unsigned char* lds, const Gemm g, const StaticOrder& S, const Epi& E) {
    int tid = threadIdx.x; asm volatile("" : "+v"(tid));
    const int wid = __builtin_amdgcn_readfirstlane(tid >> 6), lane = tid & 63, wr = wid >> 2, wc = wid & 3, fr = lane & 15, fq = lane >> 4;
    int K = g.K; asm volatile("" : "+s"(K));
    const int nt = K / BK;
    unsigned voffA[2], voffB[2];
#pragma unroll
    for (int i = 0; i < 2; ++i) { int R, C; stage_rc(tid * 16 + i * 8192, R, C); const int Rb = (R & ~31) + perm32(R & 31);
        voffA[i] = (unsigned)(R * g.lda + C) * 2u; voffB[i] = (unsigned)(Rb * g.ldb + C) * 2u; }
    const size_t kstep = (size_t)(BK * 2);
    const size_t hsA = (size_t)HALF * g.lda * 2, hsB = (size_t)HALF * g.ldb * 2;
    const size_t tsA = 2 * hsA, tsB = 2 * hsB;
    const unsigned ldsw = (unsigned)wid * 1024u;
    const int aoff = lds_byte(wr * 64 + fr, fq * 8), boff = lds_byte(wc * 32 + fr, fq * 8);
#define PG8_SA(b, h) (((b) * 2 + (h)) * HTB)
#define PG8_SB(b, h) ((4 + (b) * 2 + (h)) * HTB)
#define PG8_STAGE(bufoff, gbase, voff) do { _Pragma("unroll") for (int _i = 0; _i < 2; ++_i) \
        __builtin_amdgcn_global_load_lds((const unsigned*)((const char*)(gbase) + (voff)[_i]), (PG8_LAS unsigned*)(lds + (bufoff) + ldsw + _i * 8192), 16, 0, 0); } while (0)
#define PG8_LDA(dst, b, h) do { _Pragma("unroll") for (int m = 0; m < 4; ++m) _Pragma("unroll") for (int k = 0; k < 2; ++k) dst[m][k] = *(const PG8_LAS bf16x8*)(lds + PG8_SA(b, h) + aoff + m * 2048 + k * 1024); } while (0)
#define PG8_LDB(dst, b, h) do { _Pragma("unroll") for (int n = 0; n < 2; ++n) _Pragma("unroll") for (int k = 0; k < 2; ++k) dst[n][k] = *(const PG8_LAS bf16x8*)(lds + PG8_SB(b, h) + boff + n * 2048 + k * 1024); } while (0)
#define PG8_MMA(ai, bj, At, Bt) do { __builtin_amdgcn_s_setprio(1); _Pragma("unroll") for (int m = 0; m < 4; ++m) _Pragma("unroll") for (int n = 0; n < 2; ++n) _Pragma("unroll") for (int k = 0; k < 2; ++k) \
        acc[ai][bj][m][n] = __builtin_amdgcn_mfma_f32_16x16x32_bf16(Bt[n][k], At[m][k], acc[ai][bj][m][n], 0, 0, 0); __builtin_amdgcn_s_setprio(0); } while (0)
#define PG8_WAIT_V(n) asm volatile("s_waitcnt vmcnt(" #n ")" ::: "memory")
#define PG8_WAIT_L(n) asm volatile("s_waitcnt lgkmcnt(" #n ")" ::: "memory")
#define PG8_BAR __builtin_amdgcn_s_barrier()
#define PG8_SCHED __builtin_amdgcn_sched_barrier(0)
    Unit cur, nxt; int ui = 0;
    if (!S.next(0, cur)) return;
    f32x4 acc[2][2][4][2];
#pragma unroll
    for (int a = 0; a < 2; ++a)
#pragma unroll
        for (int b = 0; b < 2; ++b)
#pragma unroll
            for (int m = 0; m < 4; ++m)
#pragma unroll
                for (int n = 0; n < 2; ++n) acc[a][b][m][n] = (f32x4){0.f, 0.f, 0.f, 0.f};
    bf16x8 At[4][2], B0[2][2], B1[2][2];
    const char* cA = (const char*)g.A + (size_t)cur.pm * tsA; const char* cB = (const char*)g.Bt + (size_t)cur.pn * tsB;
    PG8_STAGE(PG8_SB(0, 0), cB, voffB); PG8_STAGE(PG8_SB(0, 1), cB + hsB, voffB); PG8_STAGE(PG8_SA(0, 0), cA, voffA); PG8_STAGE(PG8_SA(0, 1), cA + hsA, voffA);
    if (wr == 1) PG8_BAR;
    PG8_WAIT_V(2); PG8_BAR;
    PG8_STAGE(PG8_SB(1, 0), cB + kstep, voffB); PG8_STAGE(PG8_SA(1, 0), cA + kstep, voffA); PG8_STAGE(PG8_SB(1, 1), cB + hsB + kstep, voffB);
    PG8_WAIT_V(6); PG8_BAR;
    for (;;) {
        const bool has_next = S.next(ui + 1, nxt);
        const char* nA = has_next ? (const char*)g.A + (size_t)nxt.pm * tsA : cA; const char* nB = has_next ? (const char*)g.Bt + (size_t)nxt.pn * tsB : cB;
        for (int t = 0; t < nt; t += 2) {
            const bool last = (t == nt - 2);
            const char* a1 = cA + (size_t)(t + 1) * kstep;
            const char* a2 = last ? nA : cA + (size_t)(t + 2) * kstep; const char* b2 = last ? nB : cB + (size_t)(t + 2) * kstep;
            const char* a3 = a2 + kstep; const char* b3 = b2 + kstep;
            PG8_LDB(B0, 0, 0); PG8_LDB(B1, 0, 1); PG8_SCHED; PG8_LDA(At, 0, 0); PG8_STAGE(PG8_SA(1, 1), a1 + hsA, voffA);
            PG8_WAIT_V(8); PG8_WAIT_L(0); PG8_BAR; PG8_MMA(0, 0, At, B0); PG8_MMA(0, 1, At, B1); PG8_BAR; PG8_SCHED;
            PG8_LDA(At, 0, 1); PG8_STAGE(PG8_SB(0, 0), b2, voffB); PG8_STAGE(PG8_SB(0, 1), b2 + hsB, voffB); PG8_STAGE(PG8_SA(0, 0), a2, voffA);
            PG8_WAIT_V(8); PG8_WAIT_L(0); PG8_BAR; PG8_MMA(1, 0, At, B0); PG8_MMA(1, 1, At, B1); PG8_BAR; PG8_SCHED;
            PG8_LDB(B0, 1, 0); PG8_LDB(B1, 1, 1); PG8_SCHED; PG8_LDA(At, 1, 0); PG8_STAGE(PG8_SA(0, 1), a2 + hsA, voffA);
            PG8_WAIT_V(8); PG8_WAIT_L(0); PG8_BAR; PG8_MMA(0, 0, At, B0); PG8_MMA(0, 1, At, B1); PG8_BAR; PG8_SCHED;
            PG8_LDA(At, 1, 1); PG8_STAGE(PG8_SB(1, 0), b3, voffB); PG8_STAGE(PG8_SB(1, 1), b3 + hsB, voffB); PG8_STAGE(PG8_SA(1, 0), a3, voffA);
            PG8_WAIT_V(8); PG8_WAIT_L(0); PG8_BAR; PG8_MMA(1, 0, At, B0); PG8_MMA(1, 1, At, B1); PG8_BAR; PG8_SCHED;
        }
        if (wr == 0) PG8_BAR;
        E(acc, cur, wr, wc, fr, fq);
        if (!has_next) break;
#pragma unroll
        for (int a = 0; a < 2; ++a)
#pragma unroll
            for (int b = 0; b < 2; ++b)
#pragma unroll
                for (int m = 0; m < 4; ++m)
#pragma unroll
                    for (int n = 0; n < 2; ++n) acc[a][b][m][n] = (f32x4){0.f, 0.f, 0.f, 0.f};
        cur = nxt; cA = nA; cB = nB; ++ui;
        if (wr == 1) PG8_BAR;
    }
    PG8_WAIT_V(0);
    PG8_BAR;
#undef PG8_SA
#undef PG8_SB
#undef PG8_STAGE
#undef PG8_LDA
#undef PG8_LDB
#undef PG8_MMA
#undef PG8_WAIT_V
#undef PG8_WAIT_L
#undef PG8_BAR
#undef PG8_SCHED
}
}

__device__ __forceinline__ void st16_wt(void* p, u32x4 w) { asm volatile("global_store_dwordx4 %0, %1, off sc1\n\ts_nop 1" :: "v"(p), "v"(w) : "memory"); }
struct FPlain { static constexpr bool HEAVY = false; bf16* O; int ld; float sc;
    __device__ __forceinline__ void operator()(int row, int col, f32x4 a, f32x4 b) const {
        u32x4 w; w.x = cvt_pk(a[0] * sc, a[1] * sc); w.y = cvt_pk(a[2] * sc, a[3] * sc); w.z = cvt_pk(b[0] * sc, b[1] * sc); w.w = cvt_pk(b[2] * sc, b[3] * sc);
        st16_wt(O + (size_t)row * ld + col, w); } };
struct FRelu2 { static constexpr bool HEAVY = false; bf16* O; int ld;
    __device__ __forceinline__ void operator()(int row, int col, f32x4 a, f32x4 b) const {
        float v[8] = {a[0], a[1], a[2], a[3], b[0], b[1], b[2], b[3]};
#pragma unroll
        for (int i = 0; i < 8; ++i) { const float r = fmaxf(v[i], 0.f); v[i] = r * r; }
        st16_wt(O + (size_t)row * ld + col, pack8(v)); } };
template <int MODE> struct FSig { static constexpr bool HEAVY = true; bf16* O; int ld; const float* bias;
    __device__ __forceinline__ void operator()(int row, int col, f32x4 a, f32x4 b) const {
        const f32x4 b0 = *(const f32x4*)(bias + col), b1 = *(const f32x4*)(bias + col + 4);
        float v[8] = {a[0] + b0[0], a[1] + b0[1], a[2] + b0[2], a[3] + b0[3], b[0] + b1[0], b[1] + b1[1], b[2] + b1[2], b[3] + b1[3]};
#pragma unroll
        for (int i = 0; i < 8; ++i) { const float s = sigmoidf_(v[i]); v[i] = MODE == 0 ? -0.6065306597126334f * s : s; }
        *(u32x4*)(O + (size_t)row * ld + col) = pack8(v); } };
struct FVup { static constexpr bool HEAVY = true; bf16* O; const float* v0; const float* mu; const bf16* proj; const bf16* vfirst;
    __device__ __forceinline__ void operator()(int row, int col, f32x4 a, f32x4 b) const {
        const f32x4 b0 = *(const f32x4*)(v0 + col), b1 = *(const f32x4*)(v0 + col + 4), m0 = *(const f32x4*)(mu + col), m1 = *(const f32x4*)(mu + col + 4);
        float cur[8], prv[8], vf[8];
        unpack8(*(const u32x4*)(proj + (size_t)row * PROJ_LD + 2048 + col), cur);
        if ((row & (SEQ - 1)) != 0) unpack8(*(const u32x4*)(proj + (size_t)(row - 1) * PROJ_LD + 2048 + col), prv);
        else {
#pragma unroll
            for (int i = 0; i < 8; ++i) prv[i] = 0.f; }
        unpack8(*(const u32x4*)(vfirst + (size_t)row * 1024 + col), vf);
        const float acc8[8] = {a[0] + b0[0], a[1] + b0[1], a[2] + b0[2], a[3] + b0[3], b[0] + b1[0], b[1] + b1[1], b[2] + b1[2], b[3] + b1[3]};
        const float mu8[8] = {m0[0], m0[1], m0[2], m0[3], m1[0], m1[1], m1[2], m1[3]};
        float v[8];
#pragma unroll
        for (int i = 0; i < 8; ++i) { const float vs = cur[i] + (prv[i] - cur[i]) * mu8[i]; v[i] = vs + (vf[i] - vs) * sigmoidf_(acc8[i]); }
        *(u32x4*)(O + (size_t)row * 1024 + col) = pack8(v); } };
struct FQ { static constexpr bool HEAVY = true; bf16* O; const float* cosT; const float* sinT;
    __device__ __forceinline__ void operator()(int row, int col, f32x4 a, f32x4 b) const {
        const int cc = col % 192;
        float v[8] = {a[0], a[1], a[2], a[3], b[0], b[1], b[2], b[3]};
        if (cc >= 128) { const int i0 = (cc - 128) >> 1, pos = row & (SEQ - 1);
            const f32x4 c = *(const f32x4*)(cosT + pos * 32 + i0), s = *(const f32x4*)(sinT + pos * 32 + i0);
#pragma unroll
            for (int i = 0; i < 4; ++i) { const float x1 = v[2 * i], x2 = v[2 * i + 1]; v[2 * i] = x1 * c[i] - x2 * s[i]; v[2 * i + 1] = x1 * s[i] + x2 * c[i]; } }
#pragma unroll
        for (int i = 0; i < 8; ++i) v[i] *= QSCALE_MLA;
        *(u32x4*)(O + (size_t)row * 1536 + col) = pack8(v); } };

#define XB_TMO      128
#define XB_XCNT(j)  (256  + 64 * (j))
#define XB_XSUB(j)  (1280 + 64 * (j))
#define XB_XGEN(j)  (2304 + 64 * (j))
#define XB_TOP      3328
#define XB_TOPGEN   3392
#define XCD_BAR_WORDS 3456
#define XB_SPIN_CAP (1u << 20)
__device__ __forceinline__ unsigned xb_ld(unsigned* p)              { return __hip_atomic_load(p, __ATOMIC_RELAXED, __HIP_MEMORY_SCOPE_AGENT); }
__device__ __forceinline__ unsigned xb_add(unsigned* p, unsigned v) { return __hip_atomic_fetch_add(p, v, __ATOMIC_RELAXED, __HIP_MEMORY_SCOPE_AGENT); }
__device__ __forceinline__ unsigned xb_xcc_id() { return (unsigned)__builtin_amdgcn_s_getreg((3 << 11) | 20) & 0xFu; }
#define XB_SPIN(cond, bar) do { unsigned _sp = 0; while (cond) { __builtin_amdgcn_s_sleep(1); \
    if ((++_sp & 255u) == 0u) { if (xb_ld(&(bar)[XB_TMO])) break; if (_sp > XB_SPIN_CAP) { atomicAdd(&(bar)[XB_TMO], 1u); break; } } } } while (0)
struct XcdBarrier { unsigned* bar; unsigned x; volatile LAS unsigned* st; };
__device__ __forceinline__ XcdBarrier xcd_barrier_post(unsigned* bar, volatile LAS unsigned* st) {
    XcdBarrier b; b.bar = bar; b.x = xb_xcc_id(); b.st = st;
    if (threadIdx.x == 0) (void)xb_add(&bar[XB_XCNT(b.x)], 1u);
    return b;
}
__device__ __forceinline__ void xcd_barrier_complete(unsigned* bar, unsigned x, unsigned& nloc, unsigned& nx) {
    const unsigned G = gridDim.x * gridDim.y * gridDim.z;
    unsigned sum, cnt, mine, sp = 0u;
    for (;;) {
        sum = 0u; cnt = 0u; mine = 0u;
#pragma unroll
        for (unsigned j = 0; j < 16; ++j) { const unsigned c = xb_ld(&bar[XB_XCNT(j)]); sum += c; cnt += (c > 0u) ? 1u : 0u; mine = (j == x) ? c : mine; }
        if (sum == G) break;
        __builtin_amdgcn_s_sleep(1);
        if ((++sp & 255u) == 0u) { if (xb_ld(&bar[XB_TMO])) break; if (sp > XB_SPIN_CAP) { atomicAdd(&bar[XB_TMO], 1u); break; } }
    }
    nloc = mine > 0u ? mine : 1u; nx = cnt > 0u ? cnt : 1u;
}
__device__ __forceinline__ void xcd_barrier(const XcdBarrier& b) {
    asm volatile("s_waitcnt vmcnt(0)" ::: "memory");
    __syncthreads();
    if (threadIdx.x == 0) {
        unsigned* bar = b.bar;
        __builtin_amdgcn_s_waitcnt(0);
        unsigned nloc = b.st[0], nx = b.st[1];
        if (nloc == 0u) { xcd_barrier_complete(bar, b.x, nloc, nx); b.st[0] = nloc; b.st[1] = nx; }
        const unsigned old = xb_add(&bar[XB_XSUB(b.x)], 1u);
        const unsigned gen = old / nloc;
        if (old + 1u == (gen + 1u) * nloc) {
            __builtin_amdgcn_fence(__ATOMIC_RELEASE, "agent");
            asm volatile("s_waitcnt vmcnt(0)" ::: "memory");
            const unsigned og = xb_add(&bar[XB_TOP], 1u);
            const unsigned tg = og / nx;
            if (og + 1u == (tg + 1u) * nx) xb_add(&bar[XB_TOPGEN], 1u);
            else XB_SPIN(xb_ld(&bar[XB_TOPGEN]) == tg, bar);
            __builtin_amdgcn_fence(__ATOMIC_ACQUIRE, "agent");
            xb_add(&bar[XB_XGEN(b.x)], 1u);
            asm volatile("s_waitcnt vmcnt(0)" ::: "memory");
        } else {
            XB_SPIN(xb_ld(&bar[XB_XGEN(b.x)]) == gen, bar);
            __builtin_amdgcn_fence(__ATOMIC_ACQUIRE, "agent");
            asm volatile("s_waitcnt vmcnt(0)" ::: "memory");
        }
    }
    __syncthreads();
}

struct Args { const float* in[N_IN]; float* out; unsigned char* ws; int lo, hi; };
typedef const __attribute__((address_space(4))) Args* ArgsP;
struct Frame {
    LAS unsigned char* lds;
    int tid, lane, wave, vcu, G, bx;
    unsigned char* ws;
    float* H;
};
#define WSP(type, off) ((type*)(F.ws + (off)))
#define WL(off) ((off) >= WO_FF1 ? WS_WFF + ((off) - WO_FF1) : WS_W + (size_t)(l & 1) * W_LSTRIDE + (off))

__constant__ int JK[15]  = {2048, 2048, 256, 256, 2048, 2048, 2048, 2048, 512, 96, 96, 64, 512, 2048, 8192};
__constant__ int JKP[15] = {2048, 2048, 256, 256, 2048, 2048, 2048, 2048, 512, 128, 128, 128, 512, 2048, 8192};
__constant__ int JN[15]  = {4352, 64, 1024, 2048, 2048, 512, 512, 512, 2048, 1024, 1024, 1024, 1536, 8192, 2048};
__constant__ int JIN[15] = {I_WIN, I_WINV, I_GUP, I_WUKV, I_WOUT, I_WQM, I_WKM, I_WVM, I_WOM, I_WUP, I_AUP, I_VUP, I_WUQ, I_FF1, I_FF2};
__constant__ unsigned JDST[15] = {(unsigned)(WO_IN / KiB), (unsigned)(WO_IN / KiB), (unsigned)(WO_GUP / KiB), (unsigned)(WO_UKV / KiB), (unsigned)(WO_OUT / KiB), (unsigned)(WO_QM / KiB),
                                  (unsigned)(WO_KM / KiB), (unsigned)(WO_VM / KiB), (unsigned)(WO_OM / KiB), (unsigned)(WO_UP / KiB), (unsigned)(WO_AUP / KiB), (unsigned)(WO_VUP / KiB),
                                  (unsigned)(WO_UQ / KiB), (unsigned)(WO_FF1 / KiB), (unsigned)(WO_FF2 / KiB)};
__device__ __forceinline__ void p0_transpose_item(const float* W, int Kreal, int N, bf16* WT, int ldk, int row_off, LAS unsigned* scr, int item, int lane, bool rope) {
    const int nblk = N / 64, kb = item / nblk, nb = item % nblk, k0 = 64 * kb, n0 = 64 * nb;
    const int m = lane & 15, q = lane >> 4;
    f32x4 v[16];
#pragma unroll
    for (int i = 0; i < 16; ++i) { const int k = k0 + 8 * (i >> 1) + 2 * q + (i & 1); const int kc = k < Kreal ? k : Kreal - 1;
        v[i] = __builtin_nontemporal_load((const f32x4*)(W + (size_t)kc * N + n0 + 4 * m)); }
    if (k0 + 64 > Kreal) {
#pragma unroll
        for (int i = 0; i < 16; ++i) { const int k = k0 + 8 * (i >> 1) + 2 * q + (i & 1); if (k >= Kreal) v[i] = (f32x4){0.f, 0.f, 0.f, 0.f}; }
    }
#pragma unroll
    for (int j = 0; j < 8; ++j)
#pragma unroll
        for (int c = 0; c < 4; ++c) scr[(4 * m + c) * 32 + ((4 * j + q) ^ (4 * (m & 7)))] = cvt_pk(v[2 * j][c], v[2 * j + 1][c]);
    asm volatile("s_waitcnt lgkmcnt(0)" ::: "memory");
    const int x = lane & 7, r = lane >> 3;
#pragma unroll
    for (int t = 0; t < 8; ++t) { const int n = r + 8 * t; const u32x4 o = *(const LAS u32x4*)(scr + n * 32 + 4 * (x ^ ((n >> 2) & 7)));
        const int nd = rope ? 2 * (n & 31) + (n >> 5) : n;
        *(u32x4*)(WT + (size_t)(row_off + n0 + nd) * ldk + k0 + 8 * x) = o; }
    asm volatile("s_waitcnt lgkmcnt(0)" ::: "memory");
}
__device__ __forceinline__ void rms_row_2048(const float* xrow, const float* g, bf16* orow, bf16* copy, int lane) {
    f32x4 v[8]; float ss = 0.f;
#pragma unroll
    for (int j = 0; j < 4; ++j) { v[2 * j] = *(const f32x4*)(xrow + lane * 8 + 512 * j); v[2 * j + 1] = *(const f32x4*)(xrow + lane * 8 + 512 * j + 4); }
#pragma unroll
    for (int j = 0; j < 8; ++j) ss += (v[j][0] * v[j][0] + v[j][1] * v[j][1]) + (v[j][2] * v[j][2] + v[j][3] * v[j][3]);
    const float rstd = rsqrtf(wave_sum(ss) * (1.f / 2048.f) + NORM_EPS);
#pragma unroll
    for (int j = 0; j < 4; ++j) { const int c = lane * 8 + 512 * j;
        if (copy) { u32x4 w; w.x = cvt_pk(v[2 * j][0], v[2 * j][1]); w.y = cvt_pk(v[2 * j][2], v[2 * j][3]); w.z = cvt_pk(v[2 * j + 1][0], v[2 * j + 1][1]); w.w = cvt_pk(v[2 * j + 1][2], v[2 * j + 1][3]); *(u32x4*)(copy + c) = w; }
        const f32x4 g0 = *(const f32x4*)(g + c), g1 = *(const f32x4*)(g + c + 4); const f32x4 a = v[2 * j] * rstd * g0, b = v[2 * j + 1] * rstd * g1;
        u32x4 w; w.x = cvt_pk(a[0], a[1]); w.y = cvt_pk(a[2], a[3]); w.z = cvt_pk(b[0], b[1]); w.w = cvt_pk(b[2], b[3]);
        *(u32x4*)(orow + c) = w; }
}
__device__ __forceinline__ void convert_layer(Frame& F, ArgsP A, int l, int part, int wrank, int wcount) {
    LAS unsigned* scr = (LAS unsigned*)(F.lds + F.wave * 16384);
    const int k_lo = (part == 2) ? 13 : (part == 3 ? 14 : 0), k_hi = (part == 1) ? 13 : (part == 2 ? 14 : 15);
    int base = 0;
    for (int k = k_lo; k < k_hi; ++k) {
        const bool prev = (k == 1 || k == 11);
        if (prev && l == 0) continue;
        const int K = JK[k], KP = JKP[k], N = JN[k], row_off = (k == 1) ? INW : 0;
        const float* W = A->in[JIN[k]] + (size_t)(prev ? l - 1 : l) * K * N; const size_t dst = WL((size_t)JDST[k] * KiB);
        const int nitems = (KP / 64) * (N / 64);
        int first = (wrank - base) % wcount; if (first < 0) first += wcount;
        for (int it = first; it < nitems; it += wcount) p0_transpose_item(W, K, N, WSP(bf16, dst), KP, row_off, scr, it, F.lane, k == 12 && (it % (N / 64)) % 3 == 2);
        base = (base + nitems) % wcount;
    }
    if (part <= 1 && l > 0) {
        const long gt = (long)wrank * 64 + F.lane, NGT = (long)wcount * 64;
        unsigned* O = (unsigned*)(WSP(bf16, WL(WO_IN)) + (size_t)(INW + 64) * D);
        for (long i = gt; i < 192 * D / 2; i += NGT) O[i] = 0u;
    }
}
__device__ __forceinline__ void p0_prologue(Frame& F, ArgsP A) {
    const int gw = F.vcu * NWAVES + F.wave, NGW = F.G * NWAVES;
    const long gt = (long)F.vcu * NTHR + F.tid, NGT = (long)F.G * NTHR;
    convert_layer(F, A, 0, 1, gw, NGW);
    { float* cT = WSP(float, WS_COS); float* sT = WSP(float, WS_SIN);
      for (long i = gt; i < SEQ * 32; i += NGT) { const int pos = (int)(i >> 5), j = (int)(i & 31);
          const float invf = __builtin_amdgcn_exp2f(-13.287712379549449f * (float)j * (1.f / 32.f));
          const double rev = (double)pos * (double)invf * 0.15915494309189535; const float fr = (float)(rev - __builtin_rint(rev));
          cT[i] = __builtin_amdgcn_cosf(fr); sT[i] = __builtin_amdgcn_sinf(fr); } }
    for (int m = gw; m < T; m += NGW) rms_row_2048(A->in[I_X] + (size_t)m * D, A->in[I_MIXPRE], WSP(bf16, WS_U) + (size_t)m * D, (bf16*)F.H + (size_t)m * D, F.lane);
    for (int m = gw; m < NB * NMEM; m += NGW) rms_row_2048(A->in[I_MEM] + (size_t)m * D, A->in[I_MEMG], WSP(bf16, WS_MEMN) + (size_t)m * D, nullptr, F.lane);
}

__device__ __forceinline__ void prep_phase(Frame& F, ArgsP A, int l) {
    const int gw = F.vcu * NWAVES + F.wave, NGW = F.G * NWAVES, lane = F.lane;
    const bf16* PROJ = WSP(bf16, WS_PROJ);
    const float* mu = A->in[I_MU] + (size_t)l * RIN;
    const float* muv = A->in[I_MUV] + (size_t)(l > 0 ? l - 1 : 0) * 64;
    const float* qg = A->in[I_QNG] + (size_t)l * 512; const float* kvg = A->in[I_KVNG] + (size_t)l * 256;
    const float* cT = WSP(float, WS_COS); const float* sT = WSP(float, WS_SIN);
    for (int m = gw; m < T; m += NGW) {
        const bf16* cur = PROJ + (size_t)m * PROJ_LD; const bool first = (m & (SEQ - 1)) == 0; const bf16* prv = cur - PROJ_LD;
        bf16* lo = WSP(bf16, WS_LORA) + (size_t)m * LORA_LD;
#pragma unroll
        for (int i = 0; i < 10; ++i) { const int oc = lane + 64 * i; int sc = -1, kind = 0; float mv = 0.f;
            if (oc < 128) { if (oc < 96) { sc = 3072 + oc; kind = 1; } }
            else if (oc < 256) { if (oc < 224) { sc = 3168 + (oc - 128); kind = 0; } }
            else if (oc < 512) { sc = 3264 + (oc - 256); kind = 2; }
            else if (oc < 576) { if (l > 0) { sc = INW + (oc - 512); kind = 3; } }
            float val = 0.f;
            if (sc >= 0) { mv = kind == 3 ? muv[sc - INW] : mu[sc]; const float y = bf1(cur[sc]), yp = first ? 0.f : bf1(prv[sc]); const float c = y + (yp - y) * mv;
                val = kind == 1 ? tanhf_(c) : (kind == 2 ? sigmoidf_(c) : c); }
            lo[oc] = f2bf(val); }
        { float v[8]; unpack8(*(const u32x4*)(cur + RIN + lane * 8), v); float ss = 0.f;
#pragma unroll
          for (int i = 0; i < 8; ++i) ss += v[i] * v[i];
          const float rstd = rsqrtf(wave_sum(ss) * (1.f / 512.f) + NORM_EPS);
          const f32x4 g0 = *(const f32x4*)(qg + lane * 8), g1 = *(const f32x4*)(qg + lane * 8 + 4);
          u32x4 w; w.x = cvt_pk(v[0] * rstd * g0[0], v[1] * rstd * g0[1]); w.y = cvt_pk(v[2] * rstd * g0[2], v[3] * rstd * g0[3]);
          w.z = cvt_pk(v[4] * rstd * g1[0], v[5] * rstd * g1[1]); w.w = cvt_pk(v[6] * rstd * g1[2], v[7] * rstd * g1[3]);
          *(u32x4*)(WSP(bf16, WS_CQN) + (size_t)m * 512 + lane * 8) = w; }
        { const u32x2 raw = *(const u32x2*)(cur + RIN + 512 + lane * 4); const float v0 = bflo(raw.x), v1 = bfhi(raw.x), v2 = bflo(raw.y), v3 = bfhi(raw.y);
          const float rstd = rsqrtf(wave_sum(v0 * v0 + v1 * v1 + v2 * v2 + v3 * v3) * (1.f / 256.f) + NORM_EPS);
          const f32x4 g0 = *(const f32x4*)(kvg + lane * 4);
          u32x2 w; w.x = cvt_pk(v0 * rstd * g0[0], v1 * rstd * g0[1]); w.y = cvt_pk(v2 * rstd * g0[2], v3 * rstd * g0[3]);
          *(u32x2*)(WSP(bf16, WS_CKVN) + (size_t)m * 256 + lane * 4) = w; }
        if (lane < 32) { const float x1 = bf1(cur[RIN + 768 + lane]), x2 = bf1(cur[RIN + 768 + 32 + lane]); const int pos = m & (SEQ - 1);
          const float c = cT[pos * 32 + lane], s = sT[pos * 32 + lane];
          *(unsigned*)(WSP(bf16, WS_KR) + (size_t)m * 64 + 2 * lane) = cvt_pk(x1 * c - x2 * s, x1 * s + x2 * c); }
        if (l == 0) {
#pragma unroll
            for (int j = 0; j < 2; ++j) { const int c = lane * 8 + 512 * j; float a[8], p[8], o[8]; unpack8(*(const u32x4*)(cur + 2048 + c), a);
                if (!first) unpack8(*(const u32x4*)(prv + 2048 + c), p); else {
#pragma unroll
                    for (int i = 0; i < 8; ++i) p[i] = 0.f; }
                const f32x4 m0 = *(const f32x4*)(mu + 2048 + c), m1 = *(const f32x4*)(mu + 2048 + c + 4);
#pragma unroll
                for (int i = 0; i < 8; ++i) o[i] = a[i] + (p[i] - a[i]) * (i < 4 ? m0[i] : m1[i - 4]);
                *(u32x4*)(WSP(bf16, WS_VF) + (size_t)m * 1024 + c) = pack8(o); } }
    }
}

constexpr int CK = 32, NCHUNK = SEQ / CK;
constexpr int CS_TS = 144, CS_TILE = 32 * CS_TS, CS_PC = 5 * CS_TILE, CS_WAVE = 5 * CS_TILE + 256;
constexpr int CS_NW = 7;
constexpr size_t SCU_BYTES = 24576; constexpr int SCU_X = 8192, SCU_PSI = 12288, SCU_G2 = 20480;
constexpr int SQ_SLOT = 18432, SQ_NSLOT = 7;
static_assert(CS_NW * CS_WAVE <= RING_BYTES && SQ_NSLOT * SQ_SLOT <= RING_BYTES, "LDS budget");
#define MF32(a, b, c) __builtin_amdgcn_mfma_f32_32x32x16_bf16((a), (b), (c), 0, 0, 0)
__device__ __forceinline__ bf16x8 pack8f(float a0, float a1, float a2, float a3, float a4, float a5, float a6, float a7) {
    u32x4 w; w.x = cvt_pk(a0, a1); w.y = cvt_pk(a2, a3); w.z = cvt_pk(a4, a5); w.w = cvt_pk(a6, a7); return __builtin_bit_cast(bf16x8, w); }
#define PACKS(x, s) pack8f((x)[8 * (s)], (x)[8 * (s) + 1], (x)[8 * (s) + 2], (x)[8 * (s) + 3], (x)[8 * (s) + 4], (x)[8 * (s) + 5], (x)[8 * (s) + 6], (x)[8 * (s) + 7])
__device__ __forceinline__ bf16x8 trfrag(const LAS unsigned char* p) {
    const s16x4 lo = __builtin_bit_cast(s16x4, __builtin_amdgcn_ds_read_tr16_b64_v4i16((LAS v4i16_t*)p));
    const s16x4 hh = __builtin_bit_cast(s16x4, __builtin_amdgcn_ds_read_tr16_b64_v4i16((LAS v4i16_t*)(p + 8 * CS_TS)));
    return (bf16x8){lo[0], lo[1], lo[2], lo[3], hh[0], hh[1], hh[2], hh[3]}; }
__device__ __forceinline__ void st_init16(unsigned char* p, const f32x16& x) {
    u32x4 w0, w1; w0.x = cvt_pk(x[0], x[1]); w0.y = cvt_pk(x[2], x[3]); w0.z = cvt_pk(x[4], x[5]); w0.w = cvt_pk(x[6], x[7]);
    w1.x = cvt_pk(x[8], x[9]); w1.y = cvt_pk(x[10], x[11]); w1.z = cvt_pk(x[12], x[13]); w1.w = cvt_pk(x[14], x[15]);
    *(u32x4*)p = w0; *(u32x4*)(p + 16) = w1; }
__device__ __forceinline__ f32x16 ld_init16(const LAS unsigned char* p) {
    const u32x4 w0 = *(const LAS u32x4*)p, w1 = *(const LAS u32x4*)(p + 16); f32x16 x;
    x[0] = bflo(w0.x); x[1] = bfhi(w0.x); x[2] = bflo(w0.y); x[3] = bfhi(w0.y); x[4] = bflo(w0.z); x[5] = bfhi(w0.z); x[6] = bflo(w0.w); x[7] = bfhi(w0.w);
    x[8] = bflo(w1.x); x[9] = bfhi(w1.x); x[10] = bflo(w1.y); x[11] = bfhi(w1.y); x[12] = bflo(w1.z); x[13] = bfhi(w1.z); x[14] = bflo(w1.w); x[15] = bfhi(w1.w); return x; }

struct CsRaw { u32x4 r[4], k[4], a[4], e[4]; bf16 rp, kp; };
__device__ __forceinline__ void cs_load_raw(Frame& F, int l, int bh, int cc, CsRaw& R) {
    const int lane = F.lane, b = bh >> 4, h = bh & 15, pc = lane & 7;
    const size_t row0 = (size_t)b * SEQ + (size_t)cc * CK;
    const bf16* PROJ = WSP(bf16, WS_PROJ); const bf16* AIC = WSP(bf16, WS_AIC); const bf16* WLOG = WSP(bf16, WS_WLOG);
#pragma unroll
    for (int i = 0; i < 4; ++i) { const size_t gr = row0 + (lane >> 3) + 8 * i;
        R.r[i] = *(const u32x4*)(PROJ + gr * PROJ_LD + h * 64 + pc * 8); R.k[i] = *(const u32x4*)(PROJ + gr * PROJ_LD + 1024 + h * 64 + pc * 8);
        R.a[i] = *(const u32x4*)(AIC + gr * 1024 + h * 64 + pc * 8); R.e[i] = *(const u32x4*)(WLOG + gr * 1024 + h * 64 + pc * 8); }
    R.rp = 0; R.kp = 0;
    if (cc > 0) { R.rp = PROJ[(row0 - 1) * PROJ_LD + h * 64 + lane]; R.kp = PROJ[(row0 - 1) * PROJ_LD + 1024 + h * 64 + lane]; }
}
__device__ __forceinline__ void cs_elementwise(Frame& F, ArgsP A, int l, int bh, int cc, LAS unsigned char* wl, const CsRaw& R) {
    const int lane = F.lane, b = bh >> 4, h = bh & 15, ch = h * 64 + lane;
    const size_t row0 = (size_t)b * SEQ + (size_t)cc * CK;
    float* RKB = WSP(float, WS_RKB);
    const bf16* VV = (l == 0) ? WSP(bf16, WS_VF) : WSP(bf16, WS_VV);
    u32x4 vraw[4];
#pragma unroll
    for (int i = 0; i < 4; ++i) vraw[i] = *(const u32x4*)(VV + (row0 + (lane >> 3) + 8 * i) * 1024 + h * 64 + (lane & 7) * 8);
#pragma unroll
    for (int i = 0; i < 4; ++i) { LAS unsigned char* p = wl + ((lane >> 3) + 8 * i) * CS_TS + (lane & 7) * 16;
        *(LAS u32x4*)(p) = R.k[i]; *(LAS u32x4*)(p + CS_TILE) = R.a[i]; *(LAS u32x4*)(p + 2 * CS_TILE) = R.e[i]; *(LAS u32x4*)(p + 3 * CS_TILE) = R.r[i]; }
    const float mur = A->in[I_MU][(size_t)l * RIN + ch], muk = A->in[I_MU][(size_t)l * RIN + 1024 + ch];
    const float ckk = A->in[I_KK][(size_t)l * 1024 + ch], cka = A->in[I_KA][(size_t)l * 1024 + ch], crk = A->in[I_RK][(size_t)l * 1024 + ch];
    float rp = bf1(R.rp), kp_ = bf1(R.kp);
    float lp = 0.f, pexc = 1.f;
    constexpr float L2E = 1.4426950408889634f;
    asm volatile("s_waitcnt lgkmcnt(0)" ::: "memory");
#pragma unroll 8
    for (int tt = 0; tt < CK; ++tt) {
        LAS unsigned char* rowp = wl + tt * CS_TS + lane * 2;
        const float kc = bf1(*(const LAS bf16*)(rowp)), aa = bf1(*(const LAS bf16*)(rowp + CS_TILE)), ee = bf1(*(const LAS bf16*)(rowp + 2 * CS_TILE)), rc = bf1(*(const LAS bf16*)(rowp + 3 * CS_TILE));
        const float rs = rc + (rp - rc) * mur, ks = kc + (kp_ - kc) * muk; rp = rc; kp_ = kc;
        float kk = ks * ckk; const float ss = wave_sum(kk * kk); kk *= rsqrtf(fmaxf(ss, 1e-24f));
        const float kq = ks * (1.f + (aa - 1.f) * cka);
        const float rkb = wave_sum(rs * kq * crk);
        lp += ee;
        const float pinc = __builtin_amdgcn_exp2f(lp * L2E), pinv = __builtin_amdgcn_exp2f(-lp * L2E);
        *(LAS bf16*)(rowp) = f2bf(-kk * pexc);
        *(LAS bf16*)(rowp + CS_TILE) = f2bf(kk * aa * pinv);
        *(LAS bf16*)(rowp + 2 * CS_TILE) = f2bf(kq * pinv);
        *(LAS bf16*)(rowp + 3 * CS_TILE) = f2bf(rs * pinc);
        pexc = pinc;
        if (lane == 0) RKB[(row0 + tt) * 16 + h] = rkb;
    }
    ((LAS float*)(wl + CS_PC))[lane] = __builtin_amdgcn_exp2f(lp * L2E);
#pragma unroll
    for (int i = 0; i < 4; ++i) *(LAS u32x4*)(wl + 4 * CS_TILE + ((lane >> 3) + 8 * i) * CS_TS + (lane & 7) * 16) = vraw[i];
}
__device__ __forceinline__ void cs_mfma(Frame& F, const LAS unsigned char* wl, unsigned char* ub) {
    const int lane = F.lane, r32 = lane & 31, h = lane >> 5, q4 = (lane & 15) >> 2, pp = lane & 3, blk = (lane >> 4) & 1;
    const LAS unsigned char* tA = wl; const LAS unsigned char* tB = wl + CS_TILE; const LAS unsigned char* tK = wl + 2 * CS_TILE;
    const LAS unsigned char* tR = wl + 3 * CS_TILE; const LAS unsigned char* tV = wl + 4 * CS_TILE;
    const int rowoff = r32 * CS_TS + h * 16, troff = (4 * h + q4) * CS_TS + blk * 32 + pp * 8;
#define FROW(t, s) (*(const LAS bf16x8*)((t) + rowoff + (s) * 32))
#define FTR(t, ct, s) trfrag((t) + troff + (s) * 16 * CS_TS + (ct) * 64)
    const f32x16 Z = (f32x16){};
    f32x16 P = Z, PT = Z;
#pragma unroll
    for (int s = 0; s < 4; ++s) { const bf16x8 fa = FROW(tA, s), fb = FROW(tB, s); P = MF32(fb, fa, P); PT = MF32(fa, fb, PT); }
#pragma unroll
    for (int r = 0; r < 16; ++r) { const int cr = crow(r, h); if (!(cr < r32)) P[r] = 0.f; if (!(r32 < cr)) PT[r] = 0.f; }
    f32x16 TmT = PT;
#pragma unroll
    for (int r = 0; r < 16; ++r) if (crow(r, h) == r32) TmT[r] += 1.f;
    f32x16 Tm;
#pragma unroll
    for (int it = 0; it < 4; ++it) {
        const bf16x8 pP0 = PACKS(P, 0), pP1 = PACKS(P, 1), pT0 = PACKS(PT, 0), pT1 = PACKS(PT, 1);
        f32x16 Pn = MF32(pT0, pP0, Z); Pn = MF32(pT1, pP1, Pn);
        f32x16 Y = Pn;
#pragma unroll
        for (int r = 0; r < 16; ++r) if (crow(r, h) == r32) Y[r] += 1.f;
        const bf16x8 y0 = PACKS(Y, 0), y1 = PACKS(Y, 1), t0 = PACKS(TmT, 0), t1 = PACKS(TmT, 1);
        if (it < 3) {
            f32x16 PTn = MF32(pP0, pT0, Z); PTn = MF32(pP1, pT1, PTn);
            f32x16 Tn = MF32(y0, t0, Z); Tn = MF32(y1, t1, Tn);
            P = Pn; PT = PTn; TmT = Tn;
        } else { Tm = MF32(t0, y0, Z); Tm = MF32(t1, y1, Tm); }
    }
    f32x16 W1;
    { f32x16 NakT = Z;
#pragma unroll
      for (int s = 0; s < 4; ++s) NakT = MF32(FROW(tA, s), FROW(tK, s), NakT);
#pragma unroll
      for (int r = 0; r < 16; ++r) if (!(r32 < crow(r, h))) NakT[r] = 0.f;
      W1 = MF32(PACKS(NakT, 0), PACKS(Tm, 0), Z); W1 = MF32(PACKS(NakT, 1), PACKS(Tm, 1), W1); }
    f32x16 ATT[2], G1T[2];
    { const bf16x8 m0 = PACKS(Tm, 0), m1 = PACKS(Tm, 1), w0 = PACKS(W1, 0), w1 = PACKS(W1, 1);
#pragma unroll
      for (int ct = 0; ct < 2; ++ct) { ATT[ct] = MF32(m0, FTR(tA, ct, 0), Z); ATT[ct] = MF32(m1, FTR(tA, ct, 1), ATT[ct]);
                                       G1T[ct] = MF32(w0, FTR(tV, ct, 0), Z); G1T[ct] = MF32(w1, FTR(tV, ct, 1), G1T[ct]); } }
    f32x16 Mbr = Z, Mkr = Z;
#pragma unroll
    for (int s = 0; s < 4; ++s) { const bf16x8 fr = FROW(tR, s); Mbr = MF32(FROW(tB, s), fr, Mbr); Mkr = MF32(FROW(tK, s), fr, Mkr); }
#pragma unroll
    for (int r = 0; r < 16; ++r) if (!(crow(r, h) <= r32)) { Mbr[r] = 0.f; Mkr[r] = 0.f; }
    const bf16x8 b0 = PACKS(Mbr, 0), b1 = PACKS(Mbr, 1), k0 = PACKS(Mkr, 0), k1 = PACKS(Mkr, 1);
#pragma unroll
    for (int kt = 0; kt < 2; ++kt) {
        f32x16 X = MF32(PACKS(ATT[kt], 0), b0, Z); X = MF32(PACKS(ATT[kt], 1), b1, X);
#pragma unroll
        for (int g = 0; g < 4; ++g) { const u32x2 w = *(const LAS u32x2*)(tR + r32 * CS_TS + (32 * kt + 8 * g + 4 * h) * 2);
            X[4 * g] += bflo(w.x); X[4 * g + 1] += bfhi(w.x); X[4 * g + 2] += bflo(w.y); X[4 * g + 3] += bfhi(w.y); }
        *(bf16x8*)(ub + SCU_X + ((2 * kt) * 64 + lane) * 16) = PACKS(X, 0);
        *(bf16x8*)(ub + SCU_X + ((2 * kt + 1) * 64 + lane) * 16) = PACKS(X, 1);
    }
#pragma unroll
    for (int ct = 0; ct < 2; ++ct) {
        f32x16 G = MF32(b0, PACKS(G1T[ct], 0), Z); G = MF32(b1, PACKS(G1T[ct], 1), G);
        G = MF32(k0, FTR(tV, ct, 0), G); G = MF32(k1, FTR(tV, ct, 1), G);
        st_init16(ub + SCU_G2 + (ct * 64 + lane) * 32, G);
    }
    const LAS float* PC = (const LAS float*)(wl + CS_PC);
#pragma unroll
    for (int ct = 0; ct < 2; ++ct) {
        const float pc = PC[32 * ct + r32];
        const bf16x8 f0 = FTR(tB, ct, 0), f1 = FTR(tB, ct, 1);
#pragma unroll
        for (int kt = 0; kt < 2; ++kt) {
            f32x16 Ph = MF32(PACKS(ATT[kt], 0), f0, Z); Ph = MF32(PACKS(ATT[kt], 1), f1, Ph);
            if (kt == ct) {
#pragma unroll
                for (int r = 0; r < 16; ++r) if (crow(r, h) == r32) Ph[r] += 1.f; }
#pragma unroll
            for (int r = 0; r < 16; ++r) Ph[r] *= pc;
            *(bf16x8*)(ub + ((ct * 4 + 2 * kt) * 64 + lane) * 16) = PACKS(Ph, 0);
            *(bf16x8*)(ub + ((ct * 4 + 2 * kt + 1) * 64 + lane) * 16) = PACKS(Ph, 1);
        }
    }
#pragma unroll
    for (int mt = 0; mt < 2; ++mt) {
        const bf16x8 fb0 = FTR(tB, mt, 0), fb1 = FTR(tB, mt, 1), fk0 = FTR(tK, mt, 0), fk1 = FTR(tK, mt, 1);
        float pcr[16];
#pragma unroll
        for (int g = 0; g < 4; ++g) { const f32x4 v = *(const LAS f32x4*)(PC + 32 * mt + 8 * g + 4 * h); pcr[4 * g] = v[0]; pcr[4 * g + 1] = v[1]; pcr[4 * g + 2] = v[2]; pcr[4 * g + 3] = v[3]; }
#pragma unroll
        for (int ct = 0; ct < 2; ++ct) {
            f32x16 Ps = MF32(fb0, PACKS(G1T[ct], 0), Z); Ps = MF32(fb1, PACKS(G1T[ct], 1), Ps);
            Ps = MF32(fk0, FTR(tV, ct, 0), Ps); Ps = MF32(fk1, FTR(tV, ct, 1), Ps);
#pragma unroll
            for (int r = 0; r < 16; ++r) Ps[r] *= pcr[r];
            st_init16(ub + SCU_PSI + ((ct * 2 + mt) * 64 + lane) * 32, Ps);
        }
    }
#undef FROW
#undef FTR
}
__device__ __forceinline__ void cs_pre_phase(Frame& F, ArgsP A, int l) {
    volatile LAS unsigned* cnt = (volatile LAS unsigned*)(F.lds + LDSCTL_OFF);
    if (F.tid == 0) cnt[0] = 0u;
    __syncthreads();
    if (F.wave < CS_NW) {
        LAS unsigned char* wl = F.lds + F.wave * CS_WAVE;
        const int per = (64 * NCHUNK + F.G - 1) / F.G, ubase = F.vcu * per, uend = (ubase + per < 64 * NCHUNK) ? ubase + per : 64 * NCHUNK;
#define CS_NEXT(dst) do { unsigned v_ = 0u; if (F.lane == 0) v_ = __hip_atomic_fetch_add((LAS unsigned*)cnt, 1u, __ATOMIC_RELAXED, __HIP_MEMORY_SCOPE_WORKGROUP); dst = ubase + (int)__builtin_amdgcn_readfirstlane((int)v_); } while (0)
        int u; CS_NEXT(u);
        CsRaw R;
        if (u < uend) cs_load_raw(F, l, u >> 7, u & (NCHUNK - 1), R);
        while (u < uend) {
            cs_elementwise(F, A, l, u >> 7, u & (NCHUNK - 1), wl, R);
            int un; CS_NEXT(un);
            if (un < uend) cs_load_raw(F, l, un >> 7, un & (NCHUNK - 1), R);
            asm volatile("s_waitcnt lgkmcnt(0)" ::: "memory");
            cs_mfma(F, wl, F.ws + WS_SCAN + (size_t)u * SCU_BYTES);
            asm volatile("s_waitcnt lgkmcnt(0)" ::: "memory");
            u = un;
        }
#undef CS_NEXT
    }
}
__device__ __forceinline__ void cs_seq_unit(Frame& F, int bh, int ct) {
    const int lane = F.lane, wave = F.wave, r32 = lane & 31, h = lane >> 5;
    LAS unsigned char* L = F.lds;
    const unsigned char* ub = F.ws + WS_SCAN + (size_t)bh * NCHUNK * SCU_BYTES;
    if (wave > 0) {
        const int w = wave - 1;
        size_t so[3]; int np = 0;
#pragma unroll
        for (int k = 0; k < 3; ++k) { const int p = w + 7 * k; so[k] = p < 12 ? (size_t)p * 1024 : (p < 16 ? (size_t)SCU_PSI + ct * 4096 + (p - 12) * 1024 : (size_t)SCU_G2 + ct * 2048 + (p - 16) * 1024); if (p < 18) np = k + 1; }
#define SQ_ISSUE(c) do { const unsigned char* g_ = ub + (size_t)(c) * SCU_BYTES + lane * 16; LAS unsigned char* d_ = L + ((c) % SQ_NSLOT) * SQ_SLOT; \
        _Pragma("unroll") for (int k = 0; k < 3; ++k) if (k < np) __builtin_amdgcn_global_load_lds((const unsigned*)(g_ + so[k]), (LAS unsigned*)(d_ + (w + 7 * k) * 1024), 16, 0, 0); } while (0)
        for (int c = 0; c < 6; ++c) SQ_ISSUE(c);
        if (np == 3) asm volatile("s_waitcnt vmcnt(15)" ::: "memory"); else asm volatile("s_waitcnt vmcnt(10)" ::: "memory");
        asm volatile("s_barrier" ::: "memory");
        for (int c = 0; c < NCHUNK; ++c) {
            if (c + 6 < NCHUNK) { SQ_ISSUE(c + 6); if (np == 3) asm volatile("s_waitcnt vmcnt(15)" ::: "memory"); else asm volatile("s_waitcnt vmcnt(10)" ::: "memory"); }
            else asm volatile("s_waitcnt vmcnt(0)" ::: "memory");
            asm volatile("s_barrier" ::: "memory");
        }
#undef SQ_ISSUE
    } else {
        f32x16 S0 = (f32x16){}, S1 = (f32x16){};
        const int b = bh >> 4, hh = bh & 15;
        bf16* op = (bf16*)(F.ws + WS_Y) + ((size_t)b * SEQ) * 1024 + hh * 64 + 32 * ct + r32;
        asm volatile("s_barrier" ::: "memory");
        for (int c = 0; c < NCHUNK; ++c) {
            const LAS unsigned char* sl = L + (c % SQ_NSLOT) * SQ_SLOT;
            const bf16x8 bS0 = PACKS(S0, 0), bS1 = PACKS(S0, 1), bS2 = PACKS(S1, 0), bS3 = PACKS(S1, 1);
            f32x16 n0 = ld_init16(sl + 12288 + (0 * 64 + lane) * 32), n1 = ld_init16(sl + 12288 + (1 * 64 + lane) * 32);
            const f32x16 Z = (f32x16){};
            f32x16 m0 = MF32(*(const LAS bf16x8*)(sl + (2 * 64 + lane) * 16), bS2, Z), m1 = MF32(*(const LAS bf16x8*)(sl + (6 * 64 + lane) * 16), bS2, Z);
            n0 = MF32(*(const LAS bf16x8*)(sl + (0 * 64 + lane) * 16), bS0, n0); n1 = MF32(*(const LAS bf16x8*)(sl + (4 * 64 + lane) * 16), bS0, n1);
            m0 = MF32(*(const LAS bf16x8*)(sl + (3 * 64 + lane) * 16), bS3, m0); m1 = MF32(*(const LAS bf16x8*)(sl + (7 * 64 + lane) * 16), bS3, m1);
            n0 = MF32(*(const LAS bf16x8*)(sl + (1 * 64 + lane) * 16), bS1, n0); n1 = MF32(*(const LAS bf16x8*)(sl + (5 * 64 + lane) * 16), bS1, n1);
            f32x16 o = ld_init16(sl + 16384 + lane * 32);
            o = MF32(*(const LAS bf16x8*)(sl + 8192 + (0 * 64 + lane) * 16), bS0, o); o = MF32(*(const LAS bf16x8*)(sl + 8192 + (1 * 64 + lane) * 16), bS1, o);
            o = MF32(*(const LAS bf16x8*)(sl + 8192 + (2 * 64 + lane) * 16), bS2, o); o = MF32(*(const LAS bf16x8*)(sl + 8192 + (3 * 64 + lane) * 16), bS3, o);
            S0 = n0 + m0; S1 = n1 + m1;
#pragma unroll
            for (int r = 0; r < 16; ++r) op[(size_t)(c * CK + crow(r, h)) * 1024] = f2bf(o[r]);
            asm volatile("s_waitcnt lgkmcnt(0)\n\ts_barrier" ::: "memory");
        }
    }
    asm volatile("s_waitcnt vmcnt(0)" ::: "memory");
    __syncthreads();
}

__device__ __forceinline__ void rwkv_post_phase(Frame& F, ArgsP A, int l) {
    const int gw = F.vcu * NWAVES + F.wave, NGW = F.G * NWAVES, lane = F.lane, c0 = lane * 16, head = lane >> 2;
    const bf16* ORAW = WSP(bf16, WS_Y); const float* RKB = WSP(float, WS_RKB);
    const bf16* VV = (l == 0) ? WSP(bf16, WS_VF) : WSP(bf16, WS_VV); const bf16* GATE = WSP(bf16, WS_GATE);
    float lg[16], lb[16];
#pragma unroll
    for (int i = 0; i < 16; ++i) { lg[i] = A->in[I_LNG][(size_t)l * 1024 + c0 + i]; lb[i] = A->in[I_LNB][(size_t)l * 1024 + c0 + i]; }
    for (int m = gw; m < T; m += NGW) {
        float o[16];
#pragma unroll
        for (int j = 0; j < 2; ++j) { float t8[8]; unpack8(*(const u32x4*)(ORAW + (size_t)m * 1024 + c0 + 8 * j), t8);
#pragma unroll
            for (int i = 0; i < 8; ++i) o[8 * j + i] = t8[i]; }
        float s = 0.f;
#pragma unroll
        for (int i = 0; i < 16; ++i) s += o[i];
        s = sum4(s);
        const float mean = s * (1.f / 64.f); float q = 0.f;
#pragma unroll
        for (int i = 0; i < 16; ++i) { o[i] -= mean; q += o[i] * o[i]; }
        q = sum4(q);
        const float rstd = rsqrtf(q * (1.f / 64.f) + GN_EPS);
        const float rkb = RKB[(size_t)m * 16 + head];
        float vv[16], gg[16];
        { float t8[8]; unpack8(*(const u32x4*)(VV + (size_t)m * 1024 + c0), t8);
#pragma unroll
          for (int i = 0; i < 8; ++i) vv[i] = t8[i];
          unpack8(*(const u32x4*)(VV + (size_t)m * 1024 + c0 + 8), t8);
#pragma unroll
          for (int i = 0; i < 8; ++i) vv[8 + i] = t8[i];
          unpack8(*(const u32x4*)(GATE + (size_t)m * 1024 + c0), t8);
#pragma unroll
          for (int i = 0; i < 8; ++i) gg[i] = t8[i];
          unpack8(*(const u32x4*)(GATE + (size_t)m * 1024 + c0 + 8), t8);
#pragma unroll
          for (int i = 0; i < 8; ++i) gg[8 + i] = t8[i]; }
        float y[16];
#pragma unroll
        for (int i = 0; i < 16; ++i) y[i] = (o[i] * rstd * lg[i] + lb[i] + rkb * vv[i]) * gg[i];
        bf16* dst = WSP(bf16, WS_U) + (size_t)m * D + c0;
        u32x4 w0, w1; w0.x = cvt_pk(y[0], y[1]); w0.y = cvt_pk(y[2], y[3]); w0.z = cvt_pk(y[4], y[5]); w0.w = cvt_pk(y[6], y[7]);
        w1.x = cvt_pk(y[8], y[9]); w1.y = cvt_pk(y[10], y[11]); w1.z = cvt_pk(y[12], y[13]); w1.w = cvt_pk(y[14], y[15]);
        *(u32x4*)dst = w0; *(u32x4*)(dst + 8) = w1;
    }
}

__device__ __forceinline__ void ew_norm_phase(Frame& F, const float* gpost, const float* gpre, int e) {
    const int gw = F.vcu * NWAVES + F.wave, NGW = F.G * NWAVES, lane = F.lane;
    const bf16* Y = WSP(bf16, WS_Y); bf16* U = WSP(bf16, WS_U);
    const bf16* Hin = (e & 1) ? WSP(bf16, WS_HB) : (const bf16*)F.H;
    bf16* Hout = (e & 1) ? (bf16*)F.H : WSP(bf16, WS_HB);
    const bool last = (e == 3 * NL - 1);
    for (int m = gw; m < T; m += NGW) {
        float y[32]; float ss = 0.f;
#pragma unroll
        for (int j = 0; j < 4; ++j) { float t8[8]; unpack8(*(const u32x4*)(Y + (size_t)m * D + lane * 8 + 512 * j), t8);
#pragma unroll
            for (int i = 0; i < 8; ++i) { y[8 * j + i] = t8[i]; ss += t8[i] * t8[i]; } }
        const float rstd = rsqrtf(wave_sum(ss) * (1.f / 2048.f) + NORM_EPS);
        float hn[32]; float s2 = 0.f;
#pragma unroll
        for (int j = 0; j < 4; ++j) { const int c = lane * 8 + 512 * j;
            float h8[8]; unpack8(*(const u32x4*)(Hin + (size_t)m * D + c), h8);
            const f32x4 g0 = *(const f32x4*)(gpost + c), g1 = *(const f32x4*)(gpost + c + 4);
#pragma unroll
            for (int i = 0; i < 4; ++i) { hn[8 * j + i] = h8[i] + y[8 * j + i] * rstd * g0[i]; hn[8 * j + 4 + i] = h8[4 + i] + y[8 * j + 4 + i] * rstd * g1[i]; }
            if (last) { float* hp = F.H + (size_t)m * D + c; *(f32x4*)hp = (f32x4){hn[8 * j], hn[8 * j + 1], hn[8 * j + 2], hn[8 * j + 3]}; *(f32x4*)(hp + 4) = (f32x4){hn[8 * j + 4], hn[8 * j + 5], hn[8 * j + 6], hn[8 * j + 7]}; }
            else { u32x4 w; w.x = cvt_pk(hn[8 * j], hn[8 * j + 1]); w.y = cvt_pk(hn[8 * j + 2], hn[8 * j + 3]); w.z = cvt_pk(hn[8 * j + 4], hn[8 * j + 5]); w.w = cvt_pk(hn[8 * j + 6], hn[8 * j + 7]); *(u32x4*)(Hout + (size_t)m * D + c) = w; }
#pragma unroll
            for (int i = 0; i < 8; ++i) s2 += hn[8 * j + i] * hn[8 * j + i]; }
        if (gpre) {
            const float r2 = rsqrtf(wave_sum(s2) * (1.f / 2048.f) + NORM_EPS);
#pragma unroll
            for (int j = 0; j < 4; ++j) { const int c = lane * 8 + 512 * j; const f32x4 g0 = *(const f32x4*)(gpre + c), g1 = *(const f32x4*)(gpre + c + 4);
                u32x4 w; w.x = cvt_pk(hn[8 * j] * r2 * g0[0], hn[8 * j + 1] * r2 * g0[1]); w.y = cvt_pk(hn[8 * j + 2] * r2 * g0[2], hn[8 * j + 3] * r2 * g0[3]);
                w.z = cvt_pk(hn[8 * j + 4] * r2 * g1[0], hn[8 * j + 5] * r2 * g1[1]); w.w = cvt_pk(hn[8 * j + 6] * r2 * g1[2], hn[8 * j + 7] * r2 * g1[3]);
                *(u32x4*)(U + (size_t)m * D + c) = w; }
        }
    }
}

template <int DQK, bool CAUSAL>
__device__ __forceinline__ void attn_unit(LAS unsigned char* lds, const bf16* __restrict__ Q, int ldq, const bf16* __restrict__ K1, int ldk1, const bf16* __restrict__ K2, int ldk2,
                                          const bf16* __restrict__ V, int ldv, bf16* __restrict__ O, int ldo, int qpos0, int ntiles) {
    constexpr int KROW = DQK * 2, KT = 64 * KROW, VT = 16384, ND0 = DQK / 16, NKC = DQK / 64;
    int tid = threadIdx.x; asm volatile("" : "+v"(tid));
    const int lane = tid & 63, wid = __builtin_amdgcn_readfirstlane(tid >> 6), r32 = lane & 31, hi = lane >> 5;
    LAS unsigned char* Kl = lds; LAS unsigned char* Vl = lds + 2 * KT;
    bf16x8 qr[ND0];
    { const bf16* qrow = Q + (size_t)(wid * 32 + r32) * ldq;
#pragma unroll
      for (int d0 = 0; d0 < ND0; ++d0) qr[d0] = *(const bf16x8*)(qrow + d0 * 16 + hi * 8); }
    unsigned ksoff[NKC]; int kdst[NKC];
#pragma unroll
    for (int i = 0; i < NKC; ++i) { int row, cc;
        if (i < 2) { const int c = tid + 512 * i; row = c >> 4; cc = c & 15; ksoff[i] = (unsigned)(row * ldk1 + cc * 8) * 2u; }
        else { row = tid >> 3; cc = 16 + (tid & 7); ksoff[i] = (unsigned)(row * ldk2 + (cc - 16) * 8) * 2u; }
        const int cs = DQK == 192 ? ((cc & ~7) | ((cc ^ (row >> 1)) & 7)) : (cc ^ (row & 15));
        kdst[i] = row * KROW + cs * 16; }
    unsigned vsoff[2]; int vdst[2];
#pragma unroll
    for (int i = 0; i < 2; ++i) { const int c = tid + 512 * i, row = c >> 4, cc = c & 15; vsoff[i] = (unsigned)(row * ldv + cc * 8) * 2u; vdst[i] = row * 256 + ((cc * 16) ^ ((row & 3) << 6)); }
    constexpr int NKO = DQK == 192 ? 4 : 8;
    int koff[NKO];
#pragma unroll
    for (int j = 0; j < NKO; ++j) { const int cc = 2 * j + hi; const int cs = DQK == 192 ? ((cc ^ (r32 >> 1)) & 7) : (cc ^ (r32 & 15)); koff[j] = r32 * KROW + cs * 16; }
#define AT_KOFF(d0) (DQK == 192 ? koff[(d0) & 3] + ((d0) >> 2) * 128 : koff[(d0) & 7])
    const int q4 = (lane & 15) >> 2, pp = lane & 3, blk = (lane >> 4) & 1;
    int voff[4];
#pragma unroll
    for (int d0 = 0; d0 < 4; ++d0) voff[d0] = (4 * hi + q4) * 256 + (((d0 ^ q4) << 6) | (blk << 5) | (pp << 3));
    u32x4 ks[NKC], vs[2];
#define AT_LOAD(t) do { const char* k1b = (const char*)K1 + (size_t)(t) * 64 * ldk1 * 2; const char* k2b = (const char*)K2 + (size_t)(t) * 64 * ldk2 * 2; const char* vb = (const char*)V + (size_t)(t) * 64 * ldv * 2; \
        _Pragma("unroll") for (int i = 0; i < NKC; ++i) ks[i] = *(const u32x4*)((i < 2 ? k1b : k2b) + ksoff[i]); \
        _Pragma("unroll") for (int i = 0; i < 2; ++i) vs[i] = *(const u32x4*)(vb + vsoff[i]); } while (0)
#define AT_WRITE(bf) do { _Pragma("unroll") for (int i = 0; i < NKC; ++i) *(LAS u32x4*)(Kl + (bf) * KT + kdst[i]) = ks[i]; \
        _Pragma("unroll") for (int i = 0; i < 2; ++i) *(LAS u32x4*)(Vl + (bf) * VT + vdst[i]) = vs[i]; } while (0)
    float m_run = -1e30f, l_run = 0.f; f32x16 o[4];
#pragma unroll
    for (int d0 = 0; d0 < 4; ++d0) o[d0] = (f32x16){};
    AT_LOAD(0); AT_WRITE(0);
    __syncthreads();
    const int qpos = qpos0 + wid * 32 + r32;
    for (int t = 0; t < ntiles; ++t) {
        const int bf = t & 1;
        if (t + 1 < ntiles) AT_LOAD(t + 1);
        f32x16 p0 = (f32x16){}, p1 = (f32x16){};
#pragma unroll
        for (int d0 = 0; d0 < ND0; ++d0) {
            const bf16x8 a0 = *(const LAS bf16x8*)(Kl + bf * KT + AT_KOFF(d0));
            const bf16x8 a1 = *(const LAS bf16x8*)(Kl + bf * KT + AT_KOFF(d0) + 32 * KROW);
            p0 = __builtin_amdgcn_mfma_f32_32x32x16_bf16(a0, qr[d0], p0, 0, 0, 0);
            p1 = __builtin_amdgcn_mfma_f32_32x32x16_bf16(a1, qr[d0], p1, 0, 0, 0);
        }
        if (CAUSAL) { const int kv0 = t * 64;
            if (kv0 + 63 > qpos0 + wid * 32) { const float NEG = -__builtin_inff();
#pragma unroll
                for (int r = 0; r < 16; ++r) { const int key = kv0 + crow(r, hi); if (key > qpos) p0[r] = NEG; if (key + 32 > qpos) p1[r] = NEG; } } }
        float mx = p0[0];
#pragma unroll
        for (int r = 1; r < 16; ++r) mx = fmaxf(mx, p0[r]);
#pragma unroll
        for (int r = 0; r < 16; ++r) mx = fmaxf(mx, p1[r]);
        { auto rr = __builtin_amdgcn_permlane32_swap(__float_as_uint(mx), __float_as_uint(mx), false, false); mx = fmaxf(__uint_as_float(rr[0]), __uint_as_float(rr[1])); }
        if (__any(mx > m_run + 8.f)) {
            const float mn = fmaxf(m_run, mx), alpha = __builtin_amdgcn_exp2f(m_run - mn); m_run = mn; l_run *= alpha;
#pragma unroll
            for (int d0 = 0; d0 < 4; ++d0)
#pragma unroll
                for (int r = 0; r < 16; ++r) o[d0][r] *= alpha;
        }
        float ps = 0.f;
#pragma unroll
        for (int r = 0; r < 16; ++r) { p0[r] = __builtin_amdgcn_exp2f(p0[r] - m_run); p1[r] = __builtin_amdgcn_exp2f(p1[r] - m_run); ps += p0[r] + p1[r]; }
        l_run += ps;
        bf16x8 pa[4];
        { u32x4 w;
          w.x = cvt_pk(p0[0], p0[1]); w.y = cvt_pk(p0[2], p0[3]); w.z = cvt_pk(p0[4], p0[5]); w.w = cvt_pk(p0[6], p0[7]); pa[0] = __builtin_bit_cast(bf16x8, w);
          w.x = cvt_pk(p0[8], p0[9]); w.y = cvt_pk(p0[10], p0[11]); w.z = cvt_pk(p0[12], p0[13]); w.w = cvt_pk(p0[14], p0[15]); pa[1] = __builtin_bit_cast(bf16x8, w);
          w.x = cvt_pk(p1[0], p1[1]); w.y = cvt_pk(p1[2], p1[3]); w.z = cvt_pk(p1[4], p1[5]); w.w = cvt_pk(p1[6], p1[7]); pa[2] = __builtin_bit_cast(bf16x8, w);
          w.x = cvt_pk(p1[8], p1[9]); w.y = cvt_pk(p1[10], p1[11]); w.z = cvt_pk(p1[12], p1[13]); w.w = cvt_pk(p1[14], p1[15]); pa[3] = __builtin_bit_cast(bf16x8, w); }
#pragma unroll
        for (int d0 = 0; d0 < 4; ++d0)
#pragma unroll
            for (int s = 0; s < 4; ++s) {
                const LAS unsigned char* vp = Vl + bf * VT + voff[d0] + s * 4096;
                const s16x4 lo = __builtin_bit_cast(s16x4, __builtin_amdgcn_ds_read_tr16_b64_v4i16((LAS v4i16_t*)vp));
                const s16x4 hh = __builtin_bit_cast(s16x4, __builtin_amdgcn_ds_read_tr16_b64_v4i16((LAS v4i16_t*)(vp + 2048)));
                const bf16x8 vf = (bf16x8){lo[0], lo[1], lo[2], lo[3], hh[0], hh[1], hh[2], hh[3]};
                o[d0] = __builtin_amdgcn_mfma_f32_32x32x16_bf16(vf, pa[s], o[d0], 0, 0, 0);
            }
        if (t + 1 < ntiles) AT_WRITE(bf ^ 1);
        __syncthreads();
    }
    { auto rr = __builtin_amdgcn_permlane32_swap(__float_as_uint(l_run), __float_as_uint(l_run), false, false); l_run = __uint_as_float(rr[0]) + __uint_as_float(rr[1]); }
    const float inv = __builtin_amdgcn_rcpf(l_run);
    bf16* orow = O + (size_t)(wid * 32 + r32) * ldo;
#pragma unroll
    for (int d0 = 0; d0 < 4; ++d0)
#pragma unroll
        for (int g = 0; g < 4; ++g) { u32x2 w; w.x = cvt_pk(o[d0][4 * g] * inv, o[d0][4 * g + 1] * inv); w.y = cvt_pk(o[d0][4 * g + 2] * inv, o[d0][4 * g + 3] * inv);
            *(u32x2*)(orow + d0 * 32 + 8 * g + 4 * hi) = w; }
#undef AT_LOAD
#undef AT_WRITE
#undef AT_KOFF
}

__global__ void __launch_bounds__(NTHR, 2) fwd(Args args) {
    extern __shared__ __attribute__((aligned(16))) unsigned char lds_raw[];
    Frame F;
    F.lds = (LAS unsigned char*)lds_raw;
    F.tid = threadIdx.x; F.lane = F.tid & 63; F.wave = __builtin_amdgcn_readfirstlane(F.tid >> 6);
    F.G = gridDim.x; { const int bx = blockIdx.x; F.vcu = (F.G % 8 == 0) ? (bx % 8) * (F.G / 8) + bx / 8 : bx; }
    F.ws = args.ws; F.H = args.out;
    volatile LAS unsigned* MISC = (volatile LAS unsigned*)(F.lds + MISC_OFF);
    for (int u = F.tid; u < (LDS_BYTES - LDSCTL_OFF) / 4; u += NTHR) ((LAS unsigned*)(F.lds + LDSCTL_OFF))[u] = 0u;
    __syncthreads();
    unsigned* ctl = (unsigned*)(F.ws + WS_CTL);
    XcdBarrier bar; bar.bar = ctl + CW_BAR; bar.x = 0; bar.st = nullptr;
    if (ONE_LAUNCH) bar = xcd_barrier_post(ctl + CW_BAR, MISC + 8);
    const int lo = args.lo, hi = args.hi;
#ifndef PH_MASK
#define PH_MASK 0xfffffu
#endif
#define PHON(j) (((PH_MASK) >> (j)) & 1u)
#define IN(k) (lo <= (k) && (k) < hi)
#define PHASE_RELOAD() do { t_ = threadIdx.x; asm volatile("" : "+v"(t_)); F.tid = t_; F.lane = t_ & 63; F.wave = __builtin_amdgcn_readfirstlane(t_ >> 6); \
        A = (ArgsP)__builtin_amdgcn_kernarg_segment_ptr(); asm volatile("" : "+s"(A)); F.ws = A->ws; F.H = A->out; \
        { int g_ = gridDim.x, b_ = blockIdx.x; asm volatile("" : "+s"(g_), "+s"(b_)); F.G = g_; F.bx = b_; F.vcu = (g_ % 8 == 0) ? (b_ % 8) * (g_ / 8) + b_ / 8 : b_; } } while (0)
#define PHASE_BEGIN() int t_; ArgsP A; PHASE_RELOAD()
#define SEAM(k) do { if (IN(k) && IN((k) + 1)) { if (ONE_LAUNCH) xcd_barrier(bar); } } while (0)

    if (PHON(0) && IN(0)) { PHASE_BEGIN(); p0_prologue(F, A); SEAM(0); }

    for (int l = 0; l < NL; ++l) {
        const int pb = 1 + l * NPH;
        if (PHON(1) && IN(pb + 0)) { PHASE_BEGIN();
            const int N = (l == 0) ? INW : PROJ_LD;
            pg8::Gemm g{WSP(bf16, WS_U), WSP(bf16, WL(WO_IN)), T, N, D, D, D}; pg8::StaticOrder S; S.init(T, N, F.G, F.bx);
            pg8::Epi8<FPlain> E{{WSP(bf16, WS_PROJ), PROJ_LD, 1.f}};
            pg8::gemm_phase(F.lds, g, S, E);
            {
                PHASE_RELOAD();
                const int rem = ((T / 256) * (N / 256)) % F.G;
                if (rem != 0 && F.bx >= rem) convert_layer(F, A, l, 2, (F.bx - rem) * NWAVES + F.wave, (F.G - rem) * NWAVES);
                else if (rem == 0) convert_layer(F, A, l, 2, F.bx * NWAVES + F.wave, F.G * NWAVES);
            }
            SEAM(pb + 0);
        }
        if (PHON(2) && IN(pb + 1)) { PHASE_BEGIN(); prep_phase(F, A, l); SEAM(pb + 1); }
        if (PHON(3) && IN(pb + 2)) { PHASE_BEGIN();
            {
            { pg8::Gemm g{WSP(bf16, WS_LORA), WSP(bf16, WL(WO_UP)), T, 1024, 128, LORA_LD, 128}; pg8::StaticOrder S; S.init(T, 1024, F.G, F.bx);
              pg8::Epi8<FSig<0>> E{{WSP(bf16, WS_WLOG), 1024, A->in[I_W0] + (size_t)l * 1024}}; pg8::gemm_phase(F.lds, g, S, E); }
            PHASE_RELOAD();
            { pg8::Gemm g{WSP(bf16, WS_LORA) + 128, WSP(bf16, WL(WO_AUP)), T, 1024, 128, LORA_LD, 128}; pg8::StaticOrder S; S.init(T, 1024, F.G, F.bx);
              pg8::Epi8<FSig<1>> E{{WSP(bf16, WS_AIC), 1024, A->in[I_A0] + (size_t)l * 1024}}; pg8::gemm_phase(F.lds, g, S, E); }
            PHASE_RELOAD();
            { pg8::Gemm g{WSP(bf16, WS_LORA) + 256, WSP(bf16, WL(WO_GUP)), T, 1024, 256, LORA_LD, 256}; pg8::StaticOrder S; S.init(T, 1024, F.G, F.bx);
              pg8::Epi8<FPlain> E{{WSP(bf16, WS_GATE), 1024, 1.f}}; pg8::gemm_phase(F.lds, g, S, E); }
            PHASE_RELOAD();
            if (l > 0) { pg8::Gemm g{WSP(bf16, WS_LORA) + 512, WSP(bf16, WL(WO_VUP)), T, 1024, 128, LORA_LD, 128}; pg8::StaticOrder S; S.init(T, 1024, F.G, F.bx);
              pg8::Epi8<FVup> E{{WSP(bf16, WS_VV), A->in[I_V0] + (size_t)(l - 1) * 1024, A->in[I_MU] + (size_t)l * RIN + 2048, WSP(bf16, WS_PROJ), WSP(bf16, WS_VF)}}; pg8::gemm_phase(F.lds, g, S, E); }
            PHASE_RELOAD();
            { pg8::Gemm g{WSP(bf16, WS_CQN), WSP(bf16, WL(WO_UQ)), T, 1536, 512, 512, 512}; pg8::StaticOrder S; S.init(T, 1536, F.G, F.bx);
              pg8::Epi8<FQ> E{{WSP(bf16, WS_QB), WSP(float, WS_COS), WSP(float, WS_SIN)}}; pg8::gemm_phase(F.lds, g, S, E); }
            PHASE_RELOAD();
            { pg8::Gemm g{WSP(bf16, WS_CKVN), WSP(bf16, WL(WO_UKV)), T, 2048, 256, 256, 256}; pg8::StaticOrder S; S.init(T, 2048, F.G, F.bx);
              pg8::Epi8<FPlain> E{{WSP(bf16, WS_KV), 2048, 1.f}}; pg8::gemm_phase(F.lds, g, S, E); }
            }
            SEAM(pb + 2);
        }
        if (PHON(4) && IN(pb + 3)) { PHASE_BEGIN();
            cs_pre_phase(F, A, l);
            SEAM(pb + 3);
        }
        if (PHON(5) && IN(pb + 4)) { PHASE_BEGIN();
            if (F.G == 256) {
                const int x = F.bx & 7, i = F.bx >> 3;
                if (i < 16) { const int u = x * 16 + i; cs_seq_unit(F, u >> 1, u & 1); }
                else convert_layer(F, A, l, 3, (x * 16 + i - 16) * NWAVES + F.wave, 128 * NWAVES);
            } else {
            for (int u = F.vcu; u < 128; u += F.G) cs_seq_unit(F, u >> 1, u & 1);
            if (F.G > 128 && F.vcu >= 128) convert_layer(F, A, l, 3, (F.vcu - 128) * NWAVES + F.wave, (F.G - 128) * NWAVES);
            else if (F.G <= 128) convert_layer(F, A, l, 3, F.vcu * NWAVES + F.wave, F.G * NWAVES);
            }
            __syncthreads();
        }
        if (PHON(6) && IN(pb + 5)) { PHASE_BEGIN();
            for (int u = F.vcu; u < 256; u += F.G) {
                const int bh = u >> 3, s = u & 7, b = bh >> 3, hh = bh & 7;
#pragma unroll 1
                for (int pass = 0; pass < 2; ++pass) {
                    const int qb = pass == 0 ? s : 15 - s; const size_t r0 = (size_t)b * SEQ;
                    attn_unit<192, true>(F.lds, WSP(bf16, WS_QB) + (r0 + qb * 256) * 1536 + hh * 192, 1536,
                                         WSP(bf16, WS_KV) + r0 * 2048 + hh * 256, 2048, WSP(bf16, WS_KR) + r0 * 64, 64,
                                         WSP(bf16, WS_KV) + r0 * 2048 + hh * 256 + 128, 2048,
                                         WSP(bf16, WS_U) + (r0 + qb * 256) * D + 1024 + hh * 128, D, qb * 256, 4 * (qb + 1));
                }
            }
            SEAM(pb + 5);
        }
        if (PHON(7) && IN(pb + 6)) { PHASE_BEGIN(); rwkv_post_phase(F, A, l); SEAM(pb + 6); }
        if (PHON(8) && IN(pb + 7)) { PHASE_BEGIN();
            pg8::Gemm g{WSP(bf16, WS_U), WSP(bf16, WL(WO_OUT)), T, D, D, D, D}; pg8::StaticOrder S; S.init(T, D, F.G, F.bx);
            pg8::Epi8<FPlain> E{{WSP(bf16, WS_Y), D, 1.f}}; pg8::gemm_phase(F.lds, g, S, E);
            SEAM(pb + 7);
        }
        if (PHON(9) && IN(pb + 8)) { PHASE_BEGIN(); ew_norm_phase(F, A->in[I_MIXPOST] + (size_t)l * D, A->in[I_MEMPRE] + (size_t)l * D, 3 * l); SEAM(pb + 8); }
        if (PHON(10) && IN(pb + 9)) { PHASE_BEGIN();
            pg8::Gemm g{WSP(bf16, WS_U), WSP(bf16, WL(WO_QM)), T, 512, D, D, D}; pg8::StaticOrder S; S.init(T, 512, F.G, F.bx);
            pg8::Epi8<FPlain> E{{WSP(bf16, WS_QMEM), 512, QSCALE_MEM}}; pg8::gemm_phase(F.lds, g, S, E);
            PHASE_RELOAD();
            { pg8::Gemm g2{WSP(bf16, WS_MEMN), WSP(bf16, WL(WO_KM)), NB * NMEM, 512, D, D, D}; pg8::StaticOrder S2; S2.init(NB * NMEM, 512, F.G, (F.bx + F.G - 128 % F.G) % F.G);
              pg8::Epi8<FPlain> E2{{WSP(bf16, WS_MEMK), 512, 1.f}}; pg8::gemm_phase(F.lds, g2, S2, E2); }
            PHASE_RELOAD();
            { pg8::Gemm g2{WSP(bf16, WS_MEMN), WSP(bf16, WL(WO_VM)), NB * NMEM, 512, D, D, D}; pg8::StaticOrder S2; S2.init(NB * NMEM, 512, F.G, (F.bx + F.G - 136 % F.G) % F.G);
              pg8::Epi8<FPlain> E2{{WSP(bf16, WS_MEMV), 512, 1.f}}; pg8::gemm_phase(F.lds, g2, S2, E2); }
            if (l + 1 < NL) { PHASE_RELOAD();
                if (F.G > 144 && F.bx >= 144) convert_layer(F, A, l + 1, 1, (F.bx - 144) * NWAVES + F.wave, (F.G - 144) * NWAVES);
                else if (F.G <= 144) convert_layer(F, A, l + 1, 1, F.bx * NWAVES + F.wave, F.G * NWAVES); }
            SEAM(pb + 9);
        }
        if (PHON(11) && IN(pb + 10)) { PHASE_BEGIN();
            for (int u = F.vcu; u < 256; u += F.G) {
                const int bh = u >> 4, qb = u & 15, b = bh >> 2, hh = bh & 3; const size_t r0 = (size_t)b * SEQ + qb * 256;
                attn_unit<128, false>(F.lds, WSP(bf16, WS_QMEM) + r0 * 512 + hh * 128, 512,
                                      WSP(bf16, WS_MEMK) + (size_t)b * NMEM * 512 + hh * 128, 512, nullptr, 0,
                                      WSP(bf16, WS_MEMV) + (size_t)b * NMEM * 512 + hh * 128, 512,
                                      WSP(bf16, WS_OMEM) + r0 * 512 + hh * 128, 512, 0, NMEM / 64);
            }
            SEAM(pb + 10);
        }
        if (PHON(12) && IN(pb + 11)) { PHASE_BEGIN();
            pg8::Gemm g{WSP(bf16, WS_OMEM), WSP(bf16, WL(WO_OM)), T, D, 512, 512, 512}; pg8::StaticOrder S; S.init(T, D, F.G, F.bx);
            pg8::Epi8<FPlain> E{{WSP(bf16, WS_Y), D, 1.f}}; pg8::gemm_phase(F.lds, g, S, E);
            SEAM(pb + 11);
        }
        if (PHON(13) && IN(pb + 12)) { PHASE_BEGIN(); ew_norm_phase(F, A->in[I_MEMPOST] + (size_t)l * D, A->in[I_FFNPRE] + (size_t)l * D, 3 * l + 1); SEAM(pb + 12); }
        if (PHON(14) && IN(pb + 13)) { PHASE_BEGIN();
            pg8::Gemm g{WSP(bf16, WS_U), WSP(bf16, WL(WO_FF1)), T, FF, D, D, D}; pg8::StaticOrder S; S.init(T, FF, F.G, F.bx);
            pg8::Epi8<FRelu2> E{{WSP(bf16, WS_HID), FF}}; pg8::gemm_phase(F.lds, g, S, E);
            SEAM(pb + 13);
        }
        if (PHON(15) && IN(pb + 14)) { PHASE_BEGIN();
            pg8::Gemm g{WSP(bf16, WS_HID), WSP(bf16, WL(WO_FF2)), T, D, FF, FF, FF}; pg8::StaticOrder S; S.init(T, D, F.G, F.bx);
            pg8::Epi8<FPlain> E{{WSP(bf16, WS_Y), D, 1.f}}; pg8::gemm_phase(F.lds, g, S, E);
            SEAM(pb + 14);
        }
        if (PHON(16) && IN(pb + 15)) { PHASE_BEGIN(); ew_norm_phase(F, A->in[I_FFNPOST] + (size_t)l * D, l + 1 < NL ? A->in[I_MIXPRE] + (size_t)(l + 1) * D : nullptr, 3 * l + 2); SEAM(pb + 15); }
    }
#undef IN
#undef SEAM
}

extern "C" void kernel_launch(void* const* d_in, const int* in_sizes, int n_in, void* d_out, int out_size, void* d_ws, size_t ws_size, hipStream_t stream) {
    static int grid = 0;
    if (grid == 0) {
        if (n_in != N_IN || out_size != T * D || ws_size < WS_END) { fprintf(stderr, "kernel_launch: unexpected shapes (n_in %d, out %d, ws %zu)\n", n_in, out_size, ws_size); grid = -1; return; }
        int dev = 0, cus = 0;
        if (hipGetDevice(&dev) != hipSuccess || hipDeviceGetAttribute(&cus, hipDeviceAttributeMultiprocessorCount, dev) != hipSuccess) { grid = -1; return; }
        if (hipFuncSetAttribute((const void*)fwd, hipFuncAttributeMaxDynamicSharedMemorySize, LDS_BYTES) != hipSuccess) { fprintf(stderr, "kernel_launch: hipFuncSetAttribute failed\n"); grid = -1; return; }
        int per_cu = 0;
        if (hipOccupancyMaxActiveBlocksPerMultiprocessor(&per_cu, (const void*)fwd, NTHR, LDS_BYTES) != hipSuccess || per_cu < 1) fprintf(stderr, "kernel_launch: occupancy query says %d\n", per_cu);
        (void)hipGetLastError();
        grid = cus;
    }
    if (grid < 0) return;
    (void)hipMemsetAsync((char*)d_ws + WS_CTL, 0, CTL_BYTES, stream);
    Args a{};
    for (int i = 0; i < N_IN; ++i) a.in[i] = (const float*)d_in[i];
    a.out = (float*)d_out; a.ws = (unsigned char*)d_ws;
    const int nph = NPHASES < STOP_PHASE ? NPHASES : STOP_PHASE;
    if (ONE_LAUNCH) { a.lo = 0; a.hi = nph; hipLaunchKernelGGL(fwd, dim3(grid), dim3(NTHR), LDS_BYTES, stream, a); }
    else { for (int p = 0; p < nph; ++p) { a.lo = p; a.hi = p + 1; hipLaunchKernelGGL(fwd, dim3(grid), dim3(NTHR), LDS_BYTES, stream, a); } }
}
```

```cpp
#include <hip/hip_runtime.h>
#include <cstdio>
#include <cstdint>

#define GAS __attribute__((address_space(1)))
#define LAS __attribute__((address_space(3)))
typedef unsigned short bf16;
typedef short bf16x8 __attribute__((ext_vector_type(8)));
typedef short s16x4 __attribute__((ext_vector_type(4)));
typedef float f32x2 __attribute__((ext_vector_type(2)));
typedef float f32x4 __attribute__((ext_vector_type(4)));
typedef float f32x16 __attribute__((ext_vector_type(16)));
typedef unsigned u32x2 __attribute__((ext_vector_type(2)));
typedef unsigned u32x4 __attribute__((ext_vector_type(4)));
typedef __bf16 bf16x2_t __attribute__((ext_vector_type(2)));

#ifndef ONE_LAUNCH
#define ONE_LAUNCH 1
#endif
#ifndef STOP_PHASE
#define STOP_PHASE 1000
#endif

constexpr int T = 16384, SEQ = 4096, NB = 4, D = 2048, NL = 4, FF = 8192;
constexpr int RIN = 3520, INW = 4352, PROJ_LD = 4608;
constexpr int NMEM = 256;
constexpr float NORM_EPS = 1e-6f, GN_EPS = 64e-5f;
constexpr float QSCALE_MLA = 0.07216878364870323f * 1.4426950408889634f;
constexpr float QSCALE_MEM = 0.08838834764831845f * 1.4426950408889634f;
constexpr int NWAVES = 8, NTHR = 512;
constexpr int NPH = 16, NPHASES = 1 + NL * NPH;

enum { I_X = 0, I_MEM, I_MEMG, I_MIXPRE, I_WIN, I_WINV, I_MU, I_MUV, I_W0, I_WUP, I_A0, I_AUP, I_V0, I_VUP, I_GUP, I_KK, I_KA, I_RK, I_LNG, I_LNB,
       I_QNG, I_WUQ, I_KVNG, I_WUKV, I_WOUT, I_MIXPOST, I_MEMPRE, I_WQM, I_WKM, I_WVM, I_WOM, I_MEMPOST, I_FFNPRE, I_FF1, I_FF2, I_FFNPOST, N_IN };

constexpr size_t KiB = 1024, MiB = 1024 * 1024;
constexpr size_t WS_CTL = 0, CTL_BYTES = 1 * MiB;
constexpr size_t WS_COS = 1 * MiB, WS_SIN = 1 * MiB + 512 * KiB;
constexpr size_t WS_MEMN = 2 * MiB, WS_MEMK = 6 * MiB, WS_MEMV = 7 * MiB, WS_RKB = 8 * MiB;
constexpr size_t WS_W = 16 * MiB, W_LSTRIDE = 38 * MiB;
constexpr size_t WS_WFF = 92 * MiB;
constexpr size_t WS_HB = 156 * MiB;
constexpr size_t WS_SCAN = 220 * MiB;
constexpr size_t WO_IN = 0, WO_UP = 18 * MiB, WO_AUP = 18 * MiB + 256 * KiB, WO_GUP = 18 * MiB + 512 * KiB, WO_VUP = 19 * MiB, WO_UQ = 19 * MiB + 512 * KiB,
                 WO_UKV = 21 * MiB, WO_OUT = 22 * MiB, WO_QM = 30 * MiB, WO_KM = 32 * MiB, WO_VM = 34 * MiB, WO_OM = 36 * MiB, WO_FF1 = 38 * MiB, WO_FF2 = 70 * MiB;
constexpr size_t WS_U = 424 * MiB, WS_Y = 488 * MiB, WS_VF = 552 * MiB;
constexpr size_t WS_PROJ = 584 * MiB, WS_LORA = 728 * MiB, WS_WLOG = 748 * MiB, WS_AIC = 780 * MiB, WS_GATE = 812 * MiB, WS_VV = 844 * MiB,
                 WS_CQN = 876 * MiB, WS_CKVN = 892 * MiB, WS_KR = 900 * MiB, WS_QB = 902 * MiB, WS_KV = 950 * MiB, WS_END = 1014 * MiB;
constexpr size_t WS_HID = 584 * MiB, WS_QMEM = 840 * MiB, WS_OMEM = 856 * MiB;
constexpr int LORA_LD = 640;
constexpr int CW_TMO = 0, CW_BAR = 4096, CW_ATT = 16384;

constexpr int RING_BYTES = 163328, LDSCTL_OFF = RING_BYTES, MISC_OFF = LDSCTL_OFF + 320, LDS_BYTES = 163840;

__device__ __forceinline__ unsigned cvt_pk(float lo, float hi) { f32x2 v = {lo, hi}; bf16x2_t b = __builtin_convertvector(v, bf16x2_t); return __builtin_bit_cast(unsigned, b); }
__device__ __forceinline__ float bflo(unsigned w) { return __uint_as_float(w << 16); }
__device__ __forceinline__ float bfhi(unsigned w) { return __uint_as_float(w & 0xffff0000u); }
__device__ __forceinline__ float bf1(bf16 b) { return __uint_as_float((unsigned)b << 16); }
__device__ __forceinline__ bf16 f2bf(float f) { return (bf16)(cvt_pk(f, 0.f) & 0xffffu); }
template <int CTRL> __device__ __forceinline__ float dpp_add(float x) { return x + __int_as_float(__builtin_amdgcn_update_dpp(0, __float_as_int(x), CTRL, 0xf, 0xf, true)); }
__device__ __forceinline__ float sum4(float x) { x = dpp_add<0xB1>(x); x = dpp_add<0x4E>(x); return x; }
__device__ __forceinline__ float sum8(float x) { x = sum4(x); x = dpp_add<0x141>(x); return x; }
__device__ __forceinline__ float sum16(float x) { x = sum8(x); x = dpp_add<0x140>(x); return x; }
__device__ __forceinline__ float wave_sum(float x) {
    x = sum16(x);
    { auto r = __builtin_amdgcn_permlane16_swap(__float_as_uint(x), __float_as_uint(x), false, false); x = __uint_as_float(r[0]) + __uint_as_float(r[1]); }
    { auto r = __builtin_amdgcn_permlane32_swap(__float_as_uint(x), __float_as_uint(x), false, false); x = __uint_as_float(r[0]) + __uint_as_float(r[1]); }
    return x;
}
__device__ __forceinline__ float sigmoidf_(float x) { return __builtin_amdgcn_rcpf(1.f + __builtin_amdgcn_exp2f(-1.4426950408889634f * x)); }
__device__ __forceinline__ float tanhf_(float x) { const float e = __builtin_amdgcn_exp2f(-2.f * 1.4426950408889634f * fabsf(x)); const float t = (1.f - e) * __builtin_amdgcn_rcpf(1.f + e); return x < 0.f ? -t : t; }
__device__ __forceinline__ void unpack8(u32x4 w, float (&f)[8]) {
    f[0] = bflo(w.x); f[1] = bfhi(w.x); f[2] = bflo(w.y); f[3] = bfhi(w.y); f[4] = bflo(w.z); f[5] = bfhi(w.z); f[6] = bflo(w.w); f[7] = bfhi(w.w);
}
__device__ __forceinline__ u32x4 pack8(const float (&f)[8]) { u32x4 w; w.x = cvt_pk(f[0], f[1]); w.y = cvt_pk(f[2], f[3]); w.z = cvt_pk(f[4], f[5]); w.w = cvt_pk(f[6], f[7]); return w; }

__device__ __forceinline__ int crow(int r, int hi) { return (r & 3) + 8 * (r >> 2) + 4 * hi; }
typedef short v4i16_t __attribute__((ext_vector_type(4)));

namespace pg8 {
#define PG8_LAS __attribute__((address_space(3)))
typedef unsigned short bf16_t;
constexpr int BM = 256, BK = 64, HALF = 128, HTB = HALF * BK * 2, STAGE_BYTES = 8 * HTB, NXCD = 8, WGM = 8;
__host__ __device__ __forceinline__ int lds_byte(int r, int c) { const int st = (r >> 4) * 2 + (c >> 5), rr = r & 15, cc = c & 31, ob = rr * 64 + cc * 2; return st * 1024 + (ob ^ (((ob >> 9) & 1) << 5)); }
__host__ __device__ __forceinline__ void stage_rc(int b, int& R, int& C) { const int st = b / 1024, sb = b % 1024, swz = sb ^ (((sb >> 9) & 1) << 5); R = (st >> 1) * 16 + swz / 64; C = (st & 1) * 32 + (swz % 64) / 2; }
__host__ __device__ __forceinline__ int perm32(int rho) { const int n = rho >> 4, i = rho & 15; return 8 * (i >> 2) + 4 * n + (i & 3); }
struct Unit { int pm, pn; };
struct Gemm { const bf16_t* A; const bf16_t* Bt; int M, N, K, lda, ldb; };
struct StaticOrder {
    int nM, nN, nwg, G, c;
    __host__ __device__ void init(int M, int N, int G_, int c_) { nM = M / BM; nN = N / BM; nwg = nM * nN; G = G_; c = c_; }
    __host__ __device__ bool next(int i, Unit& u) const {
        const long L = (long)i * G + c; if (L >= nwg) return false;
        int wgid = (int)L; { const int q = nwg / NXCD, r = nwg % NXCD, xcd = wgid % NXCD, off = wgid / NXCD; wgid = (xcd < r ? xcd * (q + 1) : r * (q + 1) + (xcd - r) * q) + off; }
        const int nig = WGM * nN, gid = wgid / nig, fm = gid * WGM, gsz = (nM - fm) < WGM ? (nM - fm) : WGM;
        u.pm = fm + ((wgid % nig) % gsz); u.pn = (wgid % nig) / gsz; return true;
    }
};
template <class F> struct Epi8 {
    F f;
    __device__ __forceinline__ void operator()(const f32x4 (&acc)[2][2][4][2], const Unit& u, int wr, int wc, int fr, int fq) const {
        const int row0 = u.pm * BM + wr * 64 + fr, col0 = u.pn * BM + wc * 32 + 8 * fq;
#pragma unroll
        for (int ai = 0; ai < 2; ++ai)
#pragma unroll
            for (int m = 0; m < 4; ++m)
#pragma unroll
                for (int bj = 0; bj < 2; ++bj) { f(row0 + ai * HALF + m * 16, col0 + bj * HALF, acc[ai][bj][m][0], acc[ai][bj][m][1]); if (F::HEAVY) __builtin_amdgcn_sched_barrier(0); }
    }
};

template <class Epi>
__device__ __forceinline__ void gemm_phase(PG8_LAS unsigned char* lds, const Gemm g, const StaticOrder& S, const Epi& E) {
    int tid = threadIdx.x; asm volatile("" : "+v"(tid));
    const int wid = __builtin_amdgcn_readfirstlane(tid >> 6), lane = tid & 63, wr = wid >> 2, wc = wid & 3, fr = lane & 15, fq = lane >> 4;
    int K = g.K; asm volatile("" : "+s"(K));
    const int nt = K / BK;
    unsigned voffA[2], voffB[2];
#pragma unroll
    for (int i = 0; i < 2; ++i) { int R, C; stage_rc(tid * 16 + i * 8192, R, C); const int Rb = (R & ~31) + perm32(R & 31);
        voffA[i] = (unsigned)(R * g.lda + C) * 2u; voffB[i] = (unsigned)(Rb * g.ldb + C) * 2u; }
    const size_t kstep = (size_t)(BK * 2);
    const size_t hsA = (size_t)HALF * g.lda * 2, hsB = (size_t)HALF * g.ldb * 2;
    const size_t tsA = 2 * hsA, tsB = 2 * hsB;
    const unsigned ldsw = (unsigned)wid * 1024u;
    const int aoff = lds_byte(wr * 64 + fr, fq * 8), boff = lds_byte(wc * 32 + fr, fq * 8);
#define PG8_SA(b, h) (((b) * 2 + (h)) * HTB)
#define PG8_SB(b, h) ((4 + (b) * 2 + (h)) * HTB)
#define PG8_STAGE(bufoff, gbase, voff) do { _Pragma("unroll") for (int _i = 0; _i < 2; ++_i) \
        __builtin_amdgcn_global_load_lds((const unsigned*)((const char*)(gbase) + (voff)[_i]), (PG8_LAS unsigned*)(lds + (bufoff) + ldsw + _i * 8192), 16, 0, 0); } while (0)
#define PG8_LDA(dst, b, h) do { _Pragma("unroll") for (int m = 0; m < 4; ++m) _Pragma("unroll") for (int k = 0; k < 2; ++k) dst[m][k] = *(const PG8_LAS bf16x8*)(lds + PG8_SA(b, h) + aoff + m * 2048 + k * 1024); } while (0)
#define PG8_LDB(dst, b, h) do { _Pragma("unroll") for (int n = 0; n < 2; ++n) _Pragma("unroll") for (int k = 0; k < 2; ++k) dst[n][k] = *(const PG8_LAS bf16x8*)(lds + PG8_SB(b, h) + boff + n * 2048 + k * 1024); } while (0)
#define PG8_MMA(ai, bj, At, Bt) do { __builtin_amdgcn_s_setprio(1); _Pragma("unroll") for (int m = 0; m < 4; ++m) _Pragma("unroll") for (int n = 0; n < 2; ++n) _Pragma("unroll") for (int k = 0; k < 2; ++k) \
        acc[ai][bj][m][n] = __builtin_amdgcn_mfma_f32_16x16x32_bf16(Bt[n][k], At[m][k], acc[ai][bj][m][n], 0, 0, 0); __builtin_amdgcn_s_setprio(0); } while (0)
#define PG8_WAIT_V(n) asm volatile("s_waitcnt vmcnt(" #n ")" ::: "memory")
#define PG8_WAIT_L(n) asm volatile("s_waitcnt lgkmcnt(" #n ")" ::: "memory")
#define PG8_BAR __builtin_amdgcn_s_barrier()
#define PG8_SCHED __builtin_amdgcn_sched_barrier(0)
    Unit cur, nxt; int ui = 0;
    if (!S.next(0, cur)) return;
    f32x4 acc[2][2][4][2];
#pragma unroll
    for (int a = 0; a < 2; ++a)
#pragma unroll
        for (int b = 0; b < 2; ++b)
#pragma unroll
            for (int m = 0; m < 4; ++m)
#pragma unroll
                for (int n = 0; n < 2; ++n) acc[a][b][m][n] = (f32x4){0.f, 0.f, 0.f, 0.f};
    bf16x8 At[4][2], B0[2][2], B1[2][2];
    const char* cA = (const char*)g.A + (size_t)cur.pm * tsA; const char* cB = (const char*)g.Bt + (size_t)cur.pn * tsB;
    PG8_STAGE(PG8_SB(0, 0), cB, voffB); PG8_STAGE(PG8_SB(0, 1), cB + hsB, voffB); PG8_STAGE(PG8_SA(0, 0), cA, voffA); PG8_STAGE(PG8_SA(0, 1), cA + hsA, voffA);
    if (wr == 1) PG8_BAR;
    PG8_WAIT_V(2); PG8_BAR;
    PG8_STAGE(PG8_SB(1, 0), cB + kstep, voffB); PG8_STAGE(PG8_SA(1, 0), cA + kstep, voffA); PG8_STAGE(PG8_SB(1, 1), cB + hsB + kstep, voffB);
    PG8_WAIT_V(6); PG8_BAR;
    for (;;) {
        const bool has_next = S.next(ui + 1, nxt);
        const char* nA = has_next ? (const char*)g.A + (size_t)nxt.pm * tsA : cA; const char* nB = has_next ? (const char*)g.Bt + (size_t)nxt.pn * tsB : cB;
        for (int t = 0; t < nt; t += 2) {
            const bool last = (t == nt - 2);
            const char* a1 = cA + (size_t)(t + 1) * kstep;
            const char* a2 = last ? nA : cA + (size_t)(t + 2) * kstep; const char* b2 = last ? nB : cB + (size_t)(t + 2) * kstep;
            const char* a3 = a2 + kstep; const char* b3 = b2 + kstep;
            PG8_LDB(B0, 0, 0); PG8_LDB(B1, 0, 1); PG8_SCHED; PG8_LDA(At, 0, 0); PG8_STAGE(PG8_SA(1, 1), a1 + hsA, voffA);
            PG8_WAIT_V(8); PG8_WAIT_L(0); PG8_BAR; PG8_MMA(0, 0, At, B0); PG8_MMA(0, 1, At, B1); PG8_BAR; PG8_SCHED;
            PG8_LDA(At, 0, 1); PG8_STAGE(PG8_SB(0, 0), b2, voffB); PG8_STAGE(PG8_SB(0, 1), b2 + hsB, voffB); PG8_STAGE(PG8_SA(0, 0), a2, voffA);
            PG8_WAIT_V(8); PG8_WAIT_L(0); PG8_BAR; PG8_MMA(1, 0, At, B0); PG8_MMA(1, 1, At, B1); PG8_BAR; PG8_SCHED;
            PG8_LDB(B0, 1, 0); PG8_LDB(B1, 1, 1); PG8_SCHED; PG8_LDA(At, 1, 0); PG8_STAGE(PG8_SA(0, 1), a2 + hsA, voffA);
            PG8_WAIT_V(8); PG8_WAIT_L(0); PG8_BAR; PG8_MMA(0, 0, At, B0); PG8_MMA(0, 1, At, B1); PG8_BAR; PG8_SCHED;
            PG8_LDA(At, 1, 1); PG8_STAGE(PG8_SB(1, 0), b3, voffB); PG8_STAGE(PG8_SB(1, 1), b3 + hsB, voffB); PG8_STAGE(PG8_SA(1, 0), a3, voffA);
            PG8_WAIT_V(8); PG8_WAIT_L(0); PG8_BAR; PG8_MMA(1, 0, At, B0); PG8_MMA(1, 1, At, B1); PG8_BAR; PG8_SCHED;
        }
        if (wr == 0) PG8_BAR;
        E(acc, cur, wr, wc, fr, fq);
        if (!has_next) break;
#pragma unroll
        for (int a = 0; a < 2; ++a)
#pragma unroll
            for (int b = 0; b < 2; ++b)
#pragma unroll
                for (int m = 0; m < 4; ++m)
#pragma unroll
                    for (int n = 0; n < 2; ++n) acc[a][b][m][n] = (f32x4){0.f, 0.f, 0.f, 0.f};
        cur = nxt; cA = nA; cB = nB; ++ui;
        if (wr == 1) PG8_BAR;
    }
    PG8_WAIT_V(0);
    PG8_BAR;
#undef PG8_SA
#undef PG8_SB
#undef PG8_STAGE
#undef PG8_LDA
#undef PG8_LDB
#undef PG8_MMA
#undef PG8_WAIT_V
#undef PG8_WAIT_L
#undef PG8_BAR
#undef PG8_SCHED
}
}

__device__ __forceinline__ void st16_wt(void* p, u32x4 w) { asm volatile("global_store_dwordx4 %0, %1, off sc1\n\ts_nop 1" :: "v"(p), "v"(w) : "memory"); }
struct FPlain { static constexpr bool HEAVY = false; bf16* O; int ld; float sc;
    __device__ __forceinline__ void operator()(int row, int col, f32x4 a, f32x4 b) const {
        u32x4 w; w.x = cvt_pk(a[0] * sc, a[1] * sc); w.y = cvt_pk(a[2] * sc, a[3] * sc); w.z = cvt_pk(b[0] * sc, b[1] * sc); w.w = cvt_pk(b[2] * sc, b[3] * sc);
        st16_wt(O + (size_t)row * ld + col, w); } };
struct FRelu2 { static constexpr bool HEAVY = false; bf16* O; int ld;
    __device__ __forceinline__ void operator()(int row, int col, f32x4 a, f32x4 b) const {
        float v[8] = {a[0], a[1], a[2], a[3], b[0], b[1], b[2], b[3]};
#pragma unroll
        for (int i = 0; i < 8; ++i) { const float r = fmaxf(v[i], 0.f); v[i] = r * r; }
        st16_wt(O + (size_t)row * ld + col, pack8(v)); } };
template <int MODE> struct FSig { static constexpr bool HEAVY = true; bf16* O; int ld; const float* bias;
    __device__ __forceinline__ void operator()(int row, int col, f32x4 a, f32x4 b) const {
        const f32x4 b0 = *(const f32x4*)(bias + col), b1 = *(const f32x4*)(bias + col + 4);
        float v[8] = {a[0] + b0[0], a[1] + b0[1], a[2] + b0[2], a[3] + b0[3], b[0] + b1[0], b[1] + b1[1], b[2] + b1[2], b[3] + b1[3]};
#pragma unroll
        for (int i = 0; i < 8; ++i) { const float s = sigmoidf_(v[i]); v[i] = MODE == 0 ? -0.6065306597126334f * s : s; }
        *(u32x4*)(O + (size_t)row * ld + col) = pack8(v); } };
struct FVup { static constexpr bool HEAVY = true; bf16* O; const float* v0; const float* mu; const bf16* proj; const bf16* vfirst;
    __device__ __forceinline__ void operator()(int row, int col, f32x4 a, f32x4 b) const {
        const f32x4 b0 = *(const f32x4*)(v0 + col), b1 = *(const f32x4*)(v0 + col + 4), m0 = *(const f32x4*)(mu + col), m1 = *(const f32x4*)(mu + col + 4);
        float cur[8], prv[8], vf[8];
        unpack8(*(const u32x4*)(proj + (size_t)row * PROJ_LD + 2048 + col), cur);
        if ((row & (SEQ - 1)) != 0) unpack8(*(const u32x4*)(proj + (size_t)(row - 1) * PROJ_LD + 2048 + col), prv);
        else {
#pragma unroll
            for (int i = 0; i < 8; ++i) prv[i] = 0.f; }
        unpack8(*(const u32x4*)(vfirst + (size_t)row * 1024 + col), vf);
        const float acc8[8] = {a[0] + b0[0], a[1] + b0[1], a[2] + b0[2], a[3] + b0[3], b[0] + b1[0], b[1] + b1[1], b[2] + b1[2], b[3] + b1[3]};
        const float mu8[8] = {m0[0], m0[1], m0[2], m0[3], m1[0], m1[1], m1[2], m1[3]};
        float v[8];
#pragma unroll
        for (int i = 0; i < 8; ++i) { const float vs = cur[i] + (prv[i] - cur[i]) * mu8[i]; v[i] = vs + (vf[i] - vs) * sigmoidf_(acc8[i]); }
        *(u32x4*)(O + (size_t)row * 1024 + col) = pack8(v); } };
struct FQ { static constexpr bool HEAVY = true; bf16* O; const float* cosT; const float* sinT;
    __device__ __forceinline__ void operator()(int row, int col, f32x4 a, f32x4 b) const {
        const int cc = col % 192;
        float v[8] = {a[0], a[1], a[2], a[3], b[0], b[1], b[2], b[3]};
        if (cc >= 128) { const int i0 = (cc - 128) >> 1, pos = row & (SEQ - 1);
            const f32x4 c = *(const f32x4*)(cosT + pos * 32 + i0), s = *(const f32x4*)(sinT + pos * 32 + i0);
#pragma unroll
            for (int i = 0; i < 4; ++i) { const float x1 = v[2 * i], x2 = v[2 * i + 1]; v[2 * i] = x1 * c[i] - x2 * s[i]; v[2 * i + 1] = x1 * s[i] + x2 * c[i]; } }
#pragma unroll
        for (int i = 0; i < 8; ++i) v[i] *= QSCALE_MLA;
        *(u32x4*)(O + (size_t)row * 1536 + col) = pack8(v); } };

#define XB_TMO      128
#define XB_XCNT(j)  (256  + 64 * (j))
#define XB_XSUB(j)  (1280 + 64 * (j))
#define XB_XGEN(j)  (2304 + 64 * (j))
#define XB_TOP      3328
#define XB_TOPGEN   3392
#define XCD_BAR_WORDS 3456
#define XB_SPIN_CAP (1u << 20)
__device__ __forceinline__ unsigned xb_ld(unsigned* p)              { return __hip_atomic_load(p, __ATOMIC_RELAXED, __HIP_MEMORY_SCOPE_AGENT); }
__device__ __forceinline__ unsigned xb_add(unsigned* p, unsigned v) { return __hip_atomic_fetch_add(p, v, __ATOMIC_RELAXED, __HIP_MEMORY_SCOPE_AGENT); }
__device__ __forceinline__ unsigned xb_xcc_id() { return (unsigned)__builtin_amdgcn_s_getreg((3 << 11) | 20) & 0xFu; }
#define XB_SPIN(cond, bar) do { unsigned _sp = 0; while (cond) { __builtin_amdgcn_s_sleep(1); \
    if ((++_sp & 255u) == 0u) { if (xb_ld(&(bar)[XB_TMO])) break; if (_sp > XB_SPIN_CAP) { atomicAdd(&(bar)[XB_TMO], 1u); break; } } } } while (0)
struct XcdBarrier { unsigned* bar; unsigned x; volatile LAS unsigned* st; };
__device__ __forceinline__ XcdBarrier xcd_barrier_post(unsigned* bar, volatile LAS unsigned* st) {
    XcdBarrier b; b.bar = bar; b.x = xb_xcc_id(); b.st = st;
    if (threadIdx.x == 0) (void)xb_add(&bar[XB_XCNT(b.x)], 1u);
    return b;
}
__device__ __forceinline__ void xcd_barrier_complete(unsigned* bar, unsigned x, unsigned& nloc, unsigned& nx) {
    const unsigned G = gridDim.x * gridDim.y * gridDim.z;
    unsigned sum, cnt, mine, sp = 0u;
    for (;;) {
        sum = 0u; cnt = 0u; mine = 0u;
#pragma unroll
        for (unsigned j = 0; j < 16; ++j) { const unsigned c = xb_ld(&bar[XB_XCNT(j)]); sum += c; cnt += (c > 0u) ? 1u : 0u; mine = (j == x) ? c : mine; }
        if (sum == G) break;
        __builtin_amdgcn_s_sleep(1);
        if ((++sp & 255u) == 0u) { if (xb_ld(&bar[XB_TMO])) break; if (sp > XB_SPIN_CAP) { atomicAdd(&bar[XB_TMO], 1u); break; } }
    }
    nloc = mine > 0u ? mine : 1u; nx = cnt > 0u ? cnt : 1u;
}
__device__ __forceinline__ void xcd_barrier(const XcdBarrier& b) {
    asm volatile("s_waitcnt vmcnt(0)" ::: "memory");
    __syncthreads();
    if (threadIdx.x == 0) {
        unsigned* bar = b.bar;
        __builtin_amdgcn_s_waitcnt(0);
        unsigned nloc = b.st[0], nx = b.st[1];
        if (nloc == 0u) { xcd_barrier_complete(bar, b.x, nloc, nx); b.st[0] = nloc; b.st[1] = nx; }
        const unsigned old = xb_add(&bar[XB_XSUB(b.x)], 1u);
        const unsigned gen = old / nloc;
        if (old + 1u == (gen + 1u) * nloc) {
            __builtin_amdgcn_fence(__ATOMIC_RELEASE, "agent");
            asm volatile("s_waitcnt vmcnt(0)" ::: "memory");
            const unsigned og = xb_add(&bar[XB_TOP], 1u);
            const unsigned tg = og / nx;
            if (og + 1u == (tg + 1u) * nx) xb_add(&bar[XB_TOPGEN], 1u);
            else XB_SPIN(xb_ld(&bar[XB_TOPGEN]) == tg, bar);
            __builtin_amdgcn_fence(__ATOMIC_ACQUIRE, "agent");
            xb_add(&bar[XB_XGEN(b.x)], 1u);
            asm volatile("s_waitcnt vmcnt(0)" ::: "memory");
        } else {
            XB_SPIN(xb_ld(&bar[XB_XGEN(b.x)]) == gen, bar);
            __builtin_amdgcn_fence(__ATOMIC_ACQUIRE, "agent");
            asm volatile("s_waitcnt vmcnt(0)" ::: "memory");
        }
    }
    __syncthreads();
}

struct Args { const float* in[N_IN]; float* out; unsigned char* ws; int lo, hi; };
typedef const __attribute__((address_space(4))) Args* ArgsP;
struct Frame {
    LAS unsigned char* lds;
    int tid, lane, wave, vcu, G, bx;
    unsigned char* ws;
    float* H;
};
#define WSP(type, off) ((type*)(F.ws + (off)))
#define WL(off) ((off) >= WO_FF1 ? WS_WFF + ((off) - WO_FF1) : WS_W + (size_t)(l & 1) * W_LSTRIDE + (off))

__constant__ int JK[15]  = {2048, 2048, 256, 256, 2048, 2048, 2048, 2048, 512, 96, 96, 64, 512, 2048, 8192};
__constant__ int JKP[15] = {2048, 2048, 256, 256, 2048, 2048, 2048, 2048, 512, 128, 128, 128, 512, 2048, 8192};
__constant__ int JN[15]  = {4352, 64, 1024, 2048, 2048, 512, 512, 512, 2048, 1024, 1024, 1024, 1536, 8192, 2048};
__constant__ int JIN[15] = {I_WIN, I_WINV, I_GUP, I_WUKV, I_WOUT, I_WQM, I_WKM, I_WVM, I_WOM, I_WUP, I_AUP, I_VUP, I_WUQ, I_FF1, I_FF2};
__constant__ unsigned JDST[15] = {(unsigned)(WO_IN / KiB), (unsigned)(WO_IN / KiB), (unsigned)(WO_GUP / KiB), (unsigned)(WO_UKV / KiB), (unsigned)(WO_OUT / KiB), (unsigned)(WO_QM / KiB),
                                  (unsigned)(WO_KM / KiB), (unsigned)(WO_VM / KiB), (unsigned)(WO_OM / KiB), (unsigned)(WO_UP / KiB), (unsigned)(WO_AUP / KiB), (unsigned)(WO_VUP / KiB),
                                  (unsigned)(WO_UQ / KiB), (unsigned)(WO_FF1 / KiB), (unsigned)(WO_FF2 / KiB)};
__device__ __forceinline__ void p0_transpose_item(const float* W, int Kreal, int N, bf16* WT, int ldk, int row_off, LAS unsigned* scr, int item, int lane, bool rope) {
    const int nblk = N / 64, kb = item / nblk, nb = item % nblk, k0 = 64 * kb, n0 = 64 * nb;
    const int m = lane & 15, q = lane >> 4;
    f32x4 v[16];
#pragma unroll
    for (int i = 0; i < 16; ++i) { const int k = k0 + 8 * (i >> 1) + 2 * q + (i & 1); const int kc = k < Kreal ? k : Kreal - 1;
        v[i] = __builtin_nontemporal_load((const f32x4*)(W + (size_t)kc * N + n0 + 4 * m)); }
    if (k0 + 64 > Kreal) {
#pragma unroll
        for (int i = 0; i < 16; ++i) { const int k = k0 + 8 * (i >> 1) + 2 * q + (i & 1); if (k >= Kreal) v[i] = (f32x4){0.f, 0.f, 0.f, 0.f}; }
    }
#pragma unroll
    for (int j = 0; j < 8; ++j)
#pragma unroll
        for (int c = 0; c < 4; ++c) scr[(4 * m + c) * 32 + ((4 * j + q) ^ (4 * (m & 7)))] = cvt_pk(v[2 * j][c], v[2 * j + 1][c]);
    asm volatile("s_waitcnt lgkmcnt(0)" ::: "memory");
    const int x = lane & 7, r = lane >> 3;
#pragma unroll
    for (int t = 0; t < 8; ++t) { const int n = r + 8 * t; const u32x4 o = *(const LAS u32x4*)(scr + n * 32 + 4 * (x ^ ((n >> 2) & 7)));
        const int nd = rope ? 2 * (n & 31) + (n >> 5) : n;
        *(u32x4*)(WT + (size_t)(row_off + n0 + nd) * ldk + k0 + 8 * x) = o; }
    asm volatile("s_waitcnt lgkmcnt(0)" ::: "memory");
}
__device__ __forceinline__ void rms_row_2048(const float* xrow, const float* g, bf16* orow, bf16* copy, int lane) {
    f32x4 v[8]; float ss = 0.f;
#pragma unroll
    for (int j = 0; j < 4; ++j) { v[2 * j] = *(const f32x4*)(xrow + lane * 8 + 512 * j); v[2 * j + 1] = *(const f32x4*)(xrow + lane * 8 + 512 * j + 4); }
#pragma unroll
    for (int j = 0; j < 8; ++j) ss += (v[j][0] * v[j][0] + v[j][1] * v[j][1]) + (v[j][2] * v[j][2] + v[j][3] * v[j][3]);
    const float rstd = rsqrtf(wave_sum(ss) * (1.f / 2048.f) + NORM_EPS);
#pragma unroll
    for (int j = 0; j < 4; ++j) { const int c = lane * 8 + 512 * j;
        if (copy) { u32x4 w; w.x = cvt_pk(v[2 * j][0], v[2 * j][1]); w.y = cvt_pk(v[2 * j][2], v[2 * j][3]); w.z = cvt_pk(v[2 * j + 1][0], v[2 * j + 1][1]); w.w = cvt_pk(v[2 * j + 1][2], v[2 * j + 1][3]); *(u32x4*)(copy + c) = w; }
        const f32x4 g0 = *(const f32x4*)(g + c), g1 = *(const f32x4*)(g + c + 4); const f32x4 a = v[2 * j] * rstd * g0, b = v[2 * j + 1] * rstd * g1;
        u32x4 w; w.x = cvt_pk(a[0], a[1]); w.y = cvt_pk(a[2], a[3]); w.z = cvt_pk(b[0], b[1]); w.w = cvt_pk(b[2], b[3]);
        *(u32x4*)(orow + c) = w; }
}
__device__ __forceinline__ void convert_layer(Frame& F, ArgsP A, int l, int part, int wrank, int wcount) {
    LAS unsigned* scr = (LAS unsigned*)(F.lds + F.wave * 16384);
    const int k_lo = (part == 2) ? 13 : (part == 3 ? 14 : 0), k_hi = (part == 1) ? 13 : (part == 2 ? 14 : 15);
    int base = 0;
    for (int k = k_lo; k < k_hi; ++k) {
        const bool prev = (k == 1 || k == 11);
        if (prev && l == 0) continue;
        const int K = JK[k], KP = JKP[k], N = JN[k], row_off = (k == 1) ? INW : 0;
        const float* W = A->in[JIN[k]] + (size_t)(prev ? l - 1 : l) * K * N; const size_t dst = WL((size_t)JDST[k] * KiB);
        const int nitems = (KP / 64) * (N / 64);
        int first = (wrank - base) % wcount; if (first < 0) first += wcount;
        for (int it = first; it < nitems; it += wcount) p0_transpose_item(W, K, N, WSP(bf16, dst), KP, row_off, scr, it, F.lane, k == 12 && (it % (N / 64)) % 3 == 2);
        base = (base + nitems) % wcount;
    }
    if (part <= 1 && l > 0) {
        const long gt = (long)wrank * 64 + F.lane, NGT = (long)wcount * 64;
        unsigned* O = (unsigned*)(WSP(bf16, WL(WO_IN)) + (size_t)(INW + 64) * D);
        for (long i = gt; i < 192 * D / 2; i += NGT) O[i] = 0u;
    }
}
__device__ __forceinline__ void p0_prologue(Frame& F, ArgsP A) {
    const int gw = F.vcu * NWAVES + F.wave, NGW = F.G * NWAVES;
    const long gt = (long)F.vcu * NTHR + F.tid, NGT = (long)F.G * NTHR;
    convert_layer(F, A, 0, 1, gw, NGW);
    { float* cT = WSP(float, WS_COS); float* sT = WSP(float, WS_SIN);
      for (long i = gt; i < SEQ * 32; i += NGT) { const int pos = (int)(i >> 5), j = (int)(i & 31);
          const float invf = __builtin_amdgcn_exp2f(-13.287712379549449f * (float)j * (1.f / 32.f));
          const double rev = (double)pos * (double)invf * 0.15915494309189535; const float fr = (float)(rev - __builtin_rint(rev));
          cT[i] = __builtin_amdgcn_cosf(fr); sT[i] = __builtin_amdgcn_sinf(fr); } }
    for (int m = gw; m < T; m += NGW) rms_row_2048(A->in[I_X] + (size_t)m * D, A->in[I_MIXPRE], WSP(bf16, WS_U) + (size_t)m * D, (bf16*)F.H + (size_t)m * D, F.lane);
    for (int m = gw; m < NB * NMEM; m += NGW) rms_row_2048(A->in[I_MEM] + (size_t)m * D, A->in[I_MEMG], WSP(bf16, WS_MEMN) + (size_t)m * D, nullptr, F.lane);
}

__device__ __forceinline__ void prep_phase(Frame& F, ArgsP A, int l) {
    const int gw = F.vcu * NWAVES + F.wave, NGW = F.G * NWAVES, lane = F.lane;
    const bf16* PROJ = WSP(bf16, WS_PROJ);
    const float* mu = A->in[I_MU] + (size_t)l * RIN;
    const float* muv = A->in[I_MUV] + (size_t)(l > 0 ? l - 1 : 0) * 64;
    const float* qg = A->in[I_QNG] + (size_t)l * 512; const float* kvg = A->in[I_KVNG] + (size_t)l * 256;
    const float* cT = WSP(float, WS_COS); const float* sT = WSP(float, WS_SIN);
    for (int m = gw; m < T; m += NGW) {
        const bf16* cur = PROJ + (size_t)m * PROJ_LD; const bool first = (m & (SEQ - 1)) == 0; const bf16* prv = cur - PROJ_LD;
        bf16* lo = WSP(bf16, WS_LORA) + (size_t)m * LORA_LD;
#pragma unroll
        for (int i = 0; i < 10; ++i) { const int oc = lane + 64 * i; int sc = -1, kind = 0; float mv = 0.f;
            if (oc < 128) { if (oc < 96) { sc = 3072 + oc; kind = 1; } }
            else if (oc < 256) { if (oc < 224) { sc = 3168 + (oc - 128); kind = 0; } }
            else if (oc < 512) { sc = 3264 + (oc - 256); kind = 2; }
            else if (oc < 576) { if (l > 0) { sc = INW + (oc - 512); kind = 3; } }
            float val = 0.f;
            if (sc >= 0) { mv = kind == 3 ? muv[sc - INW] : mu[sc]; const float y = bf1(cur[sc]), yp = first ? 0.f : bf1(prv[sc]); const float c = y + (yp - y) * mv;
                val = kind == 1 ? tanhf_(c) : (kind == 2 ? sigmoidf_(c) : c); }
            lo[oc] = f2bf(val); }
        { float v[8]; unpack8(*(const u32x4*)(cur + RIN + lane * 8), v); float ss = 0.f;
#pragma unroll
          for (int i = 0; i < 8; ++i) ss += v[i] * v[i];
          const float rstd = rsqrtf(wave_sum(ss) * (1.f / 512.f) + NORM_EPS);
          const f32x4 g0 = *(const f32x4*)(qg + lane * 8), g1 = *(const f32x4*)(qg + lane * 8 + 4);
          u32x4 w; w.x = cvt_pk(v[0] * rstd * g0[0], v[1] * rstd * g0[1]); w.y = cvt_pk(v[2] * rstd * g0[2], v[3] * rstd * g0[3]);
          w.z = cvt_pk(v[4] * rstd * g1[0], v[5] * rstd * g1[1]); w.w = cvt_pk(v[6] * rstd * g1[2], v[7] * rstd * g1[3]);
          *(u32x4*)(WSP(bf16, WS_CQN) + (size_t)m * 512 + lane * 8) = w; }
        { const u32x2 raw = *(const u32x2*)(cur + RIN + 512 + lane * 4); const float v0 = bflo(raw.x), v1 = bfhi(raw.x), v2 = bflo(raw.y), v3 = bfhi(raw.y);
          const float rstd = rsqrtf(wave_sum(v0 * v0 + v1 * v1 + v2 * v2 + v3 * v3) * (1.f / 256.f) + NORM_EPS);
          const f32x4 g0 = *(const f32x4*)(kvg + lane * 4);
          u32x2 w; w.x = cvt_pk(v0 * rstd * g0[0], v1 * rstd * g0[1]); w.y = cvt_pk(v2 * rstd * g0[2], v3 * rstd * g0[3]);
          *(u32x2*)(WSP(bf16, WS_CKVN) + (size_t)m * 256 + lane * 4) = w; }
        if (lane < 32) { const float x1 = bf1(cur[RIN + 768 + lane]), x2 = bf1(cur[RIN + 768 + 32 + lane]); const int pos = m & (SEQ - 1);
          const float c = cT[pos * 32 + lane], s = sT[pos * 32 + lane];
          *(unsigned*)(WSP(bf16, WS_KR) + (size_t)m * 64 + 2 * lane) = cvt_pk(x1 * c - x2 * s, x1 * s + x2 * c); }
        if (l == 0) {
#pragma unroll
            for (int j = 0; j < 2; ++j) { const int c = lane * 8 + 512 * j; float a[8], p[8], o[8]; unpack8(*(const u32x4*)(cur + 2048 + c), a);
                if (!first) unpack8(*(const u32x4*)(prv + 2048 + c), p); else {
#pragma unroll
                    for (int i = 0; i < 8; ++i) p[i] = 0.f; }
                const f32x4 m0 = *(const f32x4*)(mu + 2048 + c), m1 = *(const f32x4*)(mu + 2048 + c + 4);
#pragma unroll
                for (int i = 0; i < 8; ++i) o[i] = a[i] + (p[i] - a[i]) * (i < 4 ? m0[i] : m1[i - 4]);
                *(u32x4*)(WSP(bf16, WS_VF) + (size_t)m * 1024 + c) = pack8(o); } }
    }
}

constexpr int CK = 32, NCHUNK = SEQ / CK;
constexpr int CS_TS = 144, CS_TILE = 32 * CS_TS, CS_PC = 5 * CS_TILE, CS_WAVE = 5 * CS_TILE + 256;
constexpr int CS_NW = 7;
constexpr size_t SCU_BYTES = 24576; constexpr int SCU_X = 8192, SCU_PSI = 12288, SCU_G2 = 20480;
constexpr int SQ_SLOT = 18432, SQ_NSLOT = 7;
static_assert(CS_NW * CS_WAVE <= RING_BYTES && SQ_NSLOT * SQ_SLOT <= RING_BYTES, "LDS budget");
#define MF32(a, b, c) __builtin_amdgcn_mfma_f32_32x32x16_bf16((a), (b), (c), 0, 0, 0)
__device__ __forceinline__ bf16x8 pack8f(float a0, float a1, float a2, float a3, float a4, float a5, float a6, float a7) {
    u32x4 w; w.x = cvt_pk(a0, a1); w.y = cvt_pk(a2, a3); w.z = cvt_pk(a4, a5); w.w = cvt_pk(a6, a7); return __builtin_bit_cast(bf16x8, w); }
#define PACKS(x, s) pack8f((x)[8 * (s)], (x)[8 * (s) + 1], (x)[8 * (s) + 2], (x)[8 * (s) + 3], (x)[8 * (s) + 4], (x)[8 * (s) + 5], (x)[8 * (s) + 6], (x)[8 * (s) + 7])
__device__ __forceinline__ bf16x8 trfrag(const LAS unsigned char* p) {
    const s16x4 lo = __builtin_bit_cast(s16x4, __builtin_amdgcn_ds_read_tr16_b64_v4i16((LAS v4i16_t*)p));
    const s16x4 hh = __builtin_bit_cast(s16x4, __builtin_amdgcn_ds_read_tr16_b64_v4i16((LAS v4i16_t*)(p + 8 * CS_TS)));
    return (bf16x8){lo[0], lo[1], lo[2], lo[3], hh[0], hh[1], hh[2], hh[3]}; }
__device__ __forceinline__ void st_init16(unsigned char* p, const f32x16& x) {
    u32x4 w0, w1; w0.x = cvt_pk(x[0], x[1]); w0.y = cvt_pk(x[2], x[3]); w0.z = cvt_pk(x[4], x[5]); w0.w = cvt_pk(x[6], x[7]);
    w1.x = cvt_pk(x[8], x[9]); w1.y = cvt_pk(x[10], x[11]); w1.z = cvt_pk(x[12], x[13]); w1.w = cvt_pk(x[14], x[15]);
    *(u32x4*)p = w0; *(u32x4*)(p + 16) = w1; }
__device__ __forceinline__ f32x16 ld_init16(const LAS unsigned char* p) {
    const u32x4 w0 = *(const LAS u32x4*)p, w1 = *(const LAS u32x4*)(p + 16); f32x16 x;
    x[0] = bflo(w0.x); x[1] = bfhi(w0.x); x[2] = bflo(w0.y); x[3] = bfhi(w0.y); x[4] = bflo(w0.z); x[5] = bfhi(w0.z); x[6] = bflo(w0.w); x[7] = bfhi(w0.w);
    x[8] = bflo(w1.x); x[9] = bfhi(w1.x); x[10] = bflo(w1.y); x[11] = bfhi(w1.y); x[12] = bflo(w1.z); x[13] = bfhi(w1.z); x[14] = bflo(w1.w); x[15] = bfhi(w1.w); return x; }

struct CsRaw { u32x4 r[4], k[4], a[4], e[4]; bf16 rp, kp; };
__device__ __forceinline__ void cs_load_raw(Frame& F, int l, int bh, int cc, CsRaw& R) {
    const int lane = F.lane, b = bh >> 4, h = bh & 15, pc = lane & 7;
    const size_t row0 = (size_t)b * SEQ + (size_t)cc * CK;
    const bf16* PROJ = WSP(bf16, WS_PROJ); const bf16* AIC = WSP(bf16, WS_AIC); const bf16* WLOG = WSP(bf16, WS_WLOG);
#pragma unroll
    for (int i = 0; i < 4; ++i) { const size_t gr = row0 + (lane >> 3) + 8 * i;
        R.r[i] = *(const u32x4*)(PROJ + gr * PROJ_LD + h * 64 + pc * 8); R.k[i] = *(const u32x4*)(PROJ + gr * PROJ_LD + 1024 + h * 64 + pc * 8);
        R.a[i] = *(const u32x4*)(AIC + gr * 1024 + h * 64 + pc * 8); R.e[i] = *(const u32x4*)(WLOG + gr * 1024 + h * 64 + pc * 8); }
    R.rp = 0; R.kp = 0;
    if (cc > 0) { R.rp = PROJ[(row0 - 1) * PROJ_LD + h * 64 + lane]; R.kp = PROJ[(row0 - 1) * PROJ_LD + 1024 + h * 64 + lane]; }
}
__device__ __forceinline__ void cs_elementwise(Frame& F, ArgsP A, int l, int bh, int cc, LAS unsigned char* wl, const CsRaw& R) {
    const int lane = F.lane, b = bh >> 4, h = bh & 15, ch = h * 64 + lane;
    const size_t row0 = (size_t)b * SEQ + (size_t)cc * CK;
    float* RKB = WSP(float, WS_RKB);
    const bf16* VV = (l == 0) ? WSP(bf16, WS_VF) : WSP(bf16, WS_VV);
    u32x4 vraw[4];
#pragma unroll
    for (int i = 0; i < 4; ++i) vraw[i] = *(const u32x4*)(VV + (row0 + (lane >> 3) + 8 * i) * 1024 + h * 64 + (lane & 7) * 8);
#pragma unroll
    for (int i = 0; i < 4; ++i) { LAS unsigned char* p = wl + ((lane >> 3) + 8 * i) * CS_TS + (lane & 7) * 16;
        *(LAS u32x4*)(p) = R.k[i]; *(LAS u32x4*)(p + CS_TILE) = R.a[i]; *(LAS u32x4*)(p + 2 * CS_TILE) = R.e[i]; *(LAS u32x4*)(p + 3 * CS_TILE) = R.r[i]; }
    const float mur = A->in[I_MU][(size_t)l * RIN + ch], muk = A->in[I_MU][(size_t)l * RIN + 1024 + ch];
    const float ckk = A->in[I_KK][(size_t)l * 1024 + ch], cka = A->in[I_KA][(size_t)l * 1024 + ch], crk = A->in[I_RK][(size_t)l * 1024 + ch];
    float rp = bf1(R.rp), kp_ = bf1(R.kp);
    float lp = 0.f, pexc = 1.f;
    constexpr float L2E = 1.4426950408889634f;
    asm volatile("s_waitcnt lgkmcnt(0)" ::: "memory");
#pragma unroll 8
    for (int tt = 0; tt < CK; ++tt) {
        LAS unsigned char* rowp = wl + tt * CS_TS + lane * 2;
        const float kc = bf1(*(const LAS bf16*)(rowp)), aa = bf1(*(const LAS bf16*)(rowp + CS_TILE)), ee = bf1(*(const LAS bf16*)(rowp + 2 * CS_TILE)), rc = bf1(*(const LAS bf16*)(rowp + 3 * CS_TILE));
        const float rs = rc + (rp - rc) * mur, ks = kc + (kp_ - kc) * muk; rp = rc; kp_ = kc;
        float kk = ks * ckk; const float ss = wave_sum(kk * kk); kk *= rsqrtf(fmaxf(ss, 1e-24f));
        const float kq = ks * (1.f + (aa - 1.f) * cka);
        const float rkb = wave_sum(rs * kq * crk);
        lp += ee;
        const float pinc = __builtin_amdgcn_exp2f(lp * L2E), pinv = __builtin_amdgcn_exp2f(-lp * L2E);
        *(LAS bf16*)(rowp) = f2bf(-kk * pexc);
        *(LAS bf16*)(rowp + CS_TILE) = f2bf(kk * aa * pinv);
        *(LAS bf16*)(rowp + 2 * CS_TILE) = f2bf(kq * pinv);
        *(LAS bf16*)(rowp + 3 * CS_TILE) = f2bf(rs * pinc);
        pexc = pinc;
        if (lane == 0) RKB[(row0 + tt) * 16 + h] = rkb;
    }
    ((LAS float*)(wl + CS_PC))[lane] = __builtin_amdgcn_exp2f(lp * L2E);
#pragma unroll
    for (int i = 0; i < 4; ++i) *(LAS u32x4*)(wl + 4 * CS_TILE + ((lane >> 3) + 8 * i) * CS_TS + (lane & 7) * 16) = vraw[i];
}
__device__ __forceinline__ void cs_mfma(Frame& F, const LAS unsigned char* wl, unsigned char* ub) {
    const int lane = F.lane, r32 = lane & 31, h = lane >> 5, q4 = (lane & 15) >> 2, pp = lane & 3, blk = (lane >> 4) & 1;
    const LAS unsigned char* tA = wl; const LAS unsigned char* tB = wl + CS_TILE; const LAS unsigned char* tK = wl + 2 * CS_TILE;
    const LAS unsigned char* tR = wl + 3 * CS_TILE; const LAS unsigned char* tV = wl + 4 * CS_TILE;
    const int rowoff = r32 * CS_TS + h * 16, troff = (4 * h + q4) * CS_TS + blk * 32 + pp * 8;
#define FROW(t, s) (*(const LAS bf16x8*)((t) + rowoff + (s) * 32))
#define FTR(t, ct, s) trfrag((t) + troff + (s) * 16 * CS_TS + (ct) * 64)
    const f32x16 Z = (f32x16){};
    f32x16 P = Z, PT = Z;
#pragma unroll
    for (int s = 0; s < 4; ++s) { const bf16x8 fa = FROW(tA, s), fb = FROW(tB, s); P = MF32(fb, fa, P); PT = MF32(fa, fb, PT); }
#pragma unroll
    for (int r = 0; r < 16; ++r) { const int cr = crow(r, h); if (!(cr < r32)) P[r] = 0.f; if (!(r32 < cr)) PT[r] = 0.f; }
    f32x16 TmT = PT;
#pragma unroll
    for (int r = 0; r < 16; ++r) if (crow(r, h) == r32) TmT[r] += 1.f;
    f32x16 Tm;
#pragma unroll
    for (int it = 0; it < 4; ++it) {
        const bf16x8 pP0 = PACKS(P, 0), pP1 = PACKS(P, 1), pT0 = PACKS(PT, 0), pT1 = PACKS(PT, 1);
        f32x16 Pn = MF32(pT0, pP0, Z); Pn = MF32(pT1, pP1, Pn);
        f32x16 Y = Pn;
#pragma unroll
        for (int r = 0; r < 16; ++r) if (crow(r, h) == r32) Y[r] += 1.f;
        const bf16x8 y0 = PACKS(Y, 0), y1 = PACKS(Y, 1), t0 = PACKS(TmT, 0), t1 = PACKS(TmT, 1);
        if (it < 3) {
            f32x16 PTn = MF32(pP0, pT0, Z); PTn = MF32(pP1, pT1, PTn);
            f32x16 Tn = MF32(y0, t0, Z); Tn = MF32(y1, t1, Tn);
            P = Pn; PT = PTn; TmT = Tn;
        } else { Tm = MF32(t0, y0, Z); Tm = MF32(t1, y1, Tm); }
    }
    f32x16 W1;
    { f32x16 NakT = Z;
#pragma unroll
      for (int s = 0; s < 4; ++s) NakT = MF32(FROW(tA, s), FROW(tK, s), NakT);
#pragma unroll
      for (int r = 0; r < 16; ++r) if (!(r32 < crow(r, h))) NakT[r] = 0.f;
      W1 = MF32(PACKS(NakT, 0), PACKS(Tm, 0), Z); W1 = MF32(PACKS(NakT, 1), PACKS(Tm, 1), W1); }
    f32x16 ATT[2], G1T[2];
    { const bf16x8 m0 = PACKS(Tm, 0), m1 = PACKS(Tm, 1), w0 = PACKS(W1, 0), w1 = PACKS(W1, 1);
#pragma unroll
      for (int ct = 0; ct < 2; ++ct) { ATT[ct] = MF32(m0, FTR(tA, ct, 0), Z); ATT[ct] = MF32(m1, FTR(tA, ct, 1), ATT[ct]);
                                       G1T[ct] = MF32(w0, FTR(tV, ct, 0), Z); G1T[ct] = MF32(w1, FTR(tV, ct, 1), G1T[ct]); } }
    f32x16 Mbr = Z, Mkr = Z;
#pragma unroll
    for (int s = 0; s < 4; ++s) { const bf16x8 fr = FROW(tR, s); Mbr = MF32(FROW(tB, s), fr, Mbr); Mkr = MF32(FROW(tK, s), fr, Mkr); }
#pragma unroll
    for (int r = 0; r < 16; ++r) if (!(crow(r, h) <= r32)) { Mbr[r] = 0.f; Mkr[r] = 0.f; }
    const bf16x8 b0 = PACKS(Mbr, 0), b1 = PACKS(Mbr, 1), k0 = PACKS(Mkr, 0), k1 = PACKS(Mkr, 1);
#pragma unroll
    for (int kt = 0; kt < 2; ++kt) {
        f32x16 X = MF32(PACKS(ATT[kt], 0), b0, Z); X = MF32(PACKS(ATT[kt], 1), b1, X);
#pragma unroll
        for (int g = 0; g < 4; ++g) { const u32x2 w = *(const LAS u32x2*)(tR + r32 * CS_TS + (32 * kt + 8 * g + 4 * h) * 2);
            X[4 * g] += bflo(w.x); X[4 * g + 1] += bfhi(w.x); X[4 * g + 2] += bflo(w.y); X[4 * g + 3] += bfhi(w.y); }
        *(bf16x8*)(ub + SCU_X + ((2 * kt) * 64 + lane) * 16) = PACKS(X, 0);
        *(bf16x8*)(ub + SCU_X + ((2 * kt + 1) * 64 + lane) * 16) = PACKS(X, 1);
    }
#pragma unroll
    for (int ct = 0; ct < 2; ++ct) {
        f32x16 G = MF32(b0, PACKS(G1T[ct], 0), Z); G = MF32(b1, PACKS(G1T[ct], 1), G);
        G = MF32(k0, FTR(tV, ct, 0), G); G = MF32(k1, FTR(tV, ct, 1), G);
        st_init16(ub + SCU_G2 + (ct * 64 + lane) * 32, G);
    }
    const LAS float* PC = (const LAS float*)(wl + CS_PC);
#pragma unroll
    for (int ct = 0; ct < 2; ++ct) {
        const float pc = PC[32 * ct + r32];
        const bf16x8 f0 = FTR(tB, ct, 0), f1 = FTR(tB, ct, 1);
#pragma unroll
        for (int kt = 0; kt < 2; ++kt) {
            f32x16 Ph = MF32(PACKS(ATT[kt], 0), f0, Z); Ph = MF32(PACKS(ATT[kt], 1), f1, Ph);
            if (kt == ct) {
#pragma unroll
                for (int r = 0; r < 16; ++r) if (crow(r, h) == r32) Ph[r] += 1.f; }
#pragma unroll
            for (int r = 0; r < 16; ++r) Ph[r] *= pc;
            *(bf16x8*)(ub + ((ct * 4 + 2 * kt) * 64 + lane) * 16) = PACKS(Ph, 0);
            *(bf16x8*)(ub + ((ct * 4 + 2 * kt + 1) * 64 + lane) * 16) = PACKS(Ph, 1);
        }
    }
#pragma unroll
    for (int mt = 0; mt < 2; ++mt) {
        const bf16x8 fb0 = FTR(tB, mt, 0), fb1 = FTR(tB, mt, 1), fk0 = FTR(tK, mt, 0), fk1 = FTR(tK, mt, 1);
        float pcr[16];
#pragma unroll
        for (int g = 0; g < 4; ++g) { const f32x4 v = *(const LAS f32x4*)(PC + 32 * mt + 8 * g + 4 * h); pcr[4 * g] = v[0]; pcr[4 * g + 1] = v[1]; pcr[4 * g + 2] = v[2]; pcr[4 * g + 3] = v[3]; }
#pragma unroll
        for (int ct = 0; ct < 2; ++ct) {
            f32x16 Ps = MF32(fb0, PACKS(G1T[ct], 0), Z); Ps = MF32(fb1, PACKS(G1T[ct], 1), Ps);
            Ps = MF32(fk0, FTR(tV, ct, 0), Ps); Ps = MF32(fk1, FTR(tV, ct, 1), Ps);
#pragma unroll
            for (int r = 0; r < 16; ++r) Ps[r] *= pcr[r];
            st_init16(ub + SCU_PSI + ((ct * 2 + mt) * 64 + lane) * 32, Ps);
        }
    }
#undef FROW
#undef FTR
}
__device__ __forceinline__ void cs_pre_phase(Frame& F, ArgsP A, int l) {
    volatile LAS unsigned* cnt = (volatile LAS unsigned*)(F.lds + LDSCTL_OFF);
    if (F.tid == 0) cnt[0] = 0u;
    __syncthreads();
    if (F.wave < CS_NW) {
        LAS unsigned char* wl = F.lds + F.wave * CS_WAVE;
        const int per = (64 * NCHUNK + F.G - 1) / F.G, ubase = F.vcu * per, uend = (ubase + per < 64 * NCHUNK) ? ubase + per : 64 * NCHUNK;
#define CS_NEXT(dst) do { unsigned v_ = 0u; if (F.lane == 0) v_ = __hip_atomic_fetch_add((LAS unsigned*)cnt, 1u, __ATOMIC_RELAXED, __HIP_MEMORY_SCOPE_WORKGROUP); dst = ubase + (int)__builtin_amdgcn_readfirstlane((int)v_); } while (0)
        int u; CS_NEXT(u);
        CsRaw R;
        if (u < uend) cs_load_raw(F, l, u >> 7, u & (NCHUNK - 1), R);
        while (u < uend) {
            cs_elementwise(F, A, l, u >> 7, u & (NCHUNK - 1), wl, R);
            int un; CS_NEXT(un);
            if (un < uend) cs_load_raw(F, l, un >> 7, un & (NCHUNK - 1), R);
            asm volatile("s_waitcnt lgkmcnt(0)" ::: "memory");
            cs_mfma(F, wl, F.ws + WS_SCAN + (size_t)u * SCU_BYTES);
            asm volatile("s_waitcnt lgkmcnt(0)" ::: "memory");
            u = un;
        }
#undef CS_NEXT
    }
}
__device__ __forceinline__ void cs_seq_unit(Frame& F, int bh, int ct) {
    const int lane = F.lane, wave = F.wave, r32 = lane & 31, h = lane >> 5;
    LAS unsigned char* L = F.lds;
    const unsigned char* ub = F.ws + WS_SCAN + (size_t)bh * NCHUNK * SCU_BYTES;
    if (wave > 0) {
        const int w = wave - 1;
        size_t so[3]; int np = 0;
#pragma unroll
        for (int k = 0; k < 3; ++k) { const int p = w + 7 * k; so[k] = p < 12 ? (size_t)p * 1024 : (p < 16 ? (size_t)SCU_PSI + ct * 4096 + (p - 12) * 1024 : (size_t)SCU_G2 + ct * 2048 + (p - 16) * 1024); if (p < 18) np = k + 1; }
#define SQ_ISSUE(c) do { const unsigned char* g_ = ub + (size_t)(c) * SCU_BYTES + lane * 16; LAS unsigned char* d_ = L + ((c) % SQ_NSLOT) * SQ_SLOT; \
        _Pragma("unroll") for (int k = 0; k < 3; ++k) if (k < np) __builtin_amdgcn_global_load_lds((const unsigned*)(g_ + so[k]), (LAS unsigned*)(d_ + (w + 7 * k) * 1024), 16, 0, 0); } while (0)
        for (int c = 0; c < 6; ++c) SQ_ISSUE(c);
        if (np == 3) asm volatile("s_waitcnt vmcnt(15)" ::: "memory"); else asm volatile("s_waitcnt vmcnt(10)" ::: "memory");
        asm volatile("s_barrier" ::: "memory");
        for (int c = 0; c < NCHUNK; ++c) {
            if (c + 6 < NCHUNK) { SQ_ISSUE(c + 6); if (np == 3) asm volatile("s_waitcnt vmcnt(15)" ::: "memory"); else asm volatile("s_waitcnt vmcnt(10)" ::: "memory"); }
            else asm volatile("s_waitcnt vmcnt(0)" ::: "memory");
            asm volatile("s_barrier" ::: "memory");
        }
#undef SQ_ISSUE
    } else {
        f32x16 S0 = (f32x16){}, S1 = (f32x16){};
        const int b = bh >> 4, hh = bh & 15;
        bf16* op = (bf16*)(F.ws + WS_Y) + ((size_t)b * SEQ) * 1024 + hh * 64 + 32 * ct + r32;
        asm volatile("s_barrier" ::: "memory");
        for (int c = 0; c < NCHUNK; ++c) {
            const LAS unsigned char* sl = L + (c % SQ_NSLOT) * SQ_SLOT;
            const bf16x8 bS0 = PACKS(S0, 0), bS1 = PACKS(S0, 1), bS2 = PACKS(S1, 0), bS3 = PACKS(S1, 1);
            f32x16 n0 = ld_init16(sl + 12288 + (0 * 64 + lane) * 32), n1 = ld_init16(sl + 12288 + (1 * 64 + lane) * 32);
            const f32x16 Z = (f32x16){};
            f32x16 m0 = MF32(*(const LAS bf16x8*)(sl + (2 * 64 + lane) * 16), bS2, Z), m1 = MF32(*(const LAS bf16x8*)(sl + (6 * 64 + lane) * 16), bS2, Z);
            n0 = MF32(*(const LAS bf16x8*)(sl + (0 * 64 + lane) * 16), bS0, n0); n1 = MF32(*(const LAS bf16x8*)(sl + (4 * 64 + lane) * 16), bS0, n1);
            m0 = MF32(*(const LAS bf16x8*)(sl + (3 * 64 + lane) * 16), bS3, m0); m1 = MF32(*(const LAS bf16x8*)(sl + (7 * 64 + lane) * 16), bS3, m1);
            n0 = MF32(*(const LAS bf16x8*)(sl + (1 * 64 + lane) * 16), bS1, n0); n1 = MF32(*(const LAS bf16x8*)(sl + (5 * 64 + lane) * 16), bS1, n1);
            f32x16 o = ld_init16(sl + 16384 + lane * 32);
            o = MF32(*(const LAS bf16x8*)(sl + 8192 + (0 * 64 + lane) * 16), bS0, o); o = MF32(*(const LAS bf16x8*)(sl + 8192 + (1 * 64 + lane) * 16), bS1, o);
            o = MF32(*(const LAS bf16x8*)(sl + 8192 + (2 * 64 + lane) * 16), bS2, o); o = MF32(*(const LAS bf16x8*)(sl + 8192 + (3 * 64 + lane) * 16), bS3, o);
            S0 = n0 + m0; S1 = n1 + m1;
#pragma unroll
            for (int r = 0; r < 16; ++r) op[(size_t)(c * CK + crow(r, h)) * 1024] = f2bf(o[r]);
            asm volatile("s_waitcnt lgkmcnt(0)\n\ts_barrier" ::: "memory");
        }
    }
    asm volatile("s_waitcnt vmcnt(0)" ::: "memory");
    __syncthreads();
}

__device__ __forceinline__ void rwkv_post_phase(Frame& F, ArgsP A, int l) {
    const int gw = F.vcu * NWAVES + F.wave, NGW = F.G * NWAVES, lane = F.lane, c0 = lane * 16, head = lane >> 2;
    const bf16* ORAW = WSP(bf16, WS_Y); const float* RKB = WSP(float, WS_RKB);
    const bf16* VV = (l == 0) ? WSP(bf16, WS_VF) : WSP(bf16, WS_VV); const bf16* GATE = WSP(bf16, WS_GATE);
    float lg[16], lb[16];
#pragma unroll
    for (int i = 0; i < 16; ++i) { lg[i] = A->in[I_LNG][(size_t)l * 1024 + c0 + i]; lb[i] = A->in[I_LNB][(size_t)l * 1024 + c0 + i]; }
    for (int m = gw; m < T; m += NGW) {
        float o[16];
#pragma unroll
        for (int j = 0; j < 2; ++j) { float t8[8]; unpack8(*(const u32x4*)(ORAW + (size_t)m * 1024 + c0 + 8 * j), t8);
#pragma unroll
            for (int i = 0; i < 8; ++i) o[8 * j + i] = t8[i]; }
        float s = 0.f;
#pragma unroll
        for (int i = 0; i < 16; ++i) s += o[i];
        s = sum4(s);
        const float mean = s * (1.f / 64.f); float q = 0.f;
#pragma unroll
        for (int i = 0; i < 16; ++i) { o[i] -= mean; q += o[i] * o[i]; }
        q = sum4(q);
        const float rstd = rsqrtf(q * (1.f / 64.f) + GN_EPS);
        const float rkb = RKB[(size_t)m * 16 + head];
        float vv[16], gg[16];
        { float t8[8]; unpack8(*(const u32x4*)(VV + (size_t)m * 1024 + c0), t8);
#pragma unroll
          for (int i = 0; i < 8; ++i) vv[i] = t8[i];
          unpack8(*(const u32x4*)(VV + (size_t)m * 1024 + c0 + 8), t8);
#pragma unroll
          for (int i = 0; i < 8; ++i) vv[8 + i] = t8[i];
          unpack8(*(const u32x4*)(GATE + (size_t)m * 1024 + c0), t8);
#pragma unroll
          for (int i = 0; i < 8; ++i) gg[i] = t8[i];
          unpack8(*(const u32x4*)(GATE + (size_t)m * 1024 + c0 + 8), t8);
#pragma unroll
          for (int i = 0; i < 8; ++i) gg[8 + i] = t8[i]; }
        float y[16];
#pragma unroll
        for (int i = 0; i < 16; ++i) y[i] = (o[i] * rstd * lg[i] + lb[i] + rkb * vv[i]) * gg[i];
        bf16* dst = WSP(bf16, WS_U) + (size_t)m * D + c0;
        u32x4 w0, w1; w0.x = cvt_pk(y[0], y[1]); w0.y = cvt_pk(y[2], y[3]); w0.z = cvt_pk(y[4], y[5]); w0.w = cvt_pk(y[6], y[7]);
        w1.x = cvt_pk(y[8], y[9]); w1.y = cvt_pk(y[10], y[11]); w1.z = cvt_pk(y[12], y[13]); w1.w = cvt_pk(y[14], y[15]);
        *(u32x4*)dst = w0; *(u32x4*)(dst + 8) = w1;
    }
}

__device__ __forceinline__ void ew_norm_phase(Frame& F, const float* gpost, const float* gpre, int e) {
    const int gw = F.vcu * NWAVES + F.wave, NGW = F.G * NWAVES, lane = F.lane;
    const bf16* Y = WSP(bf16, WS_Y); bf16* U = WSP(bf16, WS_U);
    const bf16* Hin = (e & 1) ? WSP(bf16, WS_HB) : (const bf16*)F.H;
    bf16* Hout = (e & 1) ? (bf16*)F.H : WSP(bf16, WS_HB);
    const bool last = (e == 3 * NL - 1);
    for (int m = gw; m < T; m += NGW) {
        float y[32]; float ss = 0.f;
#pragma unroll
        for (int j = 0; j < 4; ++j) { float t8[8]; unpack8(*(const u32x4*)(Y + (size_t)m * D + lane * 8 + 512 * j), t8);
#pragma unroll
            for (int i = 0; i < 8; ++i) { y[8 * j + i] = t8[i]; ss += t8[i] * t8[i]; } }
        const float rstd = rsqrtf(wave_sum(ss) * (1.f / 2048.f) + NORM_EPS);
        float hn[32]; float s2 = 0.f;
#pragma unroll
        for (int j = 0; j < 4; ++j) { const int c = lane * 8 + 512 * j;
            float h8[8]; unpack8(*(const u32x4*)(Hin + (size_t)m * D + c), h8);
            const f32x4 g0 = *(const f32x4*)(gpost + c), g1 = *(const f32x4*)(gpost + c + 4);
#pragma unroll
            for (int i = 0; i < 4; ++i) { hn[8 * j + i] = h8[i] + y[8 * j + i] * rstd * g0[i]; hn[8 * j + 4 + i] = h8[4 + i] + y[8 * j + 4 + i] * rstd * g1[i]; }
            if (last) { float* hp = F.H + (size_t)m * D + c; *(f32x4*)hp = (f32x4){hn[8 * j], hn[8 * j + 1], hn[8 * j + 2], hn[8 * j + 3]}; *(f32x4*)(hp + 4) = (f32x4){hn[8 * j + 4], hn[8 * j + 5], hn[8 * j + 6], hn[8 * j + 7]}; }
            else { u32x4 w; w.x = cvt_pk(hn[8 * j], hn[8 * j + 1]); w.y = cvt_pk(hn[8 * j + 2], hn[8 * j + 3]); w.z = cvt_pk(hn[8 * j + 4], hn[8 * j + 5]); w.w = cvt_pk(hn[8 * j + 6], hn[8 * j + 7]); *(u32x4*)(Hout + (size_t)m * D + c) = w; }
#pragma unroll
            for (int i = 0; i < 8; ++i) s2 += hn[8 * j + i] * hn[8 * j + i]; }
        if (gpre) {
            const float r2 = rsqrtf(wave_sum(s2) * (1.f / 2048.f) + NORM_EPS);
#pragma unroll
            for (int j = 0; j < 4; ++j) { const int c = lane * 8 + 512 * j; const f32x4 g0 = *(const f32x4*)(gpre + c), g1 = *(const f32x4*)(gpre + c + 4);
                u32x4 w; w.x = cvt_pk(hn[8 * j] * r2 * g0[0], hn[8 * j + 1] * r2 * g0[1]); w.y = cvt_pk(hn[8 * j + 2] * r2 * g0[2], hn[8 * j + 3] * r2 * g0[3]);
                w.z = cvt_pk(hn[8 * j + 4] * r2 * g1[0], hn[8 * j + 5] * r2 * g1[1]); w.w = cvt_pk(hn[8 * j + 6] * r2 * g1[2], hn[8 * j + 7] * r2 * g1[3]);
                *(u32x4*)(U + (size_t)m * D + c) = w; }
        }
    }
}

template <int DQK, bool CAUSAL>
__device__ __forceinline__ void attn_unit(LAS unsigned char* lds, const bf16* __restrict__ Q, int ldq, const bf16* __restrict__ K1, int ldk1, const bf16* __restrict__ K2, int ldk2,
                                          const bf16* __restrict__ V, int ldv, bf16* __restrict__ O, int ldo, int qpos0, int ntiles) {
    constexpr int KROW = DQK * 2, KT = 64 * KROW, VT = 16384, ND0 = DQK / 16, NKC = DQK / 64;
    int tid = threadIdx.x; asm volatile("" : "+v"(tid));
    const int lane = tid & 63, wid = __builtin_amdgcn_readfirstlane(tid >> 6), r32 = lane & 31, hi = lane >> 5;
    LAS unsigned char* Kl = lds; LAS unsigned char* Vl = lds + 2 * KT;
    bf16x8 qr[ND0];
    { const bf16* qrow = Q + (size_t)(wid * 32 + r32) * ldq;
#pragma unroll
      for (int d0 = 0; d0 < ND0; ++d0) qr[d0] = *(const bf16x8*)(qrow + d0 * 16 + hi * 8); }
    unsigned ksoff[NKC]; int kdst[NKC];
#pragma unroll
    for (int i = 0; i < NKC; ++i) { int row, cc;
        if (i < 2) { const int c = tid + 512 * i; row = c >> 4; cc = c & 15; ksoff[i] = (unsigned)(row * ldk1 + cc * 8) * 2u; }
        else { row = tid >> 3; cc = 16 + (tid & 7); ksoff[i] = (unsigned)(row * ldk2 + (cc - 16) * 8) * 2u; }
        const int cs = DQK == 192 ? ((cc & ~7) | ((cc ^ (row >> 1)) & 7)) : (cc ^ (row & 15));
        kdst[i] = row * KROW + cs * 16; }
    unsigned vsoff[2]; int vdst[2];
#pragma unroll
    for (int i = 0; i < 2; ++i) { const int c = tid + 512 * i, row = c >> 4, cc = c & 15; vsoff[i] = (unsigned)(row * ldv + cc * 8) * 2u; vdst[i] = row * 256 + ((cc * 16) ^ ((row & 3) << 6)); }
    constexpr int NKO = DQK == 192 ? 4 : 8;
    int koff[NKO];
#pragma unroll
    for (int j = 0; j < NKO; ++j) { const int cc = 2 * j + hi; const int cs = DQK == 192 ? ((cc ^ (r32 >> 1)) & 7) : (cc ^ (r32 & 15)); koff[j] = r32 * KROW + cs * 16; }
#define AT_KOFF(d0) (DQK == 192 ? koff[(d0) & 3] + ((d0) >> 2) * 128 : koff[(d0) & 7])
    const int q4 = (lane & 15) >> 2, pp = lane & 3, blk = (lane >> 4) & 1;
    int voff[4];
#pragma unroll
    for (int d0 = 0; d0 < 4; ++d0) voff[d0] = (4 * hi + q4) * 256 + (((d0 ^ q4) << 6) | (blk << 5) | (pp << 3));
    u32x4 ks[NKC], vs[2];
#define AT_LOAD(t) do { const char* k1b = (const char*)K1 + (size_t)(t) * 64 * ldk1 * 2; const char* k2b = (const char*)K2 + (size_t)(t) * 64 * ldk2 * 2; const char* vb = (const char*)V + (size_t)(t) * 64 * ldv * 2; \
        _Pragma("unroll") for (int i = 0; i < NKC; ++i) ks[i] = *(const u32x4*)((i < 2 ? k1b : k2b) + ksoff[i]); \
        _Pragma("unroll") for (int i = 0; i < 2; ++i) vs[i] = *(const u32x4*)(vb + vsoff[i]); } while (0)
#define AT_WRITE(bf) do { _Pragma("unroll") for (int i = 0; i < NKC; ++i) *(LAS u32x4*)(Kl + (bf) * KT + kdst[i]) = ks[i]; \
        _Pragma("unroll") for (int i = 0; i < 2; ++i) *(LAS u32x4*)(Vl + (bf) * VT + vdst[i]) = vs[i]; } while (0)
    float m_run = -1e30f, l_run = 0.f; f32x16 o[4];
#pragma unroll
    for (int d0 = 0; d0 < 4; ++d0) o[d0] = (f32x16){};
    AT_LOAD(0); AT_WRITE(0);
    __syncthreads();
    const int qpos = qpos0 + wid * 32 + r32;
    for (int t = 0; t < ntiles; ++t) {
        const int bf = t & 1;
        if (t + 1 < ntiles) AT_LOAD(t + 1);
        f32x16 p0 = (f32x16){}, p1 = (f32x16){};
#pragma unroll
        for (int d0 = 0; d0 < ND0; ++d0) {
            const bf16x8 a0 = *(const LAS bf16x8*)(Kl + bf * KT + AT_KOFF(d0));
            const bf16x8 a1 = *(const LAS bf16x8*)(Kl + bf * KT + AT_KOFF(d0) + 32 * KROW);
            p0 = __builtin_amdgcn_mfma_f32_32x32x16_bf16(a0, qr[d0], p0, 0, 0, 0);
            p1 = __builtin_amdgcn_mfma_f32_32x32x16_bf16(a1, qr[d0], p1, 0, 0, 0);
        }
        if (CAUSAL) { const int kv0 = t * 64;
            if (kv0 + 63 > qpos0 + wid * 32) { const float NEG = -__builtin_inff();
#pragma unroll
                for (int r = 0; r < 16; ++r) { const int key = kv0 + crow(r, hi); if (key > qpos) p0[r] = NEG; if (key + 32 > qpos) p1[r] = NEG; } } }
        float mx = p0[0];
#pragma unroll
        for (int r = 1; r < 16; ++r) mx = fmaxf(mx, p0[r]);
#pragma unroll
        for (int r = 0; r < 16; ++r) mx = fmaxf(mx, p1[r]);
        { auto rr = __builtin_amdgcn_permlane32_swap(__float_as_uint(mx), __float_as_uint(mx), false, false); mx = fmaxf(__uint_as_float(rr[0]), __uint_as_float(rr[1])); }
        if (__any(mx > m_run + 8.f)) {
            const float mn = fmaxf(m_run, mx), alpha = __builtin_amdgcn_exp2f(m_run - mn); m_run = mn; l_run *= alpha;
#pragma unroll
            for (int d0 = 0; d0 < 4; ++d0)
#pragma unroll
                for (int r = 0; r < 16; ++r) o[d0][r] *= alpha;
        }
        float ps = 0.f;
#pragma unroll
        for (int r = 0; r < 16; ++r) { p0[r] = __builtin_amdgcn_exp2f(p0[r] - m_run); p1[r] = __builtin_amdgcn_exp2f(p1[r] - m_run); ps += p0[r] + p1[r]; }
        l_run += ps;
        bf16x8 pa[4];
        { u32x4 w;
          w.x = cvt_pk(p0[0], p0[1]); w.y = cvt_pk(p0[2], p0[3]); w.z = cvt_pk(p0[4], p0[5]); w.w = cvt_pk(p0[6], p0[7]); pa[0] = __builtin_bit_cast(bf16x8, w);
          w.x = cvt_pk(p0[8], p0[9]); w.y = cvt_pk(p0[10], p0[11]); w.z = cvt_pk(p0[12], p0[13]); w.w = cvt_pk(p0[14], p0[15]); pa[1] = __builtin_bit_cast(bf16x8, w);
          w.x = cvt_pk(p1[0], p1[1]); w.y = cvt_pk(p1[2], p1[3]); w.z = cvt_pk(p1[4], p1[5]); w.w = cvt_pk(p1[6], p1[7]); pa[2] = __builtin_bit_cast(bf16x8, w);
          w.x = cvt_pk(p1[8], p1[9]); w.y = cvt_pk(p1[10], p1[11]); w.z = cvt_pk(p1[12], p1[13]); w.w = cvt_pk(p1[14], p1[15]); pa[3] = __builtin_bit_cast(bf16x8, w); }
#pragma unroll
        for (int d0 = 0; d0 < 4; ++d0)
#pragma unroll
            for (int s = 0; s < 4; ++s) {
                const LAS unsigned char* vp = Vl + bf * VT + voff[d0] + s * 4096;
                const s16x4 lo = __builtin_bit_cast(s16x4, __builtin_amdgcn_ds_read_tr16_b64_v4i16((LAS v4i16_t*)vp));
                const s16x4 hh = __builtin_bit_cast(s16x4, __builtin_amdgcn_ds_read_tr16_b64_v4i16((LAS v4i16_t*)(vp + 2048)));
                const bf16x8 vf = (bf16x8){lo[0], lo[1], lo[2], lo[3], hh[0], hh[1], hh[2], hh[3]};
                o[d0] = __builtin_amdgcn_mfma_f32_32x32x16_bf16(vf, pa[s], o[d0], 0, 0, 0);
            }
        if (t + 1 < ntiles) AT_WRITE(bf ^ 1);
        __syncthreads();
    }
    { auto rr = __builtin_amdgcn_permlane32_swap(__float_as_uint(l_run), __float_as_uint(l_run), false, false); l_run = __uint_as_float(rr[0]) + __uint_as_float(rr[1]); }
    const float inv = __builtin_amdgcn_rcpf(l_run);
    bf16* orow = O + (size_t)(wid * 32 + r32) * ldo;
#pragma unroll
    for (int d0 = 0; d0 < 4; ++d0)
#pragma unroll
        for (int g = 0; g < 4; ++g) { u32x2 w; w.x = cvt_pk(o[d0][4 * g] * inv, o[d0][4 * g + 1] * inv); w.y = cvt_pk(o[d0][4 * g + 2] * inv, o[d0][4 * g + 3] * inv);
            *(u32x2*)(orow + d0 * 32 + 8 * g + 4 * hi) = w; }
#undef AT_LOAD
#undef AT_WRITE
#undef AT_KOFF
}

__global__ void __launch_bounds__(NTHR, 2) fwd(Args args) {
    extern __shared__ __attribute__((aligned(16))) unsigned char lds_raw[];
    Frame F;
    F.lds = (LAS unsigned char*)lds_raw;
    F.tid = threadIdx.x; F.lane = F.tid & 63; F.wave = __builtin_amdgcn_readfirstlane(F.tid >> 6);
    F.G = gridDim.x; { const int bx = blockIdx.x; F.vcu = (F.G % 8 == 0) ? (bx % 8) * (F.G / 8) + bx / 8 : bx; }
    F.ws = args.ws; F.H = args.out;
    volatile LAS unsigned* MISC = (volatile LAS unsigned*)(F.lds + MISC_OFF);
    for (int u = F.tid; u < (LDS_BYTES - LDSCTL_OFF) / 4; u += NTHR) ((LAS unsigned*)(F.lds + LDSCTL_OFF))[u] = 0u;
    __syncthreads();
    unsigned* ctl = (unsigned*)(F.ws + WS_CTL);
    XcdBarrier bar; bar.bar = ctl + CW_BAR; bar.x = 0; bar.st = nullptr;
    if (ONE_LAUNCH) bar = xcd_barrier_post(ctl + CW_BAR, MISC + 8);
    const int lo = args.lo, hi = args.hi;
#ifndef PH_MASK
#define PH_MASK 0xfffffu
#endif
#define PHON(j) (((PH_MASK) >> (j)) & 1u)
#define IN(k) (lo <= (k) && (k) < hi)
#define PHASE_RELOAD() do { t_ = threadIdx.x; asm volatile("" : "+v"(t_)); F.tid = t_; F.lane = t_ & 63; F.wave = __builtin_amdgcn_readfirstlane(t_ >> 6); \
        A = (ArgsP)__builtin_amdgcn_kernarg_segment_ptr(); asm volatile("" : "+s"(A)); F.ws = A->ws; F.H = A->out; \
        { int g_ = gridDim.x, b_ = blockIdx.x; asm volatile("" : "+s"(g_), "+s"(b_)); F.G = g_; F.bx = b_; F.vcu = (g_ % 8 == 0) ? (b_ % 8) * (g_ / 8) + b_ / 8 : b_; } } while (0)
#define PHASE_BEGIN() int t_; ArgsP A; PHASE_RELOAD()
#define SEAM(k) do { if (IN(k) && IN((k) + 1)) { if (ONE_LAUNCH) xcd_barrier(bar); } } while (0)

    if (PHON(0) && IN(0)) { PHASE_BEGIN(); p0_prologue(F, A); SEAM(0); }

    for (int l = 0; l < NL; ++l) {
        const int pb = 1 + l * NPH;
        if (PHON(1) && IN(pb + 0)) { PHASE_BEGIN();
            const int N = (l == 0) ? INW : PROJ_LD;
            pg8::Gemm g{WSP(bf16, WS_U), WSP(bf16, WL(WO_IN)), T, N, D, D, D}; pg8::StaticOrder S; S.init(T, N, F.G, F.bx);
            pg8::Epi8<FPlain> E{{WSP(bf16, WS_PROJ), PROJ_LD, 1.f}};
            pg8::gemm_phase(F.lds, g, S, E);
            {
                PHASE_RELOAD();
                const int rem = ((T / 256) * (N / 256)) % F.G;
                if (rem != 0 && F.bx >= rem) convert_layer(F, A, l, 2, (F.bx - rem) * NWAVES + F.wave, (F.G - rem) * NWAVES);
                else if (rem == 0) convert_layer(F, A, l, 2, F.bx * NWAVES + F.wave, F.G * NWAVES);
            }
            SEAM(pb + 0);
        }
        if (PHON(2) && IN(pb + 1)) { PHASE_BEGIN(); prep_phase(F, A, l); SEAM(pb + 1); }
        if (PHON(3) && IN(pb + 2)) { PHASE_BEGIN();
            {
            { pg8::Gemm g{WSP(bf16, WS_LORA), WSP(bf16, WL(WO_UP)), T, 1024, 128, LORA_LD, 128}; pg8::StaticOrder S; S.init(T, 1024, F.G, F.bx);
              pg8::Epi8<FSig<0>> E{{WSP(bf16, WS_WLOG), 1024, A->in[I_W0] + (size_t)l * 1024}}; pg8::gemm_phase(F.lds, g, S, E); }
            PHASE_RELOAD();
            { pg8::Gemm g{WSP(bf16, WS_LORA) + 128, WSP(bf16, WL(WO_AUP)), T, 1024, 128, LORA_LD, 128}; pg8::StaticOrder S; S.init(T, 1024, F.G, F.bx);
              pg8::Epi8<FSig<1>> E{{WSP(bf16, WS_AIC), 1024, A->in[I_A0] + (size_t)l * 1024}}; pg8::gemm_phase(F.lds, g, S, E); }
            PHASE_RELOAD();
            { pg8::Gemm g{WSP(bf16, WS_LORA) + 256, WSP(bf16, WL(WO_GUP)), T, 1024, 256, LORA_LD, 256}; pg8::StaticOrder S; S.init(T, 1024, F.G, F.bx);
              pg8::Epi8<FPlain> E{{WSP(bf16, WS_GATE), 1024, 1.f}}; pg8::gemm_phase(F.lds, g, S, E); }
            PHASE_RELOAD();
            if (l > 0) { pg8::Gemm g{WSP(bf16, WS_LORA) + 512, WSP(bf16, WL(WO_VUP)), T, 1024, 128, LORA_LD, 128}; pg8::StaticOrder S; S.init(T, 1024, F.G, F.bx);
              pg8::Epi8<FVup> E{{WSP(bf16, WS_VV), A->in[I_V0] + (size_t)(l - 1) * 1024, A->in[I_MU] + (size_t)l * RIN + 2048, WSP(bf16, WS_PROJ), WSP(bf16, WS_VF)}}; pg8::gemm_phase(F.lds, g, S, E); }
            PHASE_RELOAD();
            { pg8::Gemm g{WSP(bf16, WS_CQN), WSP(bf16, WL(WO_UQ)), T, 1536, 512, 512, 512}; pg8::StaticOrder S; S.init(T, 1536, F.G, F.bx);
              pg8::Epi8<FQ> E{{WSP(bf16, WS_QB), WSP(float, WS_COS), WSP(float, WS_SIN)}}; pg8::gemm_phase(F.lds, g, S, E); }
            PHASE_RELOAD();
            { pg8::Gemm g{WSP(bf16, WS_CKVN), WSP(bf16, WL(WO_UKV)), T, 2048, 256, 256, 256}; pg8::StaticOrder S; S.init(T, 2048, F.G, F.bx);
              pg8::Epi8<FPlain> E{{WSP(bf16, WS_KV), 2048, 1.f}}; pg8::gemm_phase(F.lds, g, S, E); }
            }
            SEAM(pb + 2);
        }
        if (PHON(4) && IN(pb + 3)) { PHASE_BEGIN();
            cs_pre_phase(F, A, l);
            SEAM(pb + 3);
        }
        if (PHON(5) && IN(pb + 4)) { PHASE_BEGIN();
            if (F.G == 256) {
                const int x = F.bx & 7, i = F.bx >> 3;
                if (i < 16) { const int u = x * 16 + i; cs_seq_unit(F, u >> 1, u & 1); }
                else convert_layer(F, A, l, 3, (x * 16 + i - 16) * NWAVES + F.wave, 128 * NWAVES);
            } else {
            for (int u = F.vcu; u < 128; u += F.G) cs_seq_unit(F, u >> 1, u & 1);
            if (F.G > 128 && F.vcu >= 128) convert_layer(F, A, l, 3, (F.vcu - 128) * NWAVES + F.wave, (F.G - 128) * NWAVES);
            else if (F.G <= 128) convert_layer(F, A, l, 3, F.vcu * NWAVES + F.wave, F.G * NWAVES);
            }
            __syncthreads();
        }
        if (PHON(6) && IN(pb + 5)) { PHASE_BEGIN();
            volatile LAS unsigned* msc = (volatile LAS unsigned*)(F.lds + MISC_OFF);
            const int nq = F.G >= 8 ? 1 : 8;
            for (int qi = 0; qi < nq; ++qi) {
                const int q = (F.bx + qi) & 7;
                unsigned* cnt = (unsigned*)(F.ws + WS_CTL) + CW_ATT + (l * 8 + q) * 64;
                for (;;) {
                    if (F.tid == 0) msc[12] = xb_add(cnt, 1u);
                    __syncthreads();
                    const int v = __builtin_amdgcn_readfirstlane((int)msc[12]);
                    __syncthreads();
                    if (v >= 64) break;
                    const int qb = 15 - (v >> 2), bh = 4 * q + (v & 3), b = bh >> 3, hh = bh & 7; const size_t r0 = (size_t)b * SEQ;
                    attn_unit<192, true>(F.lds, WSP(bf16, WS_QB) + (r0 + qb * 256) * 1536 + hh * 192, 1536,
                                         WSP(bf16, WS_KV) + r0 * 2048 + hh * 256, 2048, WSP(bf16, WS_KR) + r0 * 64, 64,
                                         WSP(bf16, WS_KV) + r0 * 2048 + hh * 256 + 128, 2048,
                                         WSP(bf16, WS_U) + (r0 + qb * 256) * D + 1024 + hh * 128, D, qb * 256, 4 * (qb + 1));
                }
            }
            SEAM(pb + 5);
        }
        if (PHON(7) && IN(pb + 6)) { PHASE_BEGIN(); rwkv_post_phase(F, A, l); SEAM(pb + 6); }
        if (PHON(8) && IN(pb + 7)) { PHASE_BEGIN();
            pg8::Gemm g{WSP(bf16, WS_U), WSP(bf16, WL(WO_OUT)), T, D, D, D, D}; pg8::StaticOrder S; S.init(T, D, F.G, F.bx);
            pg8::Epi8<FPlain> E{{WSP(bf16, WS_Y), D, 1.f}}; pg8::gemm_phase(F.lds, g, S, E);
            SEAM(pb + 7);
        }
        if (PHON(9) && IN(pb + 8)) { PHASE_BEGIN(); ew_norm_phase(F, A->in[I_MIXPOST] + (size_t)l * D, A->in[I_MEMPRE] + (size_t)l * D, 3 * l); SEAM(pb + 8); }
        if (PHON(10) && IN(pb + 9)) { PHASE_BEGIN();
            pg8::Gemm g{WSP(bf16, WS_U), WSP(bf16, WL(WO_QM)), T, 512, D, D, D}; pg8::StaticOrder S; S.init(T, 512, F.G, F.bx);
            pg8::Epi8<FPlain> E{{WSP(bf16, WS_QMEM), 512, QSCALE_MEM}}; pg8::gemm_phase(F.lds, g, S, E);
            PHASE_RELOAD();
            { pg8::Gemm g2{WSP(bf16, WS_MEMN), WSP(bf16, WL(WO_KM)), NB * NMEM, 512, D, D, D}; pg8::StaticOrder S2; S2.init(NB * NMEM, 512, F.G, (F.bx + F.G - 128 % F.G) % F.G);
              pg8::Epi8<FPlain> E2{{WSP(bf16, WS_MEMK), 512, 1.f}}; pg8::gemm_phase(F.lds, g2, S2, E2); }
            PHASE_RELOAD();
            { pg8::Gemm g2{WSP(bf16, WS_MEMN), WSP(bf16, WL(WO_VM)), NB * NMEM, 512, D, D, D}; pg8::StaticOrder S2; S2.init(NB * NMEM, 512, F.G, (F.bx + F.G - 136 % F.G) % F.G);
              pg8::Epi8<FPlain> E2{{WSP(bf16, WS_MEMV), 512, 1.f}}; pg8::gemm_phase(F.lds, g2, S2, E2); }
            if (l + 1 < NL) { PHASE_RELOAD();
                if (F.G > 144 && F.bx >= 144) convert_layer(F, A, l + 1, 1, (F.bx - 144) * NWAVES + F.wave, (F.G - 144) * NWAVES);
                else if (F.G <= 144) convert_layer(F, A, l + 1, 1, F.bx * NWAVES + F.wave, F.G * NWAVES); }
            SEAM(pb + 9);
        }
        if (PHON(11) && IN(pb + 10)) { PHASE_BEGIN();
            for (int u = F.vcu; u < 256; u += F.G) {
                const int bh = u >> 4, qb = u & 15, b = bh >> 2, hh = bh & 3; const size_t r0 = (size_t)b * SEQ + qb * 256;
                attn_unit<128, false>(F.lds, WSP(bf16, WS_QMEM) + r0 * 512 + hh * 128, 512,
                                      WSP(bf16, WS_MEMK) + (size_t)b * NMEM * 512 + hh * 128, 512, nullptr, 0,
                                      WSP(bf16, WS_MEMV) + (size_t)b * NMEM * 512 + hh * 128, 512,
                                      WSP(bf16, WS_OMEM) + r0 * 512 + hh * 128, 512, 0, NMEM / 64);
            }
            SEAM(pb + 10);
        }
        if (PHON(12) && IN(pb + 11)) { PHASE_BEGIN();
            pg8::Gemm g{WSP(bf16, WS_OMEM), WSP(bf16, WL(WO_OM)), T, D, 512, 512, 512}; pg8::StaticOrder S; S.init(T, D, F.G, F.bx);
            pg8::Epi8<FPlain> E{{WSP(bf16, WS_Y), D, 1.f}}; pg8::gemm_phase(F.lds, g, S, E);
            SEAM(pb + 11);
        }
        if (PHON(13) && IN(pb + 12)) { PHASE_BEGIN(); ew_norm_phase(F, A->in[I_MEMPOST] + (size_t)l * D, A->in[I_FFNPRE] + (size_t)l * D, 3 * l + 1); SEAM(pb + 12); }
        if (PHON(14) && IN(pb + 13)) { PHASE_BEGIN();
            pg8::Gemm g{WSP(bf16, WS_U), WSP(bf16, WL(WO_FF1)), T, FF, D, D, D}; pg8::StaticOrder S; S.init(T, FF, F.G, F.bx);
            pg8::Epi8<FRelu2> E{{WSP(bf16, WS_HID), FF}}; pg8::gemm_phase(F.lds, g, S, E);
            SEAM(pb + 13);
        }
        if (PHON(15) && IN(pb + 14)) { PHASE_BEGIN();
            pg8::Gemm g{WSP(bf16, WS_HID), WSP(bf16, WL(WO_FF2)), T, D, FF, FF, FF}; pg8::StaticOrder S; S.init(T, D, F.G, F.bx);
            pg8::Epi8<FPlain> E{{WSP(bf16, WS_Y), D, 1.f}}; pg8::gemm_phase(F.lds, g, S, E);
            SEAM(pb + 14);
        }
        if (PHON(16) && IN(pb + 15)) { PHASE_BEGIN(); ew_norm_phase(F, A->in[I_FFNPOST] + (size_t)l * D, l + 1 < NL ? A->in[I_MIXPRE] + (size_t)(l + 1) * D : nullptr, 3 * l + 2); SEAM(pb + 15); }
    }
#undef IN
#undef SEAM
}

extern "C" void kernel_launch(void* const* d_in, const int* in_sizes, int n_in, void* d_out, int out_size, void* d_ws, size_t ws_size, hipStream_t stream) {
    static int grid = 0;
    if (grid == 0) {
        if (n_in != N_IN || out_size != T * D || ws_size < WS_END) { fprintf(stderr, "kernel_launch: unexpected shapes (n_in %d, out %d, ws %zu)\n", n_in, out_size, ws_size); grid = -1; return; }
        int dev = 0, cus = 0;
        if (hipGetDevice(&dev) != hipSuccess || hipDeviceGetAttribute(&cus, hipDeviceAttributeMultiprocessorCount, dev) != hipSuccess) { grid = -1; return; }
        if (hipFuncSetAttribute((const void*)fwd, hipFuncAttributeMaxDynamicSharedMemorySize, LDS_BYTES) != hipSuccess) { fprintf(stderr, "kernel_launch: hipFuncSetAttribute failed\n"); grid = -1; return; }
        int per_cu = 0;
        if (hipOccupancyMaxActiveBlocksPerMultiprocessor(&per_cu, (const void*)fwd, NTHR, LDS_BYTES) != hipSuccess || per_cu < 1) fprintf(stderr, "kernel_launch: occupancy query says %d\n", per_cu);
        (void)hipGetLastError();
        grid = cus;
    }
    if (grid < 0) return;
    (void)hipMemsetAsync((char*)d_ws + WS_CTL, 0, CTL_BYTES, stream);
    Args a{};
    for (int i = 0; i < N_IN; ++i) a.in[i] = (const float*)d_in[i];
    a.out = (float*)d_out; a.ws = (unsigned char*)d_ws;
    const int nph = NPHASES < STOP_PHASE ? NPHASES : STOP_PHASE;
    if (ONE_LAUNCH) { a.lo = 0; a.hi = nph; hipLaunchKernelGGL(fwd, dim3(grid), dim3(NTHR), LDS_BYTES, stream, a); }
    else { for (int p = 0; p < nph; ++p) { a.lo = p; a.hi = p + 1; hipLaunchKernelGGL(fwd, dim3(grid), dim3(NTHR), LDS_BYTES, stream, a); } }
}
```

```cpp
#include <hip/hip_runtime.h>
#include <cstdio>
#include <cstdint>

#define GAS __attribute__((address_space(1)))
#define LAS __attribute__((address_space(3)))
typedef unsigned short bf16;
typedef short bf16x8 __attribute__((ext_vector_type(8)));
typedef short s16x4 __attribute__((ext_vector_type(4)));
typedef float f32x2 __attribute__((ext_vector_type(2)));
typedef float f32x4 __attribute__((ext_vector_type(4)));
typedef float f32x16 __attribute__((ext_vector_type(16)));
typedef unsigned u32x2 __attribute__((ext_vector_type(2)));
typedef unsigned u32x4 __attribute__((ext_vector_type(4)));
typedef __bf16 bf16x2_t __attribute__((ext_vector_type(2)));

#ifndef ONE_LAUNCH
#define ONE_LAUNCH 1
#endif
#ifndef STOP_PHASE
#define STOP_PHASE 1000
#endif

constexpr int T = 16384, SEQ = 4096, NB = 4, D = 2048, NL = 4, FF = 8192;
constexpr int RIN = 3520, INW = 4352, PROJ_LD = 4608;
constexpr int NMEM = 256;
constexpr float NORM_EPS = 1e-6f, GN_EPS = 64e-5f;
constexpr float QSCALE_MLA = 0.07216878364870323f * 1.4426950408889634f;
constexpr float QSCALE_MEM = 0.08838834764831845f * 1.4426950408889634f;
constexpr int NWAVES = 8, NTHR = 512;
constexpr int NPH = 16, NPHASES = 1 + NL * NPH;

enum { I_X = 0, I_MEM, I_MEMG, I_MIXPRE, I_WIN, I_WINV, I_MU, I_MUV, I_W0, I_WUP, I_A0, I_AUP, I_V0, I_VUP, I_GUP, I_KK, I_KA, I_RK, I_LNG, I_LNB,
       I_QNG, I_WUQ, I_KVNG, I_WUKV, I_WOUT, I_MIXPOST, I_MEMPRE, I_WQM, I_WKM, I_WVM, I_WOM, I_MEMPOST, I_FFNPRE, I_FF1, I_FF2, I_FFNPOST, N_IN };

constexpr size_t KiB = 1024, MiB = 1024 * 1024;
constexpr size_t WS_CTL = 0, CTL_BYTES = 1 * MiB;
constexpr size_t WS_COS = 1 * MiB, WS_SIN = 1 * MiB + 512 * KiB;
constexpr size_t WS_MEMN = 2 * MiB, WS_MEMK = 6 * MiB, WS_MEMV = 7 * MiB, WS_RKB = 8 * MiB;
constexpr size_t WS_W = 16 * MiB, W_LSTRIDE = 38 * MiB;
constexpr size_t WS_WFF = 92 * MiB;
constexpr size_t WS_AO = 156 * MiB;
constexpr size_t WS_RMS = 12 * MiB;
constexpr size_t WS_SCAN = 220 * MiB;
constexpr size_t WO_IN = 0, WO_UP = 18 * MiB, WO_AUP = 18 * MiB + 256 * KiB, WO_GUP = 18 * MiB + 512 * KiB, WO_VUP = 19 * MiB, WO_UQ = 19 * MiB + 512 * KiB,
                 WO_UKV = 21 * MiB, WO_OUT = 22 * MiB, WO_QM = 30 * MiB, WO_KM = 32 * MiB, WO_VM = 34 * MiB, WO_OM = 36 * MiB, WO_FF1 = 38 * MiB, WO_FF2 = 70 * MiB;
constexpr size_t WS_U = 424 * MiB, WS_Y = 488 * MiB, WS_VF = 552 * MiB;
constexpr size_t WS_PROJ = 584 * MiB, WS_LORA = 728 * MiB, WS_WLOG = 748 * MiB, WS_AIC = 780 * MiB, WS_GATE = 812 * MiB, WS_VV = 844 * MiB,
                 WS_CQN = 876 * MiB, WS_CKVN = 892 * MiB, WS_KR = 900 * MiB, WS_QB = 902 * MiB, WS_KV = 950 * MiB, WS_END = 1014 * MiB;
constexpr size_t WS_HID = 584 * MiB, WS_QMEM = 840 * MiB, WS_OMEM = 856 * MiB;
constexpr int LORA_LD = 640;
constexpr int CW_TMO = 0, CW_BAR = 4096, CW_ATT = 16384;

constexpr int RING_BYTES = 163328, LDSCTL_OFF = RING_BYTES, MISC_OFF = LDSCTL_OFF + 320, LDS_BYTES = 163840;

__device__ __forceinline__ unsigned cvt_pk(float lo, float hi) { f32x2 v = {lo, hi}; bf16x2_t b = __builtin_convertvector(v, bf16x2_t); return __builtin_bit_cast(unsigned, b); }
__device__ __forceinline__ float bflo(unsigned w) { return __uint_as_float(w << 16); }
__device__ __forceinline__ float bfhi(unsigned w) { return __uint_as_float(w & 0xffff0000u); }
__device__ __forceinline__ float bf1(bf16 b) { return __uint_as_float((unsigned)b << 16); }
__device__ __forceinline__ bf16 f2bf(float f) { return (bf16)(cvt_pk(f, 0.f) & 0xffffu); }
template <int CTRL> __device__ __forceinline__ float dpp_add(float x) { return x + __int_as_float(__builtin_amdgcn_update_dpp(0, __float_as_int(x), CTRL, 0xf, 0xf, true)); }
__device__ __forceinline__ float sum4(float x) { x = dpp_add<0xB1>(x); x = dpp_add<0x4E>(x); return x; }
__device__ __forceinline__ float sum8(float x) { x = sum4(x); x = dpp_add<0x141>(x); return x; }
__device__ __forceinline__ float sum16(float x) { x = sum8(x); x = dpp_add<0x140>(x); return x; }
__device__ __forceinline__ float wave_sum(float x) {
    x = sum16(x);
    { auto r = __builtin_amdgcn_permlane16_swap(__float_as_uint(x), __float_as_uint(x), false, false); x = __uint_as_float(r[0]) + __uint_as_float(r[1]); }
    { auto r = __builtin_amdgcn_permlane32_swap(__float_as_uint(x), __float_as_uint(x), false, false); x = __uint_as_float(r[0]) + __uint_as_float(r[1]); }
    return x;
}
__device__ __forceinline__ float sigmoidf_(float x) { return __builtin_amdgcn_rcpf(1.f + __builtin_amdgcn_exp2f(-1.4426950408889634f * x)); }
__device__ __forceinline__ float tanhf_(float x) { const float e = __builtin_amdgcn_exp2f(-2.f * 1.4426950408889634f * fabsf(x)); const float t = (1.f - e) * __builtin_amdgcn_rcpf(1.f + e); return x < 0.f ? -t : t; }
__device__ __forceinline__ void unpack8(u32x4 w, float (&f)[8]) {
    f[0] = bflo(w.x); f[1] = bfhi(w.x); f[2] = bflo(w.y); f[3] = bfhi(w.y); f[4] = bflo(w.z); f[5] = bfhi(w.z); f[6] = bflo(w.w); f[7] = bfhi(w.w);
}
__device__ __forceinline__ u32x4 pack8(const float (&f)[8]) { u32x4 w; w.x = cvt_pk(f[0], f[1]); w.y = cvt_pk(f[2], f[3]); w.z = cvt_pk(f[4], f[5]); w.w = cvt_pk(f[6], f[7]); return w; }

__device__ __forceinline__ int crow(int r, int hi) { return (r & 3) + 8 * (r >> 2) + 4 * hi; }
typedef short v4i16_t __attribute__((ext_vector_type(4)));

namespace pg8 {
#define PG8_LAS __attribute__((address_space(3)))
typedef unsigned short bf16_t;
constexpr int BM = 256, BK = 64, HALF = 128, HTB = HALF * BK * 2, STAGE_BYTES = 8 * HTB, NXCD = 8, WGM = 8;
__host__ __device__ __forceinline__ int lds_byte(int r, int c) { const int st = (r >> 4) * 2 + (c >> 5), rr = r & 15, cc = c & 31, ob = rr * 64 + cc * 2; return st * 1024 + (ob ^ (((ob >> 9) & 1) << 5)); }
__host__ __device__ __forceinline__ void stage_rc(int b, int& R, int& C) { const int st = b / 1024, sb = b % 1024, swz = sb ^ (((sb >> 9) & 1) << 5); R = (st >> 1) * 16 + swz / 64; C = (st & 1) * 32 + (swz % 64) / 2; }
__host__ __device__ __forceinline__ int perm32(int rho) { const int n = rho >> 4, i = rho & 15; return 8 * (i >> 2) + 4 * n + (i & 3); }
struct Unit { int pm, pn; };
struct Gemm { const bf16_t* A; const bf16_t* Bt; int M, N, K, lda, ldb; };
struct StaticOrder {
    int nM, nN, nwg, G, c;
    __host__ __device__ void init(int M, int N, int G_, int c_) { nM = M / BM; nN = N / BM; nwg = nM * nN; G = G_; c = c_; }
    __host__ __device__ bool next(int i, Unit& u) const {
        const long L = (long)i * G + c; if (L >= nwg) return false;
        int wgid = (int)L; { const int q = nwg / NXCD, r = nwg % NXCD, xcd = wgid % NXCD, off = wgid / NXCD; wgid = (xcd < r ? xcd * (q + 1) : r * (q + 1) + (xcd - r) * q) + off; }
        const int nig = WGM * nN, gid = wgid / nig, fm = gid * WGM, gsz = (nM - fm) < WGM ? (nM - fm) : WGM;
        u.pm = fm + ((wgid % nig) % gsz); u.pn = (wgid % nig) / gsz; return true;
    }
};
template <class F> struct Epi8 {
    F f;
    __device__ __forceinline__ void operator()(const f32x4 (&acc)[2][2][4][2], const Unit& u, int wr, int wc, int fr, int fq) const {
        const int row0 = u.pm * BM + wr * 64 + fr, col0 = u.pn * BM + wc * 32 + 8 * fq;
#pragma unroll
        for (int ai = 0; ai < 2; ++ai)
#pragma unroll
            for (int m = 0; m < 4; ++m)
#pragma unroll
                for (int bj = 0; bj < 2; ++bj) { f(row0 + ai * HALF + m * 16, col0 + bj * HALF, acc[ai][bj][m][0], acc[ai][bj][m][1]); if (F::HEAVY) __builtin_amdgcn_sched_barrier(0); }
    }
};

template <class Epi>
__device__ __forceinline__ void gemm_phase(PG8_LAS unsigned char* lds, const Gemm g, const StaticOrder& S, const Epi& E) {
    int tid = threadIdx.x; asm volatile("" : "+v"(tid));
    const int wid = __builtin_amdgcn_readfirstlane(tid >> 6), lane = tid & 63, wr = wid >> 2, wc = wid & 3, fr = lane & 15, fq = lane >> 4;
    int K = g.K; asm volatile("" : "+s"(K));
    const int nt = K / BK;
    unsigned voffA[2], voffB[2];
#pragma unroll
    for (int i = 0; i < 2; ++i) { int R, C; stage_rc(tid * 16 + i * 8192, R, C); const int Rb = (R & ~31) + perm32(R & 31);
        voffA[i] = (unsigned)(R * g.lda + C) * 2u; voffB[i] = (unsigned)(Rb * g.ldb + C) * 2u; }
    const size_t kstep = (size_t)(BK * 2);
    const size_t hsA = (size_t)HALF * g.lda * 2, hsB = (size_t)HALF * g.ldb * 2;
    const size_t tsA = 2 * hsA, tsB = 2 * hsB;
    const unsigned ldsw = (unsigned)wid * 1024u;
    const int aoff = lds_byte(wr * 64 + fr, fq * 8), boff = lds_byte(wc * 32 + fr, fq * 8);
#define PG8_SA(b, h) (((b) * 2 + (h)) * HTB)
#define PG8_SB(b, h) ((4 + (b) * 2 + (h)) * HTB)
#define PG8_STAGE(bufoff, gbase, voff) do { _Pragma("unroll") for (int _i = 0; _i < 2; ++_i) \
        __builtin_amdgcn_global_load_lds((const unsigned*)((const char*)(gbase) + (voff)[_i]), (PG8_LAS unsigned*)(lds + (bufoff) + ldsw + _i * 8192), 16, 0, 0); } while (0)
#define PG8_LDA(dst, b, h) do { _Pragma("unroll") for (int m = 0; m < 4; ++m) _Pragma("unroll") for (int k = 0; k < 2; ++k) dst[m][k] = *(const PG8_LAS bf16x8*)(lds + PG8_SA(b, h) + aoff + m * 2048 + k * 1024); } while (0)
#define PG8_LDB(dst, b, h) do { _Pragma("unroll") for (int n = 0; n < 2; ++n) _Pragma("unroll") for (int k = 0; k < 2; ++k) dst[n][k] = *(const PG8_LAS bf16x8*)(lds + PG8_SB(b, h) + boff + n * 2048 + k * 1024); } while (0)
#define PG8_MMA(ai, bj, At, Bt) do { __builtin_amdgcn_s_setprio(1); _Pragma("unroll") for (int m = 0; m < 4; ++m) _Pragma("unroll") for (int n = 0; n < 2; ++n) _Pragma("unroll") for (int k = 0; k < 2; ++k) \
        acc[ai][bj][m][n] = __builtin_amdgcn_mfma_f32_16x16x32_bf16(Bt[n][k], At[m][k], acc[ai][bj][m][n], 0, 0, 0); __builtin_amdgcn_s_setprio(0); } while (0)
#define PG8_WAIT_V(n) asm volatile("s_waitcnt vmcnt(" #n ")" ::: "memory")
#define PG8_WAIT_L(n) asm volatile("s_waitcnt lgkmcnt(" #n ")" ::: "memory")
#define PG8_BAR __builtin_amdgcn_s_barrier()
#define PG8_SCHED __builtin_amdgcn_sched_barrier(0)
    Unit cur, nxt; int ui = 0;
    if (!S.next(0, cur)) return;
    f32x4 acc[2][2][4][2];
#pragma unroll
    for (int a = 0; a < 2; ++a)
#pragma unroll
        for (int b = 0; b < 2; ++b)
#pragma unroll
            for (int m = 0; m < 4; ++m)
#pragma unroll
                for (int n = 0; n < 2; ++n) acc[a][b][m][n] = (f32x4){0.f, 0.f, 0.f, 0.f};
    bf16x8 At[4][2], B0[2][2], B1[2][2];
    const char* cA = (const char*)g.A + (size_t)cur.pm * tsA; const char* cB = (const char*)g.Bt + (size_t)cur.pn * tsB;
    PG8_STAGE(PG8_SB(0, 0), cB, voffB); PG8_STAGE(PG8_SB(0, 1), cB + hsB, voffB); PG8_STAGE(PG8_SA(0, 0), cA, voffA); PG8_STAGE(PG8_SA(0, 1), cA + hsA, voffA);
    if (wr == 1) PG8_BAR;
    PG8_WAIT_V(2); PG8_BAR;
    PG8_STAGE(PG8_SB(1, 0), cB + kstep, voffB); PG8_STAGE(PG8_SA(1, 0), cA + kstep, voffA); PG8_STAGE(PG8_SB(1, 1), cB + hsB + kstep, voffB);
    PG8_WAIT_V(6); PG8_BAR;
    for (;;) {
        const bool has_next = S.next(ui + 1, nxt);
        const char* nA = has_next ? (const char*)g.A + (size_t)nxt.pm * tsA : cA; const char* nB = has_next ? (const char*)g.Bt + (size_t)nxt.pn * tsB : cB;
        for (int t = 0; t < nt; t += 2) {
            const bool last = (t == nt - 2);
            const char* a1 = cA + (size_t)(t + 1) * kstep;
            const char* a2 = last ? nA : cA + (size_t)(t + 2) * kstep; const char* b2 = last ? nB : cB + (size_t)(t + 2) * kstep;
            const char* a3 = a2 + kstep; const char* b3 = b2 + kstep;
            PG8_LDB(B0, 0, 0); PG8_LDB(B1, 0, 1); PG8_SCHED; PG8_LDA(At, 0, 0); PG8_STAGE(PG8_SA(1, 1), a1 + hsA, voffA);
            PG8_WAIT_V(8); PG8_WAIT_L(0); PG8_BAR; PG8_MMA(0, 0, At, B0); PG8_MMA(0, 1, At, B1); PG8_BAR; PG8_SCHED;
            PG8_LDA(At, 0, 1); PG8_STAGE(PG8_SB(0, 0), b2, voffB); PG8_STAGE(PG8_SB(0, 1), b2 + hsB, voffB); PG8_STAGE(PG8_SA(0, 0), a2, voffA);
            PG8_WAIT_V(8); PG8_WAIT_L(0); PG8_BAR; PG8_MMA(1, 0, At, B0); PG8_MMA(1, 1, At, B1); PG8_BAR; PG8_SCHED;
            PG8_LDB(B0, 1, 0); PG8_LDB(B1, 1, 1); PG8_SCHED; PG8_LDA(At, 1, 0); PG8_STAGE(PG8_SA(0, 1), a2 + hsA, voffA);
            PG8_WAIT_V(8); PG8_WAIT_L(0); PG8_BAR; PG8_MMA(0, 0, At, B0); PG8_MMA(0, 1, At, B1); PG8_BAR; PG8_SCHED;
            PG8_LDA(At, 1, 1); PG8_STAGE(PG8_SB(1, 0), b3, voffB); PG8_STAGE(PG8_SB(1, 1), b3 + hsB, voffB); PG8_STAGE(PG8_SA(1, 0), a3, voffA);
            PG8_WAIT_V(8); PG8_WAIT_L(0); PG8_BAR; PG8_MMA(1, 0, At, B0); PG8_MMA(1, 1, At, B1); PG8_BAR; PG8_SCHED;
        }
        if (wr == 0) PG8_BAR;
        E(acc, cur, wr, wc, fr, fq);
        if (!has_next) break;
#pragma unroll
        for (int a = 0; a < 2; ++a)
#pragma unroll
            for (int b = 0; b < 2; ++b)
#pragma unroll
                for (int m = 0; m < 4; ++m)
#pragma unroll
                    for (int n = 0; n < 2; ++n) acc[a][b][m][n] = (f32x4){0.f, 0.f, 0.f, 0.f};
        cur = nxt; cA = nA; cB = nB; ++ui;
        if (wr == 1) PG8_BAR;
    }
    PG8_WAIT_V(0);
    PG8_BAR;
#undef PG8_SA
#undef PG8_SB
#undef PG8_STAGE
#undef PG8_LDA
#undef PG8_LDB
#undef PG8_MMA
#undef PG8_WAIT_V
#undef PG8_WAIT_L
#undef PG8_BAR
#undef PG8_SCHED
}
}

__device__ __forceinline__ void st16_wt(void* p, u32x4 w) { asm volatile("global_store_dwordx4 %0, %1, off sc1\n\ts_nop 1" :: "v"(p), "v"(w) : "memory"); }
struct FPlain { static constexpr bool HEAVY = false; bf16* O; int ld; float sc;
    __device__ __forceinline__ void operator()(int row, int col, f32x4 a, f32x4 b) const {
        u32x4 w; w.x = cvt_pk(a[0] * sc, a[1] * sc); w.y = cvt_pk(a[2] * sc, a[3] * sc); w.z = cvt_pk(b[0] * sc, b[1] * sc); w.w = cvt_pk(b[2] * sc, b[3] * sc);
        st16_wt(O + (size_t)row * ld + col, w); } };
struct FRelu2 { static constexpr bool HEAVY = false; bf16* O; int ld;
    __device__ __forceinline__ void operator()(int row, int col, f32x4 a, f32x4 b) const {
        float v[8] = {a[0], a[1], a[2], a[3], b[0], b[1], b[2], b[3]};
#pragma unroll
        for (int i = 0; i < 8; ++i) { const float r = fmaxf(v[i], 0.f); v[i] = r * r; }
        st16_wt(O + (size_t)row * ld + col, pack8(v)); } };
template <int MODE> struct FSig { static constexpr bool HEAVY = true; bf16* O; int ld; const float* bias;
    __device__ __forceinline__ void operator()(int row, int col, f32x4 a, f32x4 b) const {
        const f32x4 b0 = *(const f32x4*)(bias + col), b1 = *(const f32x4*)(bias + col + 4);
        float v[8] = {a[0] + b0[0], a[1] + b0[1], a[2] + b0[2], a[3] + b0[3], b[0] + b1[0], b[1] + b1[1], b[2] + b1[2], b[3] + b1[3]};
#pragma unroll
        for (int i = 0; i < 8; ++i) { const float s = sigmoidf_(v[i]); v[i] = MODE == 0 ? -0.6065306597126334f * s : s; }
        *(u32x4*)(O + (size_t)row * ld + col) = pack8(v); } };
struct FVup { static constexpr bool HEAVY = true; bf16* O; const float* v0; const float* mu; const bf16* proj; const bf16* vfirst;
    __device__ __forceinline__ void operator()(int row, int col, f32x4 a, f32x4 b) const {
        const f32x4 b0 = *(const f32x4*)(v0 + col), b1 = *(const f32x4*)(v0 + col + 4), m0 = *(const f32x4*)(mu + col), m1 = *(const f32x4*)(mu + col + 4);
        float cur[8], prv[8], vf[8];
        unpack8(*(const u32x4*)(proj + (size_t)row * PROJ_LD + 2048 + col), cur);
        if ((row & (SEQ - 1)) != 0) unpack8(*(const u32x4*)(proj + (size_t)(row - 1) * PROJ_LD + 2048 + col), prv);
        else {
#pragma unroll
            for (int i = 0; i < 8; ++i) prv[i] = 0.f; }
        unpack8(*(const u32x4*)(vfirst + (size_t)row * 1024 + col), vf);
        const float acc8[8] = {a[0] + b0[0], a[1] + b0[1], a[2] + b0[2], a[3] + b0[3], b[0] + b1[0], b[1] + b1[1], b[2] + b1[2], b[3] + b1[3]};
        const float mu8[8] = {m0[0], m0[1], m0[2], m0[3], m1[0], m1[1], m1[2], m1[3]};
        float v[8];
#pragma unroll
        for (int i = 0; i < 8; ++i) { const float vs = cur[i] + (prv[i] - cur[i]) * mu8[i]; v[i] = vs + (vf[i] - vs) * sigmoidf_(acc8[i]); }
        *(u32x4*)(O + (size_t)row * 1024 + col) = pack8(v); } };
struct FQ { static constexpr bool HEAVY = true; bf16* O; const float* cosT; const float* sinT;
    __device__ __forceinline__ void operator()(int row, int col, f32x4 a, f32x4 b) const {
        const int cc = col % 192;
        float v[8] = {a[0], a[1], a[2], a[3], b[0], b[1], b[2], b[3]};
        if (cc >= 128) { const int i0 = (cc - 128) >> 1, pos = row & (SEQ - 1);
            const f32x4 c = *(const f32x4*)(cosT + pos * 32 + i0), s = *(const f32x4*)(sinT + pos * 32 + i0);
#pragma unroll
            for (int i = 0; i < 4; ++i) { const float x1 = v[2 * i], x2 = v[2 * i + 1]; v[2 * i] = x1 * c[i] - x2 * s[i]; v[2 * i + 1] = x1 * s[i] + x2 * c[i]; } }
#pragma unroll
        for (int i = 0; i < 8; ++i) v[i] *= QSCALE_MLA;
        *(u32x4*)(O + (size_t)row * 1536 + col) = pack8(v); } };

#define XB_TMO      128
#define XB_XCNT(j)  (256  + 64 * (j))
#define XB_XSUB(j)  (1280 + 64 * (j))
#define XB_XGEN(j)  (2304 + 64 * (j))
#define XB_TOP      3328
#define XB_TOPGEN   3392
#define XCD_BAR_WORDS 3456
#define XB_SPIN_CAP (1u << 20)
__device__ __forceinline__ unsigned xb_ld(unsigned* p)              { return __hip_atomic_load(p, __ATOMIC_RELAXED, __HIP_MEMORY_SCOPE_AGENT); }
__device__ __forceinline__ unsigned xb_add(unsigned* p, unsigned v) { return __hip_atomic_fetch_add(p, v, __ATOMIC_RELAXED, __HIP_MEMORY_SCOPE_AGENT); }
__device__ __forceinline__ unsigned xb_xcc_id() { return (unsigned)__builtin_amdgcn_s_getreg((3 << 11) | 20) & 0xFu; }
#define XB_SPIN(cond, bar) do { unsigned _sp = 0; while (cond) { __builtin_amdgcn_s_sleep(1); \
    if ((++_sp & 255u) == 0u) { if (xb_ld(&(bar)[XB_TMO])) break; if (_sp > XB_SPIN_CAP) { atomicAdd(&(bar)[XB_TMO], 1u); break; } } } } while (0)
struct XcdBarrier { unsigned* bar; unsigned x; volatile LAS unsigned* st; };
__device__ __forceinline__ XcdBarrier xcd_barrier_post(unsigned* bar, volatile LAS unsigned* st) {
    XcdBarrier b; b.bar = bar; b.x = xb_xcc_id(); b.st = st;
    if (threadIdx.x == 0) (void)xb_add(&bar[XB_XCNT(b.x)], 1u);
    return b;
}
__device__ __forceinline__ void xcd_barrier_complete(unsigned* bar, unsigned x, unsigned& nloc, unsigned& nx) {
    const unsigned G = gridDim.x * gridDim.y * gridDim.z;
    unsigned sum, cnt, mine, sp = 0u;
    for (;;) {
        sum = 0u; cnt = 0u; mine = 0u;
#pragma unroll
        for (unsigned j = 0; j < 16; ++j) { const unsigned c = xb_ld(&bar[XB_XCNT(j)]); sum += c; cnt += (c > 0u) ? 1u : 0u; mine = (j == x) ? c : mine; }
        if (sum == G) break;
        __builtin_amdgcn_s_sleep(1);
        if ((++sp & 255u) == 0u) { if (xb_ld(&bar[XB_TMO])) break; if (sp > XB_SPIN_CAP) { atomicAdd(&bar[XB_TMO], 1u); break; } }
    }
    nloc = mine > 0u ? mine : 1u; nx = cnt > 0u ? cnt : 1u;
}
__device__ __forceinline__ void xcd_barrier(const XcdBarrier& b) {
    asm volatile("s_waitcnt vmcnt(0)" ::: "memory");
    __syncthreads();
    if (threadIdx.x == 0) {
        unsigned* bar = b.bar;
        __builtin_amdgcn_s_waitcnt(0);
        unsigned nloc = b.st[0], nx = b.st[1];
        if (nloc == 0u) { xcd_barrier_complete(bar, b.x, nloc, nx); b.st[0] = nloc; b.st[1] = nx; }
        const unsigned old = xb_add(&bar[XB_XSUB(b.x)], 1u);
        const unsigned gen = old / nloc;
        if (old + 1u == (gen + 1u) * nloc) {
            __builtin_amdgcn_fence(__ATOMIC_RELEASE, "agent");
            asm volatile("s_waitcnt vmcnt(0)" ::: "memory");
            const unsigned og = xb_add(&bar[XB_TOP], 1u);
            const unsigned tg = og / nx;
            if (og + 1u == (tg + 1u) * nx) xb_add(&bar[XB_TOPGEN], 1u);
            else XB_SPIN(xb_ld(&bar[XB_TOPGEN]) == tg, bar);
            __builtin_amdgcn_fence(__ATOMIC_ACQUIRE, "agent");
            xb_add(&bar[XB_XGEN(b.x)], 1u);
            asm volatile("s_waitcnt vmcnt(0)" ::: "memory");
        } else {
            XB_SPIN(xb_ld(&bar[XB_XGEN(b.x)]) == gen, bar);
            __builtin_amdgcn_fence(__ATOMIC_ACQUIRE, "agent");
            asm volatile("s_waitcnt vmcnt(0)" ::: "memory");
        }
    }
    __syncthreads();
}

struct Args { const float* in[N_IN]; float* out; unsigned char* ws; int lo, hi; };
typedef const __attribute__((address_space(4))) Args* ArgsP;
struct Frame {
    LAS unsigned char* lds;
    int tid, lane, wave, vcu, G, bx;
    unsigned char* ws;
    float* H;
};
#define WSP(type, off) ((type*)(F.ws + (off)))
#define WL(off) ((off) >= WO_FF1 ? WS_WFF + ((off) - WO_FF1) : WS_W + (size_t)(l & 1) * W_LSTRIDE + (off))

__constant__ int JK[15]  = {2048, 2048, 256, 256, 2048, 2048, 2048, 2048, 512, 96, 96, 64, 512, 2048, 8192};
__constant__ int JKP[15] = {2048, 2048, 256, 256, 2048, 2048, 2048, 2048, 512, 128, 128, 128, 512, 2048, 8192};
__constant__ int JN[15]  = {4352, 64, 1024, 2048, 2048, 512, 512, 512, 2048, 1024, 1024, 1024, 1536, 8192, 2048};
__constant__ int JIN[15] = {I_WIN, I_WINV, I_GUP, I_WUKV, I_WOUT, I_WQM, I_WKM, I_WVM, I_WOM, I_WUP, I_AUP, I_VUP, I_WUQ, I_FF1, I_FF2};
__constant__ unsigned JDST[15] = {(unsigned)(WO_IN / KiB), (unsigned)(WO_IN / KiB), (unsigned)(WO_GUP / KiB), (unsigned)(WO_UKV / KiB), (unsigned)(WO_OUT / KiB), (unsigned)(WO_QM / KiB),
                                  (unsigned)(WO_KM / KiB), (unsigned)(WO_VM / KiB), (unsigned)(WO_OM / KiB), (unsigned)(WO_UP / KiB), (unsigned)(WO_AUP / KiB), (unsigned)(WO_VUP / KiB),
                                  (unsigned)(WO_UQ / KiB), (unsigned)(WO_FF1 / KiB), (unsigned)(WO_FF2 / KiB)};
__device__ __forceinline__ void p0_transpose_item(const float* W, int Kreal, int N, bf16* WT, int ldk, int row_off, LAS unsigned* scr, int item, int lane, bool rope, const float* gk) {
    const int nblk = N / 64, kb = item / nblk, nb = item % nblk, k0 = 64 * kb, n0 = 64 * nb;
    const int m = lane & 15, q = lane >> 4;
    f32x4 v[16];
#pragma unroll
    for (int i = 0; i < 16; ++i) { const int k = k0 + 8 * (i >> 1) + 2 * q + (i & 1); const int kc = k < Kreal ? k : Kreal - 1;
        v[i] = __builtin_nontemporal_load((const f32x4*)(W + (size_t)kc * N + n0 + 4 * m)); }
    if (k0 + 64 > Kreal) {
#pragma unroll
        for (int i = 0; i < 16; ++i) { const int k = k0 + 8 * (i >> 1) + 2 * q + (i & 1); if (k >= Kreal) v[i] = (f32x4){0.f, 0.f, 0.f, 0.f}; }
    }
    if (gk) {
        float gg[16];
#pragma unroll
        for (int i = 0; i < 16; ++i) gg[i] = gk[k0 + 8 * (i >> 1) + 2 * q + (i & 1)];
#pragma unroll
        for (int i = 0; i < 16; ++i) v[i] *= gg[i];
    }
#pragma unroll
    for (int j = 0; j < 8; ++j)
#pragma unroll
        for (int c = 0; c < 4; ++c) scr[(4 * m + c) * 32 + ((4 * j + q) ^ (4 * (m & 7)))] = cvt_pk(v[2 * j][c], v[2 * j + 1][c]);
    asm volatile("s_waitcnt lgkmcnt(0)" ::: "memory");
    const int x = lane & 7, r = lane >> 3;
#pragma unroll
    for (int t = 0; t < 8; ++t) { const int n = r + 8 * t; const u32x4 o = *(const LAS u32x4*)(scr + n * 32 + 4 * (x ^ ((n >> 2) & 7)));
        const int nd = rope ? 2 * (n & 31) + (n >> 5) : n;
        *(u32x4*)(WT + (size_t)(row_off + n0 + nd) * ldk + k0 + 8 * x) = o; }
    asm volatile("s_waitcnt lgkmcnt(0)" ::: "memory");
}
__device__ __forceinline__ void rms_row_2048(const float* xrow, const float* g, bf16* orow, float* rms_out, int lane) {
    f32x4 v[8]; float ss = 0.f;
#pragma unroll
    for (int j = 0; j < 4; ++j) { v[2 * j] = *(const f32x4*)(xrow + lane * 8 + 512 * j); v[2 * j + 1] = *(const f32x4*)(xrow + lane * 8 + 512 * j + 4); }
#pragma unroll
    for (int j = 0; j < 8; ++j) ss += (v[j][0] * v[j][0] + v[j][1] * v[j][1]) + (v[j][2] * v[j][2] + v[j][3] * v[j][3]);
    const float ms = wave_sum(ss) * (1.f / 2048.f) + NORM_EPS, rstd = rsqrtf(ms);
    if (rms_out && lane == 0) *rms_out = ms * rstd;
#pragma unroll
    for (int j = 0; j < 4; ++j) { const int c = lane * 8 + 512 * j;
        f32x4 a = v[2 * j] * rstd, b = v[2 * j + 1] * rstd;
        if (g) { a *= *(const f32x4*)(g + c); b *= *(const f32x4*)(g + c + 4); }
        u32x4 w; w.x = cvt_pk(a[0], a[1]); w.y = cvt_pk(a[2], a[3]); w.z = cvt_pk(b[0], b[1]); w.w = cvt_pk(b[2], b[3]);
        *(u32x4*)(orow + c) = w; }
}
__device__ __forceinline__ void convert_layer(Frame& F, ArgsP A, int l, int part, int wrank, int wcount) {
    LAS unsigned* scr = (LAS unsigned*)(F.lds + F.wave * 16384);
    const int k_lo = (part == 2) ? 13 : (part == 3 ? 14 : 0), k_hi = (part == 1) ? 13 : (part == 2 ? 14 : 15);
    int base = 0;
    for (int k = k_lo; k < k_hi; ++k) {
        const bool prev = (k == 1 || k == 11);
        if (prev && l == 0) continue;
        const int K = JK[k], KP = JKP[k], N = JN[k], row_off = (k == 1) ? INW : 0;
        const float* W = A->in[JIN[k]] + (size_t)(prev ? l - 1 : l) * K * N; const size_t dst = WL((size_t)JDST[k] * KiB);
        const int nitems = (KP / 64) * (N / 64);
        const float* gk = (k <= 1) ? A->in[I_MIXPRE] + (size_t)l * D : (k == 5 ? A->in[I_MEMPRE] + (size_t)l * D : (k == 13 ? A->in[I_FFNPRE] + (size_t)l * D : nullptr));
        int first = (wrank - base) % wcount; if (first < 0) first += wcount;
        for (int it = first; it < nitems; it += wcount) p0_transpose_item(W, K, N, WSP(bf16, dst), KP, row_off, scr, it, F.lane, k == 12 && (it % (N / 64)) % 3 == 2, gk);
        base = (base + nitems) % wcount;
    }
    if (part <= 1 && l > 0) {
        const long gt = (long)wrank * 64 + F.lane, NGT = (long)wcount * 64;
        unsigned* O = (unsigned*)(WSP(bf16, WL(WO_IN)) + (size_t)(INW + 64) * D);
        for (long i = gt; i < 192 * D / 2; i += NGT) O[i] = 0u;
    }
}
__device__ __forceinline__ void p0_prologue(Frame& F, ArgsP A) {
    const int gw = F.vcu * NWAVES + F.wave, NGW = F.G * NWAVES;
    const long gt = (long)F.vcu * NTHR + F.tid, NGT = (long)F.G * NTHR;
    convert_layer(F, A, 0, 1, gw, NGW);
    { float* cT = WSP(float, WS_COS); float* sT = WSP(float, WS_SIN);
      for (long i = gt; i < SEQ * 32; i += NGT) { const int pos = (int)(i >> 5), j = (int)(i & 31);
          const float invf = __builtin_amdgcn_exp2f(-13.287712379549449f * (float)j * (1.f / 32.f));
          const double rev = (double)pos * (double)invf * 0.15915494309189535; const float fr = (float)(rev - __builtin_rint(rev));
          cT[i] = __builtin_amdgcn_cosf(fr); sT[i] = __builtin_amdgcn_sinf(fr); } }
    for (int m = gw; m < T; m += NGW) rms_row_2048(A->in[I_X] + (size_t)m * D, nullptr, WSP(bf16, WS_U) + (size_t)m * D, WSP(float, WS_RMS) + m, F.lane);
    for (int m = gw; m < NB * NMEM; m += NGW) rms_row_2048(A->in[I_MEM] + (size_t)m * D, A->in[I_MEMG], WSP(bf16, WS_MEMN) + (size_t)m * D, nullptr, F.lane);
}

__device__ __forceinline__ void prep_phase(Frame& F, ArgsP A, int l) {
    const int gw = F.vcu * NWAVES + F.wave, NGW = F.G * NWAVES, lane = F.lane;
    const bf16* PROJ = WSP(bf16, WS_PROJ);
    const float* mu = A->in[I_MU] + (size_t)l * RIN;
    const float* muv = A->in[I_MUV] + (size_t)(l > 0 ? l - 1 : 0) * 64;
    const float* qg = A->in[I_QNG] + (size_t)l * 512; const float* kvg = A->in[I_KVNG] + (size_t)l * 256;
    const float* cT = WSP(float, WS_COS); const float* sT = WSP(float, WS_SIN);
    for (int m = gw; m < T; m += NGW) {
        const bf16* cur = PROJ + (size_t)m * PROJ_LD; const bool first = (m & (SEQ - 1)) == 0; const bf16* prv = cur - PROJ_LD;
        bf16* lo = WSP(bf16, WS_LORA) + (size_t)m * LORA_LD;
#pragma unroll
        for (int i = 0; i < 10; ++i) { const int oc = lane + 64 * i; int sc = -1, kind = 0; float mv = 0.f;
            if (oc < 128) { if (oc < 96) { sc = 3072 + oc; kind = 1; } }
            else if (oc < 256) { if (oc < 224) { sc = 3168 + (oc - 128); kind = 0; } }
            else if (oc < 512) { sc = 3264 + (oc - 256); kind = 2; }
            else if (oc < 576) { if (l > 0) { sc = INW + (oc - 512); kind = 3; } }
            float val = 0.f;
            if (sc >= 0) { mv = kind == 3 ? muv[sc - INW] : mu[sc]; const float y = bf1(cur[sc]), yp = first ? 0.f : bf1(prv[sc]); const float c = y + (yp - y) * mv;
                val = kind == 1 ? tanhf_(c) : (kind == 2 ? sigmoidf_(c) : c); }
            lo[oc] = f2bf(val); }
        { float v[8]; unpack8(*(const u32x4*)(cur + RIN + lane * 8), v); float ss = 0.f;
#pragma unroll
          for (int i = 0; i < 8; ++i) ss += v[i] * v[i];
          const float rstd = rsqrtf(wave_sum(ss) * (1.f / 512.f) + NORM_EPS);
          const f32x4 g0 = *(const f32x4*)(qg + lane * 8), g1 = *(const f32x4*)(qg + lane * 8 + 4);
          u32x4 w; w.x = cvt_pk(v[0] * rstd * g0[0], v[1] * rstd * g0[1]); w.y = cvt_pk(v[2] * rstd * g0[2], v[3] * rstd * g0[3]);
          w.z = cvt_pk(v[4] * rstd * g1[0], v[5] * rstd * g1[1]); w.w = cvt_pk(v[6] * rstd * g1[2], v[7] * rstd * g1[3]);
          *(u32x4*)(WSP(bf16, WS_CQN) + (size_t)m * 512 + lane * 8) = w; }
        { const u32x2 raw = *(const u32x2*)(cur + RIN + 512 + lane * 4); const float v0 = bflo(raw.x), v1 = bfhi(raw.x), v2 = bflo(raw.y), v3 = bfhi(raw.y);
          const float rstd = rsqrtf(wave_sum(v0 * v0 + v1 * v1 + v2 * v2 + v3 * v3) * (1.f / 256.f) + NORM_EPS);
          const f32x4 g0 = *(const f32x4*)(kvg + lane * 4);
          u32x2 w; w.x = cvt_pk(v0 * rstd * g0[0], v1 * rstd * g0[1]); w.y = cvt_pk(v2 * rstd * g0[2], v3 * rstd * g0[3]);
          *(u32x2*)(WSP(bf16, WS_CKVN) + (size_t)m * 256 + lane * 4) = w; }
        if (lane < 32) { const float x1 = bf1(cur[RIN + 768 + lane]), x2 = bf1(cur[RIN + 768 + 32 + lane]); const int pos = m & (SEQ - 1);
          const float c = cT[pos * 32 + lane], s = sT[pos * 32 + lane];
          *(unsigned*)(WSP(bf16, WS_KR) + (size_t)m * 64 + 2 * lane) = cvt_pk(x1 * c - x2 * s, x1 * s + x2 * c); }
        if (l == 0) {
#pragma unroll
            for (int j = 0; j < 2; ++j) { const int c = lane * 8 + 512 * j; float a[8], p[8], o[8]; unpack8(*(const u32x4*)(cur + 2048 + c), a);
                if (!first) unpack8(*(const u32x4*)(prv + 2048 + c), p); else {
#pragma unroll
                    for (int i = 0; i < 8; ++i) p[i] = 0.f; }
                const f32x4 m0 = *(const f32x4*)(mu + 2048 + c), m1 = *(const f32x4*)(mu + 2048 + c + 4);
#pragma unroll
                for (int i = 0; i < 8; ++i) o[i] = a[i] + (p[i] - a[i]) * (i < 4 ? m0[i] : m1[i - 4]);
                *(u32x4*)(WSP(bf16, WS_VF) + (size_t)m * 1024 + c) = pack8(o); } }
    }
}

constexpr int CK = 32, NCHUNK = SEQ / CK;
constexpr int CS_TS = 144, CS_TILE = 32 * CS_TS, CS_PC = 5 * CS_TILE, CS_WAVE = 5 * CS_TILE + 256;
constexpr int CS_NW = 7;
constexpr size_t SCU_BYTES = 24576; constexpr int SCU_X = 8192, SCU_PSI = 12288, SCU_G2 = 20480;
constexpr int SQ_SLOT = 18432, SQ_NSLOT = 7;
static_assert(CS_NW * CS_WAVE <= RING_BYTES && SQ_NSLOT * SQ_SLOT <= RING_BYTES, "LDS budget");
#define MF32(a, b, c) __builtin_amdgcn_mfma_f32_32x32x16_bf16((a), (b), (c), 0, 0, 0)
__device__ __forceinline__ bf16x8 pack8f(float a0, float a1, float a2, float a3, float a4, float a5, float a6, float a7) {
    u32x4 w; w.x = cvt_pk(a0, a1); w.y = cvt_pk(a2, a3); w.z = cvt_pk(a4, a5); w.w = cvt_pk(a6, a7); return __builtin_bit_cast(bf16x8, w); }
#define PACKS(x, s) pack8f((x)[8 * (s)], (x)[8 * (s) + 1], (x)[8 * (s) + 2], (x)[8 * (s) + 3], (x)[8 * (s) + 4], (x)[8 * (s) + 5], (x)[8 * (s) + 6], (x)[8 * (s) + 7])
__device__ __forceinline__ bf16x8 trfrag(const LAS unsigned char* p) {
    const s16x4 lo = __builtin_bit_cast(s16x4, __builtin_amdgcn_ds_read_tr16_b64_v4i16((LAS v4i16_t*)p));
    const s16x4 hh = __builtin_bit_cast(s16x4, __builtin_amdgcn_ds_read_tr16_b64_v4i16((LAS v4i16_t*)(p + 8 * CS_TS)));
    return (bf16x8){lo[0], lo[1], lo[2], lo[3], hh[0], hh[1], hh[2], hh[3]}; }
__device__ __forceinline__ void st_init16(unsigned char* p, const f32x16& x) {
    u32x4 w0, w1; w0.x = cvt_pk(x[0], x[1]); w0.y = cvt_pk(x[2], x[3]); w0.z = cvt_pk(x[4], x[5]); w0.w = cvt_pk(x[6], x[7]);
    w1.x = cvt_pk(x[8], x[9]); w1.y = cvt_pk(x[10], x[11]); w1.z = cvt_pk(x[12], x[13]); w1.w = cvt_pk(x[14], x[15]);
    *(u32x4*)p = w0; *(u32x4*)(p + 16) = w1; }
__device__ __forceinline__ f32x16 ld_init16(const LAS unsigned char* p) {
    const u32x4 w0 = *(const LAS u32x4*)p, w1 = *(const LAS u32x4*)(p + 16); f32x16 x;
    x[0] = bflo(w0.x); x[1] = bfhi(w0.x); x[2] = bflo(w0.y); x[3] = bfhi(w0.y); x[4] = bflo(w0.z); x[5] = bfhi(w0.z); x[6] = bflo(w0.w); x[7] = bfhi(w0.w);
    x[8] = bflo(w1.x); x[9] = bfhi(w1.x); x[10] = bflo(w1.y); x[11] = bfhi(w1.y); x[12] = bflo(w1.z); x[13] = bfhi(w1.z); x[14] = bflo(w1.w); x[15] = bfhi(w1.w); return x; }

struct CsRaw { u32x4 r[4], k[4], a[4], e[4]; bf16 rp, kp; };
__device__ __forceinline__ void cs_load_raw(Frame& F, int l, int bh, int cc, CsRaw& R) {
    const int lane = F.lane, b = bh >> 4, h = bh & 15, pc = lane & 7;
    const size_t row0 = (size_t)b * SEQ + (size_t)cc * CK;
    const bf16* PROJ = WSP(bf16, WS_PROJ); const bf16* AIC = WSP(bf16, WS_AIC); const bf16* WLOG = WSP(bf16, WS_WLOG);
#pragma unroll
    for (int i = 0; i < 4; ++i) { const size_t gr = row0 + (lane >> 3) + 8 * i;
        R.r[i] = *(const u32x4*)(PROJ + gr * PROJ_LD + h * 64 + pc * 8); R.k[i] = *(const u32x4*)(PROJ + gr * PROJ_LD + 1024 + h * 64 + pc * 8);
        R.a[i] = *(const u32x4*)(AIC + gr * 1024 + h * 64 + pc * 8); R.e[i] = *(const u32x4*)(WLOG + gr * 1024 + h * 64 + pc * 8); }
    R.rp = 0; R.kp = 0;
    if (cc > 0) { R.rp = PROJ[(row0 - 1) * PROJ_LD + h * 64 + lane]; R.kp = PROJ[(row0 - 1) * PROJ_LD + 1024 + h * 64 + lane]; }
}
__device__ __forceinline__ void cs_elementwise(Frame& F, ArgsP A, int l, int bh, int cc, LAS unsigned char* wl, const CsRaw& R) {
    const int lane = F.lane, b = bh >> 4, h = bh & 15, ch = h * 64 + lane;
    const size_t row0 = (size_t)b * SEQ + (size_t)cc * CK;
    float* RKB = WSP(float, WS_RKB);
    const bf16* VV = (l == 0) ? WSP(bf16, WS_VF) : WSP(bf16, WS_VV);
    u32x4 vraw[4];
#pragma unroll
    for (int i = 0; i < 4; ++i) vraw[i] = *(const u32x4*)(VV + (row0 + (lane >> 3) + 8 * i) * 1024 + h * 64 + (lane & 7) * 8);
#pragma unroll
    for (int i = 0; i < 4; ++i) { LAS unsigned char* p = wl + ((lane >> 3) + 8 * i) * CS_TS + (lane & 7) * 16;
        *(LAS u32x4*)(p) = R.k[i]; *(LAS u32x4*)(p + CS_TILE) = R.a[i]; *(LAS u32x4*)(p + 2 * CS_TILE) = R.e[i]; *(LAS u32x4*)(p + 3 * CS_TILE) = R.r[i]; }
    const float mur = A->in[I_MU][(size_t)l * RIN + ch], muk = A->in[I_MU][(size_t)l * RIN + 1024 + ch];
    const float ckk = A->in[I_KK][(size_t)l * 1024 + ch], cka = A->in[I_KA][(size_t)l * 1024 + ch], crk = A->in[I_RK][(size_t)l * 1024 + ch];
    float rp = bf1(R.rp), kp_ = bf1(R.kp);
    float lp = 0.f, pexc = 1.f;
    constexpr float L2E = 1.4426950408889634f;
    asm volatile("s_waitcnt lgkmcnt(0)" ::: "memory");
#pragma unroll 8
    for (int tt = 0; tt < CK; ++tt) {
        LAS unsigned char* rowp = wl + tt * CS_TS + lane * 2;
        const float kc = bf1(*(const LAS bf16*)(rowp)), aa = bf1(*(const LAS bf16*)(rowp + CS_TILE)), ee = bf1(*(const LAS bf16*)(rowp + 2 * CS_TILE)), rc = bf1(*(const LAS bf16*)(rowp + 3 * CS_TILE));
        const float rs = rc + (rp - rc) * mur, ks = kc + (kp_ - kc) * muk; rp = rc; kp_ = kc;
        float kk = ks * ckk; const float ss = wave_sum(kk * kk); kk *= rsqrtf(fmaxf(ss, 1e-24f));
        const float kq = ks * (1.f + (aa - 1.f) * cka);
        const float rkb = wave_sum(rs * kq * crk);
        lp += ee;
        const float pinc = __builtin_amdgcn_exp2f(lp * L2E), pinv = __builtin_amdgcn_exp2f(-lp * L2E);
        *(LAS bf16*)(rowp) = f2bf(-kk * pexc);
        *(LAS bf16*)(rowp + CS_TILE) = f2bf(kk * aa * pinv);
        *(LAS bf16*)(rowp + 2 * CS_TILE) = f2bf(kq * pinv);
        *(LAS bf16*)(rowp + 3 * CS_TILE) = f2bf(rs * pinc);
        pexc = pinc;
        if (lane == 0) RKB[(row0 + tt) * 16 + h] = rkb;
    }
    ((LAS float*)(wl + CS_PC))[lane] = __builtin_amdgcn_exp2f(lp * L2E);
#pragma unroll
    for (int i = 0; i < 4; ++i) *(LAS u32x4*)(wl + 4 * CS_TILE + ((lane >> 3) + 8 * i) * CS_TS + (lane & 7) * 16) = vraw[i];
}
__device__ __forceinline__ void cs_mfma(Frame& F, const LAS unsigned char* wl, unsigned char* ub) {
    const int lane = F.lane, r32 = lane & 31, h = lane >> 5, q4 = (lane & 15) >> 2, pp = lane & 3, blk = (lane >> 4) & 1;
    const LAS unsigned char* tA = wl; const LAS unsigned char* tB = wl + CS_TILE; const LAS unsigned char* tK = wl + 2 * CS_TILE;
    const LAS unsigned char* tR = wl + 3 * CS_TILE; const LAS unsigned char* tV = wl + 4 * CS_TILE;
    const int rowoff = r32 * CS_TS + h * 16, troff = (4 * h + q4) * CS_TS + blk * 32 + pp * 8;
#define FROW(t, s) (*(const LAS bf16x8*)((t) + rowoff + (s) * 32))
#define FTR(t, ct, s) trfrag((t) + troff + (s) * 16 * CS_TS + (ct) * 64)
    const f32x16 Z = (f32x16){};
    f32x16 P = Z, PT = Z;
#pragma unroll
    for (int s = 0; s < 4; ++s) { const bf16x8 fa = FROW(tA, s), fb = FROW(tB, s); P = MF32(fb, fa, P); PT = MF32(fa, fb, PT); }
#pragma unroll
    for (int r = 0; r < 16; ++r) { const int cr = crow(r, h); if (!(cr < r32)) P[r] = 0.f; if (!(r32 < cr)) PT[r] = 0.f; }
    f32x16 TmT = PT;
#pragma unroll
    for (int r = 0; r < 16; ++r) if (crow(r, h) == r32) TmT[r] += 1.f;
    f32x16 Tm;
#pragma unroll
    for (int it = 0; it < 4; ++it) {
        const bf16x8 pP0 = PACKS(P, 0), pP1 = PACKS(P, 1), pT0 = PACKS(PT, 0), pT1 = PACKS(PT, 1);
        f32x16 Pn = MF32(pT0, pP0, Z); Pn = MF32(pT1, pP1, Pn);
        f32x16 Y = Pn;
#pragma unroll
        for (int r = 0; r < 16; ++r) if (crow(r, h) == r32) Y[r] += 1.f;
        const bf16x8 y0 = PACKS(Y, 0), y1 = PACKS(Y, 1), t0 = PACKS(TmT, 0), t1 = PACKS(TmT, 1);
        if (it < 3) {
            f32x16 PTn = MF32(pP0, pT0, Z); PTn = MF32(pP1, pT1, PTn);
            f32x16 Tn = MF32(y0, t0, Z); Tn = MF32(y1, t1, Tn);
            P = Pn; PT = PTn; TmT = Tn;
        } else { Tm = MF32(t0, y0, Z); Tm = MF32(t1, y1, Tm); }
    }
    f32x16 W1;
    { f32x16 NakT = Z;
#pragma unroll
      for (int s = 0; s < 4; ++s) NakT = MF32(FROW(tA, s), FROW(tK, s), NakT);
#pragma unroll
      for (int r = 0; r < 16; ++r) if (!(r32 < crow(r, h))) NakT[r] = 0.f;
      W1 = MF32(PACKS(NakT, 0), PACKS(Tm, 0), Z); W1 = MF32(PACKS(NakT, 1), PACKS(Tm, 1), W1); }
    f32x16 ATT[2], G1T[2];
    { const bf16x8 m0 = PACKS(Tm, 0), m1 = PACKS(Tm, 1), w0 = PACKS(W1, 0), w1 = PACKS(W1, 1);
#pragma unroll
      for (int ct = 0; ct < 2; ++ct) { ATT[ct] = MF32(m0, FTR(tA, ct, 0), Z); ATT[ct] = MF32(m1, FTR(tA, ct, 1), ATT[ct]);
                                       G1T[ct] = MF32(w0, FTR(tV, ct, 0), Z); G1T[ct] = MF32(w1, FTR(tV, ct, 1), G1T[ct]); } }
    f32x16 Mbr = Z, Mkr = Z;
#pragma unroll
    for (int s = 0; s < 4; ++s) { const bf16x8 fr = FROW(tR, s); Mbr = MF32(FROW(tB, s), fr, Mbr); Mkr = MF32(FROW(tK, s), fr, Mkr); }
#pragma unroll
    for (int r = 0; r < 16; ++r) if (!(crow(r, h) <= r32)) { Mbr[r] = 0.f; Mkr[r] = 0.f; }
    const bf16x8 b0 = PACKS(Mbr, 0), b1 = PACKS(Mbr, 1), k0 = PACKS(Mkr, 0), k1 = PACKS(Mkr, 1);
#pragma unroll
    for (int kt = 0; kt < 2; ++kt) {
        f32x16 X = MF32(PACKS(ATT[kt], 0), b0, Z); X = MF32(PACKS(ATT[kt], 1), b1, X);
#pragma unroll
        for (int g = 0; g < 4; ++g) { const u32x2 w = *(const LAS u32x2*)(tR + r32 * CS_TS + (32 * kt + 8 * g + 4 * h) * 2);
            X[4 * g] += bflo(w.x); X[4 * g + 1] += bfhi(w.x); X[4 * g + 2] += bflo(w.y); X[4 * g + 3] += bfhi(w.y); }
        *(bf16x8*)(ub + SCU_X + ((2 * kt) * 64 + lane) * 16) = PACKS(X, 0);
        *(bf16x8*)(ub + SCU_X + ((2 * kt + 1) * 64 + lane) * 16) = PACKS(X, 1);
    }
#pragma unroll
    for (int ct = 0; ct < 2; ++ct) {
        f32x16 G = MF32(b0, PACKS(G1T[ct], 0), Z); G = MF32(b1, PACKS(G1T[ct], 1), G);
        G = MF32(k0, FTR(tV, ct, 0), G); G = MF32(k1, FTR(tV, ct, 1), G);
        st_init16(ub + SCU_G2 + (ct * 64 + lane) * 32, G);
    }
    const LAS float* PC = (const LAS float*)(wl + CS_PC);
#pragma unroll
    for (int ct = 0; ct < 2; ++ct) {
        const float pc = PC[32 * ct + r32];
        const bf16x8 f0 = FTR(tB, ct, 0), f1 = FTR(tB, ct, 1);
#pragma unroll
        for (int kt = 0; kt < 2; ++kt) {
            f32x16 Ph = MF32(PACKS(ATT[kt], 0), f0, Z); Ph = MF32(PACKS(ATT[kt], 1), f1, Ph);
            if (kt == ct) {
#pragma unroll
                for (int r = 0; r < 16; ++r) if (crow(r, h) == r32) Ph[r] += 1.f; }
#pragma unroll
            for (int r = 0; r < 16; ++r) Ph[r] *= pc;
            *(bf16x8*)(ub + ((ct * 4 + 2 * kt) * 64 + lane) * 16) = PACKS(Ph, 0);
            *(bf16x8*)(ub + ((ct * 4 + 2 * kt + 1) * 64 + lane) * 16) = PACKS(Ph, 1);
        }
    }
#pragma unroll
    for (int mt = 0; mt < 2; ++mt) {
        const bf16x8 fb0 = FTR(tB, mt, 0), fb1 = FTR(tB, mt, 1), fk0 = FTR(tK, mt, 0), fk1 = FTR(tK, mt, 1);
        float pcr[16];
#pragma unroll
        for (int g = 0; g < 4; ++g) { const f32x4 v = *(const LAS f32x4*)(PC + 32 * mt + 8 * g + 4 * h); pcr[4 * g] = v[0]; pcr[4 * g + 1] = v[1]; pcr[4 * g + 2] = v[2]; pcr[4 * g + 3] = v[3]; }
#pragma unroll
        for (int ct = 0; ct < 2; ++ct) {
            f32x16 Ps = MF32(fb0, PACKS(G1T[ct], 0), Z); Ps = MF32(fb1, PACKS(G1T[ct], 1), Ps);
            Ps = MF32(fk0, FTR(tV, ct, 0), Ps); Ps = MF32(fk1, FTR(tV, ct, 1), Ps);
#pragma unroll
            for (int r = 0; r < 16; ++r) Ps[r] *= pcr[r];
            st_init16(ub + SCU_PSI + ((ct * 2 + mt) * 64 + lane) * 32, Ps);
        }
    }
#undef FROW
#undef FTR
}
__device__ __forceinline__ void cs_pre_phase(Frame& F, ArgsP A, int l) {
    volatile LAS unsigned* cnt = (volatile LAS unsigned*)(F.lds + LDSCTL_OFF);
    if (F.tid == 0) cnt[0] = 0u;
    __syncthreads();
    if (F.wave < CS_NW) {
        LAS unsigned char* wl = F.lds + F.wave * CS_WAVE;
        const int per = (64 * NCHUNK + F.G - 1) / F.G, ubase = F.vcu * per, uend = (ubase + per < 64 * NCHUNK) ? ubase + per : 64 * NCHUNK;
#define CS_NEXT(dst) do { unsigned v_ = 0u; if (F.lane == 0) v_ = __hip_atomic_fetch_add((LAS unsigned*)cnt, 1u, __ATOMIC_RELAXED, __HIP_MEMORY_SCOPE_WORKGROUP); dst = ubase + (int)__builtin_amdgcn_readfirstlane((int)v_); } while (0)
        int u; CS_NEXT(u);
        CsRaw R;
        if (u < uend) cs_load_raw(F, l, u >> 7, u & (NCHUNK - 1), R);
        while (u < uend) {
            cs_elementwise(F, A, l, u >> 7, u & (NCHUNK - 1), wl, R);
            int un; CS_NEXT(un);
            if (un < uend) cs_load_raw(F, l, un >> 7, un & (NCHUNK - 1), R);
            asm volatile("s_waitcnt lgkmcnt(0)" ::: "memory");
            cs_mfma(F, wl, F.ws + WS_SCAN + (size_t)u * SCU_BYTES);
            asm volatile("s_waitcnt lgkmcnt(0)" ::: "memory");
            u = un;
        }
#undef CS_NEXT
    }
}
__device__ __forceinline__ void cs_seq_unit(Frame& F, int bh, int ct) {
    const int lane = F.lane, wave = F.wave, r32 = lane & 31, h = lane >> 5;
    LAS unsigned char* L = F.lds;
    const unsigned char* ub = F.ws + WS_SCAN + (size_t)bh * NCHUNK * SCU_BYTES;
    if (wave > 0) {
        const int w = wave - 1;
        size_t so[3]; int np = 0;
#pragma unroll
        for (int k = 0; k < 3; ++k) { const int p = w + 7 * k; so[k] = p < 12 ? (size_t)p * 1024 : (p < 16 ? (size_t)SCU_PSI + ct * 4096 + (p - 12) * 1024 : (size_t)SCU_G2 + ct * 2048 + (p - 16) * 1024); if (p < 18) np = k + 1; }
#define SQ_ISSUE(c) do { const unsigned char* g_ = ub + (size_t)(c) * SCU_BYTES + lane * 16; LAS unsigned char* d_ = L + ((c) % SQ_NSLOT) * SQ_SLOT; \
        _Pragma("unroll") for (int k = 0; k < 3; ++k) if (k < np) __builtin_amdgcn_global_load_lds((const unsigned*)(g_ + so[k]), (LAS unsigned*)(d_ + (w + 7 * k) * 1024), 16, 0, 0); } while (0)
        for (int c = 0; c < 6; ++c) SQ_ISSUE(c);
        if (np == 3) asm volatile("s_waitcnt vmcnt(15)" ::: "memory"); else asm volatile("s_waitcnt vmcnt(10)" ::: "memory");
        asm volatile("s_barrier" ::: "memory");
        for (int c = 0; c < NCHUNK; ++c) {
            if (c + 6 < NCHUNK) { SQ_ISSUE(c + 6); if (np == 3) asm volatile("s_waitcnt vmcnt(15)" ::: "memory"); else asm volatile("s_waitcnt vmcnt(10)" ::: "memory"); }
            else asm volatile("s_waitcnt vmcnt(0)" ::: "memory");
            asm volatile("s_barrier" ::: "memory");
        }
#undef SQ_ISSUE
    } else {
        f32x16 S0 = (f32x16){}, S1 = (f32x16){};
        const int b = bh >> 4, hh = bh & 15;
        bf16* op = (bf16*)(F.ws + WS_Y) + ((size_t)b * SEQ) * 1024 + hh * 64 + 32 * ct + r32;
        asm volatile("s_barrier" ::: "memory");
        for (int c = 0; c < NCHUNK; ++c) {
            const LAS unsigned char* sl = L + (c % SQ_NSLOT) * SQ_SLOT;
            const bf16x8 bS0 = PACKS(S0, 0), bS1 = PACKS(S0, 1), bS2 = PACKS(S1, 0), bS3 = PACKS(S1, 1);
            f32x16 n0 = ld_init16(sl + 12288 + (0 * 64 + lane) * 32), n1 = ld_init16(sl + 12288 + (1 * 64 + lane) * 32);
            const f32x16 Z = (f32x16){};
            f32x16 m0 = MF32(*(const LAS bf16x8*)(sl + (2 * 64 + lane) * 16), bS2, Z), m1 = MF32(*(const LAS bf16x8*)(sl + (6 * 64 + lane) * 16), bS2, Z);
            n0 = MF32(*(const LAS bf16x8*)(sl + (0 * 64 + lane) * 16), bS0, n0); n1 = MF32(*(const LAS bf16x8*)(sl + (4 * 64 + lane) * 16), bS0, n1);
            m0 = MF32(*(const LAS bf16x8*)(sl + (3 * 64 + lane) * 16), bS3, m0); m1 = MF32(*(const LAS bf16x8*)(sl + (7 * 64 + lane) * 16), bS3, m1);
            n0 = MF32(*(const LAS bf16x8*)(sl + (1 * 64 + lane) * 16), bS1, n0); n1 = MF32(*(const LAS bf16x8*)(sl + (5 * 64 + lane) * 16), bS1, n1);
            f32x16 o = ld_init16(sl + 16384 + lane * 32);
            o = MF32(*(const LAS bf16x8*)(sl + 8192 + (0 * 64 + lane) * 16), bS0, o); o = MF32(*(const LAS bf16x8*)(sl + 8192 + (1 * 64 + lane) * 16), bS1, o);
            o = MF32(*(const LAS bf16x8*)(sl + 8192 + (2 * 64 + lane) * 16), bS2, o); o = MF32(*(const LAS bf16x8*)(sl + 8192 + (3 * 64 + lane) * 16), bS3, o);
            S0 = n0 + m0; S1 = n1 + m1;
#pragma unroll
            for (int r = 0; r < 16; ++r) op[(size_t)(c * CK + crow(r, h)) * 1024] = f2bf(o[r]);
            asm volatile("s_waitcnt lgkmcnt(0)\n\ts_barrier" ::: "memory");
        }
    }
    asm volatile("s_waitcnt vmcnt(0)" ::: "memory");
    __syncthreads();
}

__device__ __forceinline__ void rwkv_post_phase(Frame& F, ArgsP A, int l) {
    const int gw = F.vcu * NWAVES + F.wave, NGW = F.G * NWAVES, lane = F.lane, c0 = lane * 16, head = lane >> 2;
    const bf16* ORAW = WSP(bf16, WS_Y); const float* RKB = WSP(float, WS_RKB);
    const bf16* VV = (l == 0) ? WSP(bf16, WS_VF) : WSP(bf16, WS_VV); const bf16* GATE = WSP(bf16, WS_GATE);
    float lg[16], lb[16];
#pragma unroll
    for (int i = 0; i < 16; ++i) { lg[i] = A->in[I_LNG][(size_t)l * 1024 + c0 + i]; lb[i] = A->in[I_LNB][(size_t)l * 1024 + c0 + i]; }
    for (int m = gw; m < T; m += NGW) {
        float o[16];
#pragma unroll
        for (int j = 0; j < 2; ++j) { float t8[8]; unpack8(*(const u32x4*)(ORAW + (size_t)m * 1024 + c0 + 8 * j), t8);
#pragma unroll
            for (int i = 0; i < 8; ++i) o[8 * j + i] = t8[i]; }
        float s = 0.f;
#pragma unroll
        for (int i = 0; i < 16; ++i) s += o[i];
        s = sum4(s);
        const float mean = s * (1.f / 64.f); float q = 0.f;
#pragma unroll
        for (int i = 0; i < 16; ++i) { o[i] -= mean; q += o[i] * o[i]; }
        q = sum4(q);
        const float rstd = rsqrtf(q * (1.f / 64.f) + GN_EPS);
        const float rkb = RKB[(size_t)m * 16 + head];
        float vv[16], gg[16];
        { float t8[8]; unpack8(*(const u32x4*)(VV + (size_t)m * 1024 + c0), t8);
#pragma unroll
          for (int i = 0; i < 8; ++i) vv[i] = t8[i];
          unpack8(*(const u32x4*)(VV + (size_t)m * 1024 + c0 + 8), t8);
#pragma unroll
          for (int i = 0; i < 8; ++i) vv[8 + i] = t8[i];
          unpack8(*(const u32x4*)(GATE + (size_t)m * 1024 + c0), t8);
#pragma unroll
          for (int i = 0; i < 8; ++i) gg[i] = t8[i];
          unpack8(*(const u32x4*)(GATE + (size_t)m * 1024 + c0 + 8), t8);
#pragma unroll
          for (int i = 0; i < 8; ++i) gg[8 + i] = t8[i]; }
        float y[16];
#pragma unroll
        for (int i = 0; i < 16; ++i) y[i] = (o[i] * rstd * lg[i] + lb[i] + rkb * vv[i]) * gg[i];
        bf16* dst = WSP(bf16, WS_AO) + (size_t)m * D + c0;
        u32x4 w0, w1; w0.x = cvt_pk(y[0], y[1]); w0.y = cvt_pk(y[2], y[3]); w0.z = cvt_pk(y[4], y[5]); w0.w = cvt_pk(y[6], y[7]);
        w1.x = cvt_pk(y[8], y[9]); w1.y = cvt_pk(y[10], y[11]); w1.z = cvt_pk(y[12], y[13]); w1.w = cvt_pk(y[14], y[15]);
        *(u32x4*)dst = w0; *(u32x4*)(dst + 8) = w1;
    }
}

__device__ __forceinline__ void ew_norm_phase(Frame& F, const float* gpost, bool last) {
    const int gw = F.vcu * NWAVES + F.wave, NGW = F.G * NWAVES, lane = F.lane;
    const bf16* Y = WSP(bf16, WS_Y); bf16* U = WSP(bf16, WS_U); float* RMS = WSP(float, WS_RMS);
    for (int m = gw; m < T; m += NGW) {
        float y[32]; float ss = 0.f;
#pragma unroll
        for (int j = 0; j < 4; ++j) { float t8[8]; unpack8(*(const u32x4*)(Y + (size_t)m * D + lane * 8 + 512 * j), t8);
#pragma unroll
            for (int i = 0; i < 8; ++i) { y[8 * j + i] = t8[i]; ss += t8[i] * t8[i]; } }
        const float rold = RMS[m];
        const float rstd = rsqrtf(wave_sum(ss) * (1.f / 2048.f) + NORM_EPS);
        float hn[32]; float s2 = 0.f;
#pragma unroll
        for (int j = 0; j < 4; ++j) { const int c = lane * 8 + 512 * j;
            float h8[8]; unpack8(*(const u32x4*)(U + (size_t)m * D + c), h8);
            const f32x4 g0 = *(const f32x4*)(gpost + c), g1 = *(const f32x4*)(gpost + c + 4);
#pragma unroll
            for (int i = 0; i < 4; ++i) { hn[8 * j + i] = h8[i] * rold + y[8 * j + i] * rstd * g0[i]; hn[8 * j + 4 + i] = h8[4 + i] * rold + y[8 * j + 4 + i] * rstd * g1[i]; }
            if (last) { float* hp = F.H + (size_t)m * D + c; *(f32x4*)hp = (f32x4){hn[8 * j], hn[8 * j + 1], hn[8 * j + 2], hn[8 * j + 3]}; *(f32x4*)(hp + 4) = (f32x4){hn[8 * j + 4], hn[8 * j + 5], hn[8 * j + 6], hn[8 * j + 7]}; }
#pragma unroll
            for (int i = 0; i < 8; ++i) s2 += hn[8 * j + i] * hn[8 * j + i]; }
        if (!last) {
            const float ms = wave_sum(s2) * (1.f / 2048.f) + NORM_EPS, r2 = rsqrtf(ms);
            if (lane == 0) RMS[m] = ms * r2;
#pragma unroll
            for (int j = 0; j < 4; ++j) { const int c = lane * 8 + 512 * j;
                u32x4 w; w.x = cvt_pk(hn[8 * j] * r2, hn[8 * j + 1] * r2); w.y = cvt_pk(hn[8 * j + 2] * r2, hn[8 * j + 3] * r2);
                w.z = cvt_pk(hn[8 * j + 4] * r2, hn[8 * j + 5] * r2); w.w = cvt_pk(hn[8 * j + 6] * r2, hn[8 * j + 7] * r2);
                *(u32x4*)(U + (size_t)m * D + c) = w; }
        }
    }
}

template <int DQK, bool CAUSAL>
__device__ __forceinline__ void attn_unit(LAS unsigned char* lds, const bf16* __restrict__ Q, int ldq, const bf16* __restrict__ K1, int ldk1, const bf16* __restrict__ K2, int ldk2,
                                          const bf16* __restrict__ V, int ldv, bf16* __restrict__ O, int ldo, int qpos0, int ntiles) {
    constexpr int KROW = DQK * 2, KT = 64 * KROW, VT = 16384, ND0 = DQK / 16, NKC = DQK / 64;
    int tid = threadIdx.x; asm volatile("" : "+v"(tid));
    const int lane = tid & 63, wid = __builtin_amdgcn_readfirstlane(tid >> 6), r32 = lane & 31, hi = lane >> 5;
    LAS unsigned char* Kl = lds; LAS unsigned char* Vl = lds + 2 * KT;
    bf16x8 qr[ND0];
    { const bf16* qrow = Q + (size_t)(wid * 32 + r32) * ldq;
#pragma unroll
      for (int d0 = 0; d0 < ND0; ++d0) qr[d0] = *(const bf16x8*)(qrow + d0 * 16 + hi * 8); }
    unsigned ksoff[NKC]; int kdst[NKC];
#pragma unroll
    for (int i = 0; i < NKC; ++i) { int row, cc;
        if (i < 2) { const int c = tid + 512 * i; row = c >> 4; cc = c & 15; ksoff[i] = (unsigned)(row * ldk1 + cc * 8) * 2u; }
        else { row = tid >> 3; cc = 16 + (tid & 7); ksoff[i] = (unsigned)(row * ldk2 + (cc - 16) * 8) * 2u; }
        const int cs = DQK == 192 ? ((cc & ~7) | ((cc ^ (row >> 1)) & 7)) : (cc ^ (row & 15));
        kdst[i] = row * KROW + cs * 16; }
    unsigned vsoff[2]; int vdst[2];
#pragma unroll
    for (int i = 0; i < 2; ++i) { const int c = tid + 512 * i, row = c >> 4, cc = c & 15; vsoff[i] = (unsigned)(row * ldv + cc * 8) * 2u; vdst[i] = row * 256 + ((cc * 16) ^ ((row & 3) << 6)); }
    constexpr int NKO = DQK == 192 ? 4 : 8;
    int koff[NKO];
#pragma unroll
    for (int j = 0; j < NKO; ++j) { const int cc = 2 * j + hi; const int cs = DQK == 192 ? ((cc ^ (r32 >> 1)) & 7) : (cc ^ (r32 & 15)); koff[j] = r32 * KROW + cs * 16; }
#define AT_KOFF(d0) (DQK == 192 ? koff[(d0) & 3] + ((d0) >> 2) * 128 : koff[(d0) & 7])
    const int q4 = (lane & 15) >> 2, pp = lane & 3, blk = (lane >> 4) & 1;
    int voff[4];
#pragma unroll
    for (int d0 = 0; d0 < 4; ++d0) voff[d0] = (4 * hi + q4) * 256 + (((d0 ^ q4) << 6) | (blk << 5) | (pp << 3));
    u32x4 ks[NKC], vs[2];
#define AT_LOAD(t) do { const char* k1b = (const char*)K1 + (size_t)(t) * 64 * ldk1 * 2; const char* k2b = (const char*)K2 + (size_t)(t) * 64 * ldk2 * 2; const char* vb = (const char*)V + (size_t)(t) * 64 * ldv * 2; \
        _Pragma("unroll") for (int i = 0; i < NKC; ++i) ks[i] = *(const u32x4*)((i < 2 ? k1b : k2b) + ksoff[i]); \
        _Pragma("unroll") for (int i = 0; i < 2; ++i) vs[i] = *(const u32x4*)(vb + vsoff[i]); } while (0)
#define AT_WRITE(bf) do { _Pragma("unroll") for (int i = 0; i < NKC; ++i) *(LAS u32x4*)(Kl + (bf) * KT + kdst[i]) = ks[i]; \
        _Pragma("unroll") for (int i = 0; i < 2; ++i) *(LAS u32x4*)(Vl + (bf) * VT + vdst[i]) = vs[i]; } while (0)
    float m_run = -1e30f, l_run = 0.f; f32x16 o[4];
#pragma unroll
    for (int d0 = 0; d0 < 4; ++d0) o[d0] = (f32x16){};
    AT_LOAD(0); AT_WRITE(0);
    __syncthreads();
    const int qpos = qpos0 + wid * 32 + r32;
    for (int t = 0; t < ntiles; ++t) {
        const int bf = t & 1;
        if (t + 1 < ntiles) AT_LOAD(t + 1);
        f32x16 p0 = (f32x16){}, p1 = (f32x16){};
#pragma unroll
        for (int d0 = 0; d0 < ND0; ++d0) {
            const bf16x8 a0 = *(const LAS bf16x8*)(Kl + bf * KT + AT_KOFF(d0));
            const bf16x8 a1 = *(const LAS bf16x8*)(Kl + bf * KT + AT_KOFF(d0) + 32 * KROW);
            p0 = __builtin_amdgcn_mfma_f32_32x32x16_bf16(a0, qr[d0], p0, 0, 0, 0);
            p1 = __builtin_amdgcn_mfma_f32_32x32x16_bf16(a1, qr[d0], p1, 0, 0, 0);
        }
        if (CAUSAL) { const int kv0 = t * 64;
            if (kv0 + 63 > qpos0 + wid * 32) { const float NEG = -__builtin_inff();
#pragma unroll
                for (int r = 0; r < 16; ++r) { const int key = kv0 + crow(r, hi); if (key > qpos) p0[r] = NEG; if (key + 32 > qpos) p1[r] = NEG; } } }
        float mx = p0[0];
#pragma unroll
        for (int r = 1; r < 16; ++r) mx = fmaxf(mx, p0[r]);
#pragma unroll
        for (int r = 0; r < 16; ++r) mx = fmaxf(mx, p1[r]);
        { auto rr = __builtin_amdgcn_permlane32_swap(__float_as_uint(mx), __float_as_uint(mx), false, false); mx = fmaxf(__uint_as_float(rr[0]), __uint_as_float(rr[1])); }
        if (__any(mx > m_run + 8.f)) {
            const float mn = fmaxf(m_run, mx), alpha = __builtin_amdgcn_exp2f(m_run - mn); m_run = mn; l_run *= alpha;
#pragma unroll
            for (int d0 = 0; d0 < 4; ++d0)
#pragma unroll
                for (int r = 0; r < 16; ++r) o[d0][r] *= alpha;
        }
        float ps = 0.f;
#pragma unroll
        for (int r = 0; r < 16; ++r) { p0[r] = __builtin_amdgcn_exp2f(p0[r] - m_run); p1[r] = __builtin_amdgcn_exp2f(p1[r] - m_run); ps += p0[r] + p1[r]; }
        l_run += ps;
        bf16x8 pa[4];
        { u32x4 w;
          w.x = cvt_pk(p0[0], p0[1]); w.y = cvt_pk(p0[2], p0[3]); w.z = cvt_pk(p0[4], p0[5]); w.w = cvt_pk(p0[6], p0[7]); pa[0] = __builtin_bit_cast(bf16x8, w);
          w.x = cvt_pk(p0[8], p0[9]); w.y = cvt_pk(p0[10], p0[11]); w.z = cvt_pk(p0[12], p0[13]); w.w = cvt_pk(p0[14], p0[15]); pa[1] = __builtin_bit_cast(bf16x8, w);
          w.x = cvt_pk(p1[0], p1[1]); w.y = cvt_pk(p1[2], p1[3]); w.z = cvt_pk(p1[4], p1[5]); w.w = cvt_pk(p1[6], p1[7]); pa[2] = __builtin_bit_cast(bf16x8, w);
          w.x = cvt_pk(p1[8], p1[9]); w.y = cvt_pk(p1[10], p1[11]); w.z = cvt_pk(p1[12], p1[13]); w.w = cvt_pk(p1[14], p1[15]); pa[3] = __builtin_bit_cast(bf16x8, w); }
#pragma unroll
        for (int d0 = 0; d0 < 4; ++d0)
#pragma unroll
            for (int s = 0; s < 4; ++s) {
                const LAS unsigned char* vp = Vl + bf * VT + voff[d0] + s * 4096;
                const s16x4 lo = __builtin_bit_cast(s16x4, __builtin_amdgcn_ds_read_tr16_b64_v4i16((LAS v4i16_t*)vp));
                const s16x4 hh = __builtin_bit_cast(s16x4, __builtin_amdgcn_ds_read_tr16_b64_v4i16((LAS v4i16_t*)(vp + 2048)));
                const bf16x8 vf = (bf16x8){lo[0], lo[1], lo[2], lo[3], hh[0], hh[1], hh[2], hh[3]};
                o[d0] = __builtin_amdgcn_mfma_f32_32x32x16_bf16(vf, pa[s], o[d0], 0, 0, 0);
            }
        if (t + 1 < ntiles) AT_WRITE(bf ^ 1);
        __syncthreads();
    }
    { auto rr = __builtin_amdgcn_permlane32_swap(__float_as_uint(l_run), __float_as_uint(l_run), false, false); l_run = __uint_as_float(rr[0]) + __uint_as_float(rr[1]); }
    const float inv = __builtin_amdgcn_rcpf(l_run);
    bf16* orow = O + (size_t)(wid * 32 + r32) * ldo;
#pragma unroll
    for (int d0 = 0; d0 < 4; ++d0)
#pragma unroll
        for (int g = 0; g < 4; ++g) { u32x2 w; w.x = cvt_pk(o[d0][4 * g] * inv, o[d0][4 * g + 1] * inv); w.y = cvt_pk(o[d0][4 * g + 2] * inv, o[d0][4 * g + 3] * inv);
            *(u32x2*)(orow + d0 * 32 + 8 * g + 4 * hi) = w; }
#undef AT_LOAD
#undef AT_WRITE
#undef AT_KOFF
}

__global__ void __launch_bounds__(NTHR, 2) fwd(Args args) {
    extern __shared__ __attribute__((aligned(16))) unsigned char lds_raw[];
    Frame F;
    F.lds = (LAS unsigned char*)lds_raw;
    F.tid = threadIdx.x; F.lane = F.tid & 63; F.wave = __builtin_amdgcn_readfirstlane(F.tid >> 6);
    F.G = gridDim.x; { const int bx = blockIdx.x; F.vcu = (F.G % 8 == 0) ? (bx % 8) * (F.G / 8) + bx / 8 : bx; }
    F.ws = args.ws; F.H = args.out;
    volatile LAS unsigned* MISC = (volatile LAS unsigned*)(F.lds + MISC_OFF);
    for (int u = F.tid; u < (LDS_BYTES - LDSCTL_OFF) / 4; u += NTHR) ((LAS unsigned*)(F.lds + LDSCTL_OFF))[u] = 0u;
    __syncthreads();
    unsigned* ctl = (unsigned*)(F.ws + WS_CTL);
    XcdBarrier bar; bar.bar = ctl + CW_BAR; bar.x = 0; bar.st = nullptr;
    if (ONE_LAUNCH) bar = xcd_barrier_post(ctl + CW_BAR, MISC + 8);
    const int lo = args.lo, hi = args.hi;
#ifndef PH_MASK
#define PH_MASK 0xfffffu
#endif
#define PHON(j) (((PH_MASK) >> (j)) & 1u)
#define IN(k) (lo <= (k) && (k) < hi)
#define PHASE_RELOAD() do { t_ = threadIdx.x; asm volatile("" : "+v"(t_)); F.tid = t_; F.lane = t_ & 63; F.wave = __builtin_amdgcn_readfirstlane(t_ >> 6); \
        A = (ArgsP)__builtin_amdgcn_kernarg_segment_ptr(); asm volatile("" : "+s"(A)); F.ws = A->ws; F.H = A->out; \
        { int g_ = gridDim.x, b_ = blockIdx.x; asm volatile("" : "+s"(g_), "+s"(b_)); F.G = g_; F.bx = b_; F.vcu = (g_ % 8 == 0) ? (b_ % 8) * (g_ / 8) + b_ / 8 : b_; } } while (0)
#define PHASE_BEGIN() int t_; ArgsP A; PHASE_RELOAD()
#define SEAM(k) do { if (IN(k) && IN((k) + 1)) { if (ONE_LAUNCH) xcd_barrier(bar); } } while (0)

    if (PHON(0) && IN(0)) { PHASE_BEGIN(); p0_prologue(F, A); SEAM(0); }

    for (int l = 0; l < NL; ++l) {
        const int pb = 1 + l * NPH;
        if (PHON(1) && IN(pb + 0)) { PHASE_BEGIN();
            const int N = (l == 0) ? INW : PROJ_LD;
            pg8::Gemm g{WSP(bf16, WS_U), WSP(bf16, WL(WO_IN)), T, N, D, D, D}; pg8::StaticOrder S; S.init(T, N, F.G, F.bx);
            pg8::Epi8<FPlain> E{{WSP(bf16, WS_PROJ), PROJ_LD, 1.f}};
            pg8::gemm_phase(F.lds, g, S, E);
            {
                PHASE_RELOAD();
                const int rem = ((T / 256) * (N / 256)) % F.G;
                if (rem != 0 && F.bx >= rem) convert_layer(F, A, l, 2, (F.bx - rem) * NWAVES + F.wave, (F.G - rem) * NWAVES);
                else if (rem == 0) convert_layer(F, A, l, 2, F.bx * NWAVES + F.wave, F.G * NWAVES);
            }
            SEAM(pb + 0);
        }
        if (PHON(2) && IN(pb + 1)) { PHASE_BEGIN(); prep_phase(F, A, l); SEAM(pb + 1); }
        if (PHON(3) && IN(pb + 2)) { PHASE_BEGIN();
            {
            { pg8::Gemm g{WSP(bf16, WS_LORA), WSP(bf16, WL(WO_UP)), T, 1024, 128, LORA_LD, 128}; pg8::StaticOrder S; S.init(T, 1024, F.G, F.bx);
              pg8::Epi8<FSig<0>> E{{WSP(bf16, WS_WLOG), 1024, A->in[I_W0] + (size_t)l * 1024}}; pg8::gemm_phase(F.lds, g, S, E); }
            PHASE_RELOAD();
            { pg8::Gemm g{WSP(bf16, WS_LORA) + 128, WSP(bf16, WL(WO_AUP)), T, 1024, 128, LORA_LD, 128}; pg8::StaticOrder S; S.init(T, 1024, F.G, F.bx);
              pg8::Epi8<FSig<1>> E{{WSP(bf16, WS_AIC), 1024, A->in[I_A0] + (size_t)l * 1024}}; pg8::gemm_phase(F.lds, g, S, E); }
            PHASE_RELOAD();
            { pg8::Gemm g{WSP(bf16, WS_LORA) + 256, WSP(bf16, WL(WO_GUP)), T, 1024, 256, LORA_LD, 256}; pg8::StaticOrder S; S.init(T, 1024, F.G, F.bx);
              pg8::Epi8<FPlain> E{{WSP(bf16, WS_GATE), 1024, 1.f}}; pg8::gemm_phase(F.lds, g, S, E); }
            PHASE_RELOAD();
            if (l > 0) { pg8::Gemm g{WSP(bf16, WS_LORA) + 512, WSP(bf16, WL(WO_VUP)), T, 1024, 128, LORA_LD, 128}; pg8::StaticOrder S; S.init(T, 1024, F.G, F.bx);
              pg8::Epi8<FVup> E{{WSP(bf16, WS_VV), A->in[I_V0] + (size_t)(l - 1) * 1024, A->in[I_MU] + (size_t)l * RIN + 2048, WSP(bf16, WS_PROJ), WSP(bf16, WS_VF)}}; pg8::gemm_phase(F.lds, g, S, E); }
            PHASE_RELOAD();
            { pg8::Gemm g{WSP(bf16, WS_CQN), WSP(bf16, WL(WO_UQ)), T, 1536, 512, 512, 512}; pg8::StaticOrder S; S.init(T, 1536, F.G, F.bx);
              pg8::Epi8<FQ> E{{WSP(bf16, WS_QB), WSP(float, WS_COS), WSP(float, WS_SIN)}}; pg8::gemm_phase(F.lds, g, S, E); }
            PHASE_RELOAD();
            { pg8::Gemm g{WSP(bf16, WS_CKVN), WSP(bf16, WL(WO_UKV)), T, 2048, 256, 256, 256}; pg8::StaticOrder S; S.init(T, 2048, F.G, F.bx);
              pg8::Epi8<FPlain> E{{WSP(bf16, WS_KV), 2048, 1.f}}; pg8::gemm_phase(F.lds, g, S, E); }
            }
            SEAM(pb + 2);
        }
        if (PHON(4) && IN(pb + 3)) { PHASE_BEGIN();
            cs_pre_phase(F, A, l);
            SEAM(pb + 3);
        }
        if (PHON(5) && IN(pb + 4)) { PHASE_BEGIN();
            if (F.G == 256) {
                const int x = F.bx & 7, i = F.bx >> 3;
                if (i < 16) { const int u = x * 16 + i; cs_seq_unit(F, u >> 1, u & 1); }
                else convert_layer(F, A, l, 3, (x * 16 + i - 16) * NWAVES + F.wave, 128 * NWAVES);
            } else {
            for (int u = F.vcu; u < 128; u += F.G) cs_seq_unit(F, u >> 1, u & 1);
            if (F.G > 128 && F.vcu >= 128) convert_layer(F, A, l, 3, (F.vcu - 128) * NWAVES + F.wave, (F.G - 128) * NWAVES);
            else if (F.G <= 128) convert_layer(F, A, l, 3, F.vcu * NWAVES + F.wave, F.G * NWAVES);
            }
            __syncthreads();
        }
        if (PHON(6) && IN(pb + 5)) { PHASE_BEGIN();
            volatile LAS unsigned* msc = (volatile LAS unsigned*)(F.lds + MISC_OFF);
            const int nq = F.G >= 8 ? 1 : 8;
            for (int qi = 0; qi < nq; ++qi) {
                const int q = (F.bx + qi) & 7;
                unsigned* cnt = (unsigned*)(F.ws + WS_CTL) + CW_ATT + (l * 8 + q) * 64;
                for (;;) {
                    if (F.tid == 0) msc[12] = xb_add(cnt, 1u);
                    __syncthreads();
                    const int v = __builtin_amdgcn_readfirstlane((int)msc[12]);
                    __syncthreads();
                    if (v >= 64) break;
                    const int qb = 15 - (v >> 2), bh = 4 * q + (v & 3), b = bh >> 3, hh = bh & 7; const size_t r0 = (size_t)b * SEQ;
                    attn_unit<192, true>(F.lds, WSP(bf16, WS_QB) + (r0 + qb * 256) * 1536 + hh * 192, 1536,
                                         WSP(bf16, WS_KV) + r0 * 2048 + hh * 256, 2048, WSP(bf16, WS_KR) + r0 * 64, 64,
                                         WSP(bf16, WS_KV) + r0 * 2048 + hh * 256 + 128, 2048,
                                         WSP(bf16, WS_AO) + (r0 + qb * 256) * D + 1024 + hh * 128, D, qb * 256, 4 * (qb + 1));
                }
            }
            SEAM(pb + 5);
        }
        if (PHON(7) && IN(pb + 6)) { PHASE_BEGIN(); rwkv_post_phase(F, A, l); SEAM(pb + 6); }
        if (PHON(8) && IN(pb + 7)) { PHASE_BEGIN();
            pg8::Gemm g{WSP(bf16, WS_AO), WSP(bf16, WL(WO_OUT)), T, D, D, D, D}; pg8::StaticOrder S; S.init(T, D, F.G, F.bx);
            pg8::Epi8<FPlain> E{{WSP(bf16, WS_Y), D, 1.f}}; pg8::gemm_phase(F.lds, g, S, E);
            SEAM(pb + 7);
        }
        if (PHON(9) && IN(pb + 8)) { PHASE_BEGIN(); ew_norm_phase(F, A->in[I_MIXPOST] + (size_t)l * D, false); SEAM(pb + 8); }
        if (PHON(10) && IN(pb + 9)) { PHASE_BEGIN();
            pg8::Gemm g{WSP(bf16, WS_U), WSP(bf16, WL(WO_QM)), T, 512, D, D, D}; pg8::StaticOrder S; S.init(T, 512, F.G, F.bx);
            pg8::Epi8<FPlain> E{{WSP(bf16, WS_QMEM), 512, QSCALE_MEM}}; pg8::gemm_phase(F.lds, g, S, E);
            PHASE_RELOAD();
            { pg8::Gemm g2{WSP(bf16, WS_MEMN), WSP(bf16, WL(WO_KM)), NB * NMEM, 512, D, D, D}; pg8::StaticOrder S2; S2.init(NB * NMEM, 512, F.G, (F.bx + F.G - 128 % F.G) % F.G);
              pg8::Epi8<FPlain> E2{{WSP(bf16, WS_MEMK), 512, 1.f}}; pg8::gemm_phase(F.lds, g2, S2, E2); }
            PHASE_RELOAD();
            { pg8::Gemm g2{WSP(bf16, WS_MEMN), WSP(bf16, WL(WO_VM)), NB * NMEM, 512, D, D, D}; pg8::StaticOrder S2; S2.init(NB * NMEM, 512, F.G, (F.bx + F.G - 136 % F.G) % F.G);
              pg8::Epi8<FPlain> E2{{WSP(bf16, WS_MEMV), 512, 1.f}}; pg8::gemm_phase(F.lds, g2, S2, E2); }
            if (l + 1 < NL) { PHASE_RELOAD();
                if (F.G > 144 && F.bx >= 144) convert_layer(F, A, l + 1, 1, (F.bx - 144) * NWAVES + F.wave, (F.G - 144) * NWAVES);
                else if (F.G <= 144) convert_layer(F, A, l + 1, 1, F.bx * NWAVES + F.wave, F.G * NWAVES); }
            SEAM(pb + 9);
        }
        if (PHON(11) && IN(pb + 10)) { PHASE_BEGIN();
            for (int u = F.vcu; u < 256; u += F.G) {
                const int bh = u >> 4, qb = u & 15, b = bh >> 2, hh = bh & 3; const size_t r0 = (size_t)b * SEQ + qb * 256;
                attn_unit<128, false>(F.lds, WSP(bf16, WS_QMEM) + r0 * 512 + hh * 128, 512,
                                      WSP(bf16, WS_MEMK) + (size_t)b * NMEM * 512 + hh * 128, 512, nullptr, 0,
                                      WSP(bf16, WS_MEMV) + (size_t)b * NMEM * 512 + hh * 128, 512,
                                      WSP(bf16, WS_OMEM) + r0 * 512 + hh * 128, 512, 0, NMEM / 64);
            }
            SEAM(pb + 10);
        }
        if (PHON(12) && IN(pb + 11)) { PHASE_BEGIN();
            pg8::Gemm g{WSP(bf16, WS_OMEM), WSP(bf16, WL(WO_OM)), T, D, 512, 512, 512}; pg8::StaticOrder S; S.init(T, D, F.G, F.bx);
            pg8::Epi8<FPlain> E{{WSP(bf16, WS_Y), D, 1.f}}; pg8::gemm_phase(F.lds, g, S, E);
            SEAM(pb + 11);
        }
        if (PHON(13) && IN(pb + 12)) { PHASE_BEGIN(); ew_norm_phase(F, A->in[I_MEMPOST] + (size_t)l * D, false); SEAM(pb + 12); }
        if (PHON(14) && IN(pb + 13)) { PHASE_BEGIN();
            pg8::Gemm g{WSP(bf16, WS_U), WSP(bf16, WL(WO_FF1)), T, FF, D, D, D}; pg8::StaticOrder S; S.init(T, FF, F.G, F.bx);
            pg8::Epi8<FRelu2> E{{WSP(bf16, WS_HID), FF}}; pg8::gemm_phase(F.lds, g, S, E);
            SEAM(pb + 13);
        }
        if (PHON(15) && IN(pb + 14)) { PHASE_BEGIN();
            pg8::Gemm g{WSP(bf16, WS_HID), WSP(bf16, WL(WO_FF2)), T, D, FF, FF, FF}; pg8::StaticOrder S; S.init(T, D, F.G, F.bx);
            pg8::Epi8<FPlain> E{{WSP(bf16, WS_Y), D, 1.f}}; pg8::gemm_phase(F.lds, g, S, E);
            SEAM(pb + 14);
        }
        if (PHON(16) && IN(pb + 15)) { PHASE_BEGIN(); ew_norm_phase(F, A->in[I_FFNPOST] + (size_t)l * D, l + 1 == NL); SEAM(pb + 15); }
    }
#undef IN
#undef SEAM
}

extern "C" void kernel_launch(void* const* d_in, const int* in_sizes, int n_in, void* d_out, int out_size, void* d_ws, size_t ws_size, hipStream_t stream) {
    static int grid = 0;
    if (grid == 0) {
        if (n_in != N_IN || out_size != T * D || ws_size < WS_END) { fprintf(stderr, "kernel_launch: unexpected shapes (n_in %d, out %d, ws %zu)\n", n_in, out_size, ws_size); grid = -1; return; }
        int dev = 0, cus = 0;
        if (hipGetDevice(&dev) != hipSuccess || hipDeviceGetAttribute(&cus, hipDeviceAttributeMultiprocessorCount, dev) != hipSuccess) { grid = -1; return; }
        if (hipFuncSetAttribute((const void*)fwd, hipFuncAttributeMaxDynamicSharedMemorySize, LDS_BYTES) != hipSuccess) { fprintf(stderr, "kernel_launch: hipFuncSetAttribute failed\n"); grid = -1; return; }
        int per_cu = 0;
        if (hipOccupancyMaxActiveBlocksPerMultiprocessor(&per_cu, (const void*)fwd, NTHR, LDS_BYTES) != hipSuccess || per_cu < 1) fprintf(stderr, "kernel_launch: occupancy query says %d\n", per_cu);
        (void)hipGetLastError();
        grid = cus;
    }
    if (grid < 0) return;
    (void)hipMemsetAsync((char*)d_ws + WS_CTL, 0, CTL_BYTES, stream);
    Args a{};
    for (int i = 0; i < N_IN; ++i) a.in[i] = (const float*)d_in[i];
    a.out = (float*)d_out; a.ws = (unsigned char*)d_ws;
    const int nph = NPHASES < STOP_PHASE ? NPHASES : STOP_PHASE;
    if (ONE_LAUNCH) { a.lo = 0; a.hi = nph; hipLaunchKernelGGL(fwd, dim3(grid), dim3(NTHR), LDS_BYTES, stream, a); }
    else { for (int p = 0; p < nph; ++p) { a.lo = p; a.hi = p + 1; hipLaunchKernelGGL(fwd, dim3(grid), dim3(NTHR), LDS_BYTES, stream, a); } }
}
```

```cpp
#include <hip/hip_runtime.h>
#include <cstdio>
#include <cstdint>

#define GAS __attribute__((address_space(1)))
#define LAS __attribute__((address_space(3)))
typedef unsigned short bf16;
typedef short bf16x8 __attribute__((ext_vector_type(8)));
typedef short s16x4 __attribute__((ext_vector_type(4)));
typedef float f32x2 __attribute__((ext_vector_type(2)));
typedef float f32x4 __attribute__((ext_vector_type(4)));
typedef float f32x16 __attribute__((ext_vector_type(16)));
typedef unsigned u32x2 __attribute__((ext_vector_type(2)));
typedef unsigned u32x4 __attribute__((ext_vector_type(4)));
typedef __bf16 bf16x2_t __attribute__((ext_vector_type(2)));

#ifndef ONE_LAUNCH
#define ONE_LAUNCH 1
#endif
#ifndef STOP_PHASE
#define STOP_PHASE 1000
#endif

constexpr int T = 16384, SEQ = 4096, NB = 4, D = 2048, NL = 4, FF = 8192;
constexpr int RIN = 3520, INW = 4352, PROJ_LD = 4608;
constexpr int NMEM = 256;
constexpr float NORM_EPS = 1e-6f, GN_EPS = 64e-5f;
constexpr float QSCALE_MLA = 0.07216878364870323f * 1.4426950408889634f;
constexpr float QSCALE_MEM = 0.08838834764831845f * 1.4426950408889634f;
constexpr int NWAVES = 8, NTHR = 512;
constexpr int NPH = 16, NPHASES = 1 + NL * NPH;

enum { I_X = 0, I_MEM, I_MEMG, I_MIXPRE, I_WIN, I_WINV, I_MU, I_MUV, I_W0, I_WUP, I_A0, I_AUP, I_V0, I_VUP, I_GUP, I_KK, I_KA, I_RK, I_LNG, I_LNB,
       I_QNG, I_WUQ, I_KVNG, I_WUKV, I_WOUT, I_MIXPOST, I_MEMPRE, I_WQM, I_WKM, I_WVM, I_WOM, I_MEMPOST, I_FFNPRE, I_FF1, I_FF2, I_FFNPOST, N_IN };

constexpr size_t KiB = 1024, MiB = 1024 * 1024;
constexpr size_t WS_CTL = 0, CTL_BYTES = 1 * MiB;
constexpr size_t WS_COS = 1 * MiB, WS_SIN = 1 * MiB + 512 * KiB;
constexpr size_t WS_MEMN = 2 * MiB, WS_MEMK = 6 * MiB, WS_MEMV = 7 * MiB, WS_RKB = 8 * MiB;
constexpr size_t WS_W = 16 * MiB, W_LSTRIDE = 38 * MiB;
constexpr size_t WS_WFF = 92 * MiB;
constexpr size_t WS_AO = 156 * MiB;
constexpr size_t WS_RMS = 12 * MiB;
constexpr size_t WS_SCAN = 220 * MiB;
constexpr size_t WO_IN = 0, WO_UP = 18 * MiB, WO_AUP = 18 * MiB + 256 * KiB, WO_GUP = 18 * MiB + 512 * KiB, WO_VUP = 19 * MiB, WO_UQ = 19 * MiB + 512 * KiB,
                 WO_UKV = 21 * MiB, WO_OUT = 22 * MiB, WO_QM = 30 * MiB, WO_KM = 32 * MiB, WO_VM = 34 * MiB, WO_OM = 36 * MiB, WO_FF1 = 38 * MiB, WO_FF2 = 70 * MiB;
constexpr size_t WS_U = 424 * MiB, WS_Y = 488 * MiB, WS_VF = 552 * MiB;
constexpr size_t WS_PROJ = 584 * MiB, WS_LORA = 728 * MiB, WS_WLOG = 748 * MiB, WS_AIC = 780 * MiB, WS_GATE = 812 * MiB, WS_VV = 844 * MiB,
                 WS_CQN = 876 * MiB, WS_CKVN = 892 * MiB, WS_KR = 900 * MiB, WS_QB = 902 * MiB, WS_KV = 950 * MiB, WS_END = 1014 * MiB;
constexpr size_t WS_HID = 584 * MiB, WS_QMEM = 840 * MiB, WS_OMEM = 856 * MiB;
constexpr int LORA_LD = 640;
constexpr int CW_TMO = 0, CW_BAR = 4096, CW_ATT = 16384;

constexpr int RING_BYTES = 163328, LDSCTL_OFF = RING_BYTES, MISC_OFF = LDSCTL_OFF + 320, LDS_BYTES = 163840;

__device__ __forceinline__ unsigned cvt_pk(float lo, float hi) { f32x2 v = {lo, hi}; bf16x2_t b = __builtin_convertvector(v, bf16x2_t); return __builtin_bit_cast(unsigned, b); }
__device__ __forceinline__ float bflo(unsigned w) { return __uint_as_float(w << 16); }
__device__ __forceinline__ float bfhi(unsigned w) { return __uint_as_float(w & 0xffff0000u); }
__device__ __forceinline__ float bf1(bf16 b) { return __uint_as_float((unsigned)b << 16); }
__device__ __forceinline__ bf16 f2bf(float f) { return (bf16)(cvt_pk(f, 0.f) & 0xffffu); }
template <int CTRL> __device__ __forceinline__ float dpp_add(float x) { return x + __int_as_float(__builtin_amdgcn_update_dpp(0, __float_as_int(x), CTRL, 0xf, 0xf, true)); }
__device__ __forceinline__ float sum4(float x) { x = dpp_add<0xB1>(x); x = dpp_add<0x4E>(x); return x; }
__device__ __forceinline__ float sum8(float x) { x = sum4(x); x = dpp_add<0x141>(x); return x; }
__device__ __forceinline__ float sum16(float x) { x = sum8(x); x = dpp_add<0x140>(x); return x; }
__device__ __forceinline__ float wave_sum(float x) {
    x = sum16(x);
    { auto r = __builtin_amdgcn_permlane16_swap(__float_as_uint(x), __float_as_uint(x), false, false); x = __uint_as_float(r[0]) + __uint_as_float(r[1]); }
    { auto r = __builtin_amdgcn_permlane32_swap(__float_as_uint(x), __float_as_uint(x), false, false); x = __uint_as_float(r[0]) + __uint_as_float(r[1]); }
    return x;
}
__device__ __forceinline__ float sigmoidf_(float x) { return __builtin_amdgcn_rcpf(1.f + __builtin_amdgcn_exp2f(-1.4426950408889634f * x)); }
__device__ __forceinline__ float tanhf_(float x) { const float e = __builtin_amdgcn_exp2f(-2.f * 1.4426950408889634f * fabsf(x)); const float t = (1.f - e) * __builtin_amdgcn_rcpf(1.f + e); return x < 0.f ? -t : t; }
__device__ __forceinline__ void unpack8(u32x4 w, float (&f)[8]) {
    f[0] = bflo(w.x); f[1] = bfhi(w.x); f[2] = bflo(w.y); f[3] = bfhi(w.y); f[4] = bflo(w.z); f[5] = bfhi(w.z); f[6] = bflo(w.w); f[7] = bfhi(w.w);
}
__device__ __forceinline__ u32x4 pack8(const float (&f)[8]) { u32x4 w; w.x = cvt_pk(f[0], f[1]); w.y = cvt_pk(f[2], f[3]); w.z = cvt_pk(f[4], f[5]); w.w = cvt_pk(f[6], f[7]); return w; }

__device__ __forceinline__ int crow(int r, int hi) { return (r & 3) + 8 * (r >> 2) + 4 * hi; }
typedef short v4i16_t __attribute__((ext_vector_type(4)));

namespace pg8 {
#define PG8_LAS __attribute__((address_space(3)))
typedef unsigned short bf16_t;
constexpr int BM = 256, BK = 64, HALF = 128, HTB = HALF * BK * 2, STAGE_BYTES = 8 * HTB, NXCD = 8, WGM = 8;
__host__ __device__ __forceinline__ int lds_byte(int r, int c) { const int st = (r >> 4) * 2 + (c >> 5), rr = r & 15, cc = c & 31, ob = rr * 64 + cc * 2; return st * 1024 + (ob ^ (((ob >> 9) & 1) << 5)); }
__host__ __device__ __forceinline__ void stage_rc(int b, int& R, int& C) { const int st = b / 1024, sb = b % 1024, swz = sb ^ (((sb >> 9) & 1) << 5); R = (st >> 1) * 16 + swz / 64; C = (st & 1) * 32 + (swz % 64) / 2; }
__host__ __device__ __forceinline__ int perm32(int rho) { const int n = rho >> 4, i = rho & 15; return 8 * (i >> 2) + 4 * n + (i & 3); }
struct Unit { int pm, pn; };
struct Gemm { const bf16_t* A; const bf16_t* Bt; int M, N, K, lda, ldb; };
struct StaticOrder {
    int nM, nN, nwg, G, c;
    __host__ __device__ void init(int M, int N, int G_, int c_) { nM = M / BM; nN = N / BM; nwg = nM * nN; G = G_; c = c_; }
    __host__ __device__ bool next(int i, Unit& u) const {
        const long L = (long)i * G + c; if (L >= nwg) return false;
        int wgid = (int)L; { const int q = nwg / NXCD, r = nwg % NXCD, xcd = wgid % NXCD, off = wgid / NXCD; wgid = (xcd < r ? xcd * (q + 1) : r * (q + 1) + (xcd - r) * q) + off; }
        const int nig = WGM * nN, gid = wgid / nig, fm = gid * WGM, gsz = (nM - fm) < WGM ? (nM - fm) : WGM;
        u.pm = fm + ((wgid % nig) % gsz); u.pn = (wgid % nig) / gsz; return true;
    }
};
template <class F> struct Epi8 {
    F f;
    __device__ __forceinline__ void operator()(const f32x4 (&acc)[2][2][4][2], const Unit& u, int wr, int wc, int fr, int fq) const {
        const int row0 = u.pm * BM + wr * 64 + fr, col0 = u.pn * BM + wc * 32 + 8 * fq;
#pragma unroll
        for (int ai = 0; ai < 2; ++ai)
#pragma unroll
            for (int m = 0; m < 4; ++m)
#pragma unroll
                for (int bj = 0; bj < 2; ++bj) { f(row0 + ai * HALF + m * 16, col0 + bj * HALF, acc[ai][bj][m][0], acc[ai][bj][m][1]); if (F::HEAVY) __builtin_amdgcn_sched_barrier(0); }
    }
};

template <class Epi>
__device__ __forceinline__ void gemm_phase(PG8_LAS unsigned char* lds, const Gemm g, const StaticOrder& S, const Epi& E) {
    int tid = threadIdx.x; asm volatile("" : "+v"(tid));
    const int wid = __builtin_amdgcn_readfirstlane(tid >> 6), lane = tid & 63, wr = wid >> 2, wc = wid & 3, fr = lane & 15, fq = lane >> 4;
    int K = g.K; asm volatile("" : "+s"(K));
    const int nt = K / BK;
    unsigned voffA[2], voffB[2];
#pragma unroll
    for (int i = 0; i < 2; ++i) { int R, C; stage_rc(tid * 16 + i * 8192, R, C); const int Rb = (R & ~31) + perm32(R & 31);
        voffA[i] = (unsigned)(R * g.lda + C) * 2u; voffB[i] = (unsigned)(Rb * g.ldb + C) * 2u; }
    const size_t kstep = (size_t)(BK * 2);
    const size_t hsA = (size_t)HALF * g.lda * 2, hsB = (size_t)HALF * g.ldb * 2;
    const size_t tsA = 2 * hsA, tsB = 2 * hsB;
    const unsigned ldsw = (unsigned)wid * 1024u;
    const int aoff = lds_byte(wr * 64 + fr, fq * 8), boff = lds_byte(wc * 32 + fr, fq * 8);
#define PG8_SA(b, h) (((b) * 2 + (h)) * HTB)
#define PG8_SB(b, h) ((4 + (b) * 2 + (h)) * HTB)
#define PG8_STAGE(bufoff, gbase, voff) do { _Pragma("unroll") for (int _i = 0; _i < 2; ++_i) \
        __builtin_amdgcn_global_load_lds((const unsigned*)((const char*)(gbase) + (voff)[_i]), (PG8_LAS unsigned*)(lds + (bufoff) + ldsw + _i * 8192), 16, 0, 0); } while (0)
#define PG8_LDA(dst, b, h) do { _Pragma("unroll") for (int m = 0; m < 4; ++m) _Pragma("unroll") for (int k = 0; k < 2; ++k) dst[m][k] = *(const PG8_LAS bf16x8*)(lds + PG8_SA(b, h) + aoff + m * 2048 + k * 1024); } while (0)
#define PG8_LDB(dst, b, h) do { _Pragma("unroll") for (int n = 0; n < 2; ++n) _Pragma("unroll") for (int k = 0; k < 2; ++k) dst[n][k] = *(const PG8_LAS bf16x8*)(lds + PG8_SB(b, h) + boff + n * 2048 + k * 1024); } while (0)
#define PG8_MMA(ai, bj, At, Bt) do { __builtin_amdgcn_s_setprio(1); _Pragma("unroll") for (int m = 0; m < 4; ++m) _Pragma("unroll") for (int n = 0; n < 2; ++n) _Pragma("unroll") for (int k = 0; k < 2; ++k) \
        acc[ai][bj][m][n] = __builtin_amdgcn_mfma_f32_16x16x32_bf16(Bt[n][k], At[m][k], acc[ai][bj][m][n], 0, 0, 0); __builtin_amdgcn_s_setprio(0); } while (0)
#define PG8_WAIT_V(n) asm volatile("s_waitcnt vmcnt(" #n ")" ::: "memory")
#define PG8_WAIT_L(n) asm volatile("s_waitcnt lgkmcnt(" #n ")" ::: "memory")
#define PG8_BAR __builtin_amdgcn_s_barrier()
#define PG8_SCHED __builtin_amdgcn_sched_barrier(0)
    Unit cur, nxt; int ui = 0;
    if (!S.next(0, cur)) return;
    f32x4 acc[2][2][4][2];
#pragma unroll
    for (int a = 0; a < 2; ++a)
#pragma unroll
        for (int b = 0; b < 2; ++b)
#pragma unroll
            for (int m = 0; m < 4; ++m)
#pragma unroll
                for (int n = 0; n < 2; ++n) acc[a][b][m][n] = (f32x4){0.f, 0.f, 0.f, 0.f};
    bf16x8 At[4][2], B0[2][2], B1[2][2];
    const char* cA = (const char*)g.A + (size_t)cur.pm * tsA; const char* cB = (const char*)g.Bt + (size_t)cur.pn * tsB;
    PG8_STAGE(PG8_SB(0, 0), cB, voffB); PG8_STAGE(PG8_SB(0, 1), cB + hsB, voffB); PG8_STAGE(PG8_SA(0, 0), cA, voffA); PG8_STAGE(PG8_SA(0, 1), cA + hsA, voffA);
    if (wr == 1) PG8_BAR;
    PG8_WAIT_V(2); PG8_BAR;
    PG8_STAGE(PG8_SB(1, 0), cB + kstep, voffB); PG8_STAGE(PG8_SA(1, 0), cA + kstep, voffA); PG8_STAGE(PG8_SB(1, 1), cB + hsB + kstep, voffB);
    PG8_WAIT_V(6); PG8_BAR;
    for (;;) {
        const bool has_next = S.next(ui + 1, nxt);
        const char* nA = has_next ? (const char*)g.A + (size_t)nxt.pm * tsA : cA; const char* nB = has_next ? (const char*)g.Bt + (size_t)nxt.pn * tsB : cB;
        for (int t = 0; t < nt; t += 2) {
            const bool last = (t == nt - 2);
            const char* a1 = cA + (size_t)(t + 1) * kstep;
            const char* a2 = last ? nA : cA + (size_t)(t + 2) * kstep; const char* b2 = last ? nB : cB + (size_t)(t + 2) * kstep;
            const char* a3 = a2 + kstep; const char* b3 = b2 + kstep;
            PG8_LDB(B0, 0, 0); PG8_LDB(B1, 0, 1); PG8_SCHED; PG8_LDA(At, 0, 0); PG8_STAGE(PG8_SA(1, 1), a1 + hsA, voffA);
            PG8_WAIT_V(8); PG8_WAIT_L(0); PG8_BAR; PG8_MMA(0, 0, At, B0); PG8_MMA(0, 1, At, B1); PG8_BAR; PG8_SCHED;
            PG8_LDA(At, 0, 1); PG8_STAGE(PG8_SB(0, 0), b2, voffB); PG8_STAGE(PG8_SB(0, 1), b2 + hsB, voffB); PG8_STAGE(PG8_SA(0, 0), a2, voffA);
            PG8_WAIT_V(8); PG8_WAIT_L(0); PG8_BAR; PG8_MMA(1, 0, At, B0); PG8_MMA(1, 1, At, B1); PG8_BAR; PG8_SCHED;
            PG8_LDB(B0, 1, 0); PG8_LDB(B1, 1, 1); PG8_SCHED; PG8_LDA(At, 1, 0); PG8_STAGE(PG8_SA(0, 1), a2 + hsA, voffA);
            PG8_WAIT_V(8); PG8_WAIT_L(0); PG8_BAR; PG8_MMA(0, 0, At, B0); PG8_MMA(0, 1, At, B1); PG8_BAR; PG8_SCHED;
            PG8_LDA(At, 1, 1); PG8_STAGE(PG8_SB(1, 0), b3, voffB); PG8_STAGE(PG8_SB(1, 1), b3 + hsB, voffB); PG8_STAGE(PG8_SA(1, 0), a3, voffA);
            PG8_WAIT_V(8); PG8_WAIT_L(0); PG8_BAR; PG8_MMA(1, 0, At, B0); PG8_MMA(1, 1, At, B1); PG8_BAR; PG8_SCHED;
        }
        if (wr == 0) PG8_BAR;
        E(acc, cur, wr, wc, fr, fq);
        if (!has_next) break;
#pragma unroll
        for (int a = 0; a < 2; ++a)
#pragma unroll
            for (int b = 0; b < 2; ++b)
#pragma unroll
                for (int m = 0; m < 4; ++m)
#pragma unroll
                    for (int n = 0; n < 2; ++n) acc[a][b][m][n] = (f32x4){0.f, 0.f, 0.f, 0.f};
        cur = nxt; cA = nA; cB = nB; ++ui;
        if (wr == 1) PG8_BAR;
    }
    PG8_WAIT_V(0);
    PG8_BAR;
#undef PG8_SA
#undef PG8_SB
#undef PG8_STAGE
#undef PG8_LDA
#undef PG8_LDB
#undef PG8_MMA
#undef PG8_WAIT_V
#undef PG8_WAIT_L
#undef PG8_BAR
#undef PG8_SCHED
}
}

__device__ __forceinline__ void st16_wt(void* p, u32x4 w) { asm volatile("global_store_dwordx4 %0, %1, off sc1\n\ts_nop 1" :: "v"(p), "v"(w) : "memory"); }
struct FPlain { static constexpr bool HEAVY = false; bf16* O; int ld; float sc;
    __device__ __forceinline__ void operator()(int row, int col, f32x4 a, f32x4 b) const {
        u32x4 w; w.x = cvt_pk(a[0] * sc, a[1] * sc); w.y = cvt_pk(a[2] * sc, a[3] * sc); w.z = cvt_pk(b[0] * sc, b[1] * sc); w.w = cvt_pk(b[2] * sc, b[3] * sc);
        st16_wt(O + (size_t)row * ld + col, w); } };
struct FRelu2 { static constexpr bool HEAVY = false; bf16* O; int ld;
    __device__ __forceinline__ void operator()(int row, int col, f32x4 a, f32x4 b) const {
        float v[8] = {a[0], a[1], a[2], a[3], b[0], b[1], b[2], b[3]};
#pragma unroll
        for (int i = 0; i < 8; ++i) { const float r = fmaxf(v[i], 0.f); v[i] = r * r; }
        st16_wt(O + (size_t)row * ld + col, pack8(v)); } };
template <int MODE> struct FSig { static constexpr bool HEAVY = true; bf16* O; int ld; const float* bias;
    __device__ __forceinline__ void operator()(int row, int col, f32x4 a, f32x4 b) const {
        const f32x4 b0 = *(const f32x4*)(bias + col), b1 = *(const f32x4*)(bias + col + 4);
        float v[8] = {a[0] + b0[0], a[1] + b0[1], a[2] + b0[2], a[3] + b0[3], b[0] + b1[0], b[1] + b1[1], b[2] + b1[2], b[3] + b1[3]};
#pragma unroll
        for (int i = 0; i < 8; ++i) { const float s = sigmoidf_(v[i]); v[i] = MODE == 0 ? -0.6065306597126334f * s : s; }
        *(u32x4*)(O + (size_t)row * ld + col) = pack8(v); } };
struct FVup { static constexpr bool HEAVY = true; bf16* O; const float* v0; const float* mu; const bf16* proj; const bf16* vfirst;
    __device__ __forceinline__ void operator()(int row, int col, f32x4 a, f32x4 b) const {
        const f32x4 b0 = *(const f32x4*)(v0 + col), b1 = *(const f32x4*)(v0 + col + 4), m0 = *(const f32x4*)(mu + col), m1 = *(const f32x4*)(mu + col + 4);
        float cur[8], prv[8], vf[8];
        unpack8(*(const u32x4*)(proj + (size_t)row * PROJ_LD + 2048 + col), cur);
        if ((row & (SEQ - 1)) != 0) unpack8(*(const u32x4*)(proj + (size_t)(row - 1) * PROJ_LD + 2048 + col), prv);
        else {
#pragma unroll
            for (int i = 0; i < 8; ++i) prv[i] = 0.f; }
        unpack8(*(const u32x4*)(vfirst + (size_t)row * 1024 + col), vf);
        const float acc8[8] = {a[0] + b0[0], a[1] + b0[1], a[2] + b0[2], a[3] + b0[3], b[0] + b1[0], b[1] + b1[1], b[2] + b1[2], b[3] + b1[3]};
        const float mu8[8] = {m0[0], m0[1], m0[2], m0[3], m1[0], m1[1], m1[2], m1[3]};
        float v[8];
#pragma unroll
        for (int i = 0; i < 8; ++i) { const float vs = cur[i] + (prv[i] - cur[i]) * mu8[i]; v[i] = vs + (vf[i] - vs) * sigmoidf_(acc8[i]); }
        *(u32x4*)(O + (size_t)row * 1024 + col) = pack8(v); } };
struct FQ { static constexpr bool HEAVY = true; bf16* O; const float* cosT; const float* sinT;
    __device__ __forceinline__ void operator()(int row, int col, f32x4 a, f32x4 b) const {
        const int cc = col % 192;
        float v[8] = {a[0], a[1], a[2], a[3], b[0], b[1], b[2], b[3]};
        if (cc >= 128) { const int i0 = (cc - 128) >> 1, pos = row & (SEQ - 1);
            const f32x4 c = *(const f32x4*)(cosT + pos * 32 + i0), s = *(const f32x4*)(sinT + pos * 32 + i0);
#pragma unroll
            for (int i = 0; i < 4; ++i) { const float x1 = v[2 * i], x2 = v[2 * i + 1]; v[2 * i] = x1 * c[i] - x2 * s[i]; v[2 * i + 1] = x1 * s[i] + x2 * c[i]; } }
#pragma unroll
        for (int i = 0; i < 8; ++i) v[i] *= QSCALE_MLA;
        *(u32x4*)(O + (size_t)row * 1536 + col) = pack8(v); } };

#define XB_TMO      128
#define XB_XCNT(j)  (256  + 64 * (j))
#define XB_XSUB(j)  (1280 + 64 * (j))
#define XB_XGEN(j)  (2304 + 64 * (j))
#define XB_TOP      3328
#define XB_TOPGEN   3392
#define XCD_BAR_WORDS 3456
#define XB_SPIN_CAP (1u << 20)
__device__ __forceinline__ unsigned xb_ld(unsigned* p)              { return __hip_atomic_load(p, __ATOMIC_RELAXED, __HIP_MEMORY_SCOPE_AGENT); }
__device__ __forceinline__ unsigned xb_add(unsigned* p, unsigned v) { return __hip_atomic_fetch_add(p, v, __ATOMIC_RELAXED, __HIP_MEMORY_SCOPE_AGENT); }
__device__ __forceinline__ unsigned xb_xcc_id() { return (unsigned)__builtin_amdgcn_s_getreg((3 << 11) | 20) & 0xFu; }
#define XB_SPIN(cond, bar) do { unsigned _sp = 0; while (cond) { __builtin_amdgcn_s_sleep(1); \
    if ((++_sp & 255u) == 0u) { if (xb_ld(&(bar)[XB_TMO])) break; if (_sp > XB_SPIN_CAP) { atomicAdd(&(bar)[XB_TMO], 1u); break; } } } } while (0)
struct XcdBarrier { unsigned* bar; unsigned x; volatile LAS unsigned* st; };
__device__ __forceinline__ XcdBarrier xcd_barrier_post(unsigned* bar, volatile LAS unsigned* st) {
    XcdBarrier b; b.bar = bar; b.x = xb_xcc_id(); b.st = st;
    if (threadIdx.x == 0) (void)xb_add(&bar[XB_XCNT(b.x)], 1u);
    return b;
}
__device__ __forceinline__ void xcd_barrier_complete(unsigned* bar, unsigned x, unsigned& nloc, unsigned& nx) {
    const unsigned G = gridDim.x * gridDim.y * gridDim.z;
    unsigned sum, cnt, mine, sp = 0u;
    for (;;) {
        sum = 0u; cnt = 0u; mine = 0u;
#pragma unroll
        for (unsigned j = 0; j < 16; ++j) { const unsigned c = xb_ld(&bar[XB_XCNT(j)]); sum += c; cnt += (c > 0u) ? 1u : 0u; mine = (j == x) ? c : mine; }
        if (sum == G) break;
        __builtin_amdgcn_s_sleep(1);
        if ((++sp & 255u) == 0u) { if (xb_ld(&bar[XB_TMO])) break; if (sp > XB_SPIN_CAP) { atomicAdd(&bar[XB_TMO], 1u); break; } }
    }
    nloc = mine > 0u ? mine : 1u; nx = cnt > 0u ? cnt : 1u;
}
__device__ __forceinline__ void xcd_barrier(const XcdBarrier& b) {
    asm volatile("s_waitcnt vmcnt(0)" ::: "memory");
    __syncthreads();
    if (threadIdx.x == 0) {
        unsigned* bar = b.bar;
        __builtin_amdgcn_s_waitcnt(0);
        unsigned nloc = b.st[0], nx = b.st[1];
        if (nloc == 0u) { xcd_barrier_complete(bar, b.x, nloc, nx); b.st[0] = nloc; b.st[1] = nx; }
        const unsigned old = xb_add(&bar[XB_XSUB(b.x)], 1u);
        const unsigned gen = old / nloc;
        if (old + 1u == (gen + 1u) * nloc) {
            __builtin_amdgcn_fence(__ATOMIC_RELEASE, "agent");
            asm volatile("s_waitcnt vmcnt(0)" ::: "memory");
            const unsigned og = xb_add(&bar[XB_TOP], 1u);
            const unsigned tg = og / nx;
            if (og + 1u == (tg + 1u) * nx) xb_add(&bar[XB_TOPGEN], 1u);
            else XB_SPIN(xb_ld(&bar[XB_TOPGEN]) == tg, bar);
            __builtin_amdgcn_fence(__ATOMIC_ACQUIRE, "agent");
            xb_add(&bar[XB_XGEN(b.x)], 1u);
            asm volatile("s_waitcnt vmcnt(0)" ::: "memory");
        } else {
            XB_SPIN(xb_ld(&bar[XB_XGEN(b.x)]) == gen, bar);
            __builtin_amdgcn_fence(__ATOMIC_ACQUIRE, "agent");
            asm volatile("s_waitcnt vmcnt(0)" ::: "memory");
        }
    }
    __syncthreads();
}

struct Args { const float* in[N_IN]; float* out; unsigned char* ws; int lo, hi; };
typedef const __attribute__((address_space(4))) Args* ArgsP;
struct Frame {
    LAS unsigned char* lds;
    int tid, lane, wave, vcu, G, bx;
    unsigned char* ws;
    float* H;
};
#define WSP(type, off) ((type*)(F.ws + (off)))
#define WL(off) ((off) >= WO_FF1 ? WS_WFF + ((off) - WO_FF1) : WS_W + (size_t)(l & 1) * W_LSTRIDE + (off))

__constant__ int JK[15]  = {2048, 2048, 256, 256, 2048, 2048, 2048, 2048, 512, 96, 96, 64, 512, 2048, 8192};
__constant__ int JKP[15] = {2048, 2048, 256, 256, 2048, 2048, 2048, 2048, 512, 128, 128, 128, 512, 2048, 8192};
__constant__ int JN[15]  = {4352, 64, 1024, 2048, 2048, 512, 512, 512, 2048, 1024, 1024, 1024, 1536, 8192, 2048};
__constant__ int JIN[15] = {I_WIN, I_WINV, I_GUP, I_WUKV, I_WOUT, I_WQM, I_WKM, I_WVM, I_WOM, I_WUP, I_AUP, I_VUP, I_WUQ, I_FF1, I_FF2};
__constant__ unsigned JDST[15] = {(unsigned)(WO_IN / KiB), (unsigned)(WO_IN / KiB), (unsigned)(WO_GUP / KiB), (unsigned)(WO_UKV / KiB), (unsigned)(WO_OUT / KiB), (unsigned)(WO_QM / KiB),
                                  (unsigned)(WO_KM / KiB), (unsigned)(WO_VM / KiB), (unsigned)(WO_OM / KiB), (unsigned)(WO_UP / KiB), (unsigned)(WO_AUP / KiB), (unsigned)(WO_VUP / KiB),
                                  (unsigned)(WO_UQ / KiB), (unsigned)(WO_FF1 / KiB), (unsigned)(WO_FF2 / KiB)};
__device__ __forceinline__ void p0_transpose_item(const float* W, int Kreal, int N, bf16* WT, int ldk, int row_off, LAS unsigned* scr, int item, int lane, bool rope, const float* gk) {
    const int nblk = N / 64, kb = item / nblk, nb = item % nblk, k0 = 64 * kb, n0 = 64 * nb;
    const int m = lane & 15, q = lane >> 4;
    f32x4 v[16];
#pragma unroll
    for (int i = 0; i < 16; ++i) { const int k = k0 + 8 * (i >> 1) + 2 * q + (i & 1); const int kc = k < Kreal ? k : Kreal - 1;
        v[i] = __builtin_nontemporal_load((const f32x4*)(W + (size_t)kc * N + n0 + 4 * m)); }
    if (k0 + 64 > Kreal) {
#pragma unroll
        for (int i = 0; i < 16; ++i) { const int k = k0 + 8 * (i >> 1) + 2 * q + (i & 1); if (k >= Kreal) v[i] = (f32x4){0.f, 0.f, 0.f, 0.f}; }
    }
    if (gk) {
        float gg[16];
#pragma unroll
        for (int i = 0; i < 16; ++i) gg[i] = gk[k0 + 8 * (i >> 1) + 2 * q + (i & 1)];
#pragma unroll
        for (int i = 0; i < 16; ++i) v[i] *= gg[i];
    }
#pragma unroll
    for (int j = 0; j < 8; ++j)
#pragma unroll
        for (int c = 0; c < 4; ++c) scr[(4 * m + c) * 32 + ((4 * j + q) ^ (4 * (m & 7)))] = cvt_pk(v[2 * j][c], v[2 * j + 1][c]);
    asm volatile("s_waitcnt lgkmcnt(0)" ::: "memory");
    const int x = lane & 7, r = lane >> 3;
#pragma unroll
    for (int t = 0; t < 8; ++t) { const int n = r + 8 * t; const u32x4 o = *(const LAS u32x4*)(scr + n * 32 + 4 * (x ^ ((n >> 2) & 7)));
        const int nd = rope ? 2 * (n & 31) + (n >> 5) : n;
        *(u32x4*)(WT + (size_t)(row_off + n0 + nd) * ldk + k0 + 8 * x) = o; }
    asm volatile("s_waitcnt lgkmcnt(0)" ::: "memory");
}
__device__ __forceinline__ void rms_row_2048(const float* xrow, const float* g, bf16* orow, float* rms_out, int lane) {
    f32x4 v[8]; float ss = 0.f;
#pragma unroll
    for (int j = 0; j < 4; ++j) { v[2 * j] = *(const f32x4*)(xrow + lane * 8 + 512 * j); v[2 * j + 1] = *(const f32x4*)(xrow + lane * 8 + 512 * j + 4); }
#pragma unroll
    for (int j = 0; j < 8; ++j) ss += (v[j][0] * v[j][0] + v[j][1] * v[j][1]) + (v[j][2] * v[j][2] + v[j][3] * v[j][3]);
    const float ms = wave_sum(ss) * (1.f / 2048.f) + NORM_EPS, rstd = rsqrtf(ms);
    if (rms_out && lane == 0) *rms_out = ms * rstd;
#pragma unroll
    for (int j = 0; j < 4; ++j) { const int c = lane * 8 + 512 * j;
        f32x4 a = v[2 * j] * rstd, b = v[2 * j + 1] * rstd;
        if (g) { a *= *(const f32x4*)(g + c); b *= *(const f32x4*)(g + c + 4); }
        u32x4 w; w.x = cvt_pk(a[0], a[1]); w.y = cvt_pk(a[2], a[3]); w.z = cvt_pk(b[0], b[1]); w.w = cvt_pk(b[2], b[3]);
        *(u32x4*)(orow + c) = w; }
}
__device__ __forceinline__ void convert_layer(Frame& F, ArgsP A, int l, int part, int wrank, int wcount) {
    LAS unsigned* scr = (LAS unsigned*)(F.lds + F.wave * 16384);
    const int k_lo = (part == 2) ? 13 : (part == 3 ? 14 : 0), k_hi = (part == 1) ? 13 : (part == 2 ? 14 : 15);
    int base = 0;
    for (int k = k_lo; k < k_hi; ++k) {
        const bool prev = (k == 1 || k == 11);
        if (prev && l == 0) continue;
        const int K = JK[k], KP = JKP[k], N = JN[k], row_off = (k == 1) ? INW : 0;
        const float* W = A->in[JIN[k]] + (size_t)(prev ? l - 1 : l) * K * N; const size_t dst = WL((size_t)JDST[k] * KiB);
        const int nitems = (KP / 64) * (N / 64);
        const float* gk = (k <= 1) ? A->in[I_MIXPRE] + (size_t)l * D : (k == 5 ? A->in[I_MEMPRE] + (size_t)l * D : (k == 13 ? A->in[I_FFNPRE] + (size_t)l * D : nullptr));
        int first = (wrank - base) % wcount; if (first < 0) first += wcount;
        for (int it = first; it < nitems; it += wcount) p0_transpose_item(W, K, N, WSP(bf16, dst), KP, row_off, scr, it, F.lane, k == 12 && (it % (N / 64)) % 3 == 2, gk);
        base = (base + nitems) % wcount;
    }
    if (part <= 1 && l > 0) {
        const long gt = (long)wrank * 64 + F.lane, NGT = (long)wcount * 64;
        unsigned* O = (unsigned*)(WSP(bf16, WL(WO_IN)) + (size_t)(INW + 64) * D);
        for (long i = gt; i < 192 * D / 2; i += NGT) O[i] = 0u;
    }
}
__device__ __forceinline__ void p0_prologue(Frame& F, ArgsP A) {
    const int gw = F.vcu * NWAVES + F.wave, NGW = F.G * NWAVES;
    const long gt = (long)F.vcu * NTHR + F.tid, NGT = (long)F.G * NTHR;
    convert_layer(F, A, 0, 1, gw, NGW);
    { float* cT = WSP(float, WS_COS); float* sT = WSP(float, WS_SIN);
      for (long i = gt; i < SEQ * 32; i += NGT) { const int pos = (int)(i >> 5), j = (int)(i & 31);
          const float invf = __builtin_amdgcn_exp2f(-13.287712379549449f * (float)j * (1.f / 32.f));
          const double rev = (double)pos * (double)invf * 0.15915494309189535; const float fr = (float)(rev - __builtin_rint(rev));
          cT[i] = __builtin_amdgcn_cosf(fr); sT[i] = __builtin_amdgcn_sinf(fr); } }
    for (int m = gw; m < T; m += NGW) rms_row_2048(A->in[I_X] + (size_t)m * D, nullptr, WSP(bf16, WS_U) + (size_t)m * D, WSP(float, WS_RMS) + m, F.lane);
    for (int m = gw; m < NB * NMEM; m += NGW) rms_row_2048(A->in[I_MEM] + (size_t)m * D, A->in[I_MEMG], WSP(bf16, WS_MEMN) + (size_t)m * D, nullptr, F.lane);
}

struct PrepRaw { u32x4 lc, lp, cq, vc[2], vp[2]; u32x2 ckv; bf16 k1, k2; float rc, rs; };
__device__ __forceinline__ void prep_load(Frame& F, int l, int m, int sc, bool act, PrepRaw& R) {
    const int lane = F.lane; const bf16* cur = WSP(bf16, WS_PROJ) + (size_t)m * PROJ_LD; const bf16* prv = cur - PROJ_LD; const bool first = (m & (SEQ - 1)) == 0;
    const u32x4 Z = (u32x4){0u, 0u, 0u, 0u};
    R.lc = act ? *(const u32x4*)(cur + sc) : Z; R.lp = (act && !first) ? *(const u32x4*)(prv + sc) : Z;
    R.cq = *(const u32x4*)(cur + RIN + lane * 8); R.ckv = *(const u32x2*)(cur + RIN + 512 + lane * 4);
    R.k1 = cur[RIN + 768 + (lane & 31)]; R.k2 = cur[RIN + 768 + 32 + (lane & 31)];
    { const int pos = m & (SEQ - 1); R.rc = WSP(float, WS_COS)[pos * 32 + (lane & 31)]; R.rs = WSP(float, WS_SIN)[pos * 32 + (lane & 31)]; }
    if (l == 0) {
#pragma unroll
        for (int j = 0; j < 2; ++j) { const int c = lane * 8 + 512 * j; R.vc[j] = *(const u32x4*)(cur + 2048 + c); R.vp[j] = first ? Z : *(const u32x4*)(prv + 2048 + c); } }
}
__device__ __forceinline__ void prep_row(Frame& F, int l, int m, int oc, int kind, const float (&mv)[8], const f32x4& qg0, const f32x4& qg1, const f32x4& kvg, const float* mu, const PrepRaw& R) {
    const int lane = F.lane;
    bf16* lo = WSP(bf16, WS_LORA) + (size_t)m * LORA_LD;
    { float y[8], yp[8], o[8]; unpack8(R.lc, y); unpack8(R.lp, yp);
#pragma unroll
      for (int i = 0; i < 8; ++i) { const float c = y[i] + (yp[i] - y[i]) * mv[i]; const float sg = sigmoidf_(kind == 1 ? 2.f * c : c); o[i] = kind == 1 ? 2.f * sg - 1.f : (kind == 2 ? sg : c); }
      *(u32x4*)(lo + oc) = pack8(o);
      if (lane < 16) *(u32x4*)(lo + (lane < 4 ? 96 + 8 * lane : (lane < 8 ? 224 + 8 * (lane - 4) : 576 + 8 * (lane - 8)))) = (u32x4){0u, 0u, 0u, 0u}; }
    { float v[8]; unpack8(R.cq, v); float ss = 0.f;
#pragma unroll
      for (int i = 0; i < 8; ++i) ss += v[i] * v[i];
      const float rstd = rsqrtf(wave_sum(ss) * (1.f / 512.f) + NORM_EPS);
      u32x4 w; w.x = cvt_pk(v[0] * rstd * qg0[0], v[1] * rstd * qg0[1]); w.y = cvt_pk(v[2] * rstd * qg0[2], v[3] * rstd * qg0[3]);
      w.z = cvt_pk(v[4] * rstd * qg1[0], v[5] * rstd * qg1[1]); w.w = cvt_pk(v[6] * rstd * qg1[2], v[7] * rstd * qg1[3]);
      *(u32x4*)(WSP(bf16, WS_CQN) + (size_t)m * 512 + lane * 8) = w; }
    { const float v0 = bflo(R.ckv.x), v1 = bfhi(R.ckv.x), v2 = bflo(R.ckv.y), v3 = bfhi(R.ckv.y);
      const float rstd = rsqrtf(wave_sum(v0 * v0 + v1 * v1 + v2 * v2 + v3 * v3) * (1.f / 256.f) + NORM_EPS);
      u32x2 w; w.x = cvt_pk(v0 * rstd * kvg[0], v1 * rstd * kvg[1]); w.y = cvt_pk(v2 * rstd * kvg[2], v3 * rstd * kvg[3]);
      *(u32x2*)(WSP(bf16, WS_CKVN) + (size_t)m * 256 + lane * 4) = w; }
    if (lane < 32) { const float x1 = bf1(R.k1), x2 = bf1(R.k2);
      *(unsigned*)(WSP(bf16, WS_KR) + (size_t)m * 64 + 2 * lane) = cvt_pk(x1 * R.rc - x2 * R.rs, x1 * R.rs + x2 * R.rc); }
    if (l == 0) {
#pragma unroll
        for (int j = 0; j < 2; ++j) { const int c = lane * 8 + 512 * j; float a[8], p[8], o[8]; unpack8(R.vc[j], a); unpack8(R.vp[j], p);
            const f32x4 m0 = *(const f32x4*)(mu + 2048 + c), m1 = *(const f32x4*)(mu + 2048 + c + 4);
#pragma unroll
            for (int i = 0; i < 8; ++i) o[i] = a[i] + (p[i] - a[i]) * (i < 4 ? m0[i] : m1[i - 4]);
            *(u32x4*)(WSP(bf16, WS_VF) + (size_t)m * 1024 + c) = pack8(o); } }
}
__device__ __forceinline__ void prep_phase(Frame& F, ArgsP A, int l) {
    const int gw = F.vcu * NWAVES + F.wave, NGW = F.G * NWAVES, lane = F.lane;
    const float* mu = A->in[I_MU] + (size_t)l * RIN;
    const float* muv = A->in[I_MUV] + (size_t)(l > 0 ? l - 1 : 0) * 64;
    const int sc = lane < 56 ? 3072 + 8 * lane : INW + 8 * (lane - 56);
    const int oc = lane < 12 ? 8 * lane : (lane < 24 ? 128 + 8 * (lane - 12) : (lane < 56 ? 256 + 8 * (lane - 24) : 512 + 8 * (lane - 56)));
    const int kind = lane < 12 ? 1 : (lane < 24 ? 0 : (lane < 56 ? 2 : 3));
    const bool act = kind != 3 || l > 0;
    float mv[8];
#pragma unroll
    for (int i = 0; i < 8; ++i) mv[i] = kind == 3 ? muv[8 * (lane - 56) + i] : mu[sc + i];
    const float* qg = A->in[I_QNG] + (size_t)l * 512; const float* kvgp = A->in[I_KVNG] + (size_t)l * 256;
    const f32x4 qg0 = *(const f32x4*)(qg + lane * 8), qg1 = *(const f32x4*)(qg + lane * 8 + 4), kvg = *(const f32x4*)(kvgp + lane * 4);
    for (int m = gw; m < T; m += 2 * NGW) {
        PrepRaw R0, R1; const int m1 = m + NGW;
        prep_load(F, l, m, sc, act, R0);
        if (m1 < T) prep_load(F, l, m1, sc, act, R1);
        prep_row(F, l, m, oc, kind, mv, qg0, qg1, kvg, mu, R0);
        if (m1 < T) prep_row(F, l, m1, oc, kind, mv, qg0, qg1, kvg, mu, R1);
    }
}

constexpr int CK = 32, NCHUNK = SEQ / CK;
constexpr int CS_TS = 144, CS_TILE = 32 * CS_TS, CS_PC = 5 * CS_TILE, CS_WAVE = 5 * CS_TILE + 256;
constexpr int CS_NW = 7;
constexpr size_t SCU_BYTES = 24576; constexpr int SCU_X = 8192, SCU_PSI = 12288, SCU_G2 = 20480;
constexpr int SQ_SLOT = 18432, SQ_NSLOT = 7;
static_assert(CS_NW * CS_WAVE <= RING_BYTES && SQ_NSLOT * SQ_SLOT <= RING_BYTES, "LDS budget");
#define MF32(a, b, c) __builtin_amdgcn_mfma_f32_32x32x16_bf16((a), (b), (c), 0, 0, 0)
__device__ __forceinline__ bf16x8 pack8f(float a0, float a1, float a2, float a3, float a4, float a5, float a6, float a7) {
    u32x4 w; w.x = cvt_pk(a0, a1); w.y = cvt_pk(a2, a3); w.z = cvt_pk(a4, a5); w.w = cvt_pk(a6, a7); return __builtin_bit_cast(bf16x8, w); }
#define PACKS(x, s) pack8f((x)[8 * (s)], (x)[8 * (s) + 1], (x)[8 * (s) + 2], (x)[8 * (s) + 3], (x)[8 * (s) + 4], (x)[8 * (s) + 5], (x)[8 * (s) + 6], (x)[8 * (s) + 7])
__device__ __forceinline__ bf16x8 trfrag(const LAS unsigned char* p) {
    const s16x4 lo = __builtin_bit_cast(s16x4, __builtin_amdgcn_ds_read_tr16_b64_v4i16((LAS v4i16_t*)p));
    const s16x4 hh = __builtin_bit_cast(s16x4, __builtin_amdgcn_ds_read_tr16_b64_v4i16((LAS v4i16_t*)(p + 8 * CS_TS)));
    return (bf16x8){lo[0], lo[1], lo[2], lo[3], hh[0], hh[1], hh[2], hh[3]}; }
__device__ __forceinline__ void st_init16(unsigned char* p, const f32x16& x) {
    u32x4 w0, w1; w0.x = cvt_pk(x[0], x[1]); w0.y = cvt_pk(x[2], x[3]); w0.z = cvt_pk(x[4], x[5]); w0.w = cvt_pk(x[6], x[7]);
    w1.x = cvt_pk(x[8], x[9]); w1.y = cvt_pk(x[10], x[11]); w1.z = cvt_pk(x[12], x[13]); w1.w = cvt_pk(x[14], x[15]);
    *(u32x4*)p = w0; *(u32x4*)(p + 16) = w1; }
__device__ __forceinline__ f32x16 ld_init16(const LAS unsigned char* p) {
    const u32x4 w0 = *(const LAS u32x4*)p, w1 = *(const LAS u32x4*)(p + 16); f32x16 x;
    x[0] = bflo(w0.x); x[1] = bfhi(w0.x); x[2] = bflo(w0.y); x[3] = bfhi(w0.y); x[4] = bflo(w0.z); x[5] = bfhi(w0.z); x[6] = bflo(w0.w); x[7] = bfhi(w0.w);
    x[8] = bflo(w1.x); x[9] = bfhi(w1.x); x[10] = bflo(w1.y); x[11] = bfhi(w1.y); x[12] = bflo(w1.z); x[13] = bfhi(w1.z); x[14] = bflo(w1.w); x[15] = bfhi(w1.w); return x; }

struct CsRaw { u32x4 r[4], k[4], a[4], e[4]; bf16 rp, kp; };
__device__ __forceinline__ void cs_load_raw(Frame& F, int l, int bh, int cc, CsRaw& R) {
    const int lane = F.lane, b = bh >> 4, h = bh & 15, pc = lane & 7;
    const size_t row0 = (size_t)b * SEQ + (size_t)cc * CK;
    const bf16* PROJ = WSP(bf16, WS_PROJ); const bf16* AIC = WSP(bf16, WS_AIC); const bf16* WLOG = WSP(bf16, WS_WLOG);
#pragma unroll
    for (int i = 0; i < 4; ++i) { const size_t gr = row0 + (lane >> 3) + 8 * i;
        R.r[i] = *(const u32x4*)(PROJ + gr * PROJ_LD + h * 64 + pc * 8); R.k[i] = *(const u32x4*)(PROJ + gr * PROJ_LD + 1024 + h * 64 + pc * 8);
        R.a[i] = *(const u32x4*)(AIC + gr * 1024 + h * 64 + pc * 8); R.e[i] = *(const u32x4*)(WLOG + gr * 1024 + h * 64 + pc * 8); }
    R.rp = 0; R.kp = 0;
    if (cc > 0) { R.rp = PROJ[(row0 - 1) * PROJ_LD + h * 64 + lane]; R.kp = PROJ[(row0 - 1) * PROJ_LD + 1024 + h * 64 + lane]; }
}
__device__ __forceinline__ void cs_elementwise(Frame& F, ArgsP A, int l, int bh, int cc, LAS unsigned char* wl, const CsRaw& R) {
    const int lane = F.lane, b = bh >> 4, h = bh & 15, ch = h * 64 + lane;
    const size_t row0 = (size_t)b * SEQ + (size_t)cc * CK;
    float* RKB = WSP(float, WS_RKB);
    const bf16* VV = (l == 0) ? WSP(bf16, WS_VF) : WSP(bf16, WS_VV);
    u32x4 vraw[4];
#pragma unroll
    for (int i = 0; i < 4; ++i) vraw[i] = *(const u32x4*)(VV + (row0 + (lane >> 3) + 8 * i) * 1024 + h * 64 + (lane & 7) * 8);
#pragma unroll
    for (int i = 0; i < 4; ++i) { LAS unsigned char* p = wl + ((lane >> 3) + 8 * i) * CS_TS + (lane & 7) * 16;
        *(LAS u32x4*)(p) = R.k[i]; *(LAS u32x4*)(p + CS_TILE) = R.a[i]; *(LAS u32x4*)(p + 2 * CS_TILE) = R.e[i]; *(LAS u32x4*)(p + 3 * CS_TILE) = R.r[i]; }
    const float mur = A->in[I_MU][(size_t)l * RIN + ch], muk = A->in[I_MU][(size_t)l * RIN + 1024 + ch];
    const float ckk = A->in[I_KK][(size_t)l * 1024 + ch], cka = A->in[I_KA][(size_t)l * 1024 + ch], crk = A->in[I_RK][(size_t)l * 1024 + ch];
    float rp = bf1(R.rp), kp_ = bf1(R.kp);
    float lp = 0.f, pexc = 1.f;
    constexpr float L2E = 1.4426950408889634f;
    asm volatile("s_waitcnt lgkmcnt(0)" ::: "memory");
#pragma unroll 8
    for (int tt = 0; tt < CK; ++tt) {
        LAS unsigned char* rowp = wl + tt * CS_TS + lane * 2;
        const float kc = bf1(*(const LAS bf16*)(rowp)), aa = bf1(*(const LAS bf16*)(rowp + CS_TILE)), ee = bf1(*(const LAS bf16*)(rowp + 2 * CS_TILE)), rc = bf1(*(const LAS bf16*)(rowp + 3 * CS_TILE));
        const float rs = rc + (rp - rc) * mur, ks = kc + (kp_ - kc) * muk; rp = rc; kp_ = kc;
        float kk = ks * ckk; const float ss = wave_sum(kk * kk); kk *= rsqrtf(fmaxf(ss, 1e-24f));
        const float kq = ks * (1.f + (aa - 1.f) * cka);
        const float rkb = wave_sum(rs * kq * crk);
        lp += ee;
        const float pinc = __builtin_amdgcn_exp2f(lp * L2E), pinv = __builtin_amdgcn_exp2f(-lp * L2E);
        *(LAS bf16*)(rowp) = f2bf(-kk * pexc);
        *(LAS bf16*)(rowp + CS_TILE) = f2bf(kk * aa * pinv);
        *(LAS bf16*)(rowp + 2 * CS_TILE) = f2bf(kq * pinv);
        *(LAS bf16*)(rowp + 3 * CS_TILE) = f2bf(rs * pinc);
        pexc = pinc;
        if (lane == 0) RKB[(row0 + tt) * 16 + h] = rkb;
    }
    ((LAS float*)(wl + CS_PC))[lane] = __builtin_amdgcn_exp2f(lp * L2E);
#pragma unroll
    for (int i = 0; i < 4; ++i) *(LAS u32x4*)(wl + 4 * CS_TILE + ((lane >> 3) + 8 * i) * CS_TS + (lane & 7) * 16) = vraw[i];
}
__device__ __forceinline__ void cs_mfma(Frame& F, const LAS unsigned char* wl, unsigned char* ub) {
    const int lane = F.lane, r32 = lane & 31, h = lane >> 5, q4 = (lane & 15) >> 2, pp = lane & 3, blk = (lane >> 4) & 1;
    const LAS unsigned char* tA = wl; const LAS unsigned char* tB = wl + CS_TILE; const LAS unsigned char* tK = wl + 2 * CS_TILE;
    const LAS unsigned char* tR = wl + 3 * CS_TILE; const LAS unsigned char* tV = wl + 4 * CS_TILE;
    const int rowoff = r32 * CS_TS + h * 16, troff = (4 * h + q4) * CS_TS + blk * 32 + pp * 8;
#define FROW(t, s) (*(const LAS bf16x8*)((t) + rowoff + (s) * 32))
#define FTR(t, ct, s) trfrag((t) + troff + (s) * 16 * CS_TS + (ct) * 64)
    const f32x16 Z = (f32x16){};
    f32x16 P = Z, PT = Z;
#pragma unroll
    for (int s = 0; s < 4; ++s) { const bf16x8 fa = FROW(tA, s), fb = FROW(tB, s); P = MF32(fb, fa, P); PT = MF32(fa, fb, PT); }
#pragma unroll
    for (int r = 0; r < 16; ++r) { const int cr = crow(r, h); if (!(cr < r32)) P[r] = 0.f; if (!(r32 < cr)) PT[r] = 0.f; }
    f32x16 TmT = PT;
#pragma unroll
    for (int r = 0; r < 16; ++r) if (crow(r, h) == r32) TmT[r] += 1.f;
    f32x16 Tm;
#pragma unroll
    for (int it = 0; it < 4; ++it) {
        const bf16x8 pP0 = PACKS(P, 0), pP1 = PACKS(P, 1), pT0 = PACKS(PT, 0), pT1 = PACKS(PT, 1);
        f32x16 Pn = MF32(pT0, pP0, Z); Pn = MF32(pT1, pP1, Pn);
        f32x16 Y = Pn;
#pragma unroll
        for (int r = 0; r < 16; ++r) if (crow(r, h) == r32) Y[r] += 1.f;
        const bf16x8 y0 = PACKS(Y, 0), y1 = PACKS(Y, 1), t0 = PACKS(TmT, 0), t1 = PACKS(TmT, 1);
        if (it < 3) {
            f32x16 PTn = MF32(pP0, pT0, Z); PTn = MF32(pP1, pT1, PTn);
            f32x16 Tn = MF32(y0, t0, Z); Tn = MF32(y1, t1, Tn);
            P = Pn; PT = PTn; TmT = Tn;
        } else { Tm = MF32(t0, y0, Z); Tm = MF32(t1, y1, Tm); }
    }
    f32x16 W1;
    { f32x16 NakT = Z;
#pragma unroll
      for (int s = 0; s < 4; ++s) NakT = MF32(FROW(tA, s), FROW(tK, s), NakT);
#pragma unroll
      for (int r = 0; r < 16; ++r) if (!(r32 < crow(r, h))) NakT[r] = 0.f;
      W1 = MF32(PACKS(NakT, 0), PACKS(Tm, 0), Z); W1 = MF32(PACKS(NakT, 1), PACKS(Tm, 1), W1); }
    f32x16 ATT[2], G1T[2];
    { const bf16x8 m0 = PACKS(Tm, 0), m1 = PACKS(Tm, 1), w0 = PACKS(W1, 0), w1 = PACKS(W1, 1);
#pragma unroll
      for (int ct = 0; ct < 2; ++ct) { ATT[ct] = MF32(m0, FTR(tA, ct, 0), Z); ATT[ct] = MF32(m1, FTR(tA, ct, 1), ATT[ct]);
                                       G1T[ct] = MF32(w0, FTR(tV, ct, 0), Z); G1T[ct] = MF32(w1, FTR(tV, ct, 1), G1T[ct]); } }
    f32x16 Mbr = Z, Mkr = Z;
#pragma unroll
    for (int s = 0; s < 4; ++s) { const bf16x8 fr = FROW(tR, s); Mbr = MF32(FROW(tB, s), fr, Mbr); Mkr = MF32(FROW(tK, s), fr, Mkr); }
#pragma unroll
    for (int r = 0; r < 16; ++r) if (!(crow(r, h) <= r32)) { Mbr[r] = 0.f; Mkr[r] = 0.f; }
    const bf16x8 b0 = PACKS(Mbr, 0), b1 = PACKS(Mbr, 1), k0 = PACKS(Mkr, 0), k1 = PACKS(Mkr, 1);
#pragma unroll
    for (int kt = 0; kt < 2; ++kt) {
        f32x16 X = MF32(PACKS(ATT[kt], 0), b0, Z); X = MF32(PACKS(ATT[kt], 1), b1, X);
#pragma unroll
        for (int g = 0; g < 4; ++g) { const u32x2 w = *(const LAS u32x2*)(tR + r32 * CS_TS + (32 * kt + 8 * g + 4 * h) * 2);
            X[4 * g] += bflo(w.x); X[4 * g + 1] += bfhi(w.x); X[4 * g + 2] += bflo(w.y); X[4 * g + 3] += bfhi(w.y); }
        *(bf16x8*)(ub + SCU_X + ((2 * kt) * 64 + lane) * 16) = PACKS(X, 0);
        *(bf16x8*)(ub + SCU_X + ((2 * kt + 1) * 64 + lane) * 16) = PACKS(X, 1);
    }
#pragma unroll
    for (int ct = 0; ct < 2; ++ct) {
        f32x16 G = MF32(b0, PACKS(G1T[ct], 0), Z); G = MF32(b1, PACKS(G1T[ct], 1), G);
        G = MF32(k0, FTR(tV, ct, 0), G); G = MF32(k1, FTR(tV, ct, 1), G);
        st_init16(ub + SCU_G2 + (ct * 64 + lane) * 32, G);
    }
    const LAS float* PC = (const LAS float*)(wl + CS_PC);
#pragma unroll
    for (int ct = 0; ct < 2; ++ct) {
        const float pc = PC[32 * ct + r32];
        const bf16x8 f0 = FTR(tB, ct, 0), f1 = FTR(tB, ct, 1);
#pragma unroll
        for (int kt = 0; kt < 2; ++kt) {
            f32x16 Ph = MF32(PACKS(ATT[kt], 0), f0, Z); Ph = MF32(PACKS(ATT[kt], 1), f1, Ph);
            if (kt == ct) {
#pragma unroll
                for (int r = 0; r < 16; ++r) if (crow(r, h) == r32) Ph[r] += 1.f; }
#pragma unroll
            for (int r = 0; r < 16; ++r) Ph[r] *= pc;
            *(bf16x8*)(ub + ((ct * 4 + 2 * kt) * 64 + lane) * 16) = PACKS(Ph, 0);
            *(bf16x8*)(ub + ((ct * 4 + 2 * kt + 1) * 64 + lane) * 16) = PACKS(Ph, 1);
        }
    }
#pragma unroll
    for (int mt = 0; mt < 2; ++mt) {
        const bf16x8 fb0 = FTR(tB, mt, 0), fb1 = FTR(tB, mt, 1), fk0 = FTR(tK, mt, 0), fk1 = FTR(tK, mt, 1);
        float pcr[16];
#pragma unroll
        for (int g = 0; g < 4; ++g) { const f32x4 v = *(const LAS f32x4*)(PC + 32 * mt + 8 * g + 4 * h); pcr[4 * g] = v[0]; pcr[4 * g + 1] = v[1]; pcr[4 * g + 2] = v[2]; pcr[4 * g + 3] = v[3]; }
#pragma unroll
        for (int ct = 0; ct < 2; ++ct) {
            f32x16 Ps = MF32(fb0, PACKS(G1T[ct], 0), Z); Ps = MF32(fb1, PACKS(G1T[ct], 1), Ps);
            Ps = MF32(fk0, FTR(tV, ct, 0), Ps); Ps = MF32(fk1, FTR(tV, ct, 1), Ps);
#pragma unroll
            for (int r = 0; r < 16; ++r) Ps[r] *= pcr[r];
            st_init16(ub + SCU_PSI + ((ct * 2 + mt) * 64 + lane) * 32, Ps);
        }
    }
#undef FROW
#undef FTR
}
__device__ __forceinline__ void cs_pre_phase(Frame& F, ArgsP A, int l) {
    volatile LAS unsigned* cnt = (volatile LAS unsigned*)(F.lds + LDSCTL_OFF);
    if (F.tid == 0) cnt[0] = 0u;
    __syncthreads();
    if (F.wave < CS_NW) {
        LAS unsigned char* wl = F.lds + F.wave * CS_WAVE;
        const int per = (64 * NCHUNK + F.G - 1) / F.G, ubase = F.vcu * per, uend = (ubase + per < 64 * NCHUNK) ? ubase + per : 64 * NCHUNK;
#define CS_NEXT(dst) do { unsigned v_ = 0u; if (F.lane == 0) v_ = __hip_atomic_fetch_add((LAS unsigned*)cnt, 1u, __ATOMIC_RELAXED, __HIP_MEMORY_SCOPE_WORKGROUP); dst = ubase + (int)__builtin_amdgcn_readfirstlane((int)v_); } while (0)
        int u; CS_NEXT(u);
        CsRaw R;
        if (u < uend) cs_load_raw(F, l, u >> 7, u & (NCHUNK - 1), R);
        while (u < uend) {
            cs_elementwise(F, A, l, u >> 7, u & (NCHUNK - 1), wl, R);
            int un; CS_NEXT(un);
            if (un < uend) cs_load_raw(F, l, un >> 7, un & (NCHUNK - 1), R);
            asm volatile("s_waitcnt lgkmcnt(0)" ::: "memory");
            cs_mfma(F, wl, F.ws + WS_SCAN + (size_t)u * SCU_BYTES);
            asm volatile("s_waitcnt lgkmcnt(0)" ::: "memory");
            u = un;
        }
#undef CS_NEXT
    }
}
__device__ __forceinline__ void cs_seq_unit(Frame& F, int bh, int ct) {
    const int lane = F.lane, wave = F.wave, r32 = lane & 31, h = lane >> 5;
    LAS unsigned char* L = F.lds;
    const unsigned char* ub = F.ws + WS_SCAN + (size_t)bh * NCHUNK * SCU_BYTES;
    if (wave > 0) {
        const int w = wave - 1;
        size_t so[3]; int np = 0;
#pragma unroll
        for (int k = 0; k < 3; ++k) { const int p = w + 7 * k; so[k] = p < 12 ? (size_t)p * 1024 : (p < 16 ? (size_t)SCU_PSI + ct * 4096 + (p - 12) * 1024 : (size_t)SCU_G2 + ct * 2048 + (p - 16) * 1024); if (p < 18) np = k + 1; }
#define SQ_ISSUE(c) do { const unsigned char* g_ = ub + (size_t)(c) * SCU_BYTES + lane * 16; LAS unsigned char* d_ = L + ((c) % SQ_NSLOT) * SQ_SLOT; \
        _Pragma("unroll") for (int k = 0; k < 3; ++k) if (k < np) __builtin_amdgcn_global_load_lds((const unsigned*)(g_ + so[k]), (LAS unsigned*)(d_ + (w + 7 * k) * 1024), 16, 0, 0); } while (0)
        for (int c = 0; c < 6; ++c) SQ_ISSUE(c);
        if (np == 3) asm volatile("s_waitcnt vmcnt(15)" ::: "memory"); else asm volatile("s_waitcnt vmcnt(10)" ::: "memory");
        asm volatile("s_barrier" ::: "memory");
        for (int c = 0; c < NCHUNK; ++c) {
            if (c + 6 < NCHUNK) { SQ_ISSUE(c + 6); if (np == 3) asm volatile("s_waitcnt vmcnt(15)" ::: "memory"); else asm volatile("s_waitcnt vmcnt(10)" ::: "memory"); }
            else asm volatile("s_waitcnt vmcnt(0)" ::: "memory");
            asm volatile("s_barrier" ::: "memory");
        }
#undef SQ_ISSUE
    } else {
        f32x16 S0 = (f32x16){}, S1 = (f32x16){};
        const int b = bh >> 4, hh = bh & 15;
        bf16* op = (bf16*)(F.ws + WS_Y) + ((size_t)b * SEQ) * 1024 + hh * 64 + 32 * ct + r32;
        asm volatile("s_barrier" ::: "memory");
        for (int c = 0; c < NCHUNK; ++c) {
            const LAS unsigned char* sl = L + (c % SQ_NSLOT) * SQ_SLOT;
            const bf16x8 bS0 = PACKS(S0, 0), bS1 = PACKS(S0, 1), bS2 = PACKS(S1, 0), bS3 = PACKS(S1, 1);
            f32x16 n0 = ld_init16(sl + 12288 + (0 * 64 + lane) * 32), n1 = ld_init16(sl + 12288 + (1 * 64 + lane) * 32);
            const f32x16 Z = (f32x16){};
            f32x16 m0 = MF32(*(const LAS bf16x8*)(sl + (2 * 64 + lane) * 16), bS2, Z), m1 = MF32(*(const LAS bf16x8*)(sl + (6 * 64 + lane) * 16), bS2, Z);
            n0 = MF32(*(const LAS bf16x8*)(sl + (0 * 64 + lane) * 16), bS0, n0); n1 = MF32(*(const LAS bf16x8*)(sl + (4 * 64 + lane) * 16), bS0, n1);
            m0 = MF32(*(const LAS bf16x8*)(sl + (3 * 64 + lane) * 16), bS3, m0); m1 = MF32(*(const LAS bf16x8*)(sl + (7 * 64 + lane) * 16), bS3, m1);
            n0 = MF32(*(const LAS bf16x8*)(sl + (1 * 64 + lane) * 16), bS1, n0); n1 = MF32(*(const LAS bf16x8*)(sl + (5 * 64 + lane) * 16), bS1, n1);
            f32x16 o = ld_init16(sl + 16384 + lane * 32);
            o = MF32(*(const LAS bf16x8*)(sl + 8192 + (0 * 64 + lane) * 16), bS0, o); o = MF32(*(const LAS bf16x8*)(sl + 8192 + (1 * 64 + lane) * 16), bS1, o);
            o = MF32(*(const LAS bf16x8*)(sl + 8192 + (2 * 64 + lane) * 16), bS2, o); o = MF32(*(const LAS bf16x8*)(sl + 8192 + (3 * 64 + lane) * 16), bS3, o);
            S0 = n0 + m0; S1 = n1 + m1;
#pragma unroll
            for (int r = 0; r < 16; ++r) op[(size_t)(c * CK + crow(r, h)) * 1024] = f2bf(o[r]);
            asm volatile("s_waitcnt lgkmcnt(0)\n\ts_barrier" ::: "memory");
        }
    }
    asm volatile("s_waitcnt vmcnt(0)" ::: "memory");
    __syncthreads();
}

__device__ __forceinline__ void rwkv_post_phase(Frame& F, ArgsP A, int l) {
    const int gw = F.vcu * NWAVES + F.wave, NGW = F.G * NWAVES, lane = F.lane, c0 = lane * 16, head = lane >> 2;
    const bf16* ORAW = WSP(bf16, WS_Y); const float* RKB = WSP(float, WS_RKB);
    const bf16* VV = (l == 0) ? WSP(bf16, WS_VF) : WSP(bf16, WS_VV); const bf16* GATE = WSP(bf16, WS_GATE);
    float lg[16], lb[16];
#pragma unroll
    for (int i = 0; i < 16; ++i) { lg[i] = A->in[I_LNG][(size_t)l * 1024 + c0 + i]; lb[i] = A->in[I_LNB][(size_t)l * 1024 + c0 + i]; }
    for (int m = gw; m < T; m += NGW) {
        float o[16];
#pragma unroll
        for (int j = 0; j < 2; ++j) { float t8[8]; unpack8(*(const u32x4*)(ORAW + (size_t)m * 1024 + c0 + 8 * j), t8);
#pragma unroll
            for (int i = 0; i < 8; ++i) o[8 * j + i] = t8[i]; }
        float s = 0.f;
#pragma unroll
        for (int i = 0; i < 16; ++i) s += o[i];
        s = sum4(s);
        const float mean = s * (1.f / 64.f); float q = 0.f;
#pragma unroll
        for (int i = 0; i < 16; ++i) { o[i] -= mean; q += o[i] * o[i]; }
        q = sum4(q);
        const float rstd = rsqrtf(q * (1.f / 64.f) + GN_EPS);
        const float rkb = RKB[(size_t)m * 16 + head];
        float vv[16], gg[16];
        { float t8[8]; unpack8(*(const u32x4*)(VV + (size_t)m * 1024 + c0), t8);
#pragma unroll
          for (int i = 0; i < 8; ++i) vv[i] = t8[i];
          unpack8(*(const u32x4*)(VV + (size_t)m * 1024 + c0 + 8), t8);
#pragma unroll
          for (int i = 0; i < 8; ++i) vv[8 + i] = t8[i];
          unpack8(*(const u32x4*)(GATE + (size_t)m * 1024 + c0), t8);
#pragma unroll
          for (int i = 0; i < 8; ++i) gg[i] = t8[i];
          unpack8(*(const u32x4*)(GATE + (size_t)m * 1024 + c0 + 8), t8);
#pragma unroll
          for (int i = 0; i < 8; ++i) gg[8 + i] = t8[i]; }
        float y[16];
#pragma unroll
        for (int i = 0; i < 16; ++i) y[i] = (o[i] * rstd * lg[i] + lb[i] + rkb * vv[i]) * gg[i];
        bf16* dst = WSP(bf16, WS_AO) + (size_t)m * D + c0;
        u32x4 w0, w1; w0.x = cvt_pk(y[0], y[1]); w0.y = cvt_pk(y[2], y[3]); w0.z = cvt_pk(y[4], y[5]); w0.w = cvt_pk(y[6], y[7]);
        w1.x = cvt_pk(y[8], y[9]); w1.y = cvt_pk(y[10], y[11]); w1.z = cvt_pk(y[12], y[13]); w1.w = cvt_pk(y[14], y[15]);
        *(u32x4*)dst = w0; *(u32x4*)(dst + 8) = w1;
    }
}

__device__ __forceinline__ void ew_norm_phase(Frame& F, const float* gpost, bool last) {
    const int gw = F.vcu * NWAVES + F.wave, NGW = F.G * NWAVES, lane = F.lane;
    const bf16* Y = WSP(bf16, WS_Y); bf16* U = WSP(bf16, WS_U); float* RMS = WSP(float, WS_RMS);
    for (int m = gw; m < T; m += NGW) {
        float y[32]; float ss = 0.f;
#pragma unroll
        for (int j = 0; j < 4; ++j) { float t8[8]; unpack8(*(const u32x4*)(Y + (size_t)m * D + lane * 8 + 512 * j), t8);
#pragma unroll
            for (int i = 0; i < 8; ++i) { y[8 * j + i] = t8[i]; ss += t8[i] * t8[i]; } }
        const float rold = RMS[m];
        const float rstd = rsqrtf(wave_sum(ss) * (1.f / 2048.f) + NORM_EPS);
        float hn[32]; float s2 = 0.f;
#pragma unroll
        for (int j = 0; j < 4; ++j) { const int c = lane * 8 + 512 * j;
            float h8[8]; unpack8(*(const u32x4*)(U + (size_t)m * D + c), h8);
            const f32x4 g0 = *(const f32x4*)(gpost + c), g1 = *(const f32x4*)(gpost + c + 4);
#pragma unroll
            for (int i = 0; i < 4; ++i) { hn[8 * j + i] = h8[i] * rold + y[8 * j + i] * rstd * g0[i]; hn[8 * j + 4 + i] = h8[4 + i] * rold + y[8 * j + 4 + i] * rstd * g1[i]; }
            if (last) { float* hp = F.H + (size_t)m * D + c; *(f32x4*)hp = (f32x4){hn[8 * j], hn[8 * j + 1], hn[8 * j + 2], hn[8 * j + 3]}; *(f32x4*)(hp + 4) = (f32x4){hn[8 * j + 4], hn[8 * j + 5], hn[8 * j + 6], hn[8 * j + 7]}; }
#pragma unroll
            for (int i = 0; i < 8; ++i) s2 += hn[8 * j + i] * hn[8 * j + i]; }
        if (!last) {
            const float ms = wave_sum(s2) * (1.f / 2048.f) + NORM_EPS, r2 = rsqrtf(ms);
            if (lane == 0) RMS[m] = ms * r2;
#pragma unroll
            for (int j = 0; j < 4; ++j) { const int c = lane * 8 + 512 * j;
                u32x4 w; w.x = cvt_pk(hn[8 * j] * r2, hn[8 * j + 1] * r2); w.y = cvt_pk(hn[8 * j + 2] * r2, hn[8 * j + 3] * r2);
                w.z = cvt_pk(hn[8 * j + 4] * r2, hn[8 * j + 5] * r2); w.w = cvt_pk(hn[8 * j + 6] * r2, hn[8 * j + 7] * r2);
                *(u32x4*)(U + (size_t)m * D + c) = w; }
        }
    }
}

template <int DQK, bool CAUSAL>
__device__ __forceinline__ void attn_unit(LAS unsigned char* lds, const bf16* __restrict__ Q, int ldq, const bf16* __restrict__ K1, int ldk1, const bf16* __restrict__ K2, int ldk2,
                                          const bf16* __restrict__ V, int ldv, bf16* __restrict__ O, int ldo, int qpos0, int ntiles) {
    constexpr int KROW = DQK * 2, KT = 64 * KROW, VT = 16384, ND0 = DQK / 16, NKC = DQK / 64;
    int tid = threadIdx.x; asm volatile("" : "+v"(tid));
    const int lane = tid & 63, wid = __builtin_amdgcn_readfirstlane(tid >> 6), r32 = lane & 31, hi = lane >> 5;
    LAS unsigned char* Kl = lds; LAS unsigned char* Vl = lds + 2 * KT;
    bf16x8 qr[ND0];
    { const bf16* qrow = Q + (size_t)(wid * 32 + r32) * ldq;
#pragma unroll
      for (int d0 = 0; d0 < ND0; ++d0) qr[d0] = *(const bf16x8*)(qrow + d0 * 16 + hi * 8); }
    unsigned ksoff[NKC]; int kdst[NKC];
#pragma unroll
    for (int i = 0; i < NKC; ++i) { int row, cc;
        if (i < 2) { const int c = tid + 512 * i; row = c >> 4; cc = c & 15; ksoff[i] = (unsigned)(row * ldk1 + cc * 8) * 2u; }
        else { row = tid >> 3; cc = 16 + (tid & 7); ksoff[i] = (unsigned)(row * ldk2 + (cc - 16) * 8) * 2u; }
        const int cs = DQK == 192 ? ((cc & ~7) | ((cc ^ (row >> 1)) & 7)) : (cc ^ (row & 15));
        kdst[i] = row * KROW + cs * 16; }
    unsigned vsoff[2]; int vdst[2];
#pragma unroll
    for (int i = 0; i < 2; ++i) { const int c = tid + 512 * i, row = c >> 4, cc = c & 15; vsoff[i] = (unsigned)(row * ldv + cc * 8) * 2u; vdst[i] = row * 256 + ((cc * 16) ^ ((row & 3) << 6)); }
    constexpr int NKO = DQK == 192 ? 4 : 8;
    int koff[NKO];
#pragma unroll
    for (int j = 0; j < NKO; ++j) { const int cc = 2 * j + hi; const int cs = DQK == 192 ? ((cc ^ (r32 >> 1)) & 7) : (cc ^ (r32 & 15)); koff[j] = r32 * KROW + cs * 16; }
#define AT_KOFF(d0) (DQK == 192 ? koff[(d0) & 3] + ((d0) >> 2) * 128 : koff[(d0) & 7])
    const int q4 = (lane & 15) >> 2, pp = lane & 3, blk = (lane >> 4) & 1;
    int voff[4];
#pragma unroll
    for (int d0 = 0; d0 < 4; ++d0) voff[d0] = (4 * hi + q4) * 256 + (((d0 ^ q4) << 6) | (blk << 5) | (pp << 3));
    u32x4 ks[NKC], vs[2];
#define AT_LOAD(t) do { const char* k1b = (const char*)K1 + (size_t)(t) * 64 * ldk1 * 2; const char* k2b = (const char*)K2 + (size_t)(t) * 64 * ldk2 * 2; const char* vb = (const char*)V + (size_t)(t) * 64 * ldv * 2; \
        _Pragma("unroll") for (int i = 0; i < NKC; ++i) ks[i] = *(const u32x4*)((i < 2 ? k1b : k2b) + ksoff[i]); \
        _Pragma("unroll") for (int i = 0; i < 2; ++i) vs[i] = *(const u32x4*)(vb + vsoff[i]); } while (0)
#define AT_WRITE(bf) do { _Pragma("unroll") for (int i = 0; i < NKC; ++i) *(LAS u32x4*)(Kl + (bf) * KT + kdst[i]) = ks[i]; \
        _Pragma("unroll") for (int i = 0; i < 2; ++i) *(LAS u32x4*)(Vl + (bf) * VT + vdst[i]) = vs[i]; } while (0)
    float m_run = -1e30f, l_run = 0.f; f32x16 o[4];
#pragma unroll
    for (int d0 = 0; d0 < 4; ++d0) o[d0] = (f32x16){};
    AT_LOAD(0); AT_WRITE(0);
    __syncthreads();
    const int qpos = qpos0 + wid * 32 + r32;
    for (int t = 0; t < ntiles; ++t) {
        const int bf = t & 1;
        if (t + 1 < ntiles) AT_LOAD(t + 1);
        f32x16 p0 = (f32x16){}, p1 = (f32x16){};
#pragma unroll
        for (int d0 = 0; d0 < ND0; ++d0) {
            const bf16x8 a0 = *(const LAS bf16x8*)(Kl + bf * KT + AT_KOFF(d0));
            const bf16x8 a1 = *(const LAS bf16x8*)(Kl + bf * KT + AT_KOFF(d0) + 32 * KROW);
            p0 = __builtin_amdgcn_mfma_f32_32x32x16_bf16(a0, qr[d0], p0, 0, 0, 0);
            p1 = __builtin_amdgcn_mfma_f32_32x32x16_bf16(a1, qr[d0], p1, 0, 0, 0);
        }
        if (CAUSAL) { const int kv0 = t * 64;
            if (kv0 + 63 > qpos0 + wid * 32) { const float NEG = -__builtin_inff();
#pragma unroll
                for (int r = 0; r < 16; ++r) { const int key = kv0 + crow(r, hi); if (key > qpos) p0[r] = NEG; if (key + 32 > qpos) p1[r] = NEG; } } }
        float mx = p0[0];
#pragma unroll
        for (int r = 1; r < 16; ++r) mx = fmaxf(mx, p0[r]);
#pragma unroll
        for (int r = 0; r < 16; ++r) mx = fmaxf(mx, p1[r]);
        { auto rr = __builtin_amdgcn_permlane32_swap(__float_as_uint(mx), __float_as_uint(mx), false, false); mx = fmaxf(__uint_as_float(rr[0]), __uint_as_float(rr[1])); }
        if (__any(mx > m_run + 8.f)) {
            const float mn = fmaxf(m_run, mx), alpha = __builtin_amdgcn_exp2f(m_run - mn); m_run = mn; l_run *= alpha;
#pragma unroll
            for (int d0 = 0; d0 < 4; ++d0)
#pragma unroll
                for (int r = 0; r < 16; ++r) o[d0][r] *= alpha;
        }
        float ps = 0.f;
#pragma unroll
        for (int r = 0; r < 16; ++r) { p0[r] = __builtin_amdgcn_exp2f(p0[r] - m_run); p1[r] = __builtin_amdgcn_exp2f(p1[r] - m_run); ps += p0[r] + p1[r]; }
        l_run += ps;
        bf16x8 pa[4];
        { u32x4 w;
          w.x = cvt_pk(p0[0], p0[1]); w.y = cvt_pk(p0[2], p0[3]); w.z = cvt_pk(p0[4], p0[5]); w.w = cvt_pk(p0[6], p0[7]); pa[0] = __builtin_bit_cast(bf16x8, w);
          w.x = cvt_pk(p0[8], p0[9]); w.y = cvt_pk(p0[10], p0[11]); w.z = cvt_pk(p0[12], p0[13]); w.w = cvt_pk(p0[14], p0[15]); pa[1] = __builtin_bit_cast(bf16x8, w);
          w.x = cvt_pk(p1[0], p1[1]); w.y = cvt_pk(p1[2], p1[3]); w.z = cvt_pk(p1[4], p1[5]); w.w = cvt_pk(p1[6], p1[7]); pa[2] = __builtin_bit_cast(bf16x8, w);
          w.x = cvt_pk(p1[8], p1[9]); w.y = cvt_pk(p1[10], p1[11]); w.z = cvt_pk(p1[12], p1[13]); w.w = cvt_pk(p1[14], p1[15]); pa[3] = __builtin_bit_cast(bf16x8, w); }
#pragma unroll
        for (int d0 = 0; d0 < 4; ++d0)
#pragma unroll
            for (int s = 0; s < 4; ++s) {
                const LAS unsigned char* vp = Vl + bf * VT + voff[d0] + s * 4096;
                const s16x4 lo = __builtin_bit_cast(s16x4, __builtin_amdgcn_ds_read_tr16_b64_v4i16((LAS v4i16_t*)vp));
                const s16x4 hh = __builtin_bit_cast(s16x4, __builtin_amdgcn_ds_read_tr16_b64_v4i16((LAS v4i16_t*)(vp + 2048)));
                const bf16x8 vf = (bf16x8){lo[0], lo[1], lo[2], lo[3], hh[0], hh[1], hh[2], hh[3]};
                o[d0] = __builtin_amdgcn_mfma_f32_32x32x16_bf16(vf, pa[s], o[d0], 0, 0, 0);
            }
        if (t + 1 < ntiles) AT_WRITE(bf ^ 1);
        __syncthreads();
    }
    { auto rr = __builtin_amdgcn_permlane32_swap(__float_as_uint(l_run), __float_as_uint(l_run), false, false); l_run = __uint_as_float(rr[0]) + __uint_as_float(rr[1]); }
    const float inv = __builtin_amdgcn_rcpf(l_run);
    bf16* orow = O + (size_t)(wid * 32 + r32) * ldo;
#pragma unroll
    for (int d0 = 0; d0 < 4; ++d0)
#pragma unroll
        for (int g = 0; g < 4; ++g) { u32x2 w; w.x = cvt_pk(o[d0][4 * g] * inv, o[d0][4 * g + 1] * inv); w.y = cvt_pk(o[d0][4 * g + 2] * inv, o[d0][4 * g + 3] * inv);
            *(u32x2*)(orow + d0 * 32 + 8 * g + 4 * hi) = w; }
#undef AT_LOAD
#undef AT_WRITE
#undef AT_KOFF
}

__global__ void __launch_bounds__(NTHR, 2) fwd(Args args) {
    extern __shared__ __attribute__((aligned(16))) unsigned char lds_raw[];
    Frame F;
    F.lds = (LAS unsigned char*)lds_raw;
    F.tid = threadIdx.x; F.lane = F.tid & 63; F.wave = __builtin_amdgcn_readfirstlane(F.tid >> 6);
    F.G = gridDim.x; { const int bx = blockIdx.x; F.vcu = (F.G % 8 == 0) ? (bx % 8) * (F.G / 8) + bx / 8 : bx; }
    F.ws = args.ws; F.H = args.out;
    volatile LAS unsigned* MISC = (volatile LAS unsigned*)(F.lds + MISC_OFF);
    for (int u = F.tid; u < (LDS_BYTES - LDSCTL_OFF) / 4; u += NTHR) ((LAS unsigned*)(F.lds + LDSCTL_OFF))[u] = 0u;
    __syncthreads();
    unsigned* ctl = (unsigned*)(F.ws + WS_CTL);
    XcdBarrier bar; bar.bar = ctl + CW_BAR; bar.x = 0; bar.st = nullptr;
    if (ONE_LAUNCH) bar = xcd_barrier_post(ctl + CW_BAR, MISC + 8);
    const int lo = args.lo, hi = args.hi;
#ifndef PH_MASK
#define PH_MASK 0xfffffu
#endif
#define PHON(j) (((PH_MASK) >> (j)) & 1u)
#define IN(k) (lo <= (k) && (k) < hi)
#define PHASE_RELOAD() do { t_ = threadIdx.x; asm volatile("" : "+v"(t_)); F.tid = t_; F.lane = t_ & 63; F.wave = __builtin_amdgcn_readfirstlane(t_ >> 6); \
        A = (ArgsP)__builtin_amdgcn_kernarg_segment_ptr(); asm volatile("" : "+s"(A)); F.ws = A->ws; F.H = A->out; \
        { int g_ = gridDim.x, b_ = blockIdx.x; asm volatile("" : "+s"(g_), "+s"(b_)); F.G = g_; F.bx = b_; F.vcu = (g_ % 8 == 0) ? (b_ % 8) * (g_ / 8) + b_ / 8 : b_; } } while (0)
#define PHASE_BEGIN() int t_; ArgsP A; PHASE_RELOAD()
#define SEAM(k) do { if (IN(k) && IN((k) + 1)) { if (ONE_LAUNCH) xcd_barrier(bar); } } while (0)

    if (PHON(0) && IN(0)) { PHASE_BEGIN(); p0_prologue(F, A); SEAM(0); }

    for (int l = 0; l < NL; ++l) {
        const int pb = 1 + l * NPH;
        if (PHON(1) && IN(pb + 0)) { PHASE_BEGIN();
            const int N = (l == 0) ? INW : PROJ_LD;
            pg8::Gemm g{WSP(bf16, WS_U), WSP(bf16, WL(WO_IN)), T, N, D, D, D}; pg8::StaticOrder S; S.init(T, N, F.G, F.bx);
            pg8::Epi8<FPlain> E{{WSP(bf16, WS_PROJ), PROJ_LD, 1.f}};
            pg8::gemm_phase(F.lds, g, S, E);
            {
                PHASE_RELOAD();
                const int rem = ((T / 256) * (N / 256)) % F.G;
                if (rem != 0 && F.bx >= rem) convert_layer(F, A, l, 2, (F.bx - rem) * NWAVES + F.wave, (F.G - rem) * NWAVES);
                else if (rem == 0) convert_layer(F, A, l, 2, F.bx * NWAVES + F.wave, F.G * NWAVES);
            }
            SEAM(pb + 0);
        }
        if (PHON(2) && IN(pb + 1)) { PHASE_BEGIN(); prep_phase(F, A, l); SEAM(pb + 1); }
        if (PHON(3) && IN(pb + 2)) { PHASE_BEGIN();
            {
            { pg8::Gemm g{WSP(bf16, WS_LORA), WSP(bf16, WL(WO_UP)), T, 1024, 128, LORA_LD, 128}; pg8::StaticOrder S; S.init(T, 1024, F.G, F.bx);
              pg8::Epi8<FSig<0>> E{{WSP(bf16, WS_WLOG), 1024, A->in[I_W0] + (size_t)l * 1024}}; pg8::gemm_phase(F.lds, g, S, E); }
            PHASE_RELOAD();
            { pg8::Gemm g{WSP(bf16, WS_LORA) + 128, WSP(bf16, WL(WO_AUP)), T, 1024, 128, LORA_LD, 128}; pg8::StaticOrder S; S.init(T, 1024, F.G, F.bx);
              pg8::Epi8<FSig<1>> E{{WSP(bf16, WS_AIC), 1024, A->in[I_A0] + (size_t)l * 1024}}; pg8::gemm_phase(F.lds, g, S, E); }
            PHASE_RELOAD();
            { pg8::Gemm g{WSP(bf16, WS_LORA) + 256, WSP(bf16, WL(WO_GUP)), T, 1024, 256, LORA_LD, 256}; pg8::StaticOrder S; S.init(T, 1024, F.G, F.bx);
              pg8::Epi8<FPlain> E{{WSP(bf16, WS_GATE), 1024, 1.f}}; pg8::gemm_phase(F.lds, g, S, E); }
            PHASE_RELOAD();
            if (l > 0) { pg8::Gemm g{WSP(bf16, WS_LORA) + 512, WSP(bf16, WL(WO_VUP)), T, 1024, 128, LORA_LD, 128}; pg8::StaticOrder S; S.init(T, 1024, F.G, F.bx);
              pg8::Epi8<FVup> E{{WSP(bf16, WS_VV), A->in[I_V0] + (size_t)(l - 1) * 1024, A->in[I_MU] + (size_t)l * RIN + 2048, WSP(bf16, WS_PROJ), WSP(bf16, WS_VF)}}; pg8::gemm_phase(F.lds, g, S, E); }
            PHASE_RELOAD();
            { pg8::Gemm g{WSP(bf16, WS_CQN), WSP(bf16, WL(WO_UQ)), T, 1536, 512, 512, 512}; pg8::StaticOrder S; S.init(T, 1536, F.G, F.bx);
              pg8::Epi8<FQ> E{{WSP(bf16, WS_QB), WSP(float, WS_COS), WSP(float, WS_SIN)}}; pg8::gemm_phase(F.lds, g, S, E); }
            PHASE_RELOAD();
            { pg8::Gemm g{WSP(bf16, WS_CKVN), WSP(bf16, WL(WO_UKV)), T, 2048, 256, 256, 256}; pg8::StaticOrder S; S.init(T, 2048, F.G, F.bx);
              pg8::Epi8<FPlain> E{{WSP(bf16, WS_KV), 2048, 1.f}}; pg8::gemm_phase(F.lds, g, S, E); }
            }
            SEAM(pb + 2);
        }
        if (PHON(4) && IN(pb + 3)) { PHASE_BEGIN();
            cs_pre_phase(F, A, l);
            SEAM(pb + 3);
        }
        if (PHON(5) && IN(pb + 4)) { PHASE_BEGIN();
            if (F.G == 256) {
                const int x = F.bx & 7, i = F.bx >> 3;
                if (i < 16) { const int u = x * 16 + i; cs_seq_unit(F, u >> 1, u & 1); }
                else convert_layer(F, A, l, 3, (x * 16 + i - 16) * NWAVES + F.wave, 128 * NWAVES);
            } else {
            for (int u = F.vcu; u < 128; u += F.G) cs_seq_unit(F, u >> 1, u & 1);
            if (F.G > 128 && F.vcu >= 128) convert_layer(F, A, l, 3, (F.vcu - 128) * NWAVES + F.wave, (F.G - 128) * NWAVES);
            else if (F.G <= 128) convert_layer(F, A, l, 3, F.vcu * NWAVES + F.wave, F.G * NWAVES);
            }
            __syncthreads();
        }
        if (PHON(6) && IN(pb + 5)) { PHASE_BEGIN();
            volatile LAS unsigned* msc = (volatile LAS unsigned*)(F.lds + MISC_OFF);
            const int nq = F.G >= 8 ? 1 : 8;
            for (int qi = 0; qi < nq; ++qi) {
                const int q = (F.bx + qi) & 7;
                unsigned* cnt = (unsigned*)(F.ws + WS_CTL) + CW_ATT + (l * 8 + q) * 64;
                for (;;) {
                    if (F.tid == 0) msc[12] = xb_add(cnt, 1u);
                    __syncthreads();
                    const int v = __builtin_amdgcn_readfirstlane((int)msc[12]);
                    __syncthreads();
                    if (v >= 64) break;
                    const int qb = 15 - (v >> 2), bh = 4 * q + (v & 3), b = bh >> 3, hh = bh & 7; const size_t r0 = (size_t)b * SEQ;
                    attn_unit<192, true>(F.lds, WSP(bf16, WS_QB) + (r0 + qb * 256) * 1536 + hh * 192, 1536,
                                         WSP(bf16, WS_KV) + r0 * 2048 + hh * 256, 2048, WSP(bf16, WS_KR) + r0 * 64, 64,
                                         WSP(bf16, WS_KV) + r0 * 2048 + hh * 256 + 128, 2048,
                                         WSP(bf16, WS_AO) + (r0 + qb * 256) * D + 1024 + hh * 128, D, qb * 256, 4 * (qb + 1));
                }
            }
            SEAM(pb + 5);
        }
        if (PHON(7) && IN(pb + 6)) { PHASE_BEGIN(); rwkv_post_phase(F, A, l); SEAM(pb + 6); }
        if (PHON(8) && IN(pb + 7)) { PHASE_BEGIN();
            pg8::Gemm g{WSP(bf16, WS_AO), WSP(bf16, WL(WO_OUT)), T, D, D, D, D}; pg8::StaticOrder S; S.init(T, D, F.G, F.bx);
            pg8::Epi8<FPlain> E{{WSP(bf16, WS_Y), D, 1.f}}; pg8::gemm_phase(F.lds, g, S, E);
            SEAM(pb + 7);
        }
        if (PHON(9) && IN(pb + 8)) { PHASE_BEGIN(); ew_norm_phase(F, A->in[I_MIXPOST] + (size_t)l * D, false); SEAM(pb + 8); }
        if (PHON(10) && IN(pb + 9)) { PHASE_BEGIN();
            pg8::Gemm g{WSP(bf16, WS_U), WSP(bf16, WL(WO_QM)), T, 512, D, D, D}; pg8::StaticOrder S; S.init(T, 512, F.G, F.bx);
            pg8::Epi8<FPlain> E{{WSP(bf16, WS_QMEM), 512, QSCALE_MEM}}; pg8::gemm_phase(F.lds, g, S, E);
            PHASE_RELOAD();
            { pg8::Gemm g2{WSP(bf16, WS_MEMN), WSP(bf16, WL(WO_KM)), NB * NMEM, 512, D, D, D}; pg8::StaticOrder S2; S2.init(NB * NMEM, 512, F.G, (F.bx + F.G - 128 % F.G) % F.G);
              pg8::Epi8<FPlain> E2{{WSP(bf16, WS_MEMK), 512, 1.f}}; pg8::gemm_phase(F.lds, g2, S2, E2); }
            PHASE_RELOAD();
            { pg8::Gemm g2{WSP(bf16, WS_MEMN), WSP(bf16, WL(WO_VM)), NB * NMEM, 512, D, D, D}; pg8::StaticOrder S2; S2.init(NB * NMEM, 512, F.G, (F.bx + F.G - 136 % F.G) % F.G);
              pg8::Epi8<FPlain> E2{{WSP(bf16, WS_MEMV), 512, 1.f}}; pg8::gemm_phase(F.lds, g2, S2, E2); }
            if (l + 1 < NL) { PHASE_RELOAD();
                if (F.G > 144 && F.bx >= 144) convert_layer(F, A, l + 1, 1, (F.bx - 144) * NWAVES + F.wave, (F.G - 144) * NWAVES);
                else if (F.G <= 144) convert_layer(F, A, l + 1, 1, F.bx * NWAVES + F.wave, F.G * NWAVES); }
            SEAM(pb + 9);
        }
        if (PHON(11) && IN(pb + 10)) { PHASE_BEGIN();
            for (int u = F.vcu; u < 256; u += F.G) {
                const int bh = u >> 4, qb = u & 15, b = bh >> 2, hh = bh & 3; const size_t r0 = (size_t)b * SEQ + qb * 256;
                attn_unit<128, false>(F.lds, WSP(bf16, WS_QMEM) + r0 * 512 + hh * 128, 512,
                                      WSP(bf16, WS_MEMK) + (size_t)b * NMEM * 512 + hh * 128, 512, nullptr, 0,
                                      WSP(bf16, WS_MEMV) + (size_t)b * NMEM * 512 + hh * 128, 512,
                                      WSP(bf16, WS_OMEM) + r0 * 512 + hh * 128, 512, 0, NMEM / 64);
            }
            SEAM(pb + 10);
        }
        if (PHON(12) && IN(pb + 11)) { PHASE_BEGIN();
            pg8::Gemm g{WSP(bf16, WS_OMEM), WSP(bf16, WL(WO_OM)), T, D, 512, 512, 512}; pg8::StaticOrder S; S.init(T, D, F.G, F.bx);
            pg8::Epi8<FPlain> E{{WSP(bf16, WS_Y), D, 1.f}}; pg8::gemm_phase(F.lds, g, S, E);
            SEAM(pb + 11);
        }
        if (PHON(13) && IN(pb + 12)) { PHASE_BEGIN(); ew_norm_phase(F, A->in[I_MEMPOST] + (size_t)l * D, false); SEAM(pb + 12); }
        if (PHON(14) && IN(pb + 13)) { PHASE_BEGIN();
            pg8::Gemm g{WSP(bf16, WS_U), WSP(bf16, WL(WO_FF1)), T, FF, D, D, D}; pg8::StaticOrder S; S.init(T, FF, F.G, F.bx);
            pg8::Epi8<FRelu2> E{{WSP(bf16, WS_HID), FF}}; pg8::gemm_phase(F.lds, g, S, E);
            SEAM(pb + 13);
        }
        if (PHON(15) && IN(pb + 14)) { PHASE_BEGIN();
            pg8::Gemm g{WSP(bf16, WS_HID), WSP(bf16, WL(WO_FF2)), T, D, FF, FF, FF}; pg8::StaticOrder S; S.init(T, D, F.G, F.bx);
            pg8::Epi8<FPlain> E{{WSP(bf16, WS_Y), D, 1.f}}; pg8::gemm_phase(F.lds, g, S, E);
            SEAM(pb + 14);
        }
        if (PHON(16) && IN(pb + 15)) { PHASE_BEGIN(); ew_norm_phase(F, A->in[I_FFNPOST] + (size_t)l * D, l + 1 == NL); SEAM(pb + 15); }
    }
#undef IN
#undef SEAM
}

extern "C" void kernel_launch(void* const* d_in, const int* in_sizes, int n_in, void* d_out, int out_size, void* d_ws, size_t ws_size, hipStream_t stream) {
    static int grid = 0;
    if (grid == 0) {
        if (n_in != N_IN || out_size != T * D || ws_size < WS_END) { fprintf(stderr, "kernel_launch: unexpected shapes (n_in %d, out %d, ws %zu)\n", n_in, out_size, ws_size); grid = -1; return; }
        int dev = 0, cus = 0;
        if (hipGetDevice(&dev) != hipSuccess || hipDeviceGetAttribute(&cus, hipDeviceAttributeMultiprocessorCount, dev) != hipSuccess) { grid = -1; return; }
        if (hipFuncSetAttribute((const void*)fwd, hipFuncAttributeMaxDynamicSharedMemorySize, LDS_BYTES) != hipSuccess) { fprintf(stderr, "kernel_launch: hipFuncSetAttribute failed\n"); grid = -1; return; }
        int per_cu = 0;
        if (hipOccupancyMaxActiveBlocksPerMultiprocessor(&per_cu, (const void*)fwd, NTHR, LDS_BYTES) != hipSuccess || per_cu < 1) fprintf(stderr, "kernel_launch: occupancy query says %d\n", per_cu);
        (void)hipGetLastError();
        grid = cus;
    }
    if (grid < 0) return;
    (void)hipMemsetAsync((char*)d_ws + WS_CTL, 0, CTL_BYTES, stream);
    Args a{};
    for (int i = 0; i < N_IN; ++i) a.in[i] = (const float*)d_in[i];
    a.out = (float*)d_out; a.ws = (unsigned char*)d_ws;
    const int nph = NPHASES < STOP_PHASE ? NPHASES : STOP_PHASE;
    if (ONE_LAUNCH) { a.lo = 0; a.hi = nph; hipLaunchKernelGGL(fwd, dim3(grid), dim3(NTHR), LDS_BYTES, stream, a); }
    else { for (int p = 0; p < nph; ++p) { a.lo = p; a.hi = p + 1; hipLaunchKernelGGL(fwd, dim3(grid), dim3(NTHR), LDS_BYTES, stream, a); } }
}
```

```cpp
#include <hip/hip_runtime.h>
#include <cstdio>
#include <cstdint>

#define GAS __attribute__((address_space(1)))
#define LAS __attribute__((address_space(3)))
typedef unsigned short bf16;
typedef short bf16x8 __attribute__((ext_vector_type(8)));
typedef short s16x4 __attribute__((ext_vector_type(4)));
typedef float f32x2 __attribute__((ext_vector_type(2)));
typedef float f32x4 __attribute__((ext_vector_type(4)));
typedef float f32x16 __attribute__((ext_vector_type(16)));
typedef unsigned u32x2 __attribute__((ext_vector_type(2)));
typedef unsigned u32x4 __attribute__((ext_vector_type(4)));
typedef __bf16 bf16x2_t __attribute__((ext_vector_type(2)));

#ifndef ONE_LAUNCH
#define ONE_LAUNCH 1
#endif
#ifndef STOP_PHASE
#define STOP_PHASE 1000
#endif

constexpr int T = 16384, SEQ = 4096, NB = 4, D = 2048, NL = 4, FF = 8192;
constexpr int RIN = 3520, INW = 4352, PROJ_LD = 4608;
constexpr int NMEM = 256;
constexpr float NORM_EPS = 1e-6f, GN_EPS = 64e-5f;
constexpr float QSCALE_MLA = 0.07216878364870323f * 1.4426950408889634f;
constexpr float QSCALE_MEM = 0.08838834764831845f * 1.4426950408889634f;
constexpr int NWAVES = 8, NTHR = 512;
constexpr int NPH = 16, NPHASES = 1 + NL * NPH;

enum { I_X = 0, I_MEM, I_MEMG, I_MIXPRE, I_WIN, I_WINV, I_MU, I_MUV, I_W0, I_WUP, I_A0, I_AUP, I_V0, I_VUP, I_GUP, I_KK, I_KA, I_RK, I_LNG, I_LNB,
       I_QNG, I_WUQ, I_KVNG, I_WUKV, I_WOUT, I_MIXPOST, I_MEMPRE, I_WQM, I_WKM, I_WVM, I_WOM, I_MEMPOST, I_FFNPRE, I_FF1, I_FF2, I_FFNPOST, N_IN };

constexpr size_t KiB = 1024, MiB = 1024 * 1024;
constexpr size_t WS_CTL = 0, CTL_BYTES = 1 * MiB;
constexpr size_t WS_COS = 1 * MiB, WS_SIN = 1 * MiB + 512 * KiB;
constexpr size_t WS_MEMN = 2 * MiB, WS_MEMK = 6 * MiB, WS_MEMV = 7 * MiB, WS_RKB = 8 * MiB;
constexpr size_t WS_W = 16 * MiB, W_LSTRIDE = 38 * MiB;
constexpr size_t WS_WFF = 92 * MiB;
constexpr size_t WS_AO = 156 * MiB;
constexpr size_t WS_RMS = 12 * MiB;
constexpr size_t WS_SCAN = 220 * MiB;
constexpr size_t WO_IN = 0, WO_UP = 18 * MiB, WO_AUP = 18 * MiB + 256 * KiB, WO_GUP = 18 * MiB + 512 * KiB, WO_VUP = 19 * MiB, WO_UQ = 19 * MiB + 512 * KiB,
                 WO_UKV = 21 * MiB, WO_OUT = 22 * MiB, WO_QM = 30 * MiB, WO_KM = 32 * MiB, WO_VM = 34 * MiB, WO_OM = 36 * MiB, WO_FF1 = 38 * MiB, WO_FF2 = 70 * MiB;
constexpr size_t WS_U = 424 * MiB, WS_Y = 488 * MiB, WS_VF = 552 * MiB;
constexpr size_t WS_PROJ = 584 * MiB, WS_LORA = 728 * MiB, WS_WLOG = 748 * MiB, WS_AIC = 780 * MiB, WS_GATE = 812 * MiB, WS_VV = 844 * MiB,
                 WS_CQN = 876 * MiB, WS_CKVN = 892 * MiB, WS_KR = 900 * MiB, WS_QB = 902 * MiB, WS_KV = 950 * MiB, WS_END = 1014 * MiB;
constexpr size_t WS_HID = 584 * MiB, WS_QMEM = 840 * MiB, WS_OMEM = 856 * MiB;
constexpr int LORA_LD = 640;
constexpr int CW_TMO = 0, CW_BAR = 4096, CW_ATT = 16384;

constexpr int RING_BYTES = 163328, LDSCTL_OFF = RING_BYTES, MISC_OFF = LDSCTL_OFF + 320, LDS_BYTES = 163840;

__device__ __forceinline__ unsigned cvt_pk(float lo, float hi) { f32x2 v = {lo, hi}; bf16x2_t b = __builtin_convertvector(v, bf16x2_t); return __builtin_bit_cast(unsigned, b); }
__device__ __forceinline__ float bflo(unsigned w) { return __uint_as_float(w << 16); }
__device__ __forceinline__ float bfhi(unsigned w) { return __uint_as_float(w & 0xffff0000u); }
__device__ __forceinline__ float bf1(bf16 b) { return __uint_as_float((unsigned)b << 16); }
__device__ __forceinline__ bf16 f2bf(float f) { return (bf16)(cvt_pk(f, 0.f) & 0xffffu); }
template <int CTRL> __device__ __forceinline__ float dpp_add(float x) { return x + __int_as_float(__builtin_amdgcn_update_dpp(0, __float_as_int(x), CTRL, 0xf, 0xf, true)); }
__device__ __forceinline__ float sum4(float x) { x = dpp_add<0xB1>(x); x = dpp_add<0x4E>(x); return x; }
__device__ __forceinline__ float sum8(float x) { x = sum4(x); x = dpp_add<0x141>(x); return x; }
__device__ __forceinline__ float sum16(float x) { x = sum8(x); x = dpp_add<0x140>(x); return x; }
__device__ __forceinline__ float wave_sum(float x) {
    x = sum16(x);
    { auto r = __builtin_amdgcn_permlane16_swap(__float_as_uint(x), __float_as_uint(x), false, false); x = __uint_as_float(r[0]) + __uint_as_float(r[1]); }
    { auto r = __builtin_amdgcn_permlane32_swap(__float_as_uint(x), __float_as_uint(x), false, false); x = __uint_as_float(r[0]) + __uint_as_float(r[1]); }
    return x;
}
__device__ __forceinline__ float sigmoidf_(float x) { return __builtin_amdgcn_rcpf(1.f + __builtin_amdgcn_exp2f(-1.4426950408889634f * x)); }
__device__ __forceinline__ float tanhf_(float x) { const float e = __builtin_amdgcn_exp2f(-2.f * 1.4426950408889634f * fabsf(x)); const float t = (1.f - e) * __builtin_amdgcn_rcpf(1.f + e); return x < 0.f ? -t : t; }
__device__ __forceinline__ void unpack8(u32x4 w, float (&f)[8]) {
    f[0] = bflo(w.x); f[1] = bfhi(w.x); f[2] = bflo(w.y); f[3] = bfhi(w.y); f[4] = bflo(w.z); f[5] = bfhi(w.z); f[6] = bflo(w.w); f[7] = bfhi(w.w);
}
__device__ __forceinline__ u32x4 pack8(const float (&f)[8]) { u32x4 w; w.x = cvt_pk(f[0], f[1]); w.y = cvt_pk(f[2], f[3]); w.z = cvt_pk(f[4], f[5]); w.w = cvt_pk(f[6], f[7]); return w; }

__device__ __forceinline__ int crow(int r, int hi) { return (r & 3) + 8 * (r >> 2) + 4 * hi; }
typedef short v4i16_t __attribute__((ext_vector_type(4)));

namespace pg8 {
#define PG8_LAS __attribute__((address_space(3)))
typedef unsigned short bf16_t;
constexpr int BM = 256, BK = 64, HALF = 128, HTB = HALF * BK * 2, STAGE_BYTES = 8 * HTB, NXCD = 8, WGM = 8;
__host__ __device__ __forceinline__ int lds_byte(int r, int c) { const int st = (r >> 4) * 2 + (c >> 5), rr = r & 15, cc = c & 31, ob = rr * 64 + cc * 2; return st * 1024 + (ob ^ (((ob >> 9) & 1) << 5)); }
__host__ __device__ __forceinline__ void stage_rc(int b, int& R, int& C) { const int st = b / 1024, sb = b % 1024, swz = sb ^ (((sb >> 9) & 1) << 5); R = (st >> 1) * 16 + swz / 64; C = (st & 1) * 32 + (swz % 64) / 2; }
__host__ __device__ __forceinline__ int perm32(int rho) { const int n = rho >> 4, i = rho & 15; return 8 * (i >> 2) + 4 * n + (i & 3); }
struct Unit { int pm, pn; };
struct Gemm { const bf16_t* A; const bf16_t* Bt; int M, N, K, lda, ldb; };
struct StaticOrder {
    int nM, nN, nwg, G, c;
    __host__ __device__ void init(int M, int N, int G_, int c_) { nM = M / BM; nN = N / BM; nwg = nM * nN; G = G_; c = c_; }
    __host__ __device__ bool next(int i, Unit& u) const {
        const long L = (long)i * G + c; if (L >= nwg) return false;
        int wgid = (int)L; { const int q = nwg / NXCD, r = nwg % NXCD, xcd = wgid % NXCD, off = wgid / NXCD; wgid = (xcd < r ? xcd * (q + 1) : r * (q + 1) + (xcd - r) * q) + off; }
        const int nig = WGM * nN, gid = wgid / nig, fm = gid * WGM, gsz = (nM - fm) < WGM ? (nM - fm) : WGM;
        u.pm = fm + ((wgid % nig) % gsz); u.pn = (wgid % nig) / gsz; return true;
    }
};
template <class F> struct Epi8 {
    F f;
    __device__ __forceinline__ void operator()(const f32x4 (&acc)[2][2][4][2], const Unit& u, int wr, int wc, int fr, int fq) const {
        const int row0 = u.pm * BM + wr * 64 + fr, col0 = u.pn * BM + wc * 32 + 8 * fq;
#pragma unroll
        for (int ai = 0; ai < 2; ++ai)
#pragma unroll
            for (int m = 0; m < 4; ++m)
#pragma unroll
                for (int bj = 0; bj < 2; ++bj) { f(row0 + ai * HALF + m * 16, col0 + bj * HALF, acc[ai][bj][m][0], acc[ai][bj][m][1]); if (F::HEAVY) __builtin_amdgcn_sched_barrier(0); }
    }
};

template <class Epi>
__device__ __forceinline__ void gemm_phase(PG8_LAS unsigned char* lds, const Gemm g, const StaticOrder& S, const Epi& E) {
    int tid = threadIdx.x; asm volatile("" : "+v"(tid));
    const int wid = __builtin_amdgcn_readfirstlane(tid >> 6), lane = tid & 63, wr = wid >> 2, wc = wid & 3, fr = lane & 15, fq = lane >> 4;
    int K = g.K; asm volatile("" : "+s"(K));
    const int nt = K / BK;
    unsigned voffA[2], voffB[2];
#pragma unroll
    for (int i = 0; i < 2; ++i) { int R, C; stage_rc(tid * 16 + i * 8192, R, C); const int Rb = (R & ~31) + perm32(R & 31);
        voffA[i] = (unsigned)(R * g.lda + C) * 2u; voffB[i] = (unsigned)(Rb * g.ldb + C) * 2u; }
    const size_t kstep = (size_t)(BK * 2);
    const size_t hsA = (size_t)HALF * g.lda * 2, hsB = (size_t)HALF * g.ldb * 2;
    const size_t tsA = 2 * hsA, tsB = 2 * hsB;
    const unsigned ldsw = (unsigned)wid * 1024u;
    const int aoff = lds_byte(wr * 64 + fr, fq * 8), boff = lds_byte(wc * 32 + fr, fq * 8);
#define PG8_SA(b, h) (((b) * 2 + (h)) * HTB)
#define PG8_SB(b, h) ((4 + (b) * 2 + (h)) * HTB)
#define PG8_STAGE(bufoff, gbase, voff) do { _Pragma("unroll") for (int _i = 0; _i < 2; ++_i) \
        __builtin_amdgcn_global_load_lds((const unsigned*)((const char*)(gbase) + (voff)[_i]), (PG8_LAS unsigned*)(lds + (bufoff) + ldsw + _i * 8192), 16, 0, 0); } while (0)
#define PG8_LDA(dst, b, h) do { _Pragma("unroll") for (int m = 0; m < 4; ++m) _Pragma("unroll") for (int k = 0; k < 2; ++k) dst[m][k] = *(const PG8_LAS bf16x8*)(lds + PG8_SA(b, h) + aoff + m * 2048 + k * 1024); } while (0)
#define PG8_LDB(dst, b, h) do { _Pragma("unroll") for (int n = 0; n < 2; ++n) _Pragma("unroll") for (int k = 0; k < 2; ++k) dst[n][k] = *(const PG8_LAS bf16x8*)(lds + PG8_SB(b, h) + boff + n * 2048 + k * 1024); } while (0)
#define PG8_MMA(ai, bj, At, Bt) do { __builtin_amdgcn_s_setprio(1); _Pragma("unroll") for (int m = 0; m < 4; ++m) _Pragma("unroll") for (int n = 0; n < 2; ++n) _Pragma("unroll") for (int k = 0; k < 2; ++k) \
        acc[ai][bj][m][n] = __builtin_amdgcn_mfma_f32_16x16x32_bf16(Bt[n][k], At[m][k], acc[ai][bj][m][n], 0, 0, 0); __builtin_amdgcn_s_setprio(0); } while (0)
#define PG8_WAIT_V(n) asm volatile("s_waitcnt vmcnt(" #n ")" ::: "memory")
#define PG8_WAIT_L(n) asm volatile("s_waitcnt lgkmcnt(" #n ")" ::: "memory")
#define PG8_BAR __builtin_amdgcn_s_barrier()
#define PG8_SCHED __builtin_amdgcn_sched_barrier(0)
    Unit cur, nxt; int ui = 0;
    if (!S.next(0, cur)) return;
    f32x4 acc[2][2][4][2];
#pragma unroll
    for (int a = 0; a < 2; ++a)
#pragma unroll
        for (int b = 0; b < 2; ++b)
#pragma unroll
            for (int m = 0; m < 4; ++m)
#pragma unroll
                for (int n = 0; n < 2; ++n) acc[a][b][m][n] = (f32x4){0.f, 0.f, 0.f, 0.f};
    bf16x8 At[4][2], B0[2][2], B1[2][2];
    const char* cA = (const char*)g.A + (size_t)cur.pm * tsA; const char* cB = (const char*)g.Bt + (size_t)cur.pn * tsB;
    PG8_STAGE(PG8_SB(0, 0), cB, voffB); PG8_STAGE(PG8_SB(0, 1), cB + hsB, voffB); PG8_STAGE(PG8_SA(0, 0), cA, voffA); PG8_STAGE(PG8_SA(0, 1), cA + hsA, voffA);
    if (wr == 1) PG8_BAR;
    PG8_WAIT_V(2); PG8_BAR;
    PG8_STAGE(PG8_SB(1, 0), cB + kstep, voffB); PG8_STAGE(PG8_SA(1, 0), cA + kstep, voffA); PG8_STAGE(PG8_SB(1, 1), cB + hsB + kstep, voffB);
    PG8_WAIT_V(6); PG8_BAR;
    for (;;) {
        const bool has_next = S.next(ui + 1, nxt);
        const char* nA = has_next ? (const char*)g.A + (size_t)nxt.pm * tsA : cA; const char* nB = has_next ? (const char*)g.Bt + (size_t)nxt.pn * tsB : cB;
        for (int t = 0; t < nt; t += 2) {
            const bool last = (t == nt - 2);
            const char* a1 = cA + (size_t)(t + 1) * kstep;
            const char* a2 = last ? nA : cA + (size_t)(t + 2) * kstep; const char* b2 = last ? nB : cB + (size_t)(t + 2) * kstep;
            const char* a3 = a2 + kstep; const char* b3 = b2 + kstep;
            PG8_LDB(B0, 0, 0); PG8_LDB(B1, 0, 1); PG8_SCHED; PG8_LDA(At, 0, 0); PG8_STAGE(PG8_SA(1, 1), a1 + hsA, voffA);
            PG8_WAIT_V(8); PG8_WAIT_L(0); PG8_BAR; PG8_MMA(0, 0, At, B0); PG8_MMA(0, 1, At, B1); PG8_BAR; PG8_SCHED;
            PG8_LDA(At, 0, 1); PG8_STAGE(PG8_SB(0, 0), b2, voffB); PG8_STAGE(PG8_SB(0, 1), b2 + hsB, voffB); PG8_STAGE(PG8_SA(0, 0), a2, voffA);
            PG8_WAIT_V(8); PG8_WAIT_L(0); PG8_BAR; PG8_MMA(1, 0, At, B0); PG8_MMA(1, 1, At, B1); PG8_BAR; PG8_SCHED;
            PG8_LDB(B0, 1, 0); PG8_LDB(B1, 1, 1); PG8_SCHED; PG8_LDA(At, 1, 0); PG8_STAGE(PG8_SA(0, 1), a2 + hsA, voffA);
            PG8_WAIT_V(8); PG8_WAIT_L(0); PG8_BAR; PG8_MMA(0, 0, At, B0); PG8_MMA(0, 1, At, B1); PG8_BAR; PG8_SCHED;
            PG8_LDA(At, 1, 1); PG8_STAGE(PG8_SB(1, 0), b3, voffB); PG8_STAGE(PG8_SB(1, 1), b3 + hsB, voffB); PG8_STAGE(PG8_SA(1, 0), a3, voffA);
            PG8_WAIT_V(8); PG8_WAIT_L(0); PG8_BAR; PG8_MMA(1, 0, At, B0); PG8_MMA(1, 1, At, B1); PG8_BAR; PG8_SCHED;
        }
        if (wr == 0) PG8_BAR;
        E(acc, cur, wr, wc, fr, fq);
        if (!has_next) break;
#pragma unroll
        for (int a = 0; a < 2; ++a)
#pragma unroll
            for (int b = 0; b < 2; ++b)
#pragma unroll
                for (int m = 0; m < 4; ++m)
#pragma unroll
                    for (int n = 0; n < 2; ++n) acc[a][b][m][n] = (f32x4){0.f, 0.f, 0.f, 0.f};
        cur = nxt; cA = nA; cB = nB; ++ui;
        if (wr == 1) PG8_BAR;
    }
    PG8_WAIT_V(0);
    PG8_BAR;
#undef PG8_SA
#undef PG8_SB
#undef PG8_STAGE
#undef PG8_LDA
#undef PG8_LDB
#undef PG8_MMA
#undef PG8_WAIT_V
#undef PG8_WAIT_L
#undef PG8_BAR
#undef PG8_SCHED
}
}

__device__ __forceinline__ void st16_wt(void* p, u32x4 w) { asm volatile("global_store_dwordx4 %0, %1, off sc1\n\ts_nop 1" :: "v"(p), "v"(w) : "memory"); }
struct FPlain { static constexpr bool HEAVY = false; bf16* O; int ld; float sc;
    __device__ __forceinline__ void operator()(int row, int col, f32x4 a, f32x4 b) const {
        u32x4 w; w.x = cvt_pk(a[0] * sc, a[1] * sc); w.y = cvt_pk(a[2] * sc, a[3] * sc); w.z = cvt_pk(b[0] * sc, b[1] * sc); w.w = cvt_pk(b[2] * sc, b[3] * sc);
        st16_wt(O + (size_t)row * ld + col, w); } };
struct FRelu2 { static constexpr bool HEAVY = false; bf16* O; int ld;
    __device__ __forceinline__ void operator()(int row, int col, f32x4 a, f32x4 b) const {
        float v[8] = {a[0], a[1], a[2], a[3], b[0], b[1], b[2], b[3]};
#pragma unroll
        for (int i = 0; i < 8; ++i) { const float r = fmaxf(v[i], 0.f); v[i] = r * r; }
        st16_wt(O + (size_t)row * ld + col, pack8(v)); } };
template <int MODE> struct FSig { static constexpr bool HEAVY = true; bf16* O; int ld; const float* bias;
    __device__ __forceinline__ void operator()(int row, int col, f32x4 a, f32x4 b) const {
        const f32x4 b0 = *(const f32x4*)(bias + col), b1 = *(const f32x4*)(bias + col + 4);
        float v[8] = {a[0] + b0[0], a[1] + b0[1], a[2] + b0[2], a[3] + b0[3], b[0] + b1[0], b[1] + b1[1], b[2] + b1[2], b[3] + b1[3]};
#pragma unroll
        for (int i = 0; i < 8; ++i) { const float s = sigmoidf_(v[i]); v[i] = MODE == 0 ? -0.6065306597126334f * s : s; }
        *(u32x4*)(O + (size_t)row * ld + col) = pack8(v); } };
struct FVup { static constexpr bool HEAVY = true; bf16* O; const float* v0; const float* mu; const bf16* proj; const bf16* vfirst;
    __device__ __forceinline__ void operator()(int row, int col, f32x4 a, f32x4 b) const {
        const f32x4 b0 = *(const f32x4*)(v0 + col), b1 = *(const f32x4*)(v0 + col + 4), m0 = *(const f32x4*)(mu + col), m1 = *(const f32x4*)(mu + col + 4);
        float cur[8], prv[8], vf[8];
        unpack8(*(const u32x4*)(proj + (size_t)row * PROJ_LD + 2048 + col), cur);
        if ((row & (SEQ - 1)) != 0) unpack8(*(const u32x4*)(proj + (size_t)(row - 1) * PROJ_LD + 2048 + col), prv);
        else {
#pragma unroll
            for (int i = 0; i < 8; ++i) prv[i] = 0.f; }
        unpack8(*(const u32x4*)(vfirst + (size_t)row * 1024 + col), vf);
        const float acc8[8] = {a[0] + b0[0], a[1] + b0[1], a[2] + b0[2], a[3] + b0[3], b[0] + b1[0], b[1] + b1[1], b[2] + b1[2], b[3] + b1[3]};
        const float mu8[8] = {m0[0], m0[1], m0[2], m0[3], m1[0], m1[1], m1[2], m1[3]};
        float v[8];
#pragma unroll
        for (int i = 0; i < 8; ++i) { const float vs = cur[i] + (prv[i] - cur[i]) * mu8[i]; v[i] = vs + (vf[i] - vs) * sigmoidf_(acc8[i]); }
        *(u32x4*)(O + (size_t)row * 1024 + col) = pack8(v); } };
struct FQ { static constexpr bool HEAVY = true; bf16* O; const float* cosT; const float* sinT;
    __device__ __forceinline__ void operator()(int row, int col, f32x4 a, f32x4 b) const {
        const int cc = col % 192;
        float v[8] = {a[0], a[1], a[2], a[3], b[0], b[1], b[2], b[3]};
        if (cc >= 128) { const int i0 = (cc - 128) >> 1, pos = row & (SEQ - 1);
            const f32x4 c = *(const f32x4*)(cosT + pos * 32 + i0), s = *(const f32x4*)(sinT + pos * 32 + i0);
#pragma unroll
            for (int i = 0; i < 4; ++i) { const float x1 = v[2 * i], x2 = v[2 * i + 1]; v[2 * i] = x1 * c[i] - x2 * s[i]; v[2 * i + 1] = x1 * s[i] + x2 * c[i]; } }
#pragma unroll
        for (int i = 0; i < 8; ++i) v[i] *= QSCALE_MLA;
        *(u32x4*)(O + (size_t)row * 1536 + col) = pack8(v); } };

#define XB_TMO      128
#define XB_XCNT(j)  (256  + 64 * (j))
#define XB_XSUB(j)  (1280 + 64 * (j))
#define XB_XGEN(j)  (2304 + 64 * (j))
#define XB_TOP      3328
#define XB_TOPGEN   3392
#define XCD_BAR_WORDS 3456
#define XB_SPIN_CAP (1u << 20)
__device__ __forceinline__ unsigned xb_ld(unsigned* p)              { return __hip_atomic_load(p, __ATOMIC_RELAXED, __HIP_MEMORY_SCOPE_AGENT); }
__device__ __forceinline__ unsigned xb_add(unsigned* p, unsigned v) { return __hip_atomic_fetch_add(p, v, __ATOMIC_RELAXED, __HIP_MEMORY_SCOPE_AGENT); }
__device__ __forceinline__ unsigned xb_xcc_id() { return (unsigned)__builtin_amdgcn_s_getreg((3 << 11) | 20) & 0xFu; }
#define XB_SPIN(cond, bar) do { unsigned _sp = 0; while (cond) { __builtin_amdgcn_s_sleep(1); \
    if ((++_sp & 255u) == 0u) { if (xb_ld(&(bar)[XB_TMO])) break; if (_sp > XB_SPIN_CAP) { atomicAdd(&(bar)[XB_TMO], 1u); break; } } } } while (0)
struct XcdBarrier { unsigned* bar; unsigned x; volatile LAS unsigned* st; };
__device__ __forceinline__ XcdBarrier xcd_barrier_post(unsigned* bar, volatile LAS unsigned* st) {
    XcdBarrier b; b.bar = bar; b.x = xb_xcc_id(); b.st = st;
    if (threadIdx.x == 0) (void)xb_add(&bar[XB_XCNT(b.x)], 1u);
    return b;
}
__device__ __forceinline__ void xcd_barrier_complete(unsigned* bar, unsigned x, unsigned& nloc, unsigned& nx) {
    const unsigned G = gridDim.x * gridDim.y * gridDim.z;
    unsigned sum, cnt, mine, sp = 0u;
    for (;;) {
        sum = 0u; cnt = 0u; mine = 0u;
#pragma unroll
        for (unsigned j = 0; j < 16; ++j) { const unsigned c = xb_ld(&bar[XB_XCNT(j)]); sum += c; cnt += (c > 0u) ? 1u : 0u; mine = (j == x) ? c : mine; }
        if (sum == G) break;
        __builtin_amdgcn_s_sleep(1);
        if ((++sp & 255u) == 0u) { if (xb_ld(&bar[XB_TMO])) break; if (sp > XB_SPIN_CAP) { atomicAdd(&bar[XB_TMO], 1u); break; } }
    }
    nloc = mine > 0u ? mine : 1u; nx = cnt > 0u ? cnt : 1u;
}
__device__ __forceinline__ void xcd_barrier(const XcdBarrier& b) {
    asm volatile("s_waitcnt vmcnt(0)" ::: "memory");
    __syncthreads();
    if (threadIdx.x == 0) {
        unsigned* bar = b.bar;
        __builtin_amdgcn_s_waitcnt(0);
        unsigned nloc = b.st[0], nx = b.st[1];
        if (nloc == 0u) { xcd_barrier_complete(bar, b.x, nloc, nx); b.st[0] = nloc; b.st[1] = nx; }
        const unsigned old = xb_add(&bar[XB_XSUB(b.x)], 1u);
        const unsigned gen = old / nloc;
        if (old + 1u == (gen + 1u) * nloc) {
            __builtin_amdgcn_fence(__ATOMIC_RELEASE, "agent");
            asm volatile("s_waitcnt vmcnt(0)" ::: "memory");
            const unsigned og = xb_add(&bar[XB_TOP], 1u);
            const unsigned tg = og / nx;
            if (og + 1u == (tg + 1u) * nx) xb_add(&bar[XB_TOPGEN], 1u);
            else XB_SPIN(xb_ld(&bar[XB_TOPGEN]) == tg, bar);
            __builtin_amdgcn_fence(__ATOMIC_ACQUIRE, "agent");
            xb_add(&bar[XB_XGEN(b.x)], 1u);
            asm volatile("s_waitcnt vmcnt(0)" ::: "memory");
        } else {
            XB_SPIN(xb_ld(&bar[XB_XGEN(b.x)]) == gen, bar);
            __builtin_amdgcn_fence(__ATOMIC_ACQUIRE, "agent");
            asm volatile("s_waitcnt vmcnt(0)" ::: "memory");
        }
    }
    __syncthreads();
}

struct Args { const float* in[N_IN]; float* out; unsigned char* ws; int lo, hi; };
typedef const __attribute__((address_space(4))) Args* ArgsP;
struct Frame {
    LAS unsigned char* lds;
    int tid, lane, wave, vcu, G, bx;
    unsigned char* ws;
    float* H;
};
#define WSP(type, off) ((type*)(F.ws + (off)))
#define WL(off) ((off) >= WO_FF1 ? WS_WFF + ((off) - WO_FF1) : WS_W + (size_t)(l & 1) * W_LSTRIDE + (off))

__constant__ int JK[15]  = {2048, 2048, 256, 256, 2048, 2048, 2048, 2048, 512, 96, 96, 64, 512, 2048, 8192};
__constant__ int JKP[15] = {2048, 2048, 256, 256, 2048, 2048, 2048, 2048, 512, 128, 128, 128, 512, 2048, 8192};
__constant__ int JN[15]  = {4352, 64, 1024, 2048, 2048, 512, 512, 512, 2048, 1024, 1024, 1024, 1536, 8192, 2048};
__constant__ int JIN[15] = {I_WIN, I_WINV, I_GUP, I_WUKV, I_WOUT, I_WQM, I_WKM, I_WVM, I_WOM, I_WUP, I_AUP, I_VUP, I_WUQ, I_FF1, I_FF2};
__constant__ unsigned JDST[15] = {(unsigned)(WO_IN / KiB), (unsigned)(WO_IN / KiB), (unsigned)(WO_GUP / KiB), (unsigned)(WO_UKV / KiB), (unsigned)(WO_OUT / KiB), (unsigned)(WO_QM / KiB),
                                  (unsigned)(WO_KM / KiB), (unsigned)(WO_VM / KiB), (unsigned)(WO_OM / KiB), (unsigned)(WO_UP / KiB), (unsigned)(WO_AUP / KiB), (unsigned)(WO_VUP / KiB),
                                  (unsigned)(WO_UQ / KiB), (unsigned)(WO_FF1 / KiB), (unsigned)(WO_FF2 / KiB)};
__device__ __forceinline__ void p0_transpose_item(const float* W, int Kreal, int N, bf16* WT, int ldk, int row_off, LAS unsigned* scr, int item, int lane, bool rope, const float* gk) {
    const int nblk = N / 64, kb = item / nblk, nb = item % nblk, k0 = 64 * kb, n0 = 64 * nb;
    const int m = lane & 15, q = lane >> 4;
    f32x4 v[16];
#pragma unroll
    for (int i = 0; i < 16; ++i) { const int k = k0 + 8 * (i >> 1) + 2 * q + (i & 1); const int kc = k < Kreal ? k : Kreal - 1;
        v[i] = __builtin_nontemporal_load((const f32x4*)(W + (size_t)kc * N + n0 + 4 * m)); }
    if (k0 + 64 > Kreal) {
#pragma unroll
        for (int i = 0; i < 16; ++i) { const int k = k0 + 8 * (i >> 1) + 2 * q + (i & 1); if (k >= Kreal) v[i] = (f32x4){0.f, 0.f, 0.f, 0.f}; }
    }
    if (gk) {
        float gg[16];
#pragma unroll
        for (int i = 0; i < 16; ++i) gg[i] = gk[k0 + 8 * (i >> 1) + 2 * q + (i & 1)];
#pragma unroll
        for (int i = 0; i < 16; ++i) v[i] *= gg[i];
    }
#pragma unroll
    for (int j = 0; j < 8; ++j)
#pragma unroll
        for (int c = 0; c < 4; ++c) scr[(4 * m + c) * 32 + ((4 * j + q) ^ (4 * (m & 7)))] = cvt_pk(v[2 * j][c], v[2 * j + 1][c]);
    asm volatile("s_waitcnt lgkmcnt(0)" ::: "memory");
    const int x = lane & 7, r = lane >> 3;
#pragma unroll
    for (int t = 0; t < 8; ++t) { const int n = r + 8 * t; const u32x4 o = *(const LAS u32x4*)(scr + n * 32 + 4 * (x ^ ((n >> 2) & 7)));
        const int nd = rope ? 2 * (n & 31) + (n >> 5) : n;
        *(u32x4*)(WT + (size_t)(row_off + n0 + nd) * ldk + k0 + 8 * x) = o; }
    asm volatile("s_waitcnt lgkmcnt(0)" ::: "memory");
}
__device__ __forceinline__ void rms_row_2048(const float* xrow, const float* g, bf16* orow, float* rms_out, int lane) {
    f32x4 v[8]; float ss = 0.f;
#pragma unroll
    for (int j = 0; j < 4; ++j) { v[2 * j] = *(const f32x4*)(xrow + lane * 8 + 512 * j); v[2 * j + 1] = *(const f32x4*)(xrow + lane * 8 + 512 * j + 4); }
#pragma unroll
    for (int j = 0; j < 8; ++j) ss += (v[j][0] * v[j][0] + v[j][1] * v[j][1]) + (v[j][2] * v[j][2] + v[j][3] * v[j][3]);
    const float ms = wave_sum(ss) * (1.f / 2048.f) + NORM_EPS, rstd = rsqrtf(ms);
    if (rms_out && lane == 0) *rms_out = ms * rstd;
#pragma unroll
    for (int j = 0; j < 4; ++j) { const int c = lane * 8 + 512 * j;
        f32x4 a = v[2 * j] * rstd, b = v[2 * j + 1] * rstd;
        if (g) { a *= *(const f32x4*)(g + c); b *= *(const f32x4*)(g + c + 4); }
        u32x4 w; w.x = cvt_pk(a[0], a[1]); w.y = cvt_pk(a[2], a[3]); w.z = cvt_pk(b[0], b[1]); w.w = cvt_pk(b[2], b[3]);
        *(u32x4*)(orow + c) = w; }
}
__device__ __forceinline__ void convert_layer(Frame& F, ArgsP A, int l, int part, int wrank, int wcount) {
    LAS unsigned* scr = (LAS unsigned*)(F.lds + F.wave * 16384);
    const int k_lo = (part == 2) ? 13 : (part == 3 ? 14 : 0), k_hi = (part == 1) ? 13 : (part == 2 ? 14 : 15);
    int base = 0;
    for (int k = k_lo; k < k_hi; ++k) {
        const bool prev = (k == 1 || k == 11);
        if (prev && l == 0) continue;
        const int K = JK[k], KP = JKP[k], N = JN[k], row_off = (k == 1) ? INW : 0;
        const float* W = A->in[JIN[k]] + (size_t)(prev ? l - 1 : l) * K * N; const size_t dst = WL((size_t)JDST[k] * KiB);
        const int nitems = (KP / 64) * (N / 64);
        const float* gk = (k <= 1) ? A->in[I_MIXPRE] + (size_t)l * D : (k == 5 ? A->in[I_MEMPRE] + (size_t)l * D : (k == 13 ? A->in[I_FFNPRE] + (size_t)l * D : nullptr));
        int first = (wrank - base) % wcount; if (first < 0) first += wcount;
        for (int it = first; it < nitems; it += wcount) p0_transpose_item(W, K, N, WSP(bf16, dst), KP, row_off, scr, it, F.lane, k == 12 && (it % (N / 64)) % 3 == 2, gk);
        base = (base + nitems) % wcount;
    }
    if (part <= 1 && l > 0) {
        const long gt = (long)wrank * 64 + F.lane, NGT = (long)wcount * 64;
        unsigned* O = (unsigned*)(WSP(bf16, WL(WO_IN)) + (size_t)(INW + 64) * D);
        for (long i = gt; i < 192 * D / 2; i += NGT) O[i] = 0u;
    }
}
__device__ __forceinline__ void p0_prologue(Frame& F, ArgsP A) {
    const int gw = F.vcu * NWAVES + F.wave, NGW = F.G * NWAVES;
    const long gt = (long)F.vcu * NTHR + F.tid, NGT = (long)F.G * NTHR;
    convert_layer(F, A, 0, 1, gw, NGW);
    { float* cT = WSP(float, WS_COS); float* sT = WSP(float, WS_SIN);
      for (long i = gt; i < SEQ * 32; i += NGT) { const int pos = (int)(i >> 5), j = (int)(i & 31);
          const float invf = __builtin_amdgcn_exp2f(-13.287712379549449f * (float)j * (1.f / 32.f));
          const double rev = (double)pos * (double)invf * 0.15915494309189535; const float fr = (float)(rev - __builtin_rint(rev));
          cT[i] = __builtin_amdgcn_cosf(fr); sT[i] = __builtin_amdgcn_sinf(fr); } }
    for (int m = gw; m < T; m += NGW) rms_row_2048(A->in[I_X] + (size_t)m * D, nullptr, WSP(bf16, WS_U) + (size_t)m * D, WSP(float, WS_RMS) + m, F.lane);
    for (int m = gw; m < NB * NMEM; m += NGW) rms_row_2048(A->in[I_MEM] + (size_t)m * D, A->in[I_MEMG], WSP(bf16, WS_MEMN) + (size_t)m * D, nullptr, F.lane);
}

struct PrepRaw { u32x4 lc, lp, cq, vc[2], vp[2]; u32x2 ckv; bf16 k1, k2; float rc, rs; };
__device__ __forceinline__ void prep_load(Frame& F, int l, int m, int sc, bool act, PrepRaw& R) {
    const int lane = F.lane; const bf16* cur = WSP(bf16, WS_PROJ) + (size_t)m * PROJ_LD; const bf16* prv = cur - PROJ_LD; const bool first = (m & (SEQ - 1)) == 0;
    unsigned z_ = 0u; asm volatile("" : "+v"(z_));
    const u32x4 Z = (u32x4){z_, z_, z_, z_};
    R.lc = act ? *(const u32x4*)(cur + sc) : Z; R.lp = (act && !first) ? *(const u32x4*)(prv + sc) : Z;
    R.cq = *(const u32x4*)(cur + RIN + lane * 8); R.ckv = *(const u32x2*)(cur + RIN + 512 + lane * 4);
    R.k1 = cur[RIN + 768 + (lane & 31)]; R.k2 = cur[RIN + 768 + 32 + (lane & 31)];
    { const int pos = m & (SEQ - 1); R.rc = WSP(float, WS_COS)[pos * 32 + (lane & 31)]; R.rs = WSP(float, WS_SIN)[pos * 32 + (lane & 31)]; }
    if (l == 0) {
#pragma unroll
        for (int j = 0; j < 2; ++j) { const int c = lane * 8 + 512 * j; R.vc[j] = *(const u32x4*)(cur + 2048 + c); R.vp[j] = first ? Z : *(const u32x4*)(prv + 2048 + c); } }
}
__device__ __forceinline__ void prep_row(Frame& F, int l, int m, int oc, int kind, const float (&mv)[8], const f32x4& qg0, const f32x4& qg1, const f32x4& kvg, const float* mu, const PrepRaw& R) {
    const int lane = F.lane;
    bf16* lo = WSP(bf16, WS_LORA) + (size_t)m * LORA_LD;
    { float y[8], yp[8], o[8]; unpack8(R.lc, y); unpack8(R.lp, yp);
#pragma unroll
      for (int i = 0; i < 8; ++i) { const float c = y[i] + (yp[i] - y[i]) * mv[i]; const float sg = sigmoidf_(kind == 1 ? 2.f * c : c); o[i] = kind == 1 ? 2.f * sg - 1.f : (kind == 2 ? sg : c); }
      *(u32x4*)(lo + oc) = pack8(o);
      unsigned zz = 0u; asm volatile("" : "+v"(zz));
      if (lane < 16) *(u32x4*)(lo + (lane < 4 ? 96 + 8 * lane : (lane < 8 ? 224 + 8 * (lane - 4) : 576 + 8 * (lane - 8)))) = (u32x4){zz, zz, zz, zz}; }
    { float v[8]; unpack8(R.cq, v); float ss = 0.f;
#pragma unroll
      for (int i = 0; i < 8; ++i) ss += v[i] * v[i];
      const float rstd = rsqrtf(wave_sum(ss) * (1.f / 512.f) + NORM_EPS);
      u32x4 w; w.x = cvt_pk(v[0] * rstd * qg0[0], v[1] * rstd * qg0[1]); w.y = cvt_pk(v[2] * rstd * qg0[2], v[3] * rstd * qg0[3]);
      w.z = cvt_pk(v[4] * rstd * qg1[0], v[5] * rstd * qg1[1]); w.w = cvt_pk(v[6] * rstd * qg1[2], v[7] * rstd * qg1[3]);
      *(u32x4*)(WSP(bf16, WS_CQN) + (size_t)m * 512 + lane * 8) = w; }
    { const float v0 = bflo(R.ckv.x), v1 = bfhi(R.ckv.x), v2 = bflo(R.ckv.y), v3 = bfhi(R.ckv.y);
      const float rstd = rsqrtf(wave_sum(v0 * v0 + v1 * v1 + v2 * v2 + v3 * v3) * (1.f / 256.f) + NORM_EPS);
      u32x2 w; w.x = cvt_pk(v0 * rstd * kvg[0], v1 * rstd * kvg[1]); w.y = cvt_pk(v2 * rstd * kvg[2], v3 * rstd * kvg[3]);
      *(u32x2*)(WSP(bf16, WS_CKVN) + (size_t)m * 256 + lane * 4) = w; }
    if (lane < 32) { const float x1 = bf1(R.k1), x2 = bf1(R.k2);
      *(unsigned*)(WSP(bf16, WS_KR) + (size_t)m * 64 + 2 * lane) = cvt_pk(x1 * R.rc - x2 * R.rs, x1 * R.rs + x2 * R.rc); }
    if (l == 0) {
#pragma unroll
        for (int j = 0; j < 2; ++j) { const int c = lane * 8 + 512 * j; float a[8], p[8], o[8]; unpack8(R.vc[j], a); unpack8(R.vp[j], p);
            const f32x4 m0 = *(const f32x4*)(mu + 2048 + c), m1 = *(const f32x4*)(mu + 2048 + c + 4);
#pragma unroll
            for (int i = 0; i < 8; ++i) o[i] = a[i] + (p[i] - a[i]) * (i < 4 ? m0[i] : m1[i - 4]);
            *(u32x4*)(WSP(bf16, WS_VF) + (size_t)m * 1024 + c) = pack8(o); } }
}
__device__ __forceinline__ void prep_phase(Frame& F, ArgsP A, int l) {
    const int gw = F.vcu * NWAVES + F.wave, NGW = F.G * NWAVES, lane = F.lane;
    const float* mu = A->in[I_MU] + (size_t)l * RIN;
    const float* muv = A->in[I_MUV] + (size_t)(l > 0 ? l - 1 : 0) * 64;
    const int sc = lane < 56 ? 3072 + 8 * lane : INW + 8 * (lane - 56);
    const int oc = lane < 12 ? 8 * lane : (lane < 24 ? 128 + 8 * (lane - 12) : (lane < 56 ? 256 + 8 * (lane - 24) : 512 + 8 * (lane - 56)));
    const int kind = lane < 12 ? 1 : (lane < 24 ? 0 : (lane < 56 ? 2 : 3));
    const bool act = kind != 3 || l > 0;
    float mv[8];
#pragma unroll
    for (int i = 0; i < 8; ++i) mv[i] = kind == 3 ? muv[8 * (lane - 56) + i] : mu[sc + i];
    const float* qg = A->in[I_QNG] + (size_t)l * 512; const float* kvgp = A->in[I_KVNG] + (size_t)l * 256;
    const f32x4 qg0 = *(const f32x4*)(qg + lane * 8), qg1 = *(const f32x4*)(qg + lane * 8 + 4), kvg = *(const f32x4*)(kvgp + lane * 4);
    for (int m = gw; m < T; m += 2 * NGW) {
        PrepRaw R0, R1; const int m1 = m + NGW;
        prep_load(F, l, m, sc, act, R0);
        if (m1 < T) prep_load(F, l, m1, sc, act, R1);
        prep_row(F, l, m, oc, kind, mv, qg0, qg1, kvg, mu, R0);
        if (m1 < T) prep_row(F, l, m1, oc, kind, mv, qg0, qg1, kvg, mu, R1);
    }
}

constexpr int CK = 32, NCHUNK = SEQ / CK;
constexpr int CS_TS = 144, CS_TILE = 32 * CS_TS, CS_PC = 5 * CS_TILE, CS_WAVE = 5 * CS_TILE + 256;
constexpr int CS_NW = 7;
constexpr size_t SCU_BYTES = 24576; constexpr int SCU_X = 8192, SCU_PSI = 12288, SCU_G2 = 20480;
constexpr int SQ_SLOT = 18432, SQ_NSLOT = 7;
static_assert(CS_NW * CS_WAVE <= RING_BYTES && SQ_NSLOT * SQ_SLOT <= RING_BYTES, "LDS budget");
#define MF32(a, b, c) __builtin_amdgcn_mfma_f32_32x32x16_bf16((a), (b), (c), 0, 0, 0)
__device__ __forceinline__ bf16x8 pack8f(float a0, float a1, float a2, float a3, float a4, float a5, float a6, float a7) {
    u32x4 w; w.x = cvt_pk(a0, a1); w.y = cvt_pk(a2, a3); w.z = cvt_pk(a4, a5); w.w = cvt_pk(a6, a7); return __builtin_bit_cast(bf16x8, w); }
#define PACKS(x, s) pack8f((x)[8 * (s)], (x)[8 * (s) + 1], (x)[8 * (s) + 2], (x)[8 * (s) + 3], (x)[8 * (s) + 4], (x)[8 * (s) + 5], (x)[8 * (s) + 6], (x)[8 * (s) + 7])
__device__ __forceinline__ bf16x8 trfrag(const LAS unsigned char* p) {
    const s16x4 lo = __builtin_bit_cast(s16x4, __builtin_amdgcn_ds_read_tr16_b64_v4i16((LAS v4i16_t*)p));
    const s16x4 hh = __builtin_bit_cast(s16x4, __builtin_amdgcn_ds_read_tr16_b64_v4i16((LAS v4i16_t*)(p + 8 * CS_TS)));
    return (bf16x8){lo[0], lo[1], lo[2], lo[3], hh[0], hh[1], hh[2], hh[3]}; }
__device__ __forceinline__ void st_init16(unsigned char* p, const f32x16& x) {
    u32x4 w0, w1; w0.x = cvt_pk(x[0], x[1]); w0.y = cvt_pk(x[2], x[3]); w0.z = cvt_pk(x[4], x[5]); w0.w = cvt_pk(x[6], x[7]);
    w1.x = cvt_pk(x[8], x[9]); w1.y = cvt_pk(x[10], x[11]); w1.z = cvt_pk(x[12], x[13]); w1.w = cvt_pk(x[14], x[15]);
    *(u32x4*)p = w0; *(u32x4*)(p + 16) = w1; }
__device__ __forceinline__ f32x16 ld_init16(const LAS unsigned char* p) {
    const u32x4 w0 = *(const LAS u32x4*)p, w1 = *(const LAS u32x4*)(p + 16); f32x16 x;
    x[0] = bflo(w0.x); x[1] = bfhi(w0.x); x[2] = bflo(w0.y); x[3] = bfhi(w0.y); x[4] = bflo(w0.z); x[5] = bfhi(w0.z); x[6] = bflo(w0.w); x[7] = bfhi(w0.w);
    x[8] = bflo(w1.x); x[9] = bfhi(w1.x); x[10] = bflo(w1.y); x[11] = bfhi(w1.y); x[12] = bflo(w1.z); x[13] = bfhi(w1.z); x[14] = bflo(w1.w); x[15] = bfhi(w1.w); return x; }

struct CsRaw { u32x4 r[4], k[4], a[4], e[4]; bf16 rp, kp; };
__device__ __forceinline__ void cs_load_raw(Frame& F, int l, int bh, int cc, CsRaw& R) {
    const int lane = F.lane, b = bh >> 4, h = bh & 15, pc = lane & 7;
    const size_t row0 = (size_t)b * SEQ + (size_t)cc * CK;
    const bf16* PROJ = WSP(bf16, WS_PROJ); const bf16* AIC = WSP(bf16, WS_AIC); const bf16* WLOG = WSP(bf16, WS_WLOG);
#pragma unroll
    for (int i = 0; i < 4; ++i) { const size_t gr = row0 + (lane >> 3) + 8 * i;
        R.r[i] = *(const u32x4*)(PROJ + gr * PROJ_LD + h * 64 + pc * 8); R.k[i] = *(const u32x4*)(PROJ + gr * PROJ_LD + 1024 + h * 64 + pc * 8);
        R.a[i] = *(const u32x4*)(AIC + gr * 1024 + h * 64 + pc * 8); R.e[i] = *(const u32x4*)(WLOG + gr * 1024 + h * 64 + pc * 8); }
    R.rp = 0; R.kp = 0;
    if (cc > 0) { R.rp = PROJ[(row0 - 1) * PROJ_LD + h * 64 + lane]; R.kp = PROJ[(row0 - 1) * PROJ_LD + 1024 + h * 64 + lane]; }
}
__device__ __forceinline__ void cs_elementwise(Frame& F, ArgsP A, int l, int bh, int cc, LAS unsigned char* wl, const CsRaw& R) {
    const int lane = F.lane, b = bh >> 4, h = bh & 15, ch = h * 64 + lane;
    const size_t row0 = (size_t)b * SEQ + (size_t)cc * CK;
    float* RKB = WSP(float, WS_RKB);
    const bf16* VV = (l == 0) ? WSP(bf16, WS_VF) : WSP(bf16, WS_VV);
    u32x4 vraw[4];
#pragma unroll
    for (int i = 0; i < 4; ++i) vraw[i] = *(const u32x4*)(VV + (row0 + (lane >> 3) + 8 * i) * 1024 + h * 64 + (lane & 7) * 8);
#pragma unroll
    for (int i = 0; i < 4; ++i) { LAS unsigned char* p = wl + ((lane >> 3) + 8 * i) * CS_TS + (lane & 7) * 16;
        *(LAS u32x4*)(p) = R.k[i]; *(LAS u32x4*)(p + CS_TILE) = R.a[i]; *(LAS u32x4*)(p + 2 * CS_TILE) = R.e[i]; *(LAS u32x4*)(p + 3 * CS_TILE) = R.r[i]; }
    const float mur = A->in[I_MU][(size_t)l * RIN + ch], muk = A->in[I_MU][(size_t)l * RIN + 1024 + ch];
    const float ckk = A->in[I_KK][(size_t)l * 1024 + ch], cka = A->in[I_KA][(size_t)l * 1024 + ch], crk = A->in[I_RK][(size_t)l * 1024 + ch];
    float rp = bf1(R.rp), kp_ = bf1(R.kp);
    float lp = 0.f, pexc = 1.f;
    constexpr float L2E = 1.4426950408889634f;
    asm volatile("s_waitcnt lgkmcnt(0)" ::: "memory");
#pragma unroll 8
    for (int tt = 0; tt < CK; ++tt) {
        LAS unsigned char* rowp = wl + tt * CS_TS + lane * 2;
        const float kc = bf1(*(const LAS bf16*)(rowp)), aa = bf1(*(const LAS bf16*)(rowp + CS_TILE)), ee = bf1(*(const LAS bf16*)(rowp + 2 * CS_TILE)), rc = bf1(*(const LAS bf16*)(rowp + 3 * CS_TILE));
        const float rs = rc + (rp - rc) * mur, ks = kc + (kp_ - kc) * muk; rp = rc; kp_ = kc;
        float kk = ks * ckk; const float ss = wave_sum(kk * kk); kk *= rsqrtf(fmaxf(ss, 1e-24f));
        const float kq = ks * (1.f + (aa - 1.f) * cka);
        const float rkb = wave_sum(rs * kq * crk);
        lp += ee;
        const float pinc = __builtin_amdgcn_exp2f(lp * L2E), pinv = __builtin_amdgcn_exp2f(-lp * L2E);
        *(LAS bf16*)(rowp) = f2bf(-kk * pexc);
        *(LAS bf16*)(rowp + CS_TILE) = f2bf(kk * aa * pinv);
        *(LAS bf16*)(rowp + 2 * CS_TILE) = f2bf(kq * pinv);
        *(LAS bf16*)(rowp + 3 * CS_TILE) = f2bf(rs * pinc);
        pexc = pinc;
        if (lane == 0) RKB[(row0 + tt) * 16 + h] = rkb;
    }
    ((LAS float*)(wl + CS_PC))[lane] = __builtin_amdgcn_exp2f(lp * L2E);
#pragma unroll
    for (int i = 0; i < 4; ++i) *(LAS u32x4*)(wl + 4 * CS_TILE + ((lane >> 3) + 8 * i) * CS_TS + (lane & 7) * 16) = vraw[i];
}
__device__ __forceinline__ void cs_mfma(Frame& F, const LAS unsigned char* wl, unsigned char* ub) {
    const int lane = F.lane, r32 = lane & 31, h = lane >> 5, q4 = (lane & 15) >> 2, pp = lane & 3, blk = (lane >> 4) & 1;
    const LAS unsigned char* tA = wl; const LAS unsigned char* tB = wl + CS_TILE; const LAS unsigned char* tK = wl + 2 * CS_TILE;
    const LAS unsigned char* tR = wl + 3 * CS_TILE; const LAS unsigned char* tV = wl + 4 * CS_TILE;
    const int rowoff = r32 * CS_TS + h * 16, troff = (4 * h + q4) * CS_TS + blk * 32 + pp * 8;
#define FROW(t, s) (*(const LAS bf16x8*)((t) + rowoff + (s) * 32))
#define FTR(t, ct, s) trfrag((t) + troff + (s) * 16 * CS_TS + (ct) * 64)
    const f32x16 Z = (f32x16){};
    f32x16 P = Z, PT = Z;
#pragma unroll
    for (int s = 0; s < 4; ++s) { const bf16x8 fa = FROW(tA, s), fb = FROW(tB, s); P = MF32(fb, fa, P); PT = MF32(fa, fb, PT); }
#pragma unroll
    for (int r = 0; r < 16; ++r) { const int cr = crow(r, h); if (!(cr < r32)) P[r] = 0.f; if (!(r32 < cr)) PT[r] = 0.f; }
    f32x16 TmT = PT;
#pragma unroll
    for (int r = 0; r < 16; ++r) if (crow(r, h) == r32) TmT[r] += 1.f;
    f32x16 Tm;
#pragma unroll
    for (int it = 0; it < 4; ++it) {
        const bf16x8 pP0 = PACKS(P, 0), pP1 = PACKS(P, 1), pT0 = PACKS(PT, 0), pT1 = PACKS(PT, 1);
        f32x16 Pn = MF32(pT0, pP0, Z); Pn = MF32(pT1, pP1, Pn);
        f32x16 Y = Pn;
#pragma unroll
        for (int r = 0; r < 16; ++r) if (crow(r, h) == r32) Y[r] += 1.f;
        const bf16x8 y0 = PACKS(Y, 0), y1 = PACKS(Y, 1), t0 = PACKS(TmT, 0), t1 = PACKS(TmT, 1);
        if (it < 3) {
            f32x16 PTn = MF32(pP0, pT0, Z); PTn = MF32(pP1, pT1, PTn);
            f32x16 Tn = MF32(y0, t0, Z); Tn = MF32(y1, t1, Tn);
            P = Pn; PT = PTn; TmT = Tn;
        } else { Tm = MF32(t0, y0, Z); Tm = MF32(t1, y1, Tm); }
    }
    f32x16 W1;
    { f32x16 NakT = Z;
#pragma unroll
      for (int s = 0; s < 4; ++s) NakT = MF32(FROW(tA, s), FROW(tK, s), NakT);
#pragma unroll
      for (int r = 0; r < 16; ++r) if (!(r32 < crow(r, h))) NakT[r] = 0.f;
      W1 = MF32(PACKS(NakT, 0), PACKS(Tm, 0), Z); W1 = MF32(PACKS(NakT, 1), PACKS(Tm, 1), W1); }
    f32x16 ATT[2], G1T[2];
    { const bf16x8 m0 = PACKS(Tm, 0), m1 = PACKS(Tm, 1), w0 = PACKS(W1, 0), w1 = PACKS(W1, 1);
#pragma unroll
      for (int ct = 0; ct < 2; ++ct) { ATT[ct] = MF32(m0, FTR(tA, ct, 0), Z); ATT[ct] = MF32(m1, FTR(tA, ct, 1), ATT[ct]);
                                       G1T[ct] = MF32(w0, FTR(tV, ct, 0), Z); G1T[ct] = MF32(w1, FTR(tV, ct, 1), G1T[ct]); } }
    f32x16 Mbr = Z, Mkr = Z;
#pragma unroll
    for (int s = 0; s < 4; ++s) { const bf16x8 fr = FROW(tR, s); Mbr = MF32(FROW(tB, s), fr, Mbr); Mkr = MF32(FROW(tK, s), fr, Mkr); }
#pragma unroll
    for (int r = 0; r < 16; ++r) if (!(crow(r, h) <= r32)) { Mbr[r] = 0.f; Mkr[r] = 0.f; }
    const bf16x8 b0 = PACKS(Mbr, 0), b1 = PACKS(Mbr, 1), k0 = PACKS(Mkr, 0), k1 = PACKS(Mkr, 1);
#pragma unroll
    for (int kt = 0; kt < 2; ++kt) {
        f32x16 X = MF32(PACKS(ATT[kt], 0), b0, Z); X = MF32(PACKS(ATT[kt], 1), b1, X);
#pragma unroll
        for (int g = 0; g < 4; ++g) { const u32x2 w = *(const LAS u32x2*)(tR + r32 * CS_TS + (32 * kt + 8 * g + 4 * h) * 2);
            X[4 * g] += bflo(w.x); X[4 * g + 1] += bfhi(w.x); X[4 * g + 2] += bflo(w.y); X[4 * g + 3] += bfhi(w.y); }
        *(bf16x8*)(ub + SCU_X + ((2 * kt) * 64 + lane) * 16) = PACKS(X, 0);
        *(bf16x8*)(ub + SCU_X + ((2 * kt + 1) * 64 + lane) * 16) = PACKS(X, 1);
    }
#pragma unroll
    for (int ct = 0; ct < 2; ++ct) {
        f32x16 G = MF32(b0, PACKS(G1T[ct], 0), Z); G = MF32(b1, PACKS(G1T[ct], 1), G);
        G = MF32(k0, FTR(tV, ct, 0), G); G = MF32(k1, FTR(tV, ct, 1), G);
        st_init16(ub + SCU_G2 + (ct * 64 + lane) * 32, G);
    }
    const LAS float* PC = (const LAS float*)(wl + CS_PC);
#pragma unroll
    for (int ct = 0; ct < 2; ++ct) {
        const float pc = PC[32 * ct + r32];
        const bf16x8 f0 = FTR(tB, ct, 0), f1 = FTR(tB, ct, 1);
#pragma unroll
        for (int kt = 0; kt < 2; ++kt) {
            f32x16 Ph = MF32(PACKS(ATT[kt], 0), f0, Z); Ph = MF32(PACKS(ATT[kt], 1), f1, Ph);
            if (kt == ct) {
#pragma unroll
                for (int r = 0; r < 16; ++r) if (crow(r, h) == r32) Ph[r] += 1.f; }
#pragma unroll
            for (int r = 0; r < 16; ++r) Ph[r] *= pc;
            *(bf16x8*)(ub + ((ct * 4 + 2 * kt) * 64 + lane) * 16) = PACKS(Ph, 0);
            *(bf16x8*)(ub + ((ct * 4 + 2 * kt + 1) * 64 + lane) * 16) = PACKS(Ph, 1);
        }
    }
#pragma unroll
    for (int mt = 0; mt < 2; ++mt) {
        const bf16x8 fb0 = FTR(tB, mt, 0), fb1 = FTR(tB, mt, 1), fk0 = FTR(tK, mt, 0), fk1 = FTR(tK, mt, 1);
        float pcr[16];
#pragma unroll
        for (int g = 0; g < 4; ++g) { const f32x4 v = *(const LAS f32x4*)(PC + 32 * mt + 8 * g + 4 * h); pcr[4 * g] = v[0]; pcr[4 * g + 1] = v[1]; pcr[4 * g + 2] = v[2]; pcr[4 * g + 3] = v[3]; }
#pragma unroll
        for (int ct = 0; ct < 2; ++ct) {
            f32x16 Ps = MF32(fb0, PACKS(G1T[ct], 0), Z); Ps = MF32(fb1, PACKS(G1T[ct], 1), Ps);
            Ps = MF32(fk0, FTR(tV, ct, 0), Ps); Ps = MF32(fk1, FTR(tV, ct, 1), Ps);
#pragma unroll
            for (int r = 0; r < 16; ++r) Ps[r] *= pcr[r];
            st_init16(ub + SCU_PSI + ((ct * 2 + mt) * 64 + lane) * 32, Ps);
        }
    }
#undef FROW
#undef FTR
}
__device__ __forceinline__ void cs_pre_phase(Frame& F, ArgsP A, int l) {
    volatile LAS unsigned* cnt = (volatile LAS unsigned*)(F.lds + LDSCTL_OFF);
    if (F.tid == 0) cnt[0] = 0u;
    __syncthreads();
    if (F.wave < CS_NW) {
        LAS unsigned char* wl = F.lds + F.wave * CS_WAVE;
        const int per = (64 * NCHUNK + F.G - 1) / F.G, ubase = F.vcu * per, uend = (ubase + per < 64 * NCHUNK) ? ubase + per : 64 * NCHUNK;
#define CS_NEXT(dst) do { unsigned v_ = 0u; if (F.lane == 0) v_ = __hip_atomic_fetch_add((LAS unsigned*)cnt, 1u, __ATOMIC_RELAXED, __HIP_MEMORY_SCOPE_WORKGROUP); dst = ubase + (int)__builtin_amdgcn_readfirstlane((int)v_); } while (0)
        int u; CS_NEXT(u);
        CsRaw R;
        if (u < uend) cs_load_raw(F, l, u >> 7, u & (NCHUNK - 1), R);
        while (u < uend) {
            cs_elementwise(F, A, l, u >> 7, u & (NCHUNK - 1), wl, R);
            int un; CS_NEXT(un);
            if (un < uend) cs_load_raw(F, l, un >> 7, un & (NCHUNK - 1), R);
            asm volatile("s_waitcnt lgkmcnt(0)" ::: "memory");
            cs_mfma(F, wl, F.ws + WS_SCAN + (size_t)u * SCU_BYTES);
            asm volatile("s_waitcnt lgkmcnt(0)" ::: "memory");
            u = un;
        }
#undef CS_NEXT
    }
}
__device__ __forceinline__ void cs_seq_unit(Frame& F, int bh, int ct) {
    const int lane = F.lane, wave = F.wave, r32 = lane & 31, h = lane >> 5;
    LAS unsigned char* L = F.lds;
    const unsigned char* ub = F.ws + WS_SCAN + (size_t)bh * NCHUNK * SCU_BYTES;
    if (wave > 0) {
        const int w = wave - 1;
        size_t so[3]; int np = 0;
#pragma unroll
        for (int k = 0; k < 3; ++k) { const int p = w + 7 * k; so[k] = p < 12 ? (size_t)p * 1024 : (p < 16 ? (size_t)SCU_PSI + ct * 4096 + (p - 12) * 1024 : (size_t)SCU_G2 + ct * 2048 + (p - 16) * 1024); if (p < 18) np = k + 1; }
#define SQ_ISSUE(c) do { const unsigned char* g_ = ub + (size_t)(c) * SCU_BYTES + lane * 16; LAS unsigned char* d_ = L + ((c) % SQ_NSLOT) * SQ_SLOT; \
        _Pragma("unroll") for (int k = 0; k < 3; ++k) if (k < np) __builtin_amdgcn_global_load_lds((const unsigned*)(g_ + so[k]), (LAS unsigned*)(d_ + (w + 7 * k) * 1024), 16, 0, 0); } while (0)
        for (int c = 0; c < 6; ++c) SQ_ISSUE(c);
        if (np == 3) asm volatile("s_waitcnt vmcnt(15)" ::: "memory"); else asm volatile("s_waitcnt vmcnt(10)" ::: "memory");
        asm volatile("s_barrier" ::: "memory");
        for (int c = 0; c < NCHUNK; ++c) {
            if (c + 6 < NCHUNK) { SQ_ISSUE(c + 6); if (np == 3) asm volatile("s_waitcnt vmcnt(15)" ::: "memory"); else asm volatile("s_waitcnt vmcnt(10)" ::: "memory"); }
            else asm volatile("s_waitcnt vmcnt(0)" ::: "memory");
            asm volatile("s_barrier" ::: "memory");
        }
#undef SQ_ISSUE
    } else {
        f32x16 S0 = (f32x16){}, S1 = (f32x16){};
        const int b = bh >> 4, hh = bh & 15;
        bf16* op = (bf16*)(F.ws + WS_Y) + ((size_t)b * SEQ) * 1024 + hh * 64 + 32 * ct + r32;
        asm volatile("s_barrier" ::: "memory");
        for (int c = 0; c < NCHUNK; ++c) {
            const LAS unsigned char* sl = L + (c % SQ_NSLOT) * SQ_SLOT;
            const bf16x8 bS0 = PACKS(S0, 0), bS1 = PACKS(S0, 1), bS2 = PACKS(S1, 0), bS3 = PACKS(S1, 1);
            f32x16 n0 = ld_init16(sl + 12288 + (0 * 64 + lane) * 32), n1 = ld_init16(sl + 12288 + (1 * 64 + lane) * 32);
            const f32x16 Z = (f32x16){};
            f32x16 m0 = MF32(*(const LAS bf16x8*)(sl + (2 * 64 + lane) * 16), bS2, Z), m1 = MF32(*(const LAS bf16x8*)(sl + (6 * 64 + lane) * 16), bS2, Z);
            n0 = MF32(*(const LAS bf16x8*)(sl + (0 * 64 + lane) * 16), bS0, n0); n1 = MF32(*(const LAS bf16x8*)(sl + (4 * 64 + lane) * 16), bS0, n1);
            m0 = MF32(*(const LAS bf16x8*)(sl + (3 * 64 + lane) * 16), bS3, m0); m1 = MF32(*(const LAS bf16x8*)(sl + (7 * 64 + lane) * 16), bS3, m1);
            n0 = MF32(*(const LAS bf16x8*)(sl + (1 * 64 + lane) * 16), bS1, n0); n1 = MF32(*(const LAS bf16x8*)(sl + (5 * 64 + lane) * 16), bS1, n1);
            f32x16 o = ld_init16(sl + 16384 + lane * 32);
            o = MF32(*(const LAS bf16x8*)(sl + 8192 + (0 * 64 + lane) * 16), bS0, o); o = MF32(*(const LAS bf16x8*)(sl + 8192 + (1 * 64 + lane) * 16), bS1, o);
            o = MF32(*(const LAS bf16x8*)(sl + 8192 + (2 * 64 + lane) * 16), bS2, o); o = MF32(*(const LAS bf16x8*)(sl + 8192 + (3 * 64 + lane) * 16), bS3, o);
            S0 = n0 + m0; S1 = n1 + m1;
#pragma unroll
            for (int r = 0; r < 16; ++r) op[(size_t)(c * CK + crow(r, h)) * 1024] = f2bf(o[r]);
            asm volatile("s_waitcnt lgkmcnt(0)\n\ts_barrier" ::: "memory");
        }
    }
    asm volatile("s_waitcnt vmcnt(0)" ::: "memory");
    __syncthreads();
}

struct PostRaw { u32x4 o[2], v[2], g[2]; float rkb; };
__device__ __forceinline__ void post_load(Frame& F, const bf16* VV, int m, PostRaw& R) {
    const int c0 = F.lane * 16; const size_t off = (size_t)m * 1024 + c0;
    R.o[0] = *(const u32x4*)(WSP(bf16, WS_Y) + off); R.o[1] = *(const u32x4*)(WSP(bf16, WS_Y) + off + 8);
    R.v[0] = *(const u32x4*)(VV + off); R.v[1] = *(const u32x4*)(VV + off + 8);
    R.g[0] = *(const u32x4*)(WSP(bf16, WS_GATE) + off); R.g[1] = *(const u32x4*)(WSP(bf16, WS_GATE) + off + 8);
    R.rkb = WSP(float, WS_RKB)[(size_t)m * 16 + (F.lane >> 2)];
}
__device__ __forceinline__ void post_row(Frame& F, int m, const float* lgp, const float* lbp, const PostRaw& R) {
    const int c0 = F.lane * 16;
    float lg[16], lb[16];
#pragma unroll
    for (int i = 0; i < 4; ++i) { const f32x4 a = *(const f32x4*)(lgp + c0 + 4 * i), b = *(const f32x4*)(lbp + c0 + 4 * i);
#pragma unroll
        for (int k = 0; k < 4; ++k) { lg[4 * i + k] = a[k]; lb[4 * i + k] = b[k]; } }
    float o[16], vv[16], gg[16];
#pragma unroll
    for (int j = 0; j < 2; ++j) { float t8[8]; unpack8(R.o[j], t8);
#pragma unroll
        for (int i = 0; i < 8; ++i) o[8 * j + i] = t8[i];
        unpack8(R.v[j], t8);
#pragma unroll
        for (int i = 0; i < 8; ++i) vv[8 * j + i] = t8[i];
        unpack8(R.g[j], t8);
#pragma unroll
        for (int i = 0; i < 8; ++i) gg[8 * j + i] = t8[i]; }
    float s = 0.f;
#pragma unroll
    for (int i = 0; i < 16; ++i) s += o[i];
    s = sum4(s);
    const float mean = s * (1.f / 64.f); float q = 0.f;
#pragma unroll
    for (int i = 0; i < 16; ++i) { o[i] -= mean; q += o[i] * o[i]; }
    q = sum4(q);
    const float rstd = rsqrtf(q * (1.f / 64.f) + GN_EPS);
    float y[16];
#pragma unroll
    for (int i = 0; i < 16; ++i) y[i] = (o[i] * rstd * lg[i] + lb[i] + R.rkb * vv[i]) * gg[i];
    bf16* dst = WSP(bf16, WS_AO) + (size_t)m * D + c0;
    u32x4 w0, w1; w0.x = cvt_pk(y[0], y[1]); w0.y = cvt_pk(y[2], y[3]); w0.z = cvt_pk(y[4], y[5]); w0.w = cvt_pk(y[6], y[7]);
    w1.x = cvt_pk(y[8], y[9]); w1.y = cvt_pk(y[10], y[11]); w1.z = cvt_pk(y[12], y[13]); w1.w = cvt_pk(y[14], y[15]);
    *(u32x4*)dst = w0; *(u32x4*)(dst + 8) = w1;
}
__device__ __forceinline__ void rwkv_post_phase(Frame& F, ArgsP A, int l) {
    const int gw = F.vcu * NWAVES + F.wave, NGW = F.G * NWAVES;
    const bf16* VV = (l == 0) ? WSP(bf16, WS_VF) : WSP(bf16, WS_VV);
    const float* lg = A->in[I_LNG] + (size_t)l * 1024; const float* lb = A->in[I_LNB] + (size_t)l * 1024;
    for (int m = gw; m < T; m += 2 * NGW) {
        PostRaw R0, R1; const int m1 = m + NGW;
        post_load(F, VV, m, R0);
        if (m1 < T) post_load(F, VV, m1, R1);
        post_row(F, m, lg, lb, R0);
        if (m1 < T) post_row(F, m1, lg, lb, R1);
    }
}

__device__ __forceinline__ void ew_norm_phase(Frame& F, const float* gpost, bool last) {
    const int gw = F.vcu * NWAVES + F.wave, NGW = F.G * NWAVES, lane = F.lane;
    const bf16* Y = WSP(bf16, WS_Y); bf16* U = WSP(bf16, WS_U); float* RMS = WSP(float, WS_RMS);
    for (int m = gw; m < T; m += NGW) {
        float y[32]; float ss = 0.f;
#pragma unroll
        for (int j = 0; j < 4; ++j) { float t8[8]; unpack8(*(const u32x4*)(Y + (size_t)m * D + lane * 8 + 512 * j), t8);
#pragma unroll
            for (int i = 0; i < 8; ++i) { y[8 * j + i] = t8[i]; ss += t8[i] * t8[i]; } }
        const float rold = RMS[m];
        const float rstd = rsqrtf(wave_sum(ss) * (1.f / 2048.f) + NORM_EPS);
        float hn[32]; float s2 = 0.f;
#pragma unroll
        for (int j = 0; j < 4; ++j) { const int c = lane * 8 + 512 * j;
            float h8[8]; unpack8(*(const u32x4*)(U + (size_t)m * D + c), h8);
            const f32x4 g0 = *(const f32x4*)(gpost + c), g1 = *(const f32x4*)(gpost + c + 4);
#pragma unroll
            for (int i = 0; i < 4; ++i) { hn[8 * j + i] = h8[i] * rold + y[8 * j + i] * rstd * g0[i]; hn[8 * j + 4 + i] = h8[4 + i] * rold + y[8 * j + 4 + i] * rstd * g1[i]; }
            if (last) { float* hp = F.H + (size_t)m * D + c; *(f32x4*)hp = (f32x4){hn[8 * j], hn[8 * j + 1], hn[8 * j + 2], hn[8 * j + 3]}; *(f32x4*)(hp + 4) = (f32x4){hn[8 * j + 4], hn[8 * j + 5], hn[8 * j + 6], hn[8 * j + 7]}; }
#pragma unroll
            for (int i = 0; i < 8; ++i) s2 += hn[8 * j + i] * hn[8 * j + i]; }
        if (!last) {
            const float ms = wave_sum(s2) * (1.f / 2048.f) + NORM_EPS, r2 = rsqrtf(ms);
            if (lane == 0) RMS[m] = ms * r2;
#pragma unroll
            for (int j = 0; j < 4; ++j) { const int c = lane * 8 + 512 * j;
                u32x4 w; w.x = cvt_pk(hn[8 * j] * r2, hn[8 * j + 1] * r2); w.y = cvt_pk(hn[8 * j + 2] * r2, hn[8 * j + 3] * r2);
                w.z = cvt_pk(hn[8 * j + 4] * r2, hn[8 * j + 5] * r2); w.w = cvt_pk(hn[8 * j + 6] * r2, hn[8 * j + 7] * r2);
                *(u32x4*)(U + (size_t)m * D + c) = w; }
        }
    }
}

template <int DQK, bool CAUSAL>
__device__ __forceinline__ void attn_unit(LAS unsigned char* lds, const bf16* __restrict__ Q, int ldq, const bf16* __restrict__ K1, int ldk1, const bf16* __restrict__ K2, int ldk2,
                                          const bf16* __restrict__ V, int ldv, bf16* __restrict__ O, int ldo, int qpos0, int ntiles) {
    constexpr int KROW = DQK * 2, KT = 64 * KROW, VT = 16384, ND0 = DQK / 16, NKC = DQK / 64;
    int tid = threadIdx.x; asm volatile("" : "+v"(tid));
    const int lane = tid & 63, wid = __builtin_amdgcn_readfirstlane(tid >> 6), r32 = lane & 31, hi = lane >> 5;
    LAS unsigned char* Kl = lds; LAS unsigned char* Vl = lds + 2 * KT;
    bf16x8 qr[ND0];
    { const bf16* qrow = Q + (size_t)(wid * 32 + r32) * ldq;
#pragma unroll
      for (int d0 = 0; d0 < ND0; ++d0) qr[d0] = *(const bf16x8*)(qrow + d0 * 16 + hi * 8); }
    unsigned ksoff[NKC]; int kdst[NKC];
#pragma unroll
    for (int i = 0; i < NKC; ++i) { int row, cc;
        if (i < 2) { const int c = tid + 512 * i; row = c >> 4; cc = c & 15; ksoff[i] = (unsigned)(row * ldk1 + cc * 8) * 2u; }
        else { row = tid >> 3; cc = 16 + (tid & 7); ksoff[i] = (unsigned)(row * ldk2 + (cc - 16) * 8) * 2u; }
        const int cs = DQK == 192 ? ((cc & ~7) | ((cc ^ (row >> 1)) & 7)) : (cc ^ (row & 15));
        kdst[i] = row * KROW + cs * 16; }
    unsigned vsoff[2]; int vdst[2];
#pragma unroll
    for (int i = 0; i < 2; ++i) { const int c = tid + 512 * i, row = c >> 4, cc = c & 15; vsoff[i] = (unsigned)(row * ldv + cc * 8) * 2u; vdst[i] = row * 256 + ((cc * 16) ^ ((row & 3) << 6)); }
    constexpr int NKO = DQK == 192 ? 4 : 8;
    int koff[NKO];
#pragma unroll
    for (int j = 0; j < NKO; ++j) { const int cc = 2 * j + hi; const int cs = DQK == 192 ? ((cc ^ (r32 >> 1)) & 7) : (cc ^ (r32 & 15)); koff[j] = r32 * KROW + cs * 16; }
#define AT_KOFF(d0) (DQK == 192 ? koff[(d0) & 3] + ((d0) >> 2) * 128 : koff[(d0) & 7])
    const int q4 = (lane & 15) >> 2, pp = lane & 3, blk = (lane >> 4) & 1;
    int voff[4];
#pragma unroll
    for (int d0 = 0; d0 < 4; ++d0) voff[d0] = (4 * hi + q4) * 256 + (((d0 ^ q4) << 6) | (blk << 5) | (pp << 3));
    u32x4 ks[NKC], vs[2];
#define AT_LOAD(t) do { const char* k1b = (const char*)K1 + (size_t)(t) * 64 * ldk1 * 2; const char* k2b = (const char*)K2 + (size_t)(t) * 64 * ldk2 * 2; const char* vb = (const char*)V + (size_t)(t) * 64 * ldv * 2; \
        _Pragma("unroll") for (int i = 0; i < NKC; ++i) ks[i] = *(const u32x4*)((i < 2 ? k1b : k2b) + ksoff[i]); \
        _Pragma("unroll") for (int i = 0; i < 2; ++i) vs[i] = *(const u32x4*)(vb + vsoff[i]); } while (0)
#define AT_WRITE(bf) do { _Pragma("unroll") for (int i = 0; i < NKC; ++i) *(LAS u32x4*)(Kl + (bf) * KT + kdst[i]) = ks[i]; \
        _Pragma("unroll") for (int i = 0; i < 2; ++i) *(LAS u32x4*)(Vl + (bf) * VT + vdst[i]) = vs[i]; } while (0)
    float m_run = -1e30f, l_run = 0.f; f32x16 o[4];
#pragma unroll
    for (int d0 = 0; d0 < 4; ++d0) o[d0] = (f32x16){};
    AT_LOAD(0); AT_WRITE(0);
    __syncthreads();
    const int qpos = qpos0 + wid * 32 + r32;
    for (int t = 0; t < ntiles; ++t) {
        const int bf = t & 1;
        if (t + 1 < ntiles) AT_LOAD(t + 1);
        f32x16 p0 = (f32x16){}, p1 = (f32x16){};
#pragma unroll
        for (int d0 = 0; d0 < ND0; ++d0) {
            const bf16x8 a0 = *(const LAS bf16x8*)(Kl + bf * KT + AT_KOFF(d0));
            const bf16x8 a1 = *(const LAS bf16x8*)(Kl + bf * KT + AT_KOFF(d0) + 32 * KROW);
            p0 = __builtin_amdgcn_mfma_f32_32x32x16_bf16(a0, qr[d0], p0, 0, 0, 0);
            p1 = __builtin_amdgcn_mfma_f32_32x32x16_bf16(a1, qr[d0], p1, 0, 0, 0);
        }
        if (CAUSAL) { const int kv0 = t * 64;
            if (kv0 + 63 > qpos0 + wid * 32) { const float NEG = -__builtin_inff();
#pragma unroll
                for (int r = 0; r < 16; ++r) { const int key = kv0 + crow(r, hi); if (key > qpos) p0[r] = NEG; if (key + 32 > qpos) p1[r] = NEG; } } }
        float mx = p0[0];
#pragma unroll
        for (int r = 1; r < 16; ++r) mx = fmaxf(mx, p0[r]);
#pragma unroll
        for (int r = 0; r < 16; ++r) mx = fmaxf(mx, p1[r]);
        { auto rr = __builtin_amdgcn_permlane32_swap(__float_as_uint(mx), __float_as_uint(mx), false, false); mx = fmaxf(__uint_as_float(rr[0]), __uint_as_float(rr[1])); }
        if (__any(mx > m_run + 8.f)) {
            const float mn = fmaxf(m_run, mx), alpha = __builtin_amdgcn_exp2f(m_run - mn); m_run = mn; l_run *= alpha;
#pragma unroll
            for (int d0 = 0; d0 < 4; ++d0)
#pragma unroll
                for (int r = 0; r < 16; ++r) o[d0][r] *= alpha;
        }
        float ps = 0.f;
#pragma unroll
        for (int r = 0; r < 16; ++r) { p0[r] = __builtin_amdgcn_exp2f(p0[r] - m_run); p1[r] = __builtin_amdgcn_exp2f(p1[r] - m_run); ps += p0[r] + p1[r]; }
        l_run += ps;
        bf16x8 pa[4];
        { u32x4 w;
          w.x = cvt_pk(p0[0], p0[1]); w.y = cvt_pk(p0[2], p0[3]); w.z = cvt_pk(p0[4], p0[5]); w.w = cvt_pk(p0[6], p0[7]); pa[0] = __builtin_bit_cast(bf16x8, w);
          w.x = cvt_pk(p0[8], p0[9]); w.y = cvt_pk(p0[10], p0[11]); w.z = cvt_pk(p0[12], p0[13]); w.w = cvt_pk(p0[14], p0[15]); pa[1] = __builtin_bit_cast(bf16x8, w);
          w.x = cvt_pk(p1[0], p1[1]); w.y = cvt_pk(p1[2], p1[3]); w.z = cvt_pk(p1[4], p1[5]); w.w = cvt_pk(p1[6], p1[7]); pa[2] = __builtin_bit_cast(bf16x8, w);
          w.x = cvt_pk(p1[8], p1[9]); w.y = cvt_pk(p1[10], p1[11]); w.z = cvt_pk(p1[12], p1[13]); w.w = cvt_pk(p1[14], p1[15]); pa[3] = __builtin_bit_cast(bf16x8, w); }
#pragma unroll
        for (int d0 = 0; d0 < 4; ++d0)
#pragma unroll
            for (int s = 0; s < 4; ++s) {
                const LAS unsigned char* vp = Vl + bf * VT + voff[d0] + s * 4096;
                const s16x4 lo = __builtin_bit_cast(s16x4, __builtin_amdgcn_ds_read_tr16_b64_v4i16((LAS v4i16_t*)vp));
                const s16x4 hh = __builtin_bit_cast(s16x4, __builtin_amdgcn_ds_read_tr16_b64_v4i16((LAS v4i16_t*)(vp + 2048)));
                const bf16x8 vf = (bf16x8){lo[0], lo[1], lo[2], lo[3], hh[0], hh[1], hh[2], hh[3]};
                o[d0] = __builtin_amdgcn_mfma_f32_32x32x16_bf16(vf, pa[s], o[d0], 0, 0, 0);
            }
        if (t + 1 < ntiles) AT_WRITE(bf ^ 1);
        __syncthreads();
    }
    { auto rr = __builtin_amdgcn_permlane32_swap(__float_as_uint(l_run), __float_as_uint(l_run), false, false); l_run = __uint_as_float(rr[0]) + __uint_as_float(rr[1]); }
    const float inv = __builtin_amdgcn_rcpf(l_run);
    bf16* orow = O + (size_t)(wid * 32 + r32) * ldo;
#pragma unroll
    for (int d0 = 0; d0 < 4; ++d0)
#pragma unroll
        for (int g = 0; g < 4; ++g) { u32x2 w; w.x = cvt_pk(o[d0][4 * g] * inv, o[d0][4 * g + 1] * inv); w.y = cvt_pk(o[d0][4 * g + 2] * inv, o[d0][4 * g + 3] * inv);
            *(u32x2*)(orow + d0 * 32 + 8 * g + 4 * hi) = w; }
#undef AT_LOAD
#undef AT_WRITE
#undef AT_KOFF
}

__global__ void __launch_bounds__(NTHR, 2) fwd(Args args) {
    extern __shared__ __attribute__((aligned(16))) unsigned char lds_raw[];
    Frame F;
    F.lds = (LAS unsigned char*)lds_raw;
    F.tid = threadIdx.x; F.lane = F.tid & 63; F.wave = __builtin_amdgcn_readfirstlane(F.tid >> 6);
    F.G = gridDim.x; { const int bx = blockIdx.x; F.vcu = (F.G % 8 == 0) ? (bx % 8) * (F.G / 8) + bx / 8 : bx; }
    F.ws = args.ws; F.H = args.out;
    volatile LAS unsigned* MISC = (volatile LAS unsigned*)(F.lds + MISC_OFF);
    for (int u = F.tid; u < (LDS_BYTES - LDSCTL_OFF) / 4; u += NTHR) ((LAS unsigned*)(F.lds + LDSCTL_OFF))[u] = 0u;
    __syncthreads();
    unsigned* ctl = (unsigned*)(F.ws + WS_CTL);
    XcdBarrier bar; bar.bar = ctl + CW_BAR; bar.x = 0; bar.st = nullptr;
    if (ONE_LAUNCH) bar = xcd_barrier_post(ctl + CW_BAR, MISC + 8);
    const int lo = args.lo, hi = args.hi;
#ifndef PH_MASK
#define PH_MASK 0xfffffu
#endif
#define PHON(j) (((PH_MASK) >> (j)) & 1u)
#define IN(k) (lo <= (k) && (k) < hi)
#define PHASE_RELOAD() do { t_ = threadIdx.x; asm volatile("" : "+v"(t_)); F.tid = t_; F.lane = t_ & 63; F.wave = __builtin_amdgcn_readfirstlane(t_ >> 6); \
        A = (ArgsP)__builtin_amdgcn_kernarg_segment_ptr(); asm volatile("" : "+s"(A)); F.ws = A->ws; F.H = A->out; \
        { int g_ = gridDim.x, b_ = blockIdx.x; asm volatile("" : "+s"(g_), "+s"(b_)); F.G = g_; F.bx = b_; F.vcu = (g_ % 8 == 0) ? (b_ % 8) * (g_ / 8) + b_ / 8 : b_; } } while (0)
#define PHASE_BEGIN() int t_; ArgsP A; PHASE_RELOAD()
#define SEAM(k) do { if (IN(k) && IN((k) + 1)) { if (ONE_LAUNCH) xcd_barrier(bar); } } while (0)

    if (PHON(0) && IN(0)) { PHASE_BEGIN(); p0_prologue(F, A); SEAM(0); }

    for (int l = 0; l < NL; ++l) {
        const int pb = 1 + l * NPH;
        if (PHON(1) && IN(pb + 0)) { PHASE_BEGIN();
            const int N = (l == 0) ? INW : PROJ_LD;
            pg8::Gemm g{WSP(bf16, WS_U), WSP(bf16, WL(WO_IN)), T, N, D, D, D}; pg8::StaticOrder S; S.init(T, N, F.G, F.bx);
            pg8::Epi8<FPlain> E{{WSP(bf16, WS_PROJ), PROJ_LD, 1.f}};
            pg8::gemm_phase(F.lds, g, S, E);
            {
                PHASE_RELOAD();
                const int rem = ((T / 256) * (N / 256)) % F.G;
                if (rem != 0 && F.bx >= rem) convert_layer(F, A, l, 2, (F.bx - rem) * NWAVES + F.wave, (F.G - rem) * NWAVES);
                else if (rem == 0) convert_layer(F, A, l, 2, F.bx * NWAVES + F.wave, F.G * NWAVES);
            }
            SEAM(pb + 0);
        }
        if (PHON(2) && IN(pb + 1)) { PHASE_BEGIN(); prep_phase(F, A, l); SEAM(pb + 1); }
        if (PHON(3) && IN(pb + 2)) { PHASE_BEGIN();
            {
            { pg8::Gemm g{WSP(bf16, WS_LORA), WSP(bf16, WL(WO_UP)), T, 1024, 128, LORA_LD, 128}; pg8::StaticOrder S; S.init(T, 1024, F.G, F.bx);
              pg8::Epi8<FSig<0>> E{{WSP(bf16, WS_WLOG), 1024, A->in[I_W0] + (size_t)l * 1024}}; pg8::gemm_phase(F.lds, g, S, E); }
            PHASE_RELOAD();
            { pg8::Gemm g{WSP(bf16, WS_LORA) + 128, WSP(bf16, WL(WO_AUP)), T, 1024, 128, LORA_LD, 128}; pg8::StaticOrder S; S.init(T, 1024, F.G, F.bx);
              pg8::Epi8<FSig<1>> E{{WSP(bf16, WS_AIC), 1024, A->in[I_A0] + (size_t)l * 1024}}; pg8::gemm_phase(F.lds, g, S, E); }
            PHASE_RELOAD();
            { pg8::Gemm g{WSP(bf16, WS_LORA) + 256, WSP(bf16, WL(WO_GUP)), T, 1024, 256, LORA_LD, 256}; pg8::StaticOrder S; S.init(T, 1024, F.G, F.bx);
              pg8::Epi8<FPlain> E{{WSP(bf16, WS_GATE), 1024, 1.f}}; pg8::gemm_phase(F.lds, g, S, E); }
            PHASE_RELOAD();
            if (l > 0) { pg8::Gemm g{WSP(bf16, WS_LORA) + 512, WSP(bf16, WL(WO_VUP)), T, 1024, 128, LORA_LD, 128}; pg8::StaticOrder S; S.init(T, 1024, F.G, F.bx);
              pg8::Epi8<FVup> E{{WSP(bf16, WS_VV), A->in[I_V0] + (size_t)(l - 1) * 1024, A->in[I_MU] + (size_t)l * RIN + 2048, WSP(bf16, WS_PROJ), WSP(bf16, WS_VF)}}; pg8::gemm_phase(F.lds, g, S, E); }
            PHASE_RELOAD();
            { pg8::Gemm g{WSP(bf16, WS_CQN), WSP(bf16, WL(WO_UQ)), T, 1536, 512, 512, 512}; pg8::StaticOrder S; S.init(T, 1536, F.G, F.bx);
              pg8::Epi8<FQ> E{{WSP(bf16, WS_QB), WSP(float, WS_COS), WSP(float, WS_SIN)}}; pg8::gemm_phase(F.lds, g, S, E); }
            PHASE_RELOAD();
            { pg8::Gemm g{WSP(bf16, WS_CKVN), WSP(bf16, WL(WO_UKV)), T, 2048, 256, 256, 256}; pg8::StaticOrder S; S.init(T, 2048, F.G, F.bx);
              pg8::Epi8<FPlain> E{{WSP(bf16, WS_KV), 2048, 1.f}}; pg8::gemm_phase(F.lds, g, S, E); }
            }
            SEAM(pb + 2);
        }
        if (PHON(4) && IN(pb + 3)) { PHASE_BEGIN();
            cs_pre_phase(F, A, l);
            SEAM(pb + 3);
        }
        if (PHON(5) && IN(pb + 4)) { PHASE_BEGIN();
            if (F.G == 256) {
                const int x = F.bx & 7, i = F.bx >> 3;
                if (i < 16) { const int u = x * 16 + i; cs_seq_unit(F, u >> 1, u & 1); }
                else convert_layer(F, A, l, 3, (x * 16 + i - 16) * NWAVES + F.wave, 128 * NWAVES);
            } else {
            for (int u = F.vcu; u < 128; u += F.G) cs_seq_unit(F, u >> 1, u & 1);
            if (F.G > 128 && F.vcu >= 128) convert_layer(F, A, l, 3, (F.vcu - 128) * NWAVES + F.wave, (F.G - 128) * NWAVES);
            else if (F.G <= 128) convert_layer(F, A, l, 3, F.vcu * NWAVES + F.wave, F.G * NWAVES);
            }
            __syncthreads();
        }
        if (PHON(6) && IN(pb + 5)) { PHASE_BEGIN();
            volatile LAS unsigned* msc = (volatile LAS unsigned*)(F.lds + MISC_OFF);
            const int nq = F.G >= 8 ? 1 : 8;
            for (int qi = 0; qi < nq; ++qi) {
                const int q = (F.bx + qi) & 7;
                unsigned* cnt = (unsigned*)(F.ws + WS_CTL) + CW_ATT + (l * 8 + q) * 64;
                for (;;) {
                    if (F.tid == 0) msc[12] = xb_add(cnt, 1u);
                    __syncthreads();
                    const int v = __builtin_amdgcn_readfirstlane((int)msc[12]);
                    __syncthreads();
                    if (v >= 64) break;
                    const int qb = 15 - (v >> 2), bh = 4 * q + (v & 3), b = bh >> 3, hh = bh & 7; const size_t r0 = (size_t)b * SEQ;
                    attn_unit<192, true>(F.lds, WSP(bf16, WS_QB) + (r0 + qb * 256) * 1536 + hh * 192, 1536,
                                         WSP(bf16, WS_KV) + r0 * 2048 + hh * 256, 2048, WSP(bf16, WS_KR) + r0 * 64, 64,
                                         WSP(bf16, WS_KV) + r0 * 2048 + hh * 256 + 128, 2048,
                                         WSP(bf16, WS_AO) + (r0 + qb * 256) * D + 1024 + hh * 128, D, qb * 256, 4 * (qb + 1));
                }
            }
            SEAM(pb + 5);
        }
        if (PHON(7) && IN(pb + 6)) { PHASE_BEGIN(); rwkv_post_phase(F, A, l); SEAM(pb + 6); }
        if (PHON(8) && IN(pb + 7)) { PHASE_BEGIN();
            pg8::Gemm g{WSP(bf16, WS_AO), WSP(bf16, WL(WO_OUT)), T, D, D, D, D}; pg8::StaticOrder S; S.init(T, D, F.G, F.bx);
            pg8::Epi8<FPlain> E{{WSP(bf16, WS_Y), D, 1.f}}; pg8::gemm_phase(F.lds, g, S, E);
            SEAM(pb + 7);
        }
        if (PHON(9) && IN(pb + 8)) { PHASE_BEGIN(); ew_norm_phase(F, A->in[I_MIXPOST] + (size_t)l * D, false); SEAM(pb + 8); }
        if (PHON(10) && IN(pb + 9)) { PHASE_BEGIN();
            pg8::Gemm g{WSP(bf16, WS_U), WSP(bf16, WL(WO_QM)), T, 512, D, D, D}; pg8::StaticOrder S; S.init(T, 512, F.G, F.bx);
            pg8::Epi8<FPlain> E{{WSP(bf16, WS_QMEM), 512, QSCALE_MEM}}; pg8::gemm_phase(F.lds, g, S, E);
            PHASE_RELOAD();
            { pg8::Gemm g2{WSP(bf16, WS_MEMN), WSP(bf16, WL(WO_KM)), NB * NMEM, 512, D, D, D}; pg8::StaticOrder S2; S2.init(NB * NMEM, 512, F.G, (F.bx + F.G - 128 % F.G) % F.G);
              pg8::Epi8<FPlain> E2{{WSP(bf16, WS_MEMK), 512, 1.f}}; pg8::gemm_phase(F.lds, g2, S2, E2); }
            PHASE_RELOAD();
            { pg8::Gemm g2{WSP(bf16, WS_MEMN), WSP(bf16, WL(WO_VM)), NB * NMEM, 512, D, D, D}; pg8::StaticOrder S2; S2.init(NB * NMEM, 512, F.G, (F.bx + F.G - 136 % F.G) % F.G);
              pg8::Epi8<FPlain> E2{{WSP(bf16, WS_MEMV), 512, 1.f}}; pg8::gemm_phase(F.lds, g2, S2, E2); }
            if (l + 1 < NL) { PHASE_RELOAD();
                if (F.G > 144 && F.bx >= 144) convert_layer(F, A, l + 1, 1, (F.bx - 144) * NWAVES + F.wave, (F.G - 144) * NWAVES);
                else if (F.G <= 144) convert_layer(F, A, l + 1, 1, F.bx * NWAVES + F.wave, F.G * NWAVES); }
            SEAM(pb + 9);
        }
        if (PHON(11) && IN(pb + 10)) { PHASE_BEGIN();
            for (int u = F.vcu; u < 256; u += F.G) {
                const int bh = u >> 4, qb = u & 15, b = bh >> 2, hh = bh & 3; const size_t r0 = (size_t)b * SEQ + qb * 256;
                attn_unit<128, false>(F.lds, WSP(bf16, WS_QMEM) + r0 * 512 + hh * 128, 512,
                                      WSP(bf16, WS_MEMK) + (size_t)b * NMEM * 512 + hh * 128, 512, nullptr, 0,
                                      WSP(bf16, WS_MEMV) + (size_t)b * NMEM * 512 + hh * 128, 512,
                                      WSP(bf16, WS_OMEM) + r0 * 512 + hh * 128, 512, 0, NMEM / 64);
            }
            SEAM(pb + 10);
        }
        if (PHON(12) && IN(pb + 11)) { PHASE_BEGIN();
            pg8::Gemm g{WSP(bf16, WS_OMEM), WSP(bf16, WL(WO_OM)), T, D, 512, 512, 512}; pg8::StaticOrder S; S.init(T, D, F.G, F.bx);
            pg8::Epi8<FPlain> E{{WSP(bf16, WS_Y), D, 1.f}}; pg8::gemm_phase(F.lds, g, S, E);
            SEAM(pb + 11);
        }
        if (PHON(13) && IN(pb + 12)) { PHASE_BEGIN(); ew_norm_phase(F, A->in[I_MEMPOST] + (size_t)l * D, false); SEAM(pb + 12); }
        if (PHON(14) && IN(pb + 13)) { PHASE_BEGIN();
            pg8::Gemm g{WSP(bf16, WS_U), WSP(bf16, WL(WO_FF1)), T, FF, D, D, D}; pg8::StaticOrder S; S.init(T, FF, F.G, F.bx);
            pg8::Epi8<FRelu2> E{{WSP(bf16, WS_HID), FF}}; pg8::gemm_phase(F.lds, g, S, E);
            SEAM(pb + 13);
        }
        if (PHON(15) && IN(pb + 14)) { PHASE_BEGIN();
            pg8::Gemm g{WSP(bf16, WS_HID), WSP(bf16, WL(WO_FF2)), T, D, FF, FF, FF}; pg8::StaticOrder S; S.init(T, D, F.G, F.bx);
            pg8::Epi8<FPlain> E{{WSP(bf16, WS_Y), D, 1.f}}; pg8::gemm_phase(F.lds, g, S, E);
            SEAM(pb + 14);
        }
        if (PHON(16) && IN(pb + 15)) { PHASE_BEGIN(); ew_norm_phase(F, A->in[I_FFNPOST] + (size_t)l * D, l + 1 == NL); SEAM(pb + 15); }
    }
#undef IN
#undef SEAM
}

extern "C" void kernel_launch(void* const* d_in, const int* in_sizes, int n_in, void* d_out, int out_size, void* d_ws, size_t ws_size, hipStream_t stream) {
    static int grid = 0;
    if (grid == 0) {
        if (n_in != N_IN || out_size != T * D || ws_size < WS_END) { fprintf(stderr, "kernel_launch: unexpected shapes (n_in %d, out %d, ws %zu)\n", n_in, out_size, ws_size); grid = -1; return; }
        int dev = 0, cus = 0;
        if (hipGetDevice(&dev) != hipSuccess || hipDeviceGetAttribute(&cus, hipDeviceAttributeMultiprocessorCount, dev) != hipSuccess) { grid = -1; return; }
        if (hipFuncSetAttribute((const void*)fwd, hipFuncAttributeMaxDynamicSharedMemorySize, LDS_BYTES) != hipSuccess) { fprintf(stderr, "kernel_launch: hipFuncSetAttribute failed\n"); grid = -1; return; }
        int per_cu = 0;
        if (hipOccupancyMaxActiveBlocksPerMultiprocessor(&per_cu, (const void*)fwd, NTHR, LDS_BYTES) != hipSuccess || per_cu < 1) fprintf(stderr, "kernel_launch: occupancy query says %d\n", per_cu);
        (void)hipGetLastError();
        grid = cus;
    }
    if (grid < 0) return;
    (void)hipMemsetAsync((char*)d_ws + WS_CTL, 0, CTL_BYTES, stream);
    Args a{};
    for (int i = 0; i < N_IN; ++i) a.in[i] = (const float*)d_in[i];
    a.out = (float*)d_out; a.ws = (unsigned char*)d_ws;
    const int nph = NPHASES < STOP_PHASE ? NPHASES : STOP_PHASE;
    if (ONE_LAUNCH) { a.lo = 0; a.hi = nph; hipLaunchKernelGGL(fwd, dim3(grid), dim3(NTHR), LDS_BYTES, stream, a); }
    else { for (int p = 0; p < nph; ++p) { a.lo = p; a.hi = p + 1; hipLaunchKernelGGL(fwd, dim3(grid), dim3(NTHR), LDS_BYTES, stream, a); } }
}
```

```cpp
#include <hip/hip_runtime.h>
#include <cstdio>
#include <cstdint>

#define GAS __attribute__((address_space(1)))
#define LAS __attribute__((address_space(3)))
typedef unsigned short bf16;
typedef short bf16x8 __attribute__((ext_vector_type(8)));
typedef short s16x4 __attribute__((ext_vector_type(4)));
typedef float f32x2 __attribute__((ext_vector_type(2)));
typedef float f32x4 __attribute__((ext_vector_type(4)));
typedef float f32x16 __attribute__((ext_vector_type(16)));
typedef unsigned u32x2 __attribute__((ext_vector_type(2)));
typedef unsigned u32x4 __attribute__((ext_vector_type(4)));
typedef __bf16 bf16x2_t __attribute__((ext_vector_type(2)));

#ifndef ONE_LAUNCH
#define ONE_LAUNCH 1
#endif
#ifndef STOP_PHASE
#define STOP_PHASE 1000
#endif

constexpr int T = 16384, SEQ = 4096, NB = 4, D = 2048, NL = 4, FF = 8192;
constexpr int RIN = 3520, INW = 4352, PROJ_LD = 4608;
constexpr int NMEM = 256;
constexpr float NORM_EPS = 1e-6f, GN_EPS = 64e-5f;
constexpr float QSCALE_MLA = 0.07216878364870323f * 1.4426950408889634f;
constexpr float QSCALE_MEM = 0.08838834764831845f * 1.4426950408889634f;
constexpr int NWAVES = 8, NTHR = 512;
constexpr int NPH = 16, NPHASES = 1 + NL * NPH;

enum { I_X = 0, I_MEM, I_MEMG, I_MIXPRE, I_WIN, I_WINV, I_MU, I_MUV, I_W0, I_WUP, I_A0, I_AUP, I_V0, I_VUP, I_GUP, I_KK, I_KA, I_RK, I_LNG, I_LNB,
       I_QNG, I_WUQ, I_KVNG, I_WUKV, I_WOUT, I_MIXPOST, I_MEMPRE, I_WQM, I_WKM, I_WVM, I_WOM, I_MEMPOST, I_FFNPRE, I_FF1, I_FF2, I_FFNPOST, N_IN };

constexpr size_t KiB = 1024, MiB = 1024 * 1024;
constexpr size_t WS_CTL = 0, CTL_BYTES = 1 * MiB;
constexpr size_t WS_COS = 1 * MiB, WS_SIN = 1 * MiB + 512 * KiB;
constexpr size_t WS_MEMN = 2 * MiB, WS_MEMK = 6 * MiB, WS_MEMV = 7 * MiB, WS_RKB = 8 * MiB;
constexpr size_t WS_W = 16 * MiB, W_LSTRIDE = 38 * MiB;
constexpr size_t WS_WFF = 92 * MiB;
constexpr size_t WS_AO = 156 * MiB;
constexpr size_t WS_RMS = 12 * MiB;
constexpr size_t WS_SCAN = 220 * MiB;
constexpr size_t WO_IN = 0, WO_UP = 18 * MiB, WO_AUP = 18 * MiB + 256 * KiB, WO_GUP = 18 * MiB + 512 * KiB, WO_VUP = 19 * MiB, WO_UQ = 19 * MiB + 512 * KiB,
                 WO_UKV = 21 * MiB, WO_OUT = 22 * MiB, WO_QM = 30 * MiB, WO_KM = 32 * MiB, WO_VM = 34 * MiB, WO_OM = 36 * MiB, WO_FF1 = 38 * MiB, WO_FF2 = 70 * MiB;
constexpr size_t WS_U = 424 * MiB, WS_Y = 488 * MiB, WS_VF = 552 * MiB;
constexpr size_t WS_PROJ = 584 * MiB, WS_LORA = 728 * MiB, WS_WLOG = 748 * MiB, WS_AIC = 780 * MiB, WS_GATE = 812 * MiB, WS_VV = 844 * MiB,
                 WS_CQN = 876 * MiB, WS_CKVN = 892 * MiB, WS_KR = 900 * MiB, WS_QB = 902 * MiB, WS_KV = 950 * MiB, WS_END = 1014 * MiB;
constexpr size_t WS_HID = 584 * MiB, WS_QMEM = 840 * MiB, WS_OMEM = 856 * MiB;
constexpr int LORA_LD = 640;
constexpr int CW_TMO = 0, CW_BAR = 4096, CW_ATT = 16384;

constexpr int RING_BYTES = 163328, LDSCTL_OFF = RING_BYTES, MISC_OFF = LDSCTL_OFF + 320, LDS_BYTES = 163840;

__device__ __forceinline__ unsigned cvt_pk(float lo, float hi) { f32x2 v = {lo, hi}; bf16x2_t b = __builtin_convertvector(v, bf16x2_t); return __builtin_bit_cast(unsigned, b); }
__device__ __forceinline__ float bflo(unsigned w) { return __uint_as_float(w << 16); }
__device__ __forceinline__ float bfhi(unsigned w) { return __uint_as_float(w & 0xffff0000u); }
__device__ __forceinline__ float bf1(bf16 b) { return __uint_as_float((unsigned)b << 16); }
__device__ __forceinline__ bf16 f2bf(float f) { return (bf16)(cvt_pk(f, 0.f) & 0xffffu); }
template <int CTRL> __device__ __forceinline__ float dpp_add(float x) { return x + __int_as_float(__builtin_amdgcn_update_dpp(0, __float_as_int(x), CTRL, 0xf, 0xf, true)); }
__device__ __forceinline__ float sum4(float x) { x = dpp_add<0xB1>(x); x = dpp_add<0x4E>(x); return x; }
__device__ __forceinline__ float sum8(float x) { x = sum4(x); x = dpp_add<0x141>(x); return x; }
__device__ __forceinline__ float sum16(float x) { x = sum8(x); x = dpp_add<0x140>(x); return x; }
__device__ __forceinline__ float wave_sum(float x) {
    x = sum16(x);
    { auto r = __builtin_amdgcn_permlane16_swap(__float_as_uint(x), __float_as_uint(x), false, false); x = __uint_as_float(r[0]) + __uint_as_float(r[1]); }
    { auto r = __builtin_amdgcn_permlane32_swap(__float_as_uint(x), __float_as_uint(x), false, false); x = __uint_as_float(r[0]) + __uint_as_float(r[1]); }
    return x;
}
__device__ __forceinline__ float sigmoidf_(float x) { return __builtin_amdgcn_rcpf(1.f + __builtin_amdgcn_exp2f(-1.4426950408889634f * x)); }
__device__ __forceinline__ float tanhf_(float x) { const float e = __builtin_amdgcn_exp2f(-2.f * 1.4426950408889634f * fabsf(x)); const float t = (1.f - e) * __builtin_amdgcn_rcpf(1.f + e); return x < 0.f ? -t : t; }
__device__ __forceinline__ void unpack8(u32x4 w, float (&f)[8]) {
    f[0] = bflo(w.x); f[1] = bfhi(w.x); f[2] = bflo(w.y); f[3] = bfhi(w.y); f[4] = bflo(w.z); f[5] = bfhi(w.z); f[6] = bflo(w.w); f[7] = bfhi(w.w);
}
__device__ __forceinline__ u32x4 pack8(const float (&f)[8]) { u32x4 w; w.x = cvt_pk(f[0], f[1]); w.y = cvt_pk(f[2], f[3]); w.z = cvt_pk(f[4], f[5]); w.w = cvt_pk(f[6], f[7]); return w; }

__device__ __forceinline__ int crow(int r, int hi) { return (r & 3) + 8 * (r >> 2) + 4 * hi; }
typedef short v4i16_t __attribute__((ext_vector_type(4)));

namespace pg8 {
#define PG8_LAS __attribute__((address_space(3)))
typedef unsigned short bf16_t;
constexpr int BM = 256, BK = 64, HALF = 128, HTB = HALF * BK * 2, STAGE_BYTES = 8 * HTB, NXCD = 8, WGM = 8;
__host__ __device__ __forceinline__ int lds_byte(int r, int c) { const int st = (r >> 4) * 2 + (c >> 5), rr = r & 15, cc = c & 31, ob = rr * 64 + cc * 2; return st * 1024 + (ob ^ (((ob >> 9) & 1) << 5)); }
__host__ __device__ __forceinline__ void stage_rc(int b, int& R, int& C) { const int st = b / 1024, sb = b % 1024, swz = sb ^ (((sb >> 9) & 1) << 5); R = (st >> 1) * 16 + swz / 64; C = (st & 1) * 32 + (swz % 64) / 2; }
__host__ __device__ __forceinline__ int perm32(int rho) { const int n = rho >> 4, i = rho & 15; return 8 * (i >> 2) + 4 * n + (i & 3); }
struct Unit { int pm, pn; };
struct Gemm { const bf16_t* A; const bf16_t* Bt; int M, N, K, lda, ldb; };
struct StaticOrder {
    int nM, nN, nwg, G, c;
    __host__ __device__ void init(int M, int N, int G_, int c_) { nM = M / BM; nN = N / BM; nwg = nM * nN; G = G_; c = c_; }
    __host__ __device__ bool next(int i, Unit& u) const {
        const long L = (long)i * G + c; if (L >= nwg) return false;
        int wgid = (int)L; { const int q = nwg / NXCD, r = nwg % NXCD, xcd = wgid % NXCD, off = wgid / NXCD; wgid = (xcd < r ? xcd * (q + 1) : r * (q + 1) + (xcd - r) * q) + off; }
        const int nig = WGM * nN, gid = wgid / nig, fm = gid * WGM, gsz = (nM - fm) < WGM ? (nM - fm) : WGM;
        u.pm = fm + ((wgid % nig) % gsz); u.pn = (wgid % nig) / gsz; return true;
    }
};
struct NoRaw {};
template <class F> struct Epi8 {
    F f;
    __device__ __forceinline__ void operator()(const f32x4 (&acc)[2][2][4][2], const Unit& u, int wr, int wc, int fr, int fq) const {
        const int row0 = u.pm * BM + wr * 64 + fr, col0 = u.pn * BM + wc * 32 + 8 * fq;
        typename F::Pre pre[2]; f.pre(col0, pre[0]); f.pre(col0 + HALF, pre[1]);
        constexpr int NBAT = F::BATCH;
#pragma unroll
        for (int i0 = 0; i0 < 16; i0 += NBAT) {
            typename F::Raw raw[NBAT];
#pragma unroll
            for (int j = 0; j < NBAT; ++j) { const int i = i0 + j, ai = i >> 3, m = (i >> 1) & 3, bj = i & 1; f.load(row0 + ai * HALF + m * 16, col0 + bj * HALF, raw[j]); }
#pragma unroll
            for (int j = 0; j < NBAT; ++j) { const int i = i0 + j, ai = i >> 3, m = (i >> 1) & 3, bj = i & 1;
                f.apply(row0 + ai * HALF + m * 16, col0 + bj * HALF, acc[ai][bj][m][0], acc[ai][bj][m][1], pre[bj], raw[j]); }
            if (F::HEAVY) __builtin_amdgcn_sched_barrier(0);
        }
    }
};

template <class Epi>
__device__ __forceinline__ void gemm_phase(PG8_LAS unsigned char* lds, const Gemm g, const StaticOrder& S, const Epi& E) {
    int tid = threadIdx.x; asm volatile("" : "+v"(tid));
    const int wid = __builtin_amdgcn_readfirstlane(tid >> 6), lane = tid & 63, wr = wid >> 2, wc = wid & 3, fr = lane & 15, fq = lane >> 4;
    int K = g.K; asm volatile("" : "+s"(K));
    const int nt = K / BK;
    unsigned voffA[2], voffB[2];
#pragma unroll
    for (int i = 0; i < 2; ++i) { int R, C; stage_rc(tid * 16 + i * 8192, R, C); const int Rb = (R & ~31) + perm32(R & 31);
        voffA[i] = (unsigned)(R * g.lda + C) * 2u; voffB[i] = (unsigned)(Rb * g.ldb + C) * 2u; }
    const size_t kstep = (size_t)(BK * 2);
    const size_t hsA = (size_t)HALF * g.lda * 2, hsB = (size_t)HALF * g.ldb * 2;
    const size_t tsA = 2 * hsA, tsB = 2 * hsB;
    const unsigned ldsw = (unsigned)wid * 1024u;
    const int aoff = lds_byte(wr * 64 + fr, fq * 8), boff = lds_byte(wc * 32 + fr, fq * 8);
#define PG8_SA(b, h) (((b) * 2 + (h)) * HTB)
#define PG8_SB(b, h) ((4 + (b) * 2 + (h)) * HTB)
#define PG8_STAGE(bufoff, gbase, voff) do { _Pragma("unroll") for (int _i = 0; _i < 2; ++_i) \
        __builtin_amdgcn_global_load_lds((const unsigned*)((const char*)(gbase) + (voff)[_i]), (PG8_LAS unsigned*)(lds + (bufoff) + ldsw + _i * 8192), 16, 0, 0); } while (0)
#define PG8_LDA(dst, b, h) do { _Pragma("unroll") for (int m = 0; m < 4; ++m) _Pragma("unroll") for (int k = 0; k < 2; ++k) dst[m][k] = *(const PG8_LAS bf16x8*)(lds + PG8_SA(b, h) + aoff + m * 2048 + k * 1024); } while (0)
#define PG8_LDB(dst, b, h) do { _Pragma("unroll") for (int n = 0; n < 2; ++n) _Pragma("unroll") for (int k = 0; k < 2; ++k) dst[n][k] = *(const PG8_LAS bf16x8*)(lds + PG8_SB(b, h) + boff + n * 2048 + k * 1024); } while (0)
#define PG8_MMA(ai, bj, At, Bt) do { __builtin_amdgcn_s_setprio(1); _Pragma("unroll") for (int m = 0; m < 4; ++m) _Pragma("unroll") for (int n = 0; n < 2; ++n) _Pragma("unroll") for (int k = 0; k < 2; ++k) \
        acc[ai][bj][m][n] = __builtin_amdgcn_mfma_f32_16x16x32_bf16(Bt[n][k], At[m][k], acc[ai][bj][m][n], 0, 0, 0); __builtin_amdgcn_s_setprio(0); } while (0)
#define PG8_WAIT_V(n) asm volatile("s_waitcnt vmcnt(" #n ")" ::: "memory")
#define PG8_WAIT_L(n) asm volatile("s_waitcnt lgkmcnt(" #n ")" ::: "memory")
#define PG8_BAR __builtin_amdgcn_s_barrier()
#define PG8_SCHED __builtin_amdgcn_sched_barrier(0)
    Unit cur, nxt; int ui = 0;
    if (!S.next(0, cur)) return;
    f32x4 acc[2][2][4][2];
#pragma unroll
    for (int a = 0; a < 2; ++a)
#pragma unroll
        for (int b = 0; b < 2; ++b)
#pragma unroll
            for (int m = 0; m < 4; ++m)
#pragma unroll
                for (int n = 0; n < 2; ++n) acc[a][b][m][n] = (f32x4){0.f, 0.f, 0.f, 0.f};
    bf16x8 At[4][2], B0[2][2], B1[2][2];
    const char* cA = (const char*)g.A + (size_t)cur.pm * tsA; const char* cB = (const char*)g.Bt + (size_t)cur.pn * tsB;
    PG8_STAGE(PG8_SB(0, 0), cB, voffB); PG8_STAGE(PG8_SB(0, 1), cB + hsB, voffB); PG8_STAGE(PG8_SA(0, 0), cA, voffA); PG8_STAGE(PG8_SA(0, 1), cA + hsA, voffA);
    if (wr == 1) PG8_BAR;
    PG8_WAIT_V(2); PG8_BAR;
    PG8_STAGE(PG8_SB(1, 0), cB + kstep, voffB); PG8_STAGE(PG8_SA(1, 0), cA + kstep, voffA); PG8_STAGE(PG8_SB(1, 1), cB + hsB + kstep, voffB);
    PG8_WAIT_V(6); PG8_BAR;
    for (;;) {
        const bool has_next = S.next(ui + 1, nxt);
        const char* nA = has_next ? (const char*)g.A + (size_t)nxt.pm * tsA : cA; const char* nB = has_next ? (const char*)g.Bt + (size_t)nxt.pn * tsB : cB;
        for (int t = 0; t < nt; t += 2) {
            const bool last = (t == nt - 2);
            const char* a1 = cA + (size_t)(t + 1) * kstep;
            const char* a2 = last ? nA : cA + (size_t)(t + 2) * kstep; const char* b2 = last ? nB : cB + (size_t)(t + 2) * kstep;
            const char* a3 = a2 + kstep; const char* b3 = b2 + kstep;
            PG8_LDB(B0, 0, 0); PG8_LDB(B1, 0, 1); PG8_SCHED; PG8_LDA(At, 0, 0); PG8_STAGE(PG8_SA(1, 1), a1 + hsA, voffA);
            PG8_WAIT_V(8); PG8_WAIT_L(0); PG8_BAR; PG8_MMA(0, 0, At, B0); PG8_MMA(0, 1, At, B1); PG8_BAR; PG8_SCHED;
            PG8_LDA(At, 0, 1); PG8_STAGE(PG8_SB(0, 0), b2, voffB); PG8_STAGE(PG8_SB(0, 1), b2 + hsB, voffB); PG8_STAGE(PG8_SA(0, 0), a2, voffA);
            PG8_WAIT_V(8); PG8_WAIT_L(0); PG8_BAR; PG8_MMA(1, 0, At, B0); PG8_MMA(1, 1, At, B1); PG8_BAR; PG8_SCHED;
            PG8_LDB(B0, 1, 0); PG8_LDB(B1, 1, 1); PG8_SCHED; PG8_LDA(At, 1, 0); PG8_STAGE(PG8_SA(0, 1), a2 + hsA, voffA);
            PG8_WAIT_V(8); PG8_WAIT_L(0); PG8_BAR; PG8_MMA(0, 0, At, B0); PG8_MMA(0, 1, At, B1); PG8_BAR; PG8_SCHED;
            PG8_LDA(At, 1, 1); PG8_STAGE(PG8_SB(1, 0), b3, voffB); PG8_STAGE(PG8_SB(1, 1), b3 + hsB, voffB); PG8_STAGE(PG8_SA(1, 0), a3, voffA);
            PG8_WAIT_V(8); PG8_WAIT_L(0); PG8_BAR; PG8_MMA(1, 0, At, B0); PG8_MMA(1, 1, At, B1); PG8_BAR; PG8_SCHED;
        }
        if (wr == 0) PG8_BAR;
        E(acc, cur, wr, wc, fr, fq);
        if (!has_next) break;
#pragma unroll
        for (int a = 0; a < 2; ++a)
#pragma unroll
            for (int b = 0; b < 2; ++b)
#pragma unroll
                for (int m = 0; m < 4; ++m)
#pragma unroll
                    for (int n = 0; n < 2; ++n) acc[a][b][m][n] = (f32x4){0.f, 0.f, 0.f, 0.f};
        cur = nxt; cA = nA; cB = nB; ++ui;
        if (wr == 1) PG8_BAR;
    }
    PG8_WAIT_V(0);
    PG8_BAR;
#undef PG8_SA
#undef PG8_SB
#undef PG8_STAGE
#undef PG8_LDA
#undef PG8_LDB
#undef PG8_MMA
#undef PG8_WAIT_V
#undef PG8_WAIT_L
#undef PG8_BAR
#undef PG8_SCHED
}
}

__device__ __forceinline__ void st16_wt(void* p, u32x4 w) { asm volatile("global_store_dwordx4 %0, %1, off sc1\n\ts_nop 1" :: "v"(p), "v"(w) : "memory"); }
struct FPlain { static constexpr bool HEAVY = false; static constexpr int BATCH = 1; typedef pg8::NoRaw Pre; typedef pg8::NoRaw Raw; bf16* O; int ld; float sc;
    __device__ __forceinline__ void pre(int, Pre&) const {}
    __device__ __forceinline__ void load(int, int, Raw&) const {}
    __device__ __forceinline__ void apply(int row, int col, f32x4 a, f32x4 b, const Pre&, const Raw&) const {
        u32x4 w; w.x = cvt_pk(a[0] * sc, a[1] * sc); w.y = cvt_pk(a[2] * sc, a[3] * sc); w.z = cvt_pk(b[0] * sc, b[1] * sc); w.w = cvt_pk(b[2] * sc, b[3] * sc);
        st16_wt(O + (size_t)row * ld + col, w); } };
struct FRelu2 { static constexpr bool HEAVY = false; static constexpr int BATCH = 1; typedef pg8::NoRaw Pre; typedef pg8::NoRaw Raw; bf16* O; int ld;
    __device__ __forceinline__ void pre(int, Pre&) const {}
    __device__ __forceinline__ void load(int, int, Raw&) const {}
    __device__ __forceinline__ void apply(int row, int col, f32x4 a, f32x4 b, const Pre&, const Raw&) const {
        float v[8] = {a[0], a[1], a[2], a[3], b[0], b[1], b[2], b[3]};
#pragma unroll
        for (int i = 0; i < 8; ++i) { const float r = fmaxf(v[i], 0.f); v[i] = r * r; }
        st16_wt(O + (size_t)row * ld + col, pack8(v)); } };
template <int MODE> struct FSig { static constexpr bool HEAVY = true; static constexpr int BATCH = 4; struct Pre { f32x4 b0, b1; }; typedef pg8::NoRaw Raw; bf16* O; int ld; const float* bias;
    __device__ __forceinline__ void pre(int col, Pre& p) const { p.b0 = *(const f32x4*)(bias + col); p.b1 = *(const f32x4*)(bias + col + 4); }
    __device__ __forceinline__ void load(int, int, Raw&) const {}
    __device__ __forceinline__ void apply(int row, int col, f32x4 a, f32x4 b, const Pre& p, const Raw&) const {
        float v[8] = {a[0] + p.b0[0], a[1] + p.b0[1], a[2] + p.b0[2], a[3] + p.b0[3], b[0] + p.b1[0], b[1] + p.b1[1], b[2] + p.b1[2], b[3] + p.b1[3]};
#pragma unroll
        for (int i = 0; i < 8; ++i) { const float s = sigmoidf_(v[i]); v[i] = MODE == 0 ? -0.6065306597126334f * s : s; }
        *(u32x4*)(O + (size_t)row * ld + col) = pack8(v); } };
struct FVup { static constexpr bool HEAVY = true; static constexpr int BATCH = 4; struct Pre { f32x4 b0, b1, m0, m1; }; struct Raw { u32x4 cur, prv, vf; };
    bf16* O; const float* v0; const float* mu; const bf16* proj; const bf16* vfirst;
    __device__ __forceinline__ void pre(int col, Pre& p) const { p.b0 = *(const f32x4*)(v0 + col); p.b1 = *(const f32x4*)(v0 + col + 4); p.m0 = *(const f32x4*)(mu + col); p.m1 = *(const f32x4*)(mu + col + 4); }
    __device__ __forceinline__ void load(int row, int col, Raw& r) const {
        r.cur = *(const u32x4*)(proj + (size_t)row * PROJ_LD + 2048 + col);
        r.prv = ((row & (SEQ - 1)) != 0) ? *(const u32x4*)(proj + (size_t)(row - 1) * PROJ_LD + 2048 + col) : (u32x4){0u, 0u, 0u, 0u};
        r.vf = *(const u32x4*)(vfirst + (size_t)row * 1024 + col); }
    __device__ __forceinline__ void apply(int row, int col, f32x4 a, f32x4 b, const Pre& p, const Raw& r) const {
        float cur[8], prv[8], vf[8]; unpack8(r.cur, cur); unpack8(r.prv, prv); unpack8(r.vf, vf);
        const float acc8[8] = {a[0] + p.b0[0], a[1] + p.b0[1], a[2] + p.b0[2], a[3] + p.b0[3], b[0] + p.b1[0], b[1] + p.b1[1], b[2] + p.b1[2], b[3] + p.b1[3]};
        const float mu8[8] = {p.m0[0], p.m0[1], p.m0[2], p.m0[3], p.m1[0], p.m1[1], p.m1[2], p.m1[3]};
        float v[8];
#pragma unroll
        for (int i = 0; i < 8; ++i) { const float vs = cur[i] + (prv[i] - cur[i]) * mu8[i]; v[i] = vs + (vf[i] - vs) * sigmoidf_(acc8[i]); }
        *(u32x4*)(O + (size_t)row * 1024 + col) = pack8(v); } };
struct FQ { static constexpr bool HEAVY = true; static constexpr int BATCH = 4; struct Pre { f32x4 w; }; typedef pg8::NoRaw Raw; bf16* O;
    __device__ __forceinline__ void pre(int col, Pre& p) const { const int cc = col % 192, i0 = cc >= 128 ? (cc - 128) >> 1 : 0;
#pragma unroll
        for (int k = 0; k < 4; ++k) p.w[k] = 0.15915494309189535f * __builtin_amdgcn_exp2f(-13.287712379549449f * (float)(i0 + k) * (1.f / 32.f)); }
    __device__ __forceinline__ void load(int, int, Raw&) const {}
    __device__ __forceinline__ void apply(int row, int col, f32x4 a, f32x4 b, const Pre& p, const Raw&) const {
        const int cc = col % 192;
        float v[8] = {a[0], a[1], a[2], a[3], b[0], b[1], b[2], b[3]};
        if (cc >= 128) { const float pos = (float)(row & (SEQ - 1));
#pragma unroll
            for (int i = 0; i < 4; ++i) { const float fr = __builtin_amdgcn_fractf(pos * p.w[i]); const float c = __builtin_amdgcn_cosf(fr), s = __builtin_amdgcn_sinf(fr);
                const float x1 = v[2 * i], x2 = v[2 * i + 1]; v[2 * i] = x1 * c - x2 * s; v[2 * i + 1] = x1 * s + x2 * c; } }
#pragma unroll
        for (int i = 0; i < 8; ++i) v[i] *= QSCALE_MLA;
        *(u32x4*)(O + (size_t)row * 1536 + col) = pack8(v); } };

#define XB_TMO      128
#define XB_XCNT(j)  (256  + 64 * (j))
#define XB_XSUB(j)  (1280 + 64 * (j))
#define XB_XGEN(j)  (2304 + 64 * (j))
#define XB_TOP      3328
#define XB_TOPGEN   3392
#define XCD_BAR_WORDS 3456
#define XB_SPIN_CAP (1u << 20)
__device__ __forceinline__ unsigned xb_ld(unsigned* p)              { return __hip_atomic_load(p, __ATOMIC_RELAXED, __HIP_MEMORY_SCOPE_AGENT); }
__device__ __forceinline__ unsigned xb_add(unsigned* p, unsigned v) { return __hip_atomic_fetch_add(p, v, __ATOMIC_RELAXED, __HIP_MEMORY_SCOPE_AGENT); }
__device__ __forceinline__ unsigned xb_xcc_id() { return (unsigned)__builtin_amdgcn_s_getreg((3 << 11) | 20) & 0xFu; }
#define XB_SPIN(cond, bar) do { unsigned _sp = 0; while (cond) { __builtin_amdgcn_s_sleep(1); \
    if ((++_sp & 255u) == 0u) { if (xb_ld(&(bar)[XB_TMO])) break; if (_sp > XB_SPIN_CAP) { atomicAdd(&(bar)[XB_TMO], 1u); break; } } } } while (0)
struct XcdBarrier { unsigned* bar; unsigned x; volatile LAS unsigned* st; };
__device__ __forceinline__ XcdBarrier xcd_barrier_post(unsigned* bar, volatile LAS unsigned* st) {
    XcdBarrier b; b.bar = bar; b.x = xb_xcc_id(); b.st = st;
    if (threadIdx.x == 0) (void)xb_add(&bar[XB_XCNT(b.x)], 1u);
    return b;
}
__device__ __forceinline__ void xcd_barrier_complete(unsigned* bar, unsigned x, unsigned& nloc, unsigned& nx) {
    const unsigned G = gridDim.x * gridDim.y * gridDim.z;
    unsigned sum, cnt, mine, sp = 0u;
    for (;;) {
        sum = 0u; cnt = 0u; mine = 0u;
#pragma unroll
        for (unsigned j = 0; j < 16; ++j) { const unsigned c = xb_ld(&bar[XB_XCNT(j)]); sum += c; cnt += (c > 0u) ? 1u : 0u; mine = (j == x) ? c : mine; }
        if (sum == G) break;
        __builtin_amdgcn_s_sleep(1);
        if ((++sp & 255u) == 0u) { if (xb_ld(&bar[XB_TMO])) break; if (sp > XB_SPIN_CAP) { atomicAdd(&bar[XB_TMO], 1u); break; } }
    }
    nloc = mine > 0u ? mine : 1u; nx = cnt > 0u ? cnt : 1u;
}
__device__ __forceinline__ void xcd_barrier(const XcdBarrier& b) {
    asm volatile("s_waitcnt vmcnt(0)" ::: "memory");
    __syncthreads();
    if (threadIdx.x == 0) {
        unsigned* bar = b.bar;
        __builtin_amdgcn_s_waitcnt(0);
        unsigned nloc = b.st[0], nx = b.st[1];
        if (nloc == 0u) { xcd_barrier_complete(bar, b.x, nloc, nx); b.st[0] = nloc; b.st[1] = nx; }
        const unsigned old = xb_add(&bar[XB_XSUB(b.x)], 1u);
        const unsigned gen = old / nloc;
        if (old + 1u == (gen + 1u) * nloc) {
            __builtin_amdgcn_fence(__ATOMIC_RELEASE, "agent");
            asm volatile("s_waitcnt vmcnt(0)" ::: "memory");
            const unsigned og = xb_add(&bar[XB_TOP], 1u);
            const unsigned tg = og / nx;
            if (og + 1u == (tg + 1u) * nx) xb_add(&bar[XB_TOPGEN], 1u);
            else XB_SPIN(xb_ld(&bar[XB_TOPGEN]) == tg, bar);
            __builtin_amdgcn_fence(__ATOMIC_ACQUIRE, "agent");
            xb_add(&bar[XB_XGEN(b.x)], 1u);
            asm volatile("s_waitcnt vmcnt(0)" ::: "memory");
        } else {
            XB_SPIN(xb_ld(&bar[XB_XGEN(b.x)]) == gen, bar);
            __builtin_amdgcn_fence(__ATOMIC_ACQUIRE, "agent");
            asm volatile("s_waitcnt vmcnt(0)" ::: "memory");
        }
    }
    __syncthreads();
}

struct Args { const float* in[N_IN]; float* out; unsigned char* ws; int lo, hi; };
typedef const __attribute__((address_space(4))) Args* ArgsP;
struct Frame {
    LAS unsigned char* lds;
    int tid, lane, wave, vcu, G, bx;
    unsigned char* ws;
    float* H;
};
#define WSP(type, off) ((type*)(F.ws + (off)))
#define WL(off) ((off) >= WO_FF1 ? WS_WFF + ((off) - WO_FF1) : WS_W + (size_t)(l & 1) * W_LSTRIDE + (off))

__constant__ int JK[15]  = {2048, 2048, 256, 256, 2048, 2048, 2048, 2048, 512, 96, 96, 64, 512, 2048, 8192};
__constant__ int JKP[15] = {2048, 2048, 256, 256, 2048, 2048, 2048, 2048, 512, 128, 128, 128, 512, 2048, 8192};
__constant__ int JN[15]  = {4352, 64, 1024, 2048, 2048, 512, 512, 512, 2048, 1024, 1024, 1024, 1536, 8192, 2048};
__constant__ int JIN[15] = {I_WIN, I_WINV, I_GUP, I_WUKV, I_WOUT, I_WQM, I_WKM, I_WVM, I_WOM, I_WUP, I_AUP, I_VUP, I_WUQ, I_FF1, I_FF2};
__constant__ unsigned JDST[15] = {(unsigned)(WO_IN / KiB), (unsigned)(WO_IN / KiB), (unsigned)(WO_GUP / KiB), (unsigned)(WO_UKV / KiB), (unsigned)(WO_OUT / KiB), (unsigned)(WO_QM / KiB),
                                  (unsigned)(WO_KM / KiB), (unsigned)(WO_VM / KiB), (unsigned)(WO_OM / KiB), (unsigned)(WO_UP / KiB), (unsigned)(WO_AUP / KiB), (unsigned)(WO_VUP / KiB),
                                  (unsigned)(WO_UQ / KiB), (unsigned)(WO_FF1 / KiB), (unsigned)(WO_FF2 / KiB)};
__device__ __forceinline__ void p0_transpose_item(const float* W, int Kreal, int N, bf16* WT, int ldk, int row_off, LAS unsigned* scr, int item, int lane, bool rope, const float* gk) {
    const int nblk = N / 64, kb = item / nblk, nb = item % nblk, k0 = 64 * kb, n0 = 64 * nb;
    const int m = lane & 15, q = lane >> 4;
    f32x4 v[16];
#pragma unroll
    for (int i = 0; i < 16; ++i) { const int k = k0 + 8 * (i >> 1) + 2 * q + (i & 1); const int kc = k < Kreal ? k : Kreal - 1;
        v[i] = __builtin_nontemporal_load((const f32x4*)(W + (size_t)kc * N + n0 + 4 * m)); }
    if (k0 + 64 > Kreal) {
#pragma unroll
        for (int i = 0; i < 16; ++i) { const int k = k0 + 8 * (i >> 1) + 2 * q + (i & 1); if (k >= Kreal) v[i] = (f32x4){0.f, 0.f, 0.f, 0.f}; }
    }
    if (gk) {
        float gg[16];
#pragma unroll
        for (int i = 0; i < 16; ++i) gg[i] = gk[k0 + 8 * (i >> 1) + 2 * q + (i & 1)];
#pragma unroll
        for (int i = 0; i < 16; ++i) v[i] *= gg[i];
    }
#pragma unroll
    for (int j = 0; j < 8; ++j)
#pragma unroll
        for (int c = 0; c < 4; ++c) scr[(4 * m + c) * 32 + ((4 * j + q) ^ (4 * (m & 7)))] = cvt_pk(v[2 * j][c], v[2 * j + 1][c]);
    asm volatile("s_waitcnt lgkmcnt(0)" ::: "memory");
    const int x = lane & 7, r = lane >> 3;
#pragma unroll
    for (int t = 0; t < 8; ++t) { const int n = r + 8 * t; const u32x4 o = *(const LAS u32x4*)(scr + n * 32 + 4 * (x ^ ((n >> 2) & 7)));
        const int nd = rope ? 2 * (n & 31) + (n >> 5) : n;
        *(u32x4*)(WT + (size_t)(row_off + n0 + nd) * ldk + k0 + 8 * x) = o; }
    asm volatile("s_waitcnt lgkmcnt(0)" ::: "memory");
}
__device__ __forceinline__ void rms_row_2048(const float* xrow, const float* g, bf16* orow, float* rms_out, int lane) {
    f32x4 v[8]; float ss = 0.f;
#pragma unroll
    for (int j = 0; j < 4; ++j) { v[2 * j] = *(const f32x4*)(xrow + lane * 8 + 512 * j); v[2 * j + 1] = *(const f32x4*)(xrow + lane * 8 + 512 * j + 4); }
#pragma unroll
    for (int j = 0; j < 8; ++j) ss += (v[j][0] * v[j][0] + v[j][1] * v[j][1]) + (v[j][2] * v[j][2] + v[j][3] * v[j][3]);
    const float ms = wave_sum(ss) * (1.f / 2048.f) + NORM_EPS, rstd = rsqrtf(ms);
    if (rms_out && lane == 0) *rms_out = ms * rstd;
#pragma unroll
    for (int j = 0; j < 4; ++j) { const int c = lane * 8 + 512 * j;
        f32x4 a = v[2 * j] * rstd, b = v[2 * j + 1] * rstd;
        if (g) { a *= *(const f32x4*)(g + c); b *= *(const f32x4*)(g + c + 4); }
        u32x4 w; w.x = cvt_pk(a[0], a[1]); w.y = cvt_pk(a[2], a[3]); w.z = cvt_pk(b[0], b[1]); w.w = cvt_pk(b[2], b[3]);
        *(u32x4*)(orow + c) = w; }
}
__device__ __forceinline__ void convert_layer(Frame& F, ArgsP A, int l, int part, int wrank, int wcount) {
    LAS unsigned* scr = (LAS unsigned*)(F.lds + F.wave * 16384);
    const int k_lo = (part == 2) ? 13 : (part == 3 ? 14 : 0), k_hi = (part == 1) ? 13 : (part == 2 ? 14 : 15);
    int base = 0;
    for (int k = k_lo; k < k_hi; ++k) {
        const bool prev = (k == 1 || k == 11);
        if (prev && l == 0) continue;
        const int K = JK[k], KP = JKP[k], N = JN[k], row_off = (k == 1) ? INW : 0;
        const float* W = A->in[JIN[k]] + (size_t)(prev ? l - 1 : l) * K * N; const size_t dst = WL((size_t)JDST[k] * KiB);
        const int nitems = (KP / 64) * (N / 64);
        const float* gk = (k <= 1) ? A->in[I_MIXPRE] + (size_t)l * D : (k == 5 ? A->in[I_MEMPRE] + (size_t)l * D : (k == 13 ? A->in[I_FFNPRE] + (size_t)l * D : nullptr));
        int first = (wrank - base) % wcount; if (first < 0) first += wcount;
        for (int it = first; it < nitems; it += wcount) p0_transpose_item(W, K, N, WSP(bf16, dst), KP, row_off, scr, it, F.lane, k == 12 && (it % (N / 64)) % 3 == 2, gk);
        base = (base + nitems) % wcount;
    }
    if (part <= 1 && l > 0) {
        const long gt = (long)wrank * 64 + F.lane, NGT = (long)wcount * 64;
        unsigned* O = (unsigned*)(WSP(bf16, WL(WO_IN)) + (size_t)(INW + 64) * D);
        for (long i = gt; i < 192 * D / 2; i += NGT) O[i] = 0u;
    }
}
__device__ __forceinline__ void p0_prologue(Frame& F, ArgsP A) {
    const int gw = F.vcu * NWAVES + F.wave, NGW = F.G * NWAVES;
    const long gt = (long)F.vcu * NTHR + F.tid, NGT = (long)F.G * NTHR;
    convert_layer(F, A, 0, 1, gw, NGW);
    { float* cT = WSP(float, WS_COS); float* sT = WSP(float, WS_SIN);
      for (long i = gt; i < SEQ * 32; i += NGT) { const int pos = (int)(i >> 5), j = (int)(i & 31);
          const float invf = __builtin_amdgcn_exp2f(-13.287712379549449f * (float)j * (1.f / 32.f));
          const double rev = (double)pos * (double)invf * 0.15915494309189535; const float fr = (float)(rev - __builtin_rint(rev));
          cT[i] = __builtin_amdgcn_cosf(fr); sT[i] = __builtin_amdgcn_sinf(fr); } }
    for (int m = gw; m < T; m += NGW) rms_row_2048(A->in[I_X] + (size_t)m * D, nullptr, WSP(bf16, WS_U) + (size_t)m * D, WSP(float, WS_RMS) + m, F.lane);
    for (int m = gw; m < NB * NMEM; m += NGW) rms_row_2048(A->in[I_MEM] + (size_t)m * D, A->in[I_MEMG], WSP(bf16, WS_MEMN) + (size_t)m * D, nullptr, F.lane);
}

struct PrepRaw { u32x4 lc, lp, cq, vc[2], vp[2]; u32x2 ckv; bf16 k1, k2; float rc, rs; };
__device__ __forceinline__ void prep_load(Frame& F, int l, int m, int sc, bool act, PrepRaw& R) {
    const int lane = F.lane; const bf16* cur = WSP(bf16, WS_PROJ) + (size_t)m * PROJ_LD; const bf16* prv = cur - PROJ_LD; const bool first = (m & (SEQ - 1)) == 0;
    unsigned z_ = 0u; asm volatile("" : "+v"(z_));
    const u32x4 Z = (u32x4){z_, z_, z_, z_};
    R.lc = act ? *(const u32x4*)(cur + sc) : Z; R.lp = (act && !first) ? *(const u32x4*)(prv + sc) : Z;
    R.cq = *(const u32x4*)(cur + RIN + lane * 8); R.ckv = *(const u32x2*)(cur + RIN + 512 + lane * 4);
    R.k1 = cur[RIN + 768 + (lane & 31)]; R.k2 = cur[RIN + 768 + 32 + (lane & 31)];
    { const int pos = m & (SEQ - 1); R.rc = WSP(float, WS_COS)[pos * 32 + (lane & 31)]; R.rs = WSP(float, WS_SIN)[pos * 32 + (lane & 31)]; }
    if (l == 0) {
#pragma unroll
        for (int j = 0; j < 2; ++j) { const int c = lane * 8 + 512 * j; R.vc[j] = *(const u32x4*)(cur + 2048 + c); R.vp[j] = first ? Z : *(const u32x4*)(prv + 2048 + c); } }
}
__device__ __forceinline__ void prep_row(Frame& F, int l, int m, int oc, int kind, const float (&mv)[8], const f32x4& qg0, const f32x4& qg1, const f32x4& kvg, const float* mu, const PrepRaw& R) {
    const int lane = F.lane;
    bf16* lo = WSP(bf16, WS_LORA) + (size_t)m * LORA_LD;
    { float y[8], yp[8], o[8]; unpack8(R.lc, y); unpack8(R.lp, yp);
#pragma unroll
      for (int i = 0; i < 8; ++i) { const float c = y[i] + (yp[i] - y[i]) * mv[i]; const float sg = sigmoidf_(kind == 1 ? 2.f * c : c); o[i] = kind == 1 ? 2.f * sg - 1.f : (kind == 2 ? sg : c); }
      *(u32x4*)(lo + oc) = pack8(o);
      unsigned zz = 0u; asm volatile("" : "+v"(zz));
      if (lane < 16) *(u32x4*)(lo + (lane < 4 ? 96 + 8 * lane : (lane < 8 ? 224 + 8 * (lane - 4) : 576 + 8 * (lane - 8)))) = (u32x4){zz, zz, zz, zz}; }
    { float v[8]; unpack8(R.cq, v); float ss = 0.f;
#pragma unroll
      for (int i = 0; i < 8; ++i) ss += v[i] * v[i];
      const float rstd = rsqrtf(wave_sum(ss) * (1.f / 512.f) + NORM_EPS);
      u32x4 w; w.x = cvt_pk(v[0] * rstd * qg0[0], v[1] * rstd * qg0[1]); w.y = cvt_pk(v[2] * rstd * qg0[2], v[3] * rstd * qg0[3]);
      w.z = cvt_pk(v[4] * rstd * qg1[0], v[5] * rstd * qg1[1]); w.w = cvt_pk(v[6] * rstd * qg1[2], v[7] * rstd * qg1[3]);
      *(u32x4*)(WSP(bf16, WS_CQN) + (size_t)m * 512 + lane * 8) = w; }
    { const float v0 = bflo(R.ckv.x), v1 = bfhi(R.ckv.x), v2 = bflo(R.ckv.y), v3 = bfhi(R.ckv.y);
      const float rstd = rsqrtf(wave_sum(v0 * v0 + v1 * v1 + v2 * v2 + v3 * v3) * (1.f / 256.f) + NORM_EPS);
      u32x2 w; w.x = cvt_pk(v0 * rstd * kvg[0], v1 * rstd * kvg[1]); w.y = cvt_pk(v2 * rstd * kvg[2], v3 * rstd * kvg[3]);
      *(u32x2*)(WSP(bf16, WS_CKVN) + (size_t)m * 256 + lane * 4) = w; }
    if (lane < 32) { const float x1 = bf1(R.k1), x2 = bf1(R.k2);
      *(unsigned*)(WSP(bf16, WS_KR) + (size_t)m * 64 + 2 * lane) = cvt_pk(x1 * R.rc - x2 * R.rs, x1 * R.rs + x2 * R.rc); }
    if (l == 0) {
#pragma unroll
        for (int j = 0; j < 2; ++j) { const int c = lane * 8 + 512 * j; float a[8], p[8], o[8]; unpack8(R.vc[j], a); unpack8(R.vp[j], p);
            const f32x4 m0 = *(const f32x4*)(mu + 2048 + c), m1 = *(const f32x4*)(mu + 2048 + c + 4);
#pragma unroll
            for (int i = 0; i < 8; ++i) o[i] = a[i] + (p[i] - a[i]) * (i < 4 ? m0[i] : m1[i - 4]);
            *(u32x4*)(WSP(bf16, WS_VF) + (size_t)m * 1024 + c) = pack8(o); } }
}
__device__ __forceinline__ void prep_phase(Frame& F, ArgsP A, int l) {
    const int gw = F.vcu * NWAVES + F.wave, NGW = F.G * NWAVES, lane = F.lane;
    const float* mu = A->in[I_MU] + (size_t)l * RIN;
    const float* muv = A->in[I_MUV] + (size_t)(l > 0 ? l - 1 : 0) * 64;
    const int sc = lane < 56 ? 3072 + 8 * lane : INW + 8 * (lane - 56);
    const int oc = lane < 12 ? 8 * lane : (lane < 24 ? 128 + 8 * (lane - 12) : (lane < 56 ? 256 + 8 * (lane - 24) : 512 + 8 * (lane - 56)));
    const int kind = lane < 12 ? 1 : (lane < 24 ? 0 : (lane < 56 ? 2 : 3));
    const bool act = kind != 3 || l > 0;
    float mv[8];
#pragma unroll
    for (int i = 0; i < 8; ++i) mv[i] = kind == 3 ? muv[8 * (lane - 56) + i] : mu[sc + i];
    const float* qg = A->in[I_QNG] + (size_t)l * 512; const float* kvgp = A->in[I_KVNG] + (size_t)l * 256;
    const f32x4 qg0 = *(const f32x4*)(qg + lane * 8), qg1 = *(const f32x4*)(qg + lane * 8 + 4), kvg = *(const f32x4*)(kvgp + lane * 4);
    for (int m = gw; m < T; m += 2 * NGW) {
        PrepRaw R0, R1; const int m1 = m + NGW;
        prep_load(F, l, m, sc, act, R0);
        if (m1 < T) prep_load(F, l, m1, sc, act, R1);
        prep_row(F, l, m, oc, kind, mv, qg0, qg1, kvg, mu, R0);
        if (m1 < T) prep_row(F, l, m1, oc, kind, mv, qg0, qg1, kvg, mu, R1);
    }
}

constexpr int CK = 32, NCHUNK = SEQ / CK;
constexpr int CS_TS = 144, CS_TILE = 32 * CS_TS, CS_PC = 5 * CS_TILE, CS_WAVE = 5 * CS_TILE + 256;
constexpr int CS_NW = 7;
constexpr size_t SCU_BYTES = 24576; constexpr int SCU_X = 8192, SCU_PSI = 12288, SCU_G2 = 20480;
constexpr int SQ_SLOT = 18432, SQ_NSLOT = 7;
static_assert(CS_NW * CS_WAVE <= RING_BYTES && SQ_NSLOT * SQ_SLOT <= RING_BYTES, "LDS budget");
#define MF32(a, b, c) __builtin_amdgcn_mfma_f32_32x32x16_bf16((a), (b), (c), 0, 0, 0)
__device__ __forceinline__ bf16x8 pack8f(float a0, float a1, float a2, float a3, float a4, float a5, float a6, float a7) {
    u32x4 w; w.x = cvt_pk(a0, a1); w.y = cvt_pk(a2, a3); w.z = cvt_pk(a4, a5); w.w = cvt_pk(a6, a7); return __builtin_bit_cast(bf16x8, w); }
#define PACKS(x, s) pack8f((x)[8 * (s)], (x)[8 * (s) + 1], (x)[8 * (s) + 2], (x)[8 * (s) + 3], (x)[8 * (s) + 4], (x)[8 * (s) + 5], (x)[8 * (s) + 6], (x)[8 * (s) + 7])
__device__ __forceinline__ bf16x8 trfrag(const LAS unsigned char* p) {
    const s16x4 lo = __builtin_bit_cast(s16x4, __builtin_amdgcn_ds_read_tr16_b64_v4i16((LAS v4i16_t*)p));
    const s16x4 hh = __builtin_bit_cast(s16x4, __builtin_amdgcn_ds_read_tr16_b64_v4i16((LAS v4i16_t*)(p + 8 * CS_TS)));
    return (bf16x8){lo[0], lo[1], lo[2], lo[3], hh[0], hh[1], hh[2], hh[3]}; }
__device__ __forceinline__ void st_init16(unsigned char* p, const f32x16& x) {
    u32x4 w0, w1; w0.x = cvt_pk(x[0], x[1]); w0.y = cvt_pk(x[2], x[3]); w0.z = cvt_pk(x[4], x[5]); w0.w = cvt_pk(x[6], x[7]);
    w1.x = cvt_pk(x[8], x[9]); w1.y = cvt_pk(x[10], x[11]); w1.z = cvt_pk(x[12], x[13]); w1.w = cvt_pk(x[14], x[15]);
    *(u32x4*)p = w0; *(u32x4*)(p + 16) = w1; }
__device__ __forceinline__ f32x16 ld_init16(const LAS unsigned char* p) {
    const u32x4 w0 = *(const LAS u32x4*)p, w1 = *(const LAS u32x4*)(p + 16); f32x16 x;
    x[0] = bflo(w0.x); x[1] = bfhi(w0.x); x[2] = bflo(w0.y); x[3] = bfhi(w0.y); x[4] = bflo(w0.z); x[5] = bfhi(w0.z); x[6] = bflo(w0.w); x[7] = bfhi(w0.w);
    x[8] = bflo(w1.x); x[9] = bfhi(w1.x); x[10] = bflo(w1.y); x[11] = bfhi(w1.y); x[12] = bflo(w1.z); x[13] = bfhi(w1.z); x[14] = bflo(w1.w); x[15] = bfhi(w1.w); return x; }

struct CsRaw { u32x4 r[4], k[4], a[4], e[4]; bf16 rp, kp; };
__device__ __forceinline__ void cs_load_raw(Frame& F, int l, int bh, int cc, CsRaw& R) {
    const int lane = F.lane, b = bh >> 4, h = bh & 15, pc = lane & 7;
    const size_t row0 = (size_t)b * SEQ + (size_t)cc * CK;
    const bf16* PROJ = WSP(bf16, WS_PROJ); const bf16* AIC = WSP(bf16, WS_AIC); const bf16* WLOG = WSP(bf16, WS_WLOG);
#pragma unroll
    for (int i = 0; i < 4; ++i) { const size_t gr = row0 + (lane >> 3) + 8 * i;
        R.r[i] = *(const u32x4*)(PROJ + gr * PROJ_LD + h * 64 + pc * 8); R.k[i] = *(const u32x4*)(PROJ + gr * PROJ_LD + 1024 + h * 64 + pc * 8);
        R.a[i] = *(const u32x4*)(AIC + gr * 1024 + h * 64 + pc * 8); R.e[i] = *(const u32x4*)(WLOG + gr * 1024 + h * 64 + pc * 8); }
    R.rp = 0; R.kp = 0;
    if (cc > 0) { R.rp = PROJ[(row0 - 1) * PROJ_LD + h * 64 + lane]; R.kp = PROJ[(row0 - 1) * PROJ_LD + 1024 + h * 64 + lane]; }
}
__device__ __forceinline__ void cs_elementwise(Frame& F, ArgsP A, int l, int bh, int cc, LAS unsigned char* wl, const CsRaw& R) {
    const int lane = F.lane, b = bh >> 4, h = bh & 15, ch = h * 64 + lane;
    const size_t row0 = (size_t)b * SEQ + (size_t)cc * CK;
    float* RKB = WSP(float, WS_RKB);
    const bf16* VV = (l == 0) ? WSP(bf16, WS_VF) : WSP(bf16, WS_VV);
    u32x4 vraw[4];
#pragma unroll
    for (int i = 0; i < 4; ++i) vraw[i] = *(const u32x4*)(VV + (row0 + (lane >> 3) + 8 * i) * 1024 + h * 64 + (lane & 7) * 8);
#pragma unroll
    for (int i = 0; i < 4; ++i) { LAS unsigned char* p = wl + ((lane >> 3) + 8 * i) * CS_TS + (lane & 7) * 16;
        *(LAS u32x4*)(p) = R.k[i]; *(LAS u32x4*)(p + CS_TILE) = R.a[i]; *(LAS u32x4*)(p + 2 * CS_TILE) = R.e[i]; *(LAS u32x4*)(p + 3 * CS_TILE) = R.r[i]; }
    const float mur = A->in[I_MU][(size_t)l * RIN + ch], muk = A->in[I_MU][(size_t)l * RIN + 1024 + ch];
    const float ckk = A->in[I_KK][(size_t)l * 1024 + ch], cka = A->in[I_KA][(size_t)l * 1024 + ch], crk = A->in[I_RK][(size_t)l * 1024 + ch];
    float rp = bf1(R.rp), kp_ = bf1(R.kp);
    float lp = 0.f, pexc = 1.f;
    constexpr float L2E = 1.4426950408889634f;
    asm volatile("s_waitcnt lgkmcnt(0)" ::: "memory");
#pragma unroll 8
    for (int tt = 0; tt < CK; ++tt) {
        LAS unsigned char* rowp = wl + tt * CS_TS + lane * 2;
        const float kc = bf1(*(const LAS bf16*)(rowp)), aa = bf1(*(const LAS bf16*)(rowp + CS_TILE)), ee = bf1(*(const LAS bf16*)(rowp + 2 * CS_TILE)), rc = bf1(*(const LAS bf16*)(rowp + 3 * CS_TILE));
        const float rs = rc + (rp - rc) * mur, ks = kc + (kp_ - kc) * muk; rp = rc; kp_ = kc;
        float kk = ks * ckk; const float ss = wave_sum(kk * kk); kk *= rsqrtf(fmaxf(ss, 1e-24f));
        const float kq = ks * (1.f + (aa - 1.f) * cka);
        const float rkb = wave_sum(rs * kq * crk);
        lp += ee;
        const float pinc = __builtin_amdgcn_exp2f(lp * L2E), pinv = __builtin_amdgcn_exp2f(-lp * L2E);
        *(LAS bf16*)(rowp) = f2bf(-kk * pexc);
        *(LAS bf16*)(rowp + CS_TILE) = f2bf(kk * aa * pinv);
        *(LAS bf16*)(rowp + 2 * CS_TILE) = f2bf(kq * pinv);
        *(LAS bf16*)(rowp + 3 * CS_TILE) = f2bf(rs * pinc);
        pexc = pinc;
        if (lane == 0) RKB[(row0 + tt) * 16 + h] = rkb;
    }
    ((LAS float*)(wl + CS_PC))[lane] = __builtin_amdgcn_exp2f(lp * L2E);
#pragma unroll
    for (int i = 0; i < 4; ++i) *(LAS u32x4*)(wl + 4 * CS_TILE + ((lane >> 3) + 8 * i) * CS_TS + (lane & 7) * 16) = vraw[i];
}
__device__ __forceinline__ void cs_mfma(Frame& F, const LAS unsigned char* wl, unsigned char* ub) {
    const int lane = F.lane, r32 = lane & 31, h = lane >> 5, q4 = (lane & 15) >> 2, pp = lane & 3, blk = (lane >> 4) & 1;
    const LAS unsigned char* tA = wl; const LAS unsigned char* tB = wl + CS_TILE; const LAS unsigned char* tK = wl + 2 * CS_TILE;
    const LAS unsigned char* tR = wl + 3 * CS_TILE; const LAS unsigned char* tV = wl + 4 * CS_TILE;
    const int rowoff = r32 * CS_TS + h * 16, troff = (4 * h + q4) * CS_TS + blk * 32 + pp * 8;
#define FROW(t, s) (*(const LAS bf16x8*)((t) + rowoff + (s) * 32))
#define FTR(t, ct, s) trfrag((t) + troff + (s) * 16 * CS_TS + (ct) * 64)
    const f32x16 Z = (f32x16){};
    f32x16 P = Z, PT = Z;
#pragma unroll
    for (int s = 0; s < 4; ++s) { const bf16x8 fa = FROW(tA, s), fb = FROW(tB, s); P = MF32(fb, fa, P); PT = MF32(fa, fb, PT); }
#pragma unroll
    for (int r = 0; r < 16; ++r) { const int cr = crow(r, h); if (!(cr < r32)) P[r] = 0.f; if (!(r32 < cr)) PT[r] = 0.f; }
    f32x16 TmT = PT;
#pragma unroll
    for (int r = 0; r < 16; ++r) if (crow(r, h) == r32) TmT[r] += 1.f;
    f32x16 Tm;
#pragma unroll
    for (int it = 0; it < 4; ++it) {
        const bf16x8 pP0 = PACKS(P, 0), pP1 = PACKS(P, 1), pT0 = PACKS(PT, 0), pT1 = PACKS(PT, 1);
        f32x16 Pn = MF32(pT0, pP0, Z); Pn = MF32(pT1, pP1, Pn);
        f32x16 Y = Pn;
#pragma unroll
        for (int r = 0; r < 16; ++r) if (crow(r, h) == r32) Y[r] += 1.f;
        const bf16x8 y0 = PACKS(Y, 0), y1 = PACKS(Y, 1), t0 = PACKS(TmT, 0), t1 = PACKS(TmT, 1);
        if (it < 3) {
            f32x16 PTn = MF32(pP0, pT0, Z); PTn = MF32(pP1, pT1, PTn);
            f32x16 Tn = MF32(y0, t0, Z); Tn = MF32(y1, t1, Tn);
            P = Pn; PT = PTn; TmT = Tn;
        } else { Tm = MF32(t0, y0, Z); Tm = MF32(t1, y1, Tm); }
    }
    f32x16 W1;
    { f32x16 NakT = Z;
#pragma unroll
      for (int s = 0; s < 4; ++s) NakT = MF32(FROW(tA, s), FROW(tK, s), NakT);
#pragma unroll
      for (int r = 0; r < 16; ++r) if (!(r32 < crow(r, h))) NakT[r] = 0.f;
      W1 = MF32(PACKS(NakT, 0), PACKS(Tm, 0), Z); W1 = MF32(PACKS(NakT, 1), PACKS(Tm, 1), W1); }
    f32x16 ATT[2], G1T[2];
    { const bf16x8 m0 = PACKS(Tm, 0), m1 = PACKS(Tm, 1), w0 = PACKS(W1, 0), w1 = PACKS(W1, 1);
#pragma unroll
      for (int ct = 0; ct < 2; ++ct) { ATT[ct] = MF32(m0, FTR(tA, ct, 0), Z); ATT[ct] = MF32(m1, FTR(tA, ct, 1), ATT[ct]);
                                       G1T[ct] = MF32(w0, FTR(tV, ct, 0), Z); G1T[ct] = MF32(w1, FTR(tV, ct, 1), G1T[ct]); } }
    f32x16 Mbr = Z, Mkr = Z;
#pragma unroll
    for (int s = 0; s < 4; ++s) { const bf16x8 fr = FROW(tR, s); Mbr = MF32(FROW(tB, s), fr, Mbr); Mkr = MF32(FROW(tK, s), fr, Mkr); }
#pragma unroll
    for (int r = 0; r < 16; ++r) if (!(crow(r, h) <= r32)) { Mbr[r] = 0.f; Mkr[r] = 0.f; }
    const bf16x8 b0 = PACKS(Mbr, 0), b1 = PACKS(Mbr, 1), k0 = PACKS(Mkr, 0), k1 = PACKS(Mkr, 1);
#pragma unroll
    for (int kt = 0; kt < 2; ++kt) {
        f32x16 X = MF32(PACKS(ATT[kt], 0), b0, Z); X = MF32(PACKS(ATT[kt], 1), b1, X);
#pragma unroll
        for (int g = 0; g < 4; ++g) { const u32x2 w = *(const LAS u32x2*)(tR + r32 * CS_TS + (32 * kt + 8 * g + 4 * h) * 2);
            X[4 * g] += bflo(w.x); X[4 * g + 1] += bfhi(w.x); X[4 * g + 2] += bflo(w.y); X[4 * g + 3] += bfhi(w.y); }
        *(bf16x8*)(ub + SCU_X + ((2 * kt) * 64 + lane) * 16) = PACKS(X, 0);
        *(bf16x8*)(ub + SCU_X + ((2 * kt + 1) * 64 + lane) * 16) = PACKS(X, 1);
    }
#pragma unroll
    for (int ct = 0; ct < 2; ++ct) {
        f32x16 G = MF32(b0, PACKS(G1T[ct], 0), Z); G = MF32(b1, PACKS(G1T[ct], 1), G);
        G = MF32(k0, FTR(tV, ct, 0), G); G = MF32(k1, FTR(tV, ct, 1), G);
        st_init16(ub + SCU_G2 + (ct * 64 + lane) * 32, G);
    }
    const LAS float* PC = (const LAS float*)(wl + CS_PC);
#pragma unroll
    for (int ct = 0; ct < 2; ++ct) {
        const float pc = PC[32 * ct + r32];
        const bf16x8 f0 = FTR(tB, ct, 0), f1 = FTR(tB, ct, 1);
#pragma unroll
        for (int kt = 0; kt < 2; ++kt) {
            f32x16 Ph = MF32(PACKS(ATT[kt], 0), f0, Z); Ph = MF32(PACKS(ATT[kt], 1), f1, Ph);
            if (kt == ct) {
#pragma unroll
                for (int r = 0; r < 16; ++r) if (crow(r, h) == r32) Ph[r] += 1.f; }
#pragma unroll
            for (int r = 0; r < 16; ++r) Ph[r] *= pc;
            *(bf16x8*)(ub + ((ct * 4 + 2 * kt) * 64 + lane) * 16) = PACKS(Ph, 0);
            *(bf16x8*)(ub + ((ct * 4 + 2 * kt + 1) * 64 + lane) * 16) = PACKS(Ph, 1);
        }
    }
#pragma unroll
    for (int mt = 0; mt < 2; ++mt) {
        const bf16x8 fb0 = FTR(tB, mt, 0), fb1 = FTR(tB, mt, 1), fk0 = FTR(tK, mt, 0), fk1 = FTR(tK, mt, 1);
        float pcr[16];
#pragma unroll
        for (int g = 0; g < 4; ++g) { const f32x4 v = *(const LAS f32x4*)(PC + 32 * mt + 8 * g + 4 * h); pcr[4 * g] = v[0]; pcr[4 * g + 1] = v[1]; pcr[4 * g + 2] = v[2]; pcr[4 * g + 3] = v[3]; }
#pragma unroll
        for (int ct = 0; ct < 2; ++ct) {
            f32x16 Ps = MF32(fb0, PACKS(G1T[ct], 0), Z); Ps = MF32(fb1, PACKS(G1T[ct], 1), Ps);
            Ps = MF32(fk0, FTR(tV, ct, 0), Ps); Ps = MF32(fk1, FTR(tV, ct, 1), Ps);
#pragma unroll
            for (int r = 0; r < 16; ++r) Ps[r] *= pcr[r];
            st_init16(ub + SCU_PSI + ((ct * 2 + mt) * 64 + lane) * 32, Ps);
        }
    }
#undef FROW
#undef FTR
}
__device__ __forceinline__ void cs_pre_phase(Frame& F, ArgsP A, int l) {
    volatile LAS unsigned* cnt = (volatile LAS unsigned*)(F.lds + LDSCTL_OFF);
    if (F.tid == 0) cnt[0] = 0u;
    __syncthreads();
    if (F.wave < CS_NW) {
        LAS unsigned char* wl = F.lds + F.wave * CS_WAVE;
        const int per = (64 * NCHUNK + F.G - 1) / F.G, ubase = F.vcu * per, uend = (ubase + per < 64 * NCHUNK) ? ubase + per : 64 * NCHUNK;
#define CS_NEXT(dst) do { unsigned v_ = 0u; if (F.lane == 0) v_ = __hip_atomic_fetch_add((LAS unsigned*)cnt, 1u, __ATOMIC_RELAXED, __HIP_MEMORY_SCOPE_WORKGROUP); dst = ubase + (int)__builtin_amdgcn_readfirstlane((int)v_); } while (0)
        int u; CS_NEXT(u);
        CsRaw R;
        if (u < uend) cs_load_raw(F, l, u >> 7, u & (NCHUNK - 1), R);
        while (u < uend) {
            cs_elementwise(F, A, l, u >> 7, u & (NCHUNK - 1), wl, R);
            int un; CS_NEXT(un);
            if (un < uend) cs_load_raw(F, l, un >> 7, un & (NCHUNK - 1), R);
            asm volatile("s_waitcnt lgkmcnt(0)" ::: "memory");
            cs_mfma(F, wl, F.ws + WS_SCAN + (size_t)u * SCU_BYTES);
            asm volatile("s_waitcnt lgkmcnt(0)" ::: "memory");
            u = un;
        }
#undef CS_NEXT
    }
}
__device__ __forceinline__ void cs_seq_unit(Frame& F, int bh, int ct) {
    const int lane = F.lane, wave = F.wave, r32 = lane & 31, h = lane >> 5;
    LAS unsigned char* L = F.lds;
    const unsigned char* ub = F.ws + WS_SCAN + (size_t)bh * NCHUNK * SCU_BYTES;
    if (wave > 0) {
        const int w = wave - 1;
        size_t so[3]; int np = 0;
#pragma unroll
        for (int k = 0; k < 3; ++k) { const int p = w + 7 * k; so[k] = p < 12 ? (size_t)p * 1024 : (p < 16 ? (size_t)SCU_PSI + ct * 4096 + (p - 12) * 1024 : (size_t)SCU_G2 + ct * 2048 + (p - 16) * 1024); if (p < 18) np = k + 1; }
#define SQ_ISSUE(c) do { const unsigned char* g_ = ub + (size_t)(c) * SCU_BYTES + lane * 16; LAS unsigned char* d_ = L + ((c) % SQ_NSLOT) * SQ_SLOT; \
        _Pragma("unroll") for (int k = 0; k < 3; ++k) if (k < np) __builtin_amdgcn_global_load_lds((const unsigned*)(g_ + so[k]), (LAS unsigned*)(d_ + (w + 7 * k) * 1024), 16, 0, 0); } while (0)
        for (int c = 0; c < 6; ++c) SQ_ISSUE(c);
        if (np == 3) asm volatile("s_waitcnt vmcnt(15)" ::: "memory"); else asm volatile("s_waitcnt vmcnt(10)" ::: "memory");
        asm volatile("s_barrier" ::: "memory");
        for (int c = 0; c < NCHUNK; ++c) {
            if (c + 6 < NCHUNK) { SQ_ISSUE(c + 6); if (np == 3) asm volatile("s_waitcnt vmcnt(15)" ::: "memory"); else asm volatile("s_waitcnt vmcnt(10)" ::: "memory"); }
            else asm volatile("s_waitcnt vmcnt(0)" ::: "memory");
            asm volatile("s_barrier" ::: "memory");
        }
#undef SQ_ISSUE
    } else {
        f32x16 S0 = (f32x16){}, S1 = (f32x16){};
        const int b = bh >> 4, hh = bh & 15;
        bf16* op = (bf16*)(F.ws + WS_Y) + ((size_t)b * SEQ) * 1024 + hh * 64 + 32 * ct + r32;
        asm volatile("s_barrier" ::: "memory");
        for (int c = 0; c < NCHUNK; ++c) {
            const LAS unsigned char* sl = L + (c % SQ_NSLOT) * SQ_SLOT;
            const bf16x8 bS0 = PACKS(S0, 0), bS1 = PACKS(S0, 1), bS2 = PACKS(S1, 0), bS3 = PACKS(S1, 1);
            f32x16 n0 = ld_init16(sl + 12288 + (0 * 64 + lane) * 32), n1 = ld_init16(sl + 12288 + (1 * 64 + lane) * 32);
            const f32x16 Z = (f32x16){};
            f32x16 m0 = MF32(*(const LAS bf16x8*)(sl + (2 * 64 + lane) * 16), bS2, Z), m1 = MF32(*(const LAS bf16x8*)(sl + (6 * 64 + lane) * 16), bS2, Z);
            n0 = MF32(*(const LAS bf16x8*)(sl + (0 * 64 + lane) * 16), bS0, n0); n1 = MF32(*(const LAS bf16x8*)(sl + (4 * 64 + lane) * 16), bS0, n1);
            m0 = MF32(*(const LAS bf16x8*)(sl + (3 * 64 + lane) * 16), bS3, m0); m1 = MF32(*(const LAS bf16x8*)(sl + (7 * 64 + lane) * 16), bS3, m1);
            n0 = MF32(*(const LAS bf16x8*)(sl + (1 * 64 + lane) * 16), bS1, n0); n1 = MF32(*(const LAS bf16x8*)(sl + (5 * 64 + lane) * 16), bS1, n1);
            f32x16 o = ld_init16(sl + 16384 + lane * 32);
            o = MF32(*(const LAS bf16x8*)(sl + 8192 + (0 * 64 + lane) * 16), bS0, o); o = MF32(*(const LAS bf16x8*)(sl + 8192 + (1 * 64 + lane) * 16), bS1, o);
            o = MF32(*(const LAS bf16x8*)(sl + 8192 + (2 * 64 + lane) * 16), bS2, o); o = MF32(*(const LAS bf16x8*)(sl + 8192 + (3 * 64 + lane) * 16), bS3, o);
            S0 = n0 + m0; S1 = n1 + m1;
#pragma unroll
            for (int r = 0; r < 16; ++r) op[(size_t)(c * CK + crow(r, h)) * 1024] = f2bf(o[r]);
            asm volatile("s_waitcnt lgkmcnt(0)\n\ts_barrier" ::: "memory");
        }
    }
    asm volatile("s_waitcnt vmcnt(0)" ::: "memory");
    __syncthreads();
}

struct PostRaw { u32x4 o[2], v[2], g[2]; float rkb; };
__device__ __forceinline__ void post_load(Frame& F, const bf16* VV, int m, PostRaw& R) {
    const int c0 = F.lane * 16; const size_t off = (size_t)m * 1024 + c0;
    R.o[0] = *(const u32x4*)(WSP(bf16, WS_Y) + off); R.o[1] = *(const u32x4*)(WSP(bf16, WS_Y) + off + 8);
    R.v[0] = *(const u32x4*)(VV + off); R.v[1] = *(const u32x4*)(VV + off + 8);
    R.g[0] = *(const u32x4*)(WSP(bf16, WS_GATE) + off); R.g[1] = *(const u32x4*)(WSP(bf16, WS_GATE) + off + 8);
    R.rkb = WSP(float, WS_RKB)[(size_t)m * 16 + (F.lane >> 2)];
}
__device__ __forceinline__ void post_row(Frame& F, int m, const float* lgp, const float* lbp, const PostRaw& R) {
    const int c0 = F.lane * 16;
    float lg[16], lb[16];
#pragma unroll
    for (int i = 0; i < 4; ++i) { const f32x4 a = *(const f32x4*)(lgp + c0 + 4 * i), b = *(const f32x4*)(lbp + c0 + 4 * i);
#pragma unroll
        for (int k = 0; k < 4; ++k) { lg[4 * i + k] = a[k]; lb[4 * i + k] = b[k]; } }
    float o[16], vv[16], gg[16];
#pragma unroll
    for (int j = 0; j < 2; ++j) { float t8[8]; unpack8(R.o[j], t8);
#pragma unroll
        for (int i = 0; i < 8; ++i) o[8 * j + i] = t8[i];
        unpack8(R.v[j], t8);
#pragma unroll
        for (int i = 0; i < 8; ++i) vv[8 * j + i] = t8[i];
        unpack8(R.g[j], t8);
#pragma unroll
        for (int i = 0; i < 8; ++i) gg[8 * j + i] = t8[i]; }
    float s = 0.f;
#pragma unroll
    for (int i = 0; i < 16; ++i) s += o[i];
    s = sum4(s);
    const float mean = s * (1.f / 64.f); float q = 0.f;
#pragma unroll
    for (int i = 0; i < 16; ++i) { o[i] -= mean; q += o[i] * o[i]; }
    q = sum4(q);
    const float rstd = rsqrtf(q * (1.f / 64.f) + GN_EPS);
    float y[16];
#pragma unroll
    for (int i = 0; i < 16; ++i) y[i] = (o[i] * rstd * lg[i] + lb[i] + R.rkb * vv[i]) * gg[i];
    bf16* dst = WSP(bf16, WS_AO) + (size_t)m * D + c0;
    u32x4 w0, w1; w0.x = cvt_pk(y[0], y[1]); w0.y = cvt_pk(y[2], y[3]); w0.z = cvt_pk(y[4], y[5]); w0.w = cvt_pk(y[6], y[7]);
    w1.x = cvt_pk(y[8], y[9]); w1.y = cvt_pk(y[10], y[11]); w1.z = cvt_pk(y[12], y[13]); w1.w = cvt_pk(y[14], y[15]);
    *(u32x4*)dst = w0; *(u32x4*)(dst + 8) = w1;
}
__device__ __forceinline__ void rwkv_post_phase(Frame& F, ArgsP A, int l) {
    const int gw = F.vcu * NWAVES + F.wave, NGW = F.G * NWAVES;
    const bf16* VV = (l == 0) ? WSP(bf16, WS_VF) : WSP(bf16, WS_VV);
    const float* lg = A->in[I_LNG] + (size_t)l * 1024; const float* lb = A->in[I_LNB] + (size_t)l * 1024;
    for (int m = gw; m < T; m += 2 * NGW) {
        PostRaw R0, R1; const int m1 = m + NGW;
        post_load(F, VV, m, R0);
        if (m1 < T) post_load(F, VV, m1, R1);
        post_row(F, m, lg, lb, R0);
        if (m1 < T) post_row(F, m1, lg, lb, R1);
    }
}

__device__ __forceinline__ void ew_norm_phase(Frame& F, const float* gpost, bool last) {
    const int gw = F.vcu * NWAVES + F.wave, NGW = F.G * NWAVES, lane = F.lane;
    const bf16* Y = WSP(bf16, WS_Y); bf16* U = WSP(bf16, WS_U); float* RMS = WSP(float, WS_RMS);
    for (int m = gw; m < T; m += NGW) {
        float y[32]; float ss = 0.f;
#pragma unroll
        for (int j = 0; j < 4; ++j) { float t8[8]; unpack8(*(const u32x4*)(Y + (size_t)m * D + lane * 8 + 512 * j), t8);
#pragma unroll
            for (int i = 0; i < 8; ++i) { y[8 * j + i] = t8[i]; ss += t8[i] * t8[i]; } }
        const float rold = RMS[m];
        const float rstd = rsqrtf(wave_sum(ss) * (1.f / 2048.f) + NORM_EPS);
        float hn[32]; float s2 = 0.f;
#pragma unroll
        for (int j = 0; j < 4; ++j) { const int c = lane * 8 + 512 * j;
            float h8[8]; unpack8(*(const u32x4*)(U + (size_t)m * D + c), h8);
            const f32x4 g0 = *(const f32x4*)(gpost + c), g1 = *(const f32x4*)(gpost + c + 4);
#pragma unroll
            for (int i = 0; i < 4; ++i) { hn[8 * j + i] = h8[i] * rold + y[8 * j + i] * rstd * g0[i]; hn[8 * j + 4 + i] = h8[4 + i] * rold + y[8 * j + 4 + i] * rstd * g1[i]; }
            if (last) { float* hp = F.H + (size_t)m * D + c; *(f32x4*)hp = (f32x4){hn[8 * j], hn[8 * j + 1], hn[8 * j + 2], hn[8 * j + 3]}; *(f32x4*)(hp + 4) = (f32x4){hn[8 * j + 4], hn[8 * j + 5], hn[8 * j + 6], hn[8 * j + 7]}; }
#pragma unroll
            for (int i = 0; i < 8; ++i) s2 += hn[8 * j + i] * hn[8 * j + i]; }
        if (!last) {
            const float ms = wave_sum(s2) * (1.f / 2048.f) + NORM_EPS, r2 = rsqrtf(ms);
            if (lane == 0) RMS[m] = ms * r2;
#pragma unroll
            for (int j = 0; j < 4; ++j) { const int c = lane * 8 + 512 * j;
                u32x4 w; w.x = cvt_pk(hn[8 * j] * r2, hn[8 * j + 1] * r2); w.y = cvt_pk(hn[8 * j + 2] * r2, hn[8 * j + 3] * r2);
                w.z = cvt_pk(hn[8 * j + 4] * r2, hn[8 * j + 5] * r2); w.w = cvt_pk(hn[8 * j + 6] * r2, hn[8 * j + 7] * r2);
                *(u32x4*)(U + (size_t)m * D + c) = w; }
        }
    }
}

template <int DQK, bool CAUSAL>
__device__ __forceinline__ void attn_unit(LAS unsigned char* lds, const bf16* __restrict__ Q, int ldq, const bf16* __restrict__ K1, int ldk1, const bf16* __restrict__ K2, int ldk2,
                                          const bf16* __restrict__ V, int ldv, bf16* __restrict__ O, int ldo, int qpos0, int ntiles) {
    constexpr int KROW = DQK * 2, KT = 64 * KROW, VT = 16384, ND0 = DQK / 16, NKC = DQK / 64;
    int tid = threadIdx.x; asm volatile("" : "+v"(tid));
    const int lane = tid & 63, wid = __builtin_amdgcn_readfirstlane(tid >> 6), r32 = lane & 31, hi = lane >> 5;
    LAS unsigned char* Kl = lds; LAS unsigned char* Vl = lds + 2 * KT;
    bf16x8 qr[ND0];
    { const bf16* qrow = Q + (size_t)(wid * 32 + r32) * ldq;
#pragma unroll
      for (int d0 = 0; d0 < ND0; ++d0) qr[d0] = *(const bf16x8*)(qrow + d0 * 16 + hi * 8); }
    unsigned ksoff[NKC]; int kdst[NKC];
#pragma unroll
    for (int i = 0; i < NKC; ++i) { int row, cc;
        if (i < 2) { const int c = tid + 512 * i; row = c >> 4; cc = c & 15; ksoff[i] = (unsigned)(row * ldk1 + cc * 8) * 2u; }
        else { row = tid >> 3; cc = 16 + (tid & 7); ksoff[i] = (unsigned)(row * ldk2 + (cc - 16) * 8) * 2u; }
        const int cs = DQK == 192 ? ((cc & ~7) | ((cc ^ (row >> 1)) & 7)) : (cc ^ (row & 15));
        kdst[i] = row * KROW + cs * 16; }
    unsigned vsoff[2]; int vdst[2];
#pragma unroll
    for (int i = 0; i < 2; ++i) { const int c = tid + 512 * i, row = c >> 4, cc = c & 15; vsoff[i] = (unsigned)(row * ldv + cc * 8) * 2u; vdst[i] = row * 256 + ((cc * 16) ^ ((row & 3) << 6)); }
    constexpr int NKO = DQK == 192 ? 4 : 8;
    int koff[NKO];
#pragma unroll
    for (int j = 0; j < NKO; ++j) { const int cc = 2 * j + hi; const int cs = DQK == 192 ? ((cc ^ (r32 >> 1)) & 7) : (cc ^ (r32 & 15)); koff[j] = r32 * KROW + cs * 16; }
#define AT_KOFF(d0) (DQK == 192 ? koff[(d0) & 3] + ((d0) >> 2) * 128 : koff[(d0) & 7])
    const int q4 = (lane & 15) >> 2, pp = lane & 3, blk = (lane >> 4) & 1;
    int voff[4];
#pragma unroll
    for (int d0 = 0; d0 < 4; ++d0) voff[d0] = (4 * hi + q4) * 256 + (((d0 ^ q4) << 6) | (blk << 5) | (pp << 3));
    u32x4 ks[NKC], vs[2];
#define AT_LOAD(t) do { const char* k1b = (const char*)K1 + (size_t)(t) * 64 * ldk1 * 2; const char* k2b = (const char*)K2 + (size_t)(t) * 64 * ldk2 * 2; const char* vb = (const char*)V + (size_t)(t) * 64 * ldv * 2; \
        _Pragma("unroll") for (int i = 0; i < NKC; ++i) ks[i] = *(const u32x4*)((i < 2 ? k1b : k2b) + ksoff[i]); \
        _Pragma("unroll") for (int i = 0; i < 2; ++i) vs[i] = *(const u32x4*)(vb + vsoff[i]); } while (0)
#define AT_WRITE(bf) do { _Pragma("unroll") for (int i = 0; i < NKC; ++i) *(LAS u32x4*)(Kl + (bf) * KT + kdst[i]) = ks[i]; \
        _Pragma("unroll") for (int i = 0; i < 2; ++i) *(LAS u32x4*)(Vl + (bf) * VT + vdst[i]) = vs[i]; } while (0)
    float m_run = -1e30f, l_run = 0.f; f32x16 o[4];
#pragma unroll
    for (int d0 = 0; d0 < 4; ++d0) o[d0] = (f32x16){};
    AT_LOAD(0); AT_WRITE(0);
    __syncthreads();
    const int qpos = qpos0 + wid * 32 + r32;
    for (int t = 0; t < ntiles; ++t) {
        const int bf = t & 1;
        if (t + 1 < ntiles) AT_LOAD(t + 1);
        f32x16 p0 = (f32x16){}, p1 = (f32x16){};
#pragma unroll
        for (int d0 = 0; d0 < ND0; ++d0) {
            const bf16x8 a0 = *(const LAS bf16x8*)(Kl + bf * KT + AT_KOFF(d0));
            const bf16x8 a1 = *(const LAS bf16x8*)(Kl + bf * KT + AT_KOFF(d0) + 32 * KROW);
            p0 = __builtin_amdgcn_mfma_f32_32x32x16_bf16(a0, qr[d0], p0, 0, 0, 0);
            p1 = __builtin_amdgcn_mfma_f32_32x32x16_bf16(a1, qr[d0], p1, 0, 0, 0);
        }
        if (CAUSAL) { const int kv0 = t * 64;
            if (kv0 + 63 > qpos0 + wid * 32) { const float NEG = -__builtin_inff();
#pragma unroll
                for (int r = 0; r < 16; ++r) { const int key = kv0 + crow(r, hi); if (key > qpos) p0[r] = NEG; if (key + 32 > qpos) p1[r] = NEG; } } }
        float mx = p0[0];
#pragma unroll
        for (int r = 1; r < 16; ++r) mx = fmaxf(mx, p0[r]);
#pragma unroll
        for (int r = 0; r < 16; ++r) mx = fmaxf(mx, p1[r]);
        { auto rr = __builtin_amdgcn_permlane32_swap(__float_as_uint(mx), __float_as_uint(mx), false, false); mx = fmaxf(__uint_as_float(rr[0]), __uint_as_float(rr[1])); }
        if (__any(mx > m_run + 8.f)) {
            const float mn = fmaxf(m_run, mx), alpha = __builtin_amdgcn_exp2f(m_run - mn); m_run = mn; l_run *= alpha;
#pragma unroll
            for (int d0 = 0; d0 < 4; ++d0)
#pragma unroll
                for (int r = 0; r < 16; ++r) o[d0][r] *= alpha;
        }
        float ps = 0.f;
#pragma unroll
        for (int r = 0; r < 16; ++r) { p0[r] = __builtin_amdgcn_exp2f(p0[r] - m_run); p1[r] = __builtin_amdgcn_exp2f(p1[r] - m_run); ps += p0[r] + p1[r]; }
        l_run += ps;
        bf16x8 pa[4];
        { u32x4 w;
          w.x = cvt_pk(p0[0], p0[1]); w.y = cvt_pk(p0[2], p0[3]); w.z = cvt_pk(p0[4], p0[5]); w.w = cvt_pk(p0[6], p0[7]); pa[0] = __builtin_bit_cast(bf16x8, w);
          w.x = cvt_pk(p0[8], p0[9]); w.y = cvt_pk(p0[10], p0[11]); w.z = cvt_pk(p0[12], p0[13]); w.w = cvt_pk(p0[14], p0[15]); pa[1] = __builtin_bit_cast(bf16x8, w);
          w.x = cvt_pk(p1[0], p1[1]); w.y = cvt_pk(p1[2], p1[3]); w.z = cvt_pk(p1[4], p1[5]); w.w = cvt_pk(p1[6], p1[7]); pa[2] = __builtin_bit_cast(bf16x8, w);
          w.x = cvt_pk(p1[8], p1[9]); w.y = cvt_pk(p1[10], p1[11]); w.z = cvt_pk(p1[12], p1[13]); w.w = cvt_pk(p1[14], p1[15]); pa[3] = __builtin_bit_cast(bf16x8, w); }
#pragma unroll
        for (int d0 = 0; d0 < 4; ++d0)
#pragma unroll
            for (int s = 0; s < 4; ++s) {
                const LAS unsigned char* vp = Vl + bf * VT + voff[d0] + s * 4096;
                const s16x4 lo = __builtin_bit_cast(s16x4, __builtin_amdgcn_ds_read_tr16_b64_v4i16((LAS v4i16_t*)vp));
                const s16x4 hh = __builtin_bit_cast(s16x4, __builtin_amdgcn_ds_read_tr16_b64_v4i16((LAS v4i16_t*)(vp + 2048)));
                const bf16x8 vf = (bf16x8){lo[0], lo[1], lo[2], lo[3], hh[0], hh[1], hh[2], hh[3]};
                o[d0] = __builtin_amdgcn_mfma_f32_32x32x16_bf16(vf, pa[s], o[d0], 0, 0, 0);
            }
        if (t + 1 < ntiles) AT_WRITE(bf ^ 1);
        __syncthreads();
    }
    { auto rr = __builtin_amdgcn_permlane32_swap(__float_as_uint(l_run), __float_as_uint(l_run), false, false); l_run = __uint_as_float(rr[0]) + __uint_as_float(rr[1]); }
    const float inv = __builtin_amdgcn_rcpf(l_run);
    bf16* orow = O + (size_t)(wid * 32 + r32) * ldo;
#pragma unroll
    for (int d0 = 0; d0 < 4; ++d0)
#pragma unroll
        for (int g = 0; g < 4; ++g) { u32x2 w; w.x = cvt_pk(o[d0][4 * g] * inv, o[d0][4 * g + 1] * inv); w.y = cvt_pk(o[d0][4 * g + 2] * inv, o[d0][4 * g + 3] * inv);
            *(u32x2*)(orow + d0 * 32 + 8 * g + 4 * hi) = w; }
#undef AT_LOAD
#undef AT_WRITE
#undef AT_KOFF
}

__global__ void __launch_bounds__(NTHR, 2) fwd(Args args) {
    extern __shared__ __attribute__((aligned(16))) unsigned char lds_raw[];
    Frame F;
    F.lds = (LAS unsigned char*)lds_raw;
    F.tid = threadIdx.x; F.lane = F.tid & 63; F.wave = __builtin_amdgcn_readfirstlane(F.tid >> 6);
    F.G = gridDim.x; { const int bx = blockIdx.x; F.vcu = (F.G % 8 == 0) ? (bx % 8) * (F.G / 8) + bx / 8 : bx; }
    F.ws = args.ws; F.H = args.out;
    volatile LAS unsigned* MISC = (volatile LAS unsigned*)(F.lds + MISC_OFF);
    for (int u = F.tid; u < (LDS_BYTES - LDSCTL_OFF) / 4; u += NTHR) ((LAS unsigned*)(F.lds + LDSCTL_OFF))[u] = 0u;
    __syncthreads();
    unsigned* ctl = (unsigned*)(F.ws + WS_CTL);
    XcdBarrier bar; bar.bar = ctl + CW_BAR; bar.x = 0; bar.st = nullptr;
    if (ONE_LAUNCH) bar = xcd_barrier_post(ctl + CW_BAR, MISC + 8);
    const int lo = args.lo, hi = args.hi;
#ifndef PH_MASK
#define PH_MASK 0xfffffu
#endif
#define PHON(j) (((PH_MASK) >> (j)) & 1u)
#define IN(k) (lo <= (k) && (k) < hi)
#define PHASE_RELOAD() do { t_ = threadIdx.x; asm volatile("" : "+v"(t_)); F.tid = t_; F.lane = t_ & 63; F.wave = __builtin_amdgcn_readfirstlane(t_ >> 6); \
        A = (ArgsP)__builtin_amdgcn_kernarg_segment_ptr(); asm volatile("" : "+s"(A)); F.ws = A->ws; F.H = A->out; \
        { int g_ = gridDim.x, b_ = blockIdx.x; asm volatile("" : "+s"(g_), "+s"(b_)); F.G = g_; F.bx = b_; F.vcu = (g_ % 8 == 0) ? (b_ % 8) * (g_ / 8) + b_ / 8 : b_; } } while (0)
#define PHASE_BEGIN() int t_; ArgsP A; PHASE_RELOAD()
#define SEAM(k) do { if (IN(k) && IN((k) + 1)) { if (ONE_LAUNCH) xcd_barrier(bar); } } while (0)

    if (PHON(0) && IN(0)) { PHASE_BEGIN(); p0_prologue(F, A); SEAM(0); }

    for (int l = 0; l < NL; ++l) {
        const int pb = 1 + l * NPH;
        if (PHON(1) && IN(pb + 0)) { PHASE_BEGIN();
            const int N = (l == 0) ? INW : PROJ_LD;
            pg8::Gemm g{WSP(bf16, WS_U), WSP(bf16, WL(WO_IN)), T, N, D, D, D}; pg8::StaticOrder S; S.init(T, N, F.G, F.bx);
            pg8::Epi8<FPlain> E{{WSP(bf16, WS_PROJ), PROJ_LD, 1.f}};
            pg8::gemm_phase(F.lds, g, S, E);
            {
                PHASE_RELOAD();
                const int rem = ((T / 256) * (N / 256)) % F.G;
                if (rem != 0 && F.bx >= rem) convert_layer(F, A, l, 2, (F.bx - rem) * NWAVES + F.wave, (F.G - rem) * NWAVES);
                else if (rem == 0) convert_layer(F, A, l, 2, F.bx * NWAVES + F.wave, F.G * NWAVES);
            }
            SEAM(pb + 0);
        }
        if (PHON(2) && IN(pb + 1)) { PHASE_BEGIN(); prep_phase(F, A, l); SEAM(pb + 1); }
        if (PHON(3) && IN(pb + 2)) { PHASE_BEGIN();
            {
            { pg8::Gemm g{WSP(bf16, WS_LORA), WSP(bf16, WL(WO_UP)), T, 1024, 128, LORA_LD, 128}; pg8::StaticOrder S; S.init(T, 1024, F.G, F.bx);
              pg8::Epi8<FSig<0>> E{{WSP(bf16, WS_WLOG), 1024, A->in[I_W0] + (size_t)l * 1024}}; pg8::gemm_phase(F.lds, g, S, E); }
            PHASE_RELOAD();
            { pg8::Gemm g{WSP(bf16, WS_LORA) + 128, WSP(bf16, WL(WO_AUP)), T, 1024, 128, LORA_LD, 128}; pg8::StaticOrder S; S.init(T, 1024, F.G, F.bx);
              pg8::Epi8<FSig<1>> E{{WSP(bf16, WS_AIC), 1024, A->in[I_A0] + (size_t)l * 1024}}; pg8::gemm_phase(F.lds, g, S, E); }
            PHASE_RELOAD();
            { pg8::Gemm g{WSP(bf16, WS_LORA) + 256, WSP(bf16, WL(WO_GUP)), T, 1024, 256, LORA_LD, 256}; pg8::StaticOrder S; S.init(T, 1024, F.G, F.bx);
              pg8::Epi8<FPlain> E{{WSP(bf16, WS_GATE), 1024, 1.f}}; pg8::gemm_phase(F.lds, g, S, E); }
            PHASE_RELOAD();
            if (l > 0) { pg8::Gemm g{WSP(bf16, WS_LORA) + 512, WSP(bf16, WL(WO_VUP)), T, 1024, 128, LORA_LD, 128}; pg8::StaticOrder S; S.init(T, 1024, F.G, F.bx);
              pg8::Epi8<FVup> E{{WSP(bf16, WS_VV), A->in[I_V0] + (size_t)(l - 1) * 1024, A->in[I_MU] + (size_t)l * RIN + 2048, WSP(bf16, WS_PROJ), WSP(bf16, WS_VF)}}; pg8::gemm_phase(F.lds, g, S, E); }
            PHASE_RELOAD();
            { pg8::Gemm g{WSP(bf16, WS_CQN), WSP(bf16, WL(WO_UQ)), T, 1536, 512, 512, 512}; pg8::StaticOrder S; S.init(T, 1536, F.G, F.bx);
              pg8::Epi8<FQ> E{{WSP(bf16, WS_QB)}}; pg8::gemm_phase(F.lds, g, S, E); }
            PHASE_RELOAD();
            { pg8::Gemm g{WSP(bf16, WS_CKVN), WSP(bf16, WL(WO_UKV)), T, 2048, 256, 256, 256}; pg8::StaticOrder S; S.init(T, 2048, F.G, F.bx);
              pg8::Epi8<FPlain> E{{WSP(bf16, WS_KV), 2048, 1.f}}; pg8::gemm_phase(F.lds, g, S, E); }
            }
            SEAM(pb + 2);
        }
        if (PHON(4) && IN(pb + 3)) { PHASE_BEGIN();
            cs_pre_phase(F, A, l);
            SEAM(pb + 3);
        }
        if (PHON(5) && IN(pb + 4)) { PHASE_BEGIN();
            if (F.G == 256) {
                const int x = F.bx & 7, i = F.bx >> 3;
                if (i < 16) { const int u = x * 16 + i; cs_seq_unit(F, u >> 1, u & 1); }
                else convert_layer(F, A, l, 3, (x * 16 + i - 16) * NWAVES + F.wave, 128 * NWAVES);
            } else {
            for (int u = F.vcu; u < 128; u += F.G) cs_seq_unit(F, u >> 1, u & 1);
            if (F.G > 128 && F.vcu >= 128) convert_layer(F, A, l, 3, (F.vcu - 128) * NWAVES + F.wave, (F.G - 128) * NWAVES);
            else if (F.G <= 128) convert_layer(F, A, l, 3, F.vcu * NWAVES + F.wave, F.G * NWAVES);
            }
            __syncthreads();
        }
        if (PHON(6) && IN(pb + 5)) { PHASE_BEGIN();
            volatile LAS unsigned* msc = (volatile LAS unsigned*)(F.lds + MISC_OFF);
            const int nq = F.G >= 8 ? 1 : 8;
            for (int qi = 0; qi < nq; ++qi) {
                const int q = (F.bx + qi) & 7;
                unsigned* cnt = (unsigned*)(F.ws + WS_CTL) + CW_ATT + (l * 8 + q) * 64;
                for (;;) {
                    if (F.tid == 0) msc[12] = xb_add(cnt, 1u);
                    __syncthreads();
                    const int v = __builtin_amdgcn_readfirstlane((int)msc[12]);
                    __syncthreads();
                    if (v >= 64) break;
                    const int qb = 15 - (v >> 2), bh = 4 * q + (v & 3), b = bh >> 3, hh = bh & 7; const size_t r0 = (size_t)b * SEQ;
                    attn_unit<192, true>(F.lds, WSP(bf16, WS_QB) + (r0 + qb * 256) * 1536 + hh * 192, 1536,
                                         WSP(bf16, WS_KV) + r0 * 2048 + hh * 256, 2048, WSP(bf16, WS_KR) + r0 * 64, 64,
                                         WSP(bf16, WS_KV) + r0 * 2048 + hh * 256 + 128, 2048,
                                         WSP(bf16, WS_AO) + (r0 + qb * 256) * D + 1024 + hh * 128, D, qb * 256, 4 * (qb + 1));
                }
            }
            SEAM(pb + 5);
        }
        if (PHON(7) && IN(pb + 6)) { PHASE_BEGIN(); rwkv_post_phase(F, A, l); SEAM(pb + 6); }
        if (PHON(8) && IN(pb + 7)) { PHASE_BEGIN();
            pg8::Gemm g{WSP(bf16, WS_AO), WSP(bf16, WL(WO_OUT)), T, D, D, D, D}; pg8::StaticOrder S; S.init(T, D, F.G, F.bx);
            pg8::Epi8<FPlain> E{{WSP(bf16, WS_Y), D, 1.f}}; pg8::gemm_phase(F.lds, g, S, E);
            SEAM(pb + 7);
        }
        if (PHON(9) && IN(pb + 8)) { PHASE_BEGIN(); ew_norm_phase(F, A->in[I_MIXPOST] + (size_t)l * D, false); SEAM(pb + 8); }
        if (PHON(10) && IN(pb + 9)) { PHASE_BEGIN();
            pg8::Gemm g{WSP(bf16, WS_U), WSP(bf16, WL(WO_QM)), T, 512, D, D, D}; pg8::StaticOrder S; S.init(T, 512, F.G, F.bx);
            pg8::Epi8<FPlain> E{{WSP(bf16, WS_QMEM), 512, QSCALE_MEM}}; pg8::gemm_phase(F.lds, g, S, E);
            PHASE_RELOAD();
            { pg8::Gemm g2{WSP(bf16, WS_MEMN), WSP(bf16, WL(WO_KM)), NB * NMEM, 512, D, D, D}; pg8::StaticOrder S2; S2.init(NB * NMEM, 512, F.G, (F.bx + F.G - 128 % F.G) % F.G);
              pg8::Epi8<FPlain> E2{{WSP(bf16, WS_MEMK), 512, 1.f}}; pg8::gemm_phase(F.lds, g2, S2, E2); }
            PHASE_RELOAD();
            { pg8::Gemm g2{WSP(bf16, WS_MEMN), WSP(bf16, WL(WO_VM)), NB * NMEM, 512, D, D, D}; pg8::StaticOrder S2; S2.init(NB * NMEM, 512, F.G, (F.bx + F.G - 136 % F.G) % F.G);
              pg8::Epi8<FPlain> E2{{WSP(bf16, WS_MEMV), 512, 1.f}}; pg8::gemm_phase(F.lds, g2, S2, E2); }
            if (l + 1 < NL) { PHASE_RELOAD();
                if (F.G > 144 && F.bx >= 144) convert_layer(F, A, l + 1, 1, (F.bx - 144) * NWAVES + F.wave, (F.G - 144) * NWAVES);
                else if (F.G <= 144) convert_layer(F, A, l + 1, 1, F.bx * NWAVES + F.wave, F.G * NWAVES); }
            SEAM(pb + 9);
        }
        if (PHON(11) && IN(pb + 10)) { PHASE_BEGIN();
            for (int u = F.vcu; u < 256; u += F.G) {
                const int bh = u >> 4, qb = u & 15, b = bh >> 2, hh = bh & 3; const size_t r0 = (size_t)b * SEQ + qb * 256;
                attn_unit<128, false>(F.lds, WSP(bf16, WS_QMEM) + r0 * 512 + hh * 128, 512,
                                      WSP(bf16, WS_MEMK) + (size_t)b * NMEM * 512 + hh * 128, 512, nullptr, 0,
                                      WSP(bf16, WS_MEMV) + (size_t)b * NMEM * 512 + hh * 128, 512,
                                      WSP(bf16, WS_OMEM) + r0 * 512 + hh * 128, 512, 0, NMEM / 64);
            }
            SEAM(pb + 10);
        }
        if (PHON(12) && IN(pb + 11)) { PHASE_BEGIN();
            pg8::Gemm g{WSP(bf16, WS_OMEM), WSP(bf16, WL(WO_OM)), T, D, 512, 512, 512}; pg8::StaticOrder S; S.init(T, D, F.G, F.bx);
            pg8::Epi8<FPlain> E{{WSP(bf16, WS_Y), D, 1.f}}; pg8::gemm_phase(F.lds, g, S, E);
            SEAM(pb + 11);
        }
        if (PHON(13) && IN(pb + 12)) { PHASE_BEGIN(); ew_norm_phase(F, A->in[I_MEMPOST] + (size_t)l * D, false); SEAM(pb + 12); }
        if (PHON(14) && IN(pb + 13)) { PHASE_BEGIN();
            pg8::Gemm g{WSP(bf16, WS_U), WSP(bf16, WL(WO_FF1)), T, FF, D, D, D}; pg8::StaticOrder S; S.init(T, FF, F.G, F.bx);
            pg8::Epi8<FRelu2> E{{WSP(bf16, WS_HID), FF}}; pg8::gemm_phase(F.lds, g, S, E);
            SEAM(pb + 13);
        }
        if (PHON(15) && IN(pb + 14)) { PHASE_BEGIN();
            pg8::Gemm g{WSP(bf16, WS_HID), WSP(bf16, WL(WO_FF2)), T, D, FF, FF, FF}; pg8::StaticOrder S; S.init(T, D, F.G, F.bx);
            pg8::Epi8<FPlain> E{{WSP(bf16, WS_Y), D, 1.f}}; pg8::gemm_phase(F.lds, g, S, E);
            SEAM(pb + 14);
        }
        if (PHON(16) && IN(pb + 15)) { PHASE_BEGIN(); ew_norm_phase(F, A->in[I_FFNPOST] + (size_t)l * D, l + 1 == NL); SEAM(pb + 15); }
    }
#undef IN
#undef SEAM
}

extern "C" void kernel_launch(void* const* d_in, const int* in_sizes, int n_in, void* d_out, int out_size, void* d_ws, size_t ws_size, hipStream_t stream) {
    static int grid = 0;
    if (grid == 0) {
        if (n_in != N_IN || out_size != T * D || ws_size < WS_END) { fprintf(stderr, "kernel_launch: unexpected shapes (n_in %d, out %d, ws %zu)\n", n_in, out_size, ws_size); grid = -1; return; }
        int dev = 0, cus = 0;
        if (hipGetDevice(&dev) != hipSuccess || hipDeviceGetAttribute(&cus, hipDeviceAttributeMultiprocessorCount, dev) != hipSuccess) { grid = -1; return; }
        if (hipFuncSetAttribute((const void*)fwd, hipFuncAttributeMaxDynamicSharedMemorySize, LDS_BYTES) != hipSuccess) { fprintf(stderr, "kernel_launch: hipFuncSetAttribute failed\n"); grid = -1; return; }
        int per_cu = 0;
        if (hipOccupancyMaxActiveBlocksPerMultiprocessor(&per_cu, (const void*)fwd, NTHR, LDS_BYTES) != hipSuccess || per_cu < 1) fprintf(stderr, "kernel_launch: occupancy query says %d\n", per_cu);
        (void)hipGetLastError();
        grid = cus;
    }
    if (grid < 0) return;
    (void)hipMemsetAsync((char*)d_ws + WS_CTL, 0, CTL_BYTES, stream);
    Args a{};
    for (int i = 0; i < N_IN; ++i) a.in[i] = (const float*)d_in[i];
    a.out = (float*)d_out; a.ws = (unsigned char*)d_ws;
    const int nph = NPHASES < STOP_PHASE ? NPHASES : STOP_PHASE;
    if (ONE_LAUNCH) { a.lo = 0; a.hi = nph; hipLaunchKernelGGL(fwd, dim3(grid), dim3(NTHR), LDS_BYTES, stream, a); }
    else { for (int p = 0; p < nph; ++p) { a.lo = p; a.hi = p + 1; hipLaunchKernelGGL(fwd, dim3(grid), dim3(NTHR), LDS_BYTES, stream, a); } }
}
```
